# Optimizing an MI355X kernel written in HIP

```python
import jax, jax.numpy as jnp
from jax import lax
import numpy as np

D_MODEL = 1024
BATCH = 16
SEQ = 2048
DEPTH = 2

HEAD_DIM = 64
NSA_Q_HEADS = 8
NSA_KV_HEADS = 2
SWA_Q_HEADS = 8
SWA_KV_HEADS = 2
MIX_WIDTH = (NSA_Q_HEADS + SWA_Q_HEADS) * HEAD_DIM
ROPE_THETA = 10000.0
CMP_STRIDE = 16
CMP_BLOCK = 2 * CMP_STRIDE
CMP_HIDDEN = 256
SEL_BLOCK = 64
SEL_TOPN = 8
NSA_WINDOW = 512
SWA_WINDOW = 128
BAND_BLOCK = 128
SEL_Q_CHUNK = 128
N_EXPERTS = 32
TOP_K = 4
D_FF = D_MODEL
SWIGLU_LIMIT = 7.0
SWIGLU_ALPHA = 1.702
P_DIM = 256
DN_ALPHA = (2 * DEPTH) ** 0.25
DN_BETA = (8 * DEPTH) ** -0.25
LN_EPS = 1e-5
NEG = -1e30
FORCE = 1e9
KV_W = NSA_KV_HEADS * HEAD_DIM
IN_SIZES = [NSA_Q_HEADS * HEAD_DIM] + [KV_W] * 6 + [NSA_Q_HEADS * 3] + [SWA_Q_HEADS * HEAD_DIM] + [SWA_KV_HEADS * HEAD_DIM] * 2
IN_COLS = sum(IN_SIZES)
IN_SPLITS = [int(v) for v in np.cumsum(IN_SIZES)[:-1]]

kernel_name = "nsa_swa_sink_hymba_moe_deepnorm"


def layer_norm(x, g, b):
    xf = x.astype(jnp.float32)
    mu = xf.mean(-1, keepdims=True)
    var = jnp.square(xf - mu).mean(-1, keepdims=True)
    return ((xf - mu) * lax.rsqrt(var + LN_EPS) * g + b).astype(x.dtype)


def rope_tables(pos):
    inv = 1.0 / (ROPE_THETA ** (jnp.arange(0, HEAD_DIM, 2, dtype=jnp.float32) / HEAD_DIM))
    ang = pos.astype(jnp.float32)[..., None] * inv
    return jnp.cos(ang), jnp.sin(ang)


def apply_rope(x, cos, sin):
    shp = cos.shape[:2] + (1,) * (x.ndim - 3) + cos.shape[2:]
    c, s = cos.reshape(shp), sin.reshape(shp)
    x1, x2 = jnp.split(x.astype(jnp.float32), 2, axis=-1)
    return jnp.concatenate([x1 * c - x2 * s, x2 * c + x1 * s], -1).astype(x.dtype)


def masked_softmax(s, mask, sink=None):
    s = jnp.where(mask, s.astype(jnp.float32), NEG)
    m = s.max(-1, keepdims=True)
    if sink is not None:
        m = jnp.maximum(m, sink)
    e = jnp.where(mask, jnp.exp(s - m), 0.0)
    den = e.sum(-1, keepdims=True)
    if sink is not None:
        den = den + jnp.exp(sink - m)
    return e / jnp.maximum(den, 1e-30)


def banded_attention(q, k, v, window, sinks=None):
    B, T, G, R, dh = q.shape
    nb = T // BAND_BLOCK
    nprev = -(-(window - 1) // BAND_BLOCK)
    pad = nprev * BAND_BLOCK

    def windows(a):
        ap = jnp.pad(a, ((0, 0), (pad, 0), (0, 0), (0, 0)))
        ab = ap.reshape(B, nb + nprev, BAND_BLOCK, G, dh)
        return jnp.concatenate([ab[:, i:i + nb] for i in range(nprev + 1)], axis=2)

    kw, vw = windows(k), windows(v)
    qb = q.reshape(B, nb, BAND_BLOCK, G, R, dh)
    s = jnp.einsum('bnqgrd,bnkgd->bngrqk', qb, kw) * (dh ** -0.5)
    blk = jnp.arange(nb)[:, None] * BAND_BLOCK
    qpos = blk + jnp.arange(BAND_BLOCK)
    kpos = blk - pad + jnp.arange((nprev + 1) * BAND_BLOCK)
    diff = qpos[:, :, None] - kpos[:, None, :]
    mask = (kpos[:, None, :] >= 0) & (diff >= 0) & (diff < window)
    mask = mask[None, :, None, None]
    sink = None if sinks is None else sinks.astype(jnp.float32).reshape(G, R)[None, None, :, :, None, None]
    p = masked_softmax(s, mask, sink)
    o = jnp.einsum('bngrqk,bnkgd->bnqgrd', p.astype(v.dtype), vw)
    return o.reshape(B, T, G, R, dh)


def compress(a, pe, w1, w2):
    B, T, G, dh = a.shape
    ch = a.reshape(B, T // CMP_STRIDE, CMP_STRIDE, G, dh)
    blk = jnp.concatenate([ch[:, :-1], ch[:, 1:]], axis=2) + pe[None, None, :, None, :]
    nc = blk.shape[1]
    flat = jnp.moveaxis(blk, 3, 2).reshape(B, nc, G, CMP_BLOCK * dh)
    return jax.nn.gelu(flat @ w1) @ w2


def nsa_mixer(q, k_c, v_c, k_s, v_s, k_w, v_w, gates, positions, ck_pe, w_ck1, w_ck2, cv_pe, w_cv1, w_cv2):
    B, T, G, R, dh = q.shape
    scale = dh ** -0.5
    kc = compress(k_c, ck_pe, w_ck1, w_ck2)
    vc = compress(v_c, cv_pe, w_cv1, w_cv2)
    nc = kc.shape[1]
    cos_c, sin_c = rope_tables(positions[:, CMP_BLOCK - 1::CMP_STRIDE])
    kc = apply_rope(kc, cos_c, sin_c)
    t = jnp.arange(T)
    cend = jnp.arange(nc) * CMP_STRIDE + CMP_BLOCK - 1
    cmask = (cend[None, :] <= t[:, None])[None, None, None]
    p_cmp = masked_softmax(jnp.einsum('btgrd,bcgd->bgrtc', q, kc) * scale, cmask)
    o_cmp = jnp.einsum('bgrtc,bcgd->btgrd', p_cmp.astype(vc.dtype), vc)
    nsel = T // SEL_BLOCK
    imp = jnp.pad(p_cmp.sum(2), ((0, 0), (0, 0), (0, 0), (0, 1)))
    imp = imp.reshape(B, G, T, nsel, SEL_BLOCK // CMP_STRIDE).sum(-1)
    j = jnp.arange(nsel)[None, :]
    cur = t[:, None] // SEL_BLOCK
    forced = (j == 0) | (j == cur) | (j == cur - 1)
    valid = j * SEL_BLOCK <= t[:, None]
    score = jnp.where(forced, FORCE, jnp.where(valid, imp, -1.0))
    topn = min(SEL_TOPN, nsel)
    _, idx = lax.top_k(score, topn)
    kb = jnp.moveaxis(k_s.reshape(B, nsel, SEL_BLOCK, G, dh), 3, 1)
    vb = jnp.moveaxis(v_s.reshape(B, nsel, SEL_BLOCK, G, dh), 3, 1)
    C = SEL_Q_CHUNK
    nq = T // C
    qc = jnp.moveaxis(q.reshape(B, nq, C, G, R, dh), 1, 0)
    ic = jnp.moveaxis(idx.reshape(B, G, nq, C, topn), 2, 0)
    bi = jnp.arange(B)[:, None, None, None]
    gi = jnp.arange(G)[None, :, None, None]

    def sel_chunk(args):
        ci, qx, ix = args
        ks = kb[bi, gi, ix].reshape(B, G, C, topn * SEL_BLOCK, dh)
        vs = vb[bi, gi, ix].reshape(B, G, C, topn * SEL_BLOCK, dh)
        kpos = (ix[..., None] * SEL_BLOCK + jnp.arange(SEL_BLOCK)).reshape(B, G, C, topn * SEL_BLOCK)
        tpos = ci * C + jnp.arange(C)
        mask = kpos[:, :, None] <= tpos[None, None, None, :, None]
        ps = masked_softmax(jnp.einsum('bcgrd,bgckd->bgrck', qx, ks) * scale, mask)
        return jnp.einsum('bgrck,bgckd->bcgrd', ps.astype(vs.dtype), vs)

    o_slc = lax.map(sel_chunk, (jnp.arange(nq), qc, ic))
    o_slc = jnp.moveaxis(o_slc, 0, 1).reshape(B, T, G, R, dh)
    o_win = banded_attention(q, k_w, v_w, NSA_WINDOW)
    g = jax.nn.sigmoid(gates.astype(jnp.float32)).reshape(B, T, G, R, 3)
    o = g[..., 0:1] * o_cmp + g[..., 1:2] * o_slc + g[..., 2:3] * o_win
    return o.astype(q.dtype).reshape(B, T, NSA_Q_HEADS * dh)


def token_mixers(x, cos, sin, positions, w_in, b_in, ck_pe, w_ck1, w_ck2, cv_pe, w_cv1, w_cv2, sinks, w_o, b_o):
    B, T, _ = x.shape
    dh = HEAD_DIM
    h = x @ w_in + b_in
    (qn, kc, vc, ks, vs, kw, vw, gates, qs, k_swa, v_swa) = jnp.split(h, IN_SPLITS, axis=-1)
    Gn, Rn = NSA_KV_HEADS, NSA_Q_HEADS // NSA_KV_HEADS
    qn = apply_rope(qn.reshape(B, T, NSA_Q_HEADS, dh), cos, sin).reshape(B, T, Gn, Rn, dh)
    kv = lambda a: a.reshape(B, T, Gn, dh)
    o_nsa = nsa_mixer(qn, kv(kc), kv(vc), apply_rope(kv(ks), cos, sin), kv(vs),
                      apply_rope(kv(kw), cos, sin), kv(vw), gates, positions,
                      ck_pe, w_ck1, w_ck2, cv_pe, w_cv1, w_cv2)
    Gs, Rs = SWA_KV_HEADS, SWA_Q_HEADS // SWA_KV_HEADS
    qs = apply_rope(qs.reshape(B, T, SWA_Q_HEADS, dh), cos, sin).reshape(B, T, Gs, Rs, dh)
    k_swa = apply_rope(k_swa.reshape(B, T, Gs, dh), cos, sin)
    o_swa = banded_attention(qs, k_swa, v_swa.reshape(B, T, Gs, dh), SWA_WINDOW, sinks)
    o = jnp.concatenate([o_nsa, o_swa.reshape(B, T, SWA_Q_HEADS * dh)], axis=-1)
    return o @ w_o + b_o


def moe(x, w_r, b_r, w_e1, b_e1, w_e2, b_e2):
    B, T, D = x.shape
    xt = x.reshape(B * T, D)
    logits = (xt @ w_r + b_r).astype(jnp.float32)
    vals, idx = lax.top_k(logits, TOP_K)
    gw = jax.nn.softmax(vals, axis=-1)
    combine = (jax.nn.one_hot(idx, N_EXPERTS, dtype=jnp.float32) * gw[..., None]).sum(1)
    y = jnp.zeros((B * T, D), jnp.float32)
    for e in range(N_EXPERTS):
        hh = xt @ w_e1[e] + b_e1[e]
        gate = jnp.minimum(hh[:, :D_FF], SWIGLU_LIMIT)
        up = jnp.clip(hh[:, D_FF:], -SWIGLU_LIMIT, SWIGLU_LIMIT)
        act = (up + 1.0) * gate * jax.nn.sigmoid(SWIGLU_ALPHA * gate)
        y = y + combine[:, e:e + 1] * (act @ w_e2[e] + b_e2[e])
    return y.astype(x.dtype).reshape(B, T, D)


def setup_inputs(seed: int = 0) -> dict:
    key = jax.random.key(seed)
    ks = jax.random.split(key, 27)
    n = lambda k, shp, sc: jax.random.normal(k, shp, jnp.float32) * sc
    L, D, dh = DEPTH, D_MODEL, HEAD_DIM
    return {
        "x": n(ks[0], (BATCH, SEQ, D), 1.0),
        "p": n(ks[1], (L, BATCH, SEQ, P_DIM), 1.0),
        "positions": (jnp.arange(SEQ, dtype=jnp.int32)[None, :] + jax.random.randint(ks[2], (BATCH, 1), 0, 4096, dtype=jnp.int32)),
        "w_in": n(ks[3], (L, D, IN_COLS), D ** -0.5),
        "b_in": n(ks[4], (L, IN_COLS), 0.02),
        "ck_pe": n(ks[5], (L, CMP_BLOCK, dh), 0.02),
        "w_ck1": n(ks[6], (L, CMP_BLOCK * dh, CMP_HIDDEN), (CMP_BLOCK * dh) ** -0.5),
        "w_ck2": n(ks[7], (L, CMP_HIDDEN, dh), CMP_HIDDEN ** -0.5),
        "cv_pe": n(ks[8], (L, CMP_BLOCK, dh), 0.02),
        "w_cv1": n(ks[9], (L, CMP_BLOCK * dh, CMP_HIDDEN), (CMP_BLOCK * dh) ** -0.5),
        "w_cv2": n(ks[10], (L, CMP_HIDDEN, dh), CMP_HIDDEN ** -0.5),
        "sinks": n(ks[11], (L, SWA_Q_HEADS), 0.5),
        "w_o": n(ks[12], (L, MIX_WIDTH, D), MIX_WIDTH ** -0.5 * DN_BETA),
        "b_o": n(ks[13], (L, D), 0.01),
        "ln1_g": 1.0 + n(ks[14], (L, D), 0.01),
        "ln1_b": n(ks[15], (L, D), 0.01),
        "w_r": n(ks[16], (L, D, N_EXPERTS), D ** -0.5),
        "b_r": n(ks[17], (L, N_EXPERTS), 0.01),
        "w_e1": n(ks[18], (L, N_EXPERTS, D, 2 * D_FF), D ** -0.5),
        "b_e1": n(ks[19], (L, N_EXPERTS, 2 * D_FF), 0.01),
        "w_e2": n(ks[20], (L, N_EXPERTS, D_FF, D), D_FF ** -0.5 * DN_BETA),
        "b_e2": n(ks[21], (L, N_EXPERTS, D), 0.01),
        "w_pg": n(ks[22], (L, D, D), D ** -0.5),
        "b_pg": n(ks[23], (L, D), 0.01),
        "w_pp": n(ks[24], (L, P_DIM, D), P_DIM ** -0.5 * DN_BETA),
        "ln2_g": 1.0 + n(ks[25], (L, D), 0.01),
        "ln2_b": n(ks[26], (L, D), 0.01),
    }


def reference(x, p, positions, w_in, b_in, ck_pe, w_ck1, w_ck2, cv_pe, w_cv1, w_cv2, sinks, w_o, b_o,
              ln1_g, ln1_b, w_r, b_r, w_e1, b_e1, w_e2, b_e2, w_pg, b_pg, w_pp, ln2_g, ln2_b):
    cos, sin = rope_tables(positions)
    for i in range(DEPTH):
        a = token_mixers(x, cos, sin, positions, w_in[i], b_in[i], ck_pe[i], w_ck1[i], w_ck2[i],
                         cv_pe[i], w_cv1[i], w_cv2[i], sinks[i], w_o[i], b_o[i])
        x = layer_norm(DN_ALPHA * x + a, ln1_g[i], ln1_b[i])
        m = moe(x, w_r[i], b_r[i], w_e1[i], b_e1[i], w_e2[i], b_e2[i])
        e = jax.nn.sigmoid(x @ w_pg[i] + b_pg[i]) * (p[i] @ w_pp[i])
        x = layer_norm(DN_ALPHA * x + m + e, ln2_g[i], ln2_b[i])
    return x
```

```cpp
#include <hip/hip_runtime.h>
#include <cstdio>
#include <cstdint>
#define MK_ONE_LAUNCH 0
namespace pg8 {
#define PG8_LAS __attribute__((address_space(3)))
typedef unsigned short bf16_t;
typedef short bf16x8 __attribute__((ext_vector_type(8)));
typedef float f32x4 __attribute__((ext_vector_type(4)));
typedef unsigned u32x4 __attribute__((ext_vector_type(4)));
constexpr int BM = 256, BK = 64, HALF = 128, HTB = HALF * BK * 2  , STAGE_BYTES = 8 * HTB, NXCD = 8, WGM = 8;

__host__ __device__ __forceinline__ int lds_byte(int r, int c) { const int st = (r >> 4) * 2 + (c >> 5), rr = r & 15, cc = c & 31, ob = rr * 64 + cc * 2; return st * 1024 + (ob ^ (((ob >> 9) & 1) << 5)); }
__host__ __device__ __forceinline__ void stage_rc(int b, int& R, int& C) { const int st = b / 1024, sb = b % 1024, swz = sb ^ (((sb >> 9) & 1) << 5); R = (st >> 1) * 16 + swz / 64; C = (st & 1) * 32 + (swz % 64) / 2; }
__host__ __device__ __forceinline__ int perm32(int rho) { const int n = rho >> 4, i = rho & 15; return 8 * (i >> 2) + 4 * n + (i & 3); }

struct Unit { int pm, pn; };
struct Gemm { const bf16_t* A; const bf16_t* Bt; int M, N, K; };

struct StaticOrder {
    int nM, nN, nwg, G, c;
    __host__ __device__ void init(int M, int N, int G_, int c_) { nM = M / BM; nN = N / BM; nwg = nM * nN; G = G_; c = c_; }
    __host__ __device__ bool next(int i, Unit& u) const {
        const long L = (long)i * G + c; if (L >= nwg) return false;
        int wgid = (int)L; { const int q = nwg / NXCD, r = nwg % NXCD, xcd = wgid % NXCD, off = wgid / NXCD; wgid = (xcd < r ? xcd * (q + 1) : r * (q + 1) + (xcd - r) * q) + off; }
        const int nig = WGM * nN, gid = wgid / nig, fm = gid * WGM, gsz = (nM - fm) < WGM ? (nM - fm) : WGM;
        u.pm = fm + ((wgid % nig) % gsz); u.pn = (wgid % nig) / gsz; return true;
    }
    __device__ __forceinline__ void a_ready(const Unit&) const {}
    __device__ __forceinline__ void done(const Unit&) const {}
};

__device__ __forceinline__ unsigned cvt_pk_bf16(float lo, float hi) { unsigned r; asm volatile("v_cvt_pk_bf16_f32 %0, %1, %2" : "=v"(r) : "v"(lo), "v"(hi)); return r; }
typedef float f32x2 __attribute__((ext_vector_type(2)));

typedef unsigned u32x2 __attribute__((ext_vector_type(2)));
__device__ __forceinline__ float sigm(float x) { return __builtin_amdgcn_rcpf(1.0f + __builtin_amdgcn_exp2f(-1.4426950408889634f * x)); }
__device__ __forceinline__ float bf_lo(unsigned w) { return __uint_as_float(w << 16); }
__device__ __forceinline__ float bf_hi(unsigned w) { return __uint_as_float(w & 0xffff0000u); }

constexpr unsigned ROPE_SEGS = 0x7D4Fu;
struct EpiIn {
    static constexpr bool PERM = true, AFTER_DRAIN = false;
    bf16_t* H; float* gates; const float* bias; const float* rope;
    __device__ __forceinline__ void operator()(const f32x4 (&acc)[2][2][4][2], const Unit& u, int wr, int wc, int fr, int fq) const {
        const int row0 = u.pm * BM + wr * 64 + fr;
#pragma unroll
        for (int bj = 0; bj < 2; ++bj) {
            const int seg = u.pn * 2 + bj;
            if (seg >= 17) continue;
            const int cg0 = u.pn * BM + bj * HALF + wc * 32 + 8 * fq;
            const f32x4 b0 = *(const f32x4*)(bias + cg0), b1 = *(const f32x4*)(bias + cg0 + 4);
            if (seg == 16) {
                const int gi = wc * 32 + 8 * fq;
                if (gi < 24) {
#pragma unroll
                    for (int ai = 0; ai < 2; ++ai)
#pragma unroll
                        for (int m = 0; m < 4; ++m) {
                            const int row = row0 + ai * HALF + m * 16;
                            f32x4 v0 = acc[ai][bj][m][0] + b0, v1 = acc[ai][bj][m][1] + b1;
                            v0 = (f32x4){sigm(v0[0]), sigm(v0[1]), sigm(v0[2]), sigm(v0[3])};
                            v1 = (f32x4){sigm(v1[0]), sigm(v1[1]), sigm(v1[2]), sigm(v1[3])};
                            float* gp = gates + (size_t)row * 32 + gi;
                            *(f32x4*)gp = v0; *(f32x4*)(gp + 4) = v1;
                        }
                }
            } else {
                const bool rope_on = (ROPE_SEGS >> seg) & 1u;
                const int g = 4 * (wc & 1) + fq;
                const int hc = seg * 128 + (wc >> 1) * 64 + 4 * g;
#pragma unroll
                for (int ai = 0; ai < 2; ++ai)
#pragma unroll
                    for (int m = 0; m < 4; ++m) {
                        const int row = row0 + ai * HALF + m * 16;
                        f32x4 v0 = acc[ai][bj][m][0] + b0, v1 = acc[ai][bj][m][1] + b1;
                        if (rope_on) {
                            const f32x4 c = *(const f32x4*)(rope + (size_t)row * 64 + 4 * g), s = *(const f32x4*)(rope + (size_t)row * 64 + 32 + 4 * g);
                            const f32x4 o0 = v0 * c - v1 * s, o1 = v1 * c + v0 * s; v0 = o0; v1 = o1;
                        }
                        u32x2 w0, w1; w0.x = cvt_pk_bf16(v0[0], v0[1]); w0.y = cvt_pk_bf16(v0[2], v0[3]); w1.x = cvt_pk_bf16(v1[0], v1[1]); w1.y = cvt_pk_bf16(v1[2], v1[3]);
                        bf16_t* hp = H + (size_t)row * 2048 + hc;
                        *(u32x2*)hp = w0; *(u32x2*)(hp + 32) = w1;
                    }
            }
        }
    }
};
struct EpiOut {
    static constexpr bool PERM = false, AFTER_DRAIN = false;
    const float* xin; float* y; const float* bias; float alpha;
    __device__ __forceinline__ void operator()(const f32x4 (&acc)[2][2][4][2], const Unit& u, int wr, int wc, int fr, int fq) const {
        const int row0 = u.pm * BM + wr * 64 + fr, col0 = u.pn * BM + wc * 32 + 4 * fq;
        f32x4 bv[2][2];
#pragma unroll
        for (int bj = 0; bj < 2; ++bj)
#pragma unroll
            for (int n = 0; n < 2; ++n) bv[bj][n] = *(const f32x4*)(bias + col0 + bj * HALF + n * 16);
#pragma unroll
        for (int ai = 0; ai < 2; ++ai)
#pragma unroll
            for (int m = 0; m < 4; ++m) {
                const size_t off = (size_t)(row0 + ai * HALF + m * 16) * 1024 + col0;
#pragma unroll
                for (int bj = 0; bj < 2; ++bj)
#pragma unroll
                    for (int n = 0; n < 2; ++n) {
                        const f32x4 xv = *(const f32x4*)(xin + off + bj * HALF + n * 16);
                        *(f32x4*)(y + off + bj * HALF + n * 16) = xv * alpha + acc[ai][bj][m][n] + bv[bj][n];
                    }
            }
    }
};
struct EpiUp {
    static constexpr bool PERM = true, AFTER_DRAIN = false;
    bf16_t* act; const float* b1p;
    __device__ __forceinline__ void operator()(const f32x4 (&acc)[2][2][4][2], const Unit& u, int wr, int wc, int fr, int fq) const {
        const int e = u.pn >> 3, pn = u.pn & 7;
        const int row0 = u.pm * BM + wr * 64 + fr, cg0 = pn * BM + wc * 32 + 8 * fq, ac0 = pn * 128 + wc * 32 + 8 * fq;
        const float* bp = b1p + (size_t)e * 2048 + cg0;
        const f32x4 bg0 = *(const f32x4*)bp, bg1 = *(const f32x4*)(bp + 4), bu0 = *(const f32x4*)(bp + HALF), bu1 = *(const f32x4*)(bp + HALF + 4);
#pragma unroll
        for (int ai = 0; ai < 2; ++ai)
#pragma unroll
            for (int m = 0; m < 4; ++m) {
                const f32x4 g0 = acc[ai][0][m][0] + bg0, g1 = acc[ai][0][m][1] + bg1, u0 = acc[ai][1][m][0] + bu0, u1 = acc[ai][1][m][1] + bu1;
                float o[8];
#pragma unroll
                for (int j = 0; j < 8; ++j) {
                    float gt = j < 4 ? g0[j & 3] : g1[j & 3], up = j < 4 ? u0[j & 3] : u1[j & 3];
                    gt = fminf(gt, 7.0f); up = fminf(fmaxf(up, -7.0f), 7.0f);
                    o[j] = (up + 1.0f) * gt * sigm(1.702f * gt);
                }
                u32x4 w; w.x = cvt_pk_bf16(o[0], o[1]); w.y = cvt_pk_bf16(o[2], o[3]); w.z = cvt_pk_bf16(o[4], o[5]); w.w = cvt_pk_bf16(o[6], o[7]);
                *(u32x4*)(act + (size_t)(row0 + ai * HALF + m * 16) * 1024 + ac0) = w;
                asm volatile("" ::: "memory");
            }
    }
};
struct EpiDown {
    static constexpr bool PERM = true, AFTER_DRAIN = false;
    bf16_t* ys; const float* b2;
    __device__ __forceinline__ void operator()(const f32x4 (&acc)[2][2][4][2], const Unit& u, int wr, int wc, int fr, int fq) const {
        const int e = u.pn >> 2, pn = u.pn & 3;
        const int row0 = u.pm * BM + wr * 64 + fr, col0 = pn * BM + wc * 32 + 8 * fq;
        f32x4 bv[2][2];
#pragma unroll
        for (int bj = 0; bj < 2; ++bj)
#pragma unroll
            for (int n = 0; n < 2; ++n) bv[bj][n] = *(const f32x4*)(b2 + (size_t)e * 1024 + col0 + bj * HALF + 4 * n);
#pragma unroll
        for (int ai = 0; ai < 2; ++ai)
#pragma unroll
            for (int m = 0; m < 4; ++m) {
                bf16_t* rowp = ys + (size_t)(row0 + ai * HALF + m * 16) * 1024 + col0;
#pragma unroll
                for (int bj = 0; bj < 2; ++bj) {
                    const f32x4 v0 = acc[ai][bj][m][0] + bv[bj][0], v1 = acc[ai][bj][m][1] + bv[bj][1];
                    u32x4 w; w.x = cvt_pk_bf16(v0[0], v0[1]); w.y = cvt_pk_bf16(v0[2], v0[3]); w.z = cvt_pk_bf16(v1[0], v1[1]); w.w = cvt_pk_bf16(v1[2], v1[3]);
                    *(u32x4*)(rowp + bj * HALF) = w;
                }
            }
    }
};
struct EpiPlain {
    static constexpr bool PERM = true, AFTER_DRAIN = false;
    bf16_t* O;
    __device__ __forceinline__ void operator()(const f32x4 (&acc)[2][2][4][2], const Unit& u, int wr, int wc, int fr, int fq) const {
        const int row0 = u.pm * BM + wr * 64 + fr, col0 = u.pn * BM + wc * 32 + 8 * fq;
#pragma unroll
        for (int ai = 0; ai < 2; ++ai)
#pragma unroll
            for (int m = 0; m < 4; ++m) {
                bf16_t* rowp = O + (size_t)(row0 + ai * HALF + m * 16) * 1024 + col0;
#pragma unroll
                for (int bj = 0; bj < 2; ++bj) {
                    const f32x4 v0 = acc[ai][bj][m][0], v1 = acc[ai][bj][m][1];
                    u32x4 w; w.x = cvt_pk_bf16(v0[0], v0[1]); w.y = cvt_pk_bf16(v0[2], v0[3]); w.z = cvt_pk_bf16(v1[0], v1[1]); w.w = cvt_pk_bf16(v1[2], v1[3]);
                    *(u32x4*)(rowp + bj * HALF) = w;
                }
            }
    }
};
struct EpiGate {
    static constexpr bool PERM = true, AFTER_DRAIN = false;
    const bf16_t* PP; bf16_t* E; const float* bias;
    __device__ __forceinline__ void operator()(const f32x4 (&acc)[2][2][4][2], const Unit& u, int wr, int wc, int fr, int fq) const {
        const int row0 = u.pm * BM + wr * 64 + fr, col0 = u.pn * BM + wc * 32 + 8 * fq;
        f32x4 bv[2][2];
#pragma unroll
        for (int bj = 0; bj < 2; ++bj)
#pragma unroll
            for (int n = 0; n < 2; ++n) bv[bj][n] = *(const f32x4*)(bias + col0 + bj * HALF + 4 * n);
#pragma unroll
        for (int ai = 0; ai < 2; ++ai)
#pragma unroll
            for (int m = 0; m < 4; ++m) {
                const size_t off = (size_t)(row0 + ai * HALF + m * 16) * 1024 + col0;
#pragma unroll
                for (int bj = 0; bj < 2; ++bj) {
                    const u32x4 pv = *(const u32x4*)(PP + off + bj * HALF);
                    const f32x4 v0 = acc[ai][bj][m][0] + bv[bj][0], v1 = acc[ai][bj][m][1] + bv[bj][1];
                    u32x4 w;
                    w.x = cvt_pk_bf16(sigm(v0[0]) * bf_lo(pv.x), sigm(v0[1]) * bf_hi(pv.x)); w.y = cvt_pk_bf16(sigm(v0[2]) * bf_lo(pv.y), sigm(v0[3]) * bf_hi(pv.y));
                    w.z = cvt_pk_bf16(sigm(v1[0]) * bf_lo(pv.z), sigm(v1[1]) * bf_hi(pv.z)); w.w = cvt_pk_bf16(sigm(v1[2]) * bf_lo(pv.w), sigm(v1[3]) * bf_hi(pv.w));
                    *(u32x4*)(E + off + bj * HALF) = w;
                }
            }
    }
};
struct MoeOrder {
    const PG8_LAS int* tile_e; int nunits, lnt, G, c;
    __device__ __forceinline__ bool next(int i, Unit& u) const {
        const int L = i * G + c; if (L >= nunits) return false;
        const int mt = L >> lnt, pn = L & ((1 << lnt) - 1);
        u.pm = mt; u.pn = (tile_e[mt] << lnt) + pn; return true;
    }
    __device__ __forceinline__ void a_ready(const Unit&) const {}
    __device__ __forceinline__ void done(const Unit&) const {}
};

template <class Epi, class Sched, bool ALIGN_EPI = false, bool SP2 = false>
__device__ __forceinline__ void gemm_phase(PG8_LAS unsigned char* lds, const Gemm g, const Sched& S, const Epi& E, const int wave_id) {
    int tid_l = wave_id * 64 + (int)__builtin_amdgcn_mbcnt_hi(~0u, __builtin_amdgcn_mbcnt_lo(~0u, 0u)); asm volatile("" : "+v"(tid_l));     const int tid = tid_l, wid = __builtin_amdgcn_readfirstlane(tid >> 6), lane = tid & 63, wr = wid >> 2, wc = wid & 3, fr = lane & 15, fq = lane >> 4;
    int K_l = g.K; asm volatile("" : "+s"(K_l)); const int K = K_l, nt = K / BK;
    unsigned voffA[2], voffB[2];
#pragma unroll
    for (int i = 0; i < 2; ++i) { int R, C; stage_rc(tid * 16 + i * 8192, R, C); const int Rb = Epi::PERM ? ((R & ~31) + perm32(R & 31)) : R;
        voffA[i] = (unsigned)(R * K + C) * 2u; voffB[i] = (unsigned)(Rb * K + C) * 2u; }
    const size_t kstep = (size_t)(BK * 2);
    const size_t hstep = (size_t)HALF * K * 2;
    const size_t tstep = 2 * hstep;
    const unsigned ldsw = (unsigned)wid * 1024u;
    const int aoff = lds_byte(wr * 64 + fr, fq * 8), boff = lds_byte(wc * 32 + fr, fq * 8);
#define PG8_SA(b, h) (((b) * 2 + (h)) * HTB)
#define PG8_SB(b, h) ((4 + (b) * 2 + (h)) * HTB)
#define PG8_STAGE(bufoff, gbase, voff) do { _Pragma("unroll") for (int _i = 0; _i < 2; ++_i) \
        __builtin_amdgcn_global_load_lds((const unsigned*)((const char*)(gbase) + (voff)[_i]), (PG8_LAS unsigned*)(lds + (bufoff) + ldsw + _i * 8192), 16, 0, 0); } while (0)
#define PG8_LDA(dst, b, h) do { _Pragma("unroll") for (int m = 0; m < 4; ++m) _Pragma("unroll") for (int k = 0; k < 2; ++k) dst[m][k] = *(const PG8_LAS bf16x8*)(lds + PG8_SA(b, h) + aoff + m * 2048 + k * 1024); } while (0)
#define PG8_LDB(dst, b, h) do { _Pragma("unroll") for (int n = 0; n < 2; ++n) _Pragma("unroll") for (int k = 0; k < 2; ++k) dst[n][k] = *(const PG8_LAS bf16x8*)(lds + PG8_SB(b, h) + boff + n * 2048 + k * 1024); } while (0)
#define PG8_MMA(ai, bj, At, Bt) do { __builtin_amdgcn_s_setprio(1); _Pragma("unroll") for (int m = 0; m < 4; ++m) _Pragma("unroll") for (int n = 0; n < 2; ++n) _Pragma("unroll") for (int k = 0; k < 2; ++k) \
        acc[ai][bj][m][n] = __builtin_amdgcn_mfma_f32_16x16x32_bf16(Bt[n][k], At[m][k], acc[ai][bj][m][n], 0, 0, 0); __builtin_amdgcn_s_setprio(0); } while (0)
#define PG8_WAIT_V(n) asm volatile("s_waitcnt vmcnt(" #n ")" ::: "memory")
#define PG8_WAIT_L(n) asm volatile("s_waitcnt lgkmcnt(" #n ")" ::: "memory")
#define PG8_BAR __builtin_amdgcn_s_barrier()
#define PG8_SCHED __builtin_amdgcn_sched_barrier(0)
    Unit cur, nxt; int ui = 0;
    if (!S.next(0, cur)) return;
    f32x4 acc[2][2][4][2];
#pragma unroll
    for (int a = 0; a < 2; ++a)
#pragma unroll
        for (int b = 0; b < 2; ++b)
#pragma unroll
            for (int m = 0; m < 4; ++m)
#pragma unroll
                for (int n = 0; n < 2; ++n) acc[a][b][m][n] = (f32x4){0.f, 0.f, 0.f, 0.f};
    bf16x8 At[4][2], B0[2][2], B1[2][2];
    const char* cA = (const char*)g.A + (size_t)cur.pm * tstep; const char* cB = (const char*)g.Bt + (size_t)cur.pn * tstep;
    S.a_ready(cur);
    if constexpr (SP2) {
        PG8_STAGE(PG8_SB(0, 0), cB, voffB); PG8_STAGE(PG8_SB(0, 1), cB + hstep, voffB); PG8_STAGE(PG8_SA(0, 0), cA, voffA); PG8_STAGE(PG8_SA(0, 1), cA + hstep, voffA);
        if (wr == 1) PG8_BAR;
        PG8_WAIT_V(2); PG8_BAR;
        PG8_STAGE(PG8_SB(1, 0), cB + kstep, voffB); PG8_STAGE(PG8_SA(1, 0), cA + kstep, voffA); PG8_STAGE(PG8_SB(1, 1), cB + hstep + kstep, voffB);
        PG8_WAIT_V(6); PG8_BAR;
    } else {
        PG8_STAGE(PG8_SB(0, 0), cB, voffB); PG8_STAGE(PG8_SA(0, 0), cA, voffA); PG8_STAGE(PG8_SB(0, 1), cB + hstep, voffB); PG8_STAGE(PG8_SA(0, 1), cA + hstep, voffA);
        if (wr == 1) PG8_BAR;
        PG8_WAIT_V(4); PG8_BAR;
        PG8_STAGE(PG8_SB(1, 0), cB + kstep, voffB); PG8_STAGE(PG8_SA(1, 0), cA + kstep, voffA); PG8_STAGE(PG8_SB(1, 1), cB + hstep + kstep, voffB);
        PG8_WAIT_V(6); PG8_BAR;
    }
    for (;;) {
        const bool has_next = S.next(ui + 1, nxt);
        const char* nA = has_next ? (const char*)g.A + (size_t)nxt.pm * tstep : cA; const char* nB = has_next ? (const char*)g.Bt + (size_t)nxt.pn * tstep : cB;
        for (int t = 0; t < nt; t += 2) {
            const bool last = (t == nt - 2);
            const char* a1 = cA + (size_t)(t + 1) * kstep;
            const char* a2 = last ? nA : cA + (size_t)(t + 2) * kstep; const char* b2 = last ? nB : cB + (size_t)(t + 2) * kstep;
            const char* a3 = a2 + kstep; const char* b3 = b2 + kstep;
            if (last && has_next) S.a_ready(nxt);
            if constexpr (SP2) {
            PG8_LDB(B0, 0, 0); PG8_LDB(B1, 0, 1); PG8_SCHED; PG8_LDA(At, 0, 0); PG8_STAGE(PG8_SA(1, 1), a1 + hstep, voffA);
            PG8_WAIT_V(8); PG8_WAIT_L(0); PG8_BAR; PG8_MMA(0, 0, At, B0); PG8_MMA(0, 1, At, B1); PG8_BAR; PG8_SCHED;
            PG8_LDA(At, 0, 1); PG8_STAGE(PG8_SB(0, 0), b2, voffB); PG8_STAGE(PG8_SB(0, 1), b2 + hstep, voffB); PG8_STAGE(PG8_SA(0, 0), a2, voffA);
            PG8_WAIT_V(8); PG8_WAIT_L(0); PG8_BAR; PG8_MMA(1, 0, At, B0); PG8_MMA(1, 1, At, B1); PG8_BAR; PG8_SCHED;
            PG8_LDB(B0, 1, 0); PG8_LDB(B1, 1, 1); PG8_SCHED; PG8_LDA(At, 1, 0); PG8_STAGE(PG8_SA(0, 1), a2 + hstep, voffA);
            PG8_WAIT_V(8); PG8_WAIT_L(0); PG8_BAR; PG8_MMA(0, 0, At, B0); PG8_MMA(0, 1, At, B1); PG8_BAR; PG8_SCHED;
            PG8_LDA(At, 1, 1); PG8_STAGE(PG8_SB(1, 0), b3, voffB); PG8_STAGE(PG8_SB(1, 1), b3 + hstep, voffB); PG8_STAGE(PG8_SA(1, 0), a3, voffA);
            PG8_WAIT_V(8); PG8_WAIT_L(0); PG8_BAR; PG8_MMA(1, 0, At, B0); PG8_MMA(1, 1, At, B1); PG8_BAR; PG8_SCHED;
            } else {
            PG8_LDB(B0, 0, 0); PG8_SCHED; PG8_LDA(At, 0, 0); PG8_STAGE(PG8_SA(1, 1), a1 + hstep, voffA);
            PG8_WAIT_L(8); PG8_BAR; PG8_WAIT_L(0); PG8_MMA(0, 0, At, B0); PG8_BAR; PG8_SCHED;
            PG8_LDB(B1, 0, 1); PG8_STAGE(PG8_SB(0, 0), b2, voffB);
            PG8_BAR; PG8_WAIT_L(0); PG8_MMA(0, 1, At, B1); PG8_BAR;
            PG8_LDA(At, 0, 1); PG8_STAGE(PG8_SA(0, 0), a2, voffA);
            PG8_BAR; PG8_WAIT_L(0); PG8_MMA(1, 0, At, B0); PG8_BAR; PG8_SCHED;
            PG8_STAGE(PG8_SB(0, 1), b2 + hstep, voffB);
            PG8_WAIT_V(6); PG8_BAR; PG8_MMA(1, 1, At, B1); PG8_BAR;
            PG8_LDB(B0, 1, 0); PG8_SCHED; PG8_LDA(At, 1, 0); PG8_STAGE(PG8_SA(0, 1), a2 + hstep, voffA);
            PG8_WAIT_L(8); PG8_BAR; PG8_WAIT_L(0); PG8_MMA(0, 0, At, B0); PG8_BAR; PG8_SCHED;
            PG8_LDB(B1, 1, 1); PG8_STAGE(PG8_SB(1, 0), b3, voffB);
            PG8_BAR; PG8_WAIT_L(0); PG8_MMA(0, 1, At, B1); PG8_BAR;
            PG8_LDA(At, 1, 1); PG8_STAGE(PG8_SA(1, 0), a3, voffA);
            PG8_BAR; PG8_WAIT_L(0); PG8_MMA(1, 0, At, B0); PG8_BAR; PG8_SCHED;
            PG8_STAGE(PG8_SB(1, 1), b3 + hstep, voffB);
            PG8_WAIT_V(6); PG8_BAR; PG8_MMA(1, 1, At, B1); PG8_BAR;
            }
        }
        if constexpr (ALIGN_EPI) { if (wr == 0) PG8_BAR; }
        if constexpr (!Epi::AFTER_DRAIN) { E(acc, cur, wr, wc, fr, fq); S.done(cur); }
        if (!has_next) break;
#pragma unroll
        for (int a = 0; a < 2; ++a)
#pragma unroll
            for (int b = 0; b < 2; ++b)
#pragma unroll
                for (int m = 0; m < 4; ++m)
#pragma unroll
                    for (int n = 0; n < 2; ++n) acc[a][b][m][n] = (f32x4){0.f, 0.f, 0.f, 0.f};
        cur = nxt; cA = nA; cB = nB; ++ui;
        if constexpr (ALIGN_EPI) { if (wr == 1) PG8_BAR; }
    }
    PG8_WAIT_V(0);
    if constexpr (!ALIGN_EPI) { if (wr == 0) PG8_BAR; }
    PG8_BAR;
    if constexpr (Epi::AFTER_DRAIN) { E.fused(acc, cur, wr, wc, fr, fq, lds, wid, lane); S.done(cur); }
#undef PG8_SA
#undef PG8_SB
#undef PG8_STAGE
#undef PG8_LDA
#undef PG8_LDB
#undef PG8_MMA
#undef PG8_WAIT_V
#undef PG8_WAIT_L
#undef PG8_BAR
#undef PG8_SCHED
}
}

constexpr int NWAVES = 8;
constexpr int NB = 16, T = 2048, D = 1024, M = NB * T, NL = 2;
constexpr int HP = 2048;
constexpr int NIN = 2304;
constexpr int PD = 256;
constexpr int NE = 32, TOPK = 4;
constexpr int MAXTILES = (M * TOPK) / 256 + NE;
constexpr int MAXSLOTS = MAXTILES * 256;
constexpr float LN_EPS = 1e-5f;
constexpr float DN_ALPHA = 1.4142135623730951f;
constexpr float SC_LOG2E = 0.125f * 1.4426950408889634f;
constexpr int C_QN = 0, C_KC = 512, C_VC = 640, C_KS = 768, C_VS = 896, C_KW = 1024, C_VW = 1152, C_QS = 1280, C_KSW = 1792, C_VSW = 1920;

constexpr size_t MiB = 1u << 20;
constexpr size_t WS_CTL = 0, CTL_ZERO_BYTES = 1 * MiB;
constexpr size_t WS_WIN = 2 * MiB;
constexpr size_t WS_WO = 12 * MiB;
constexpr size_t WS_WPG = 16 * MiB;
constexpr size_t WS_WPP = 20 * MiB;
constexpr size_t WS_WC1 = 22 * MiB;
constexpr size_t WS_WC2 = 26 * MiB;
constexpr size_t WS_WR = 27 * MiB;
constexpr size_t WS_BINP = 28 * MiB;
constexpr size_t WS_B1P = 28 * MiB + 65536;
constexpr size_t WS_ROPE = 30 * MiB;
constexpr size_t WS_GATES = 38 * MiB;
constexpr size_t WS_KCMP = 42 * MiB;
constexpr size_t WS_VCMP = 42 * MiB + 512 * 1024;
constexpr size_t WS_TOKE = 43 * MiB;
constexpr size_t WS_TOKR = 43 * MiB + 512 * 1024;
constexpr size_t WS_TOKW = 44 * MiB;
constexpr size_t WS_SLOT = 44 * MiB + 512 * 1024;
constexpr size_t WS_W1T = 48 * MiB;
constexpr size_t WS_W2T = 304 * MiB;
constexpr size_t WS_XB = 432 * MiB;
constexpr size_t WS_PB = 496 * MiB;
constexpr size_t WS_R1 = 528 * MiB;
constexpr size_t WS_H = WS_R1, WS_O = WS_R1 + 128 * MiB, WS_XG = WS_R1, WS_YS = WS_R1;
constexpr size_t WS_R2 = 808 * MiB;
constexpr size_t WS_Y1 = WS_R2, WS_ACT = WS_R2;
constexpr size_t WS_X1 = 1080 * MiB;
constexpr size_t WS_X1B = 1208 * MiB;
constexpr size_t WS_PP = 1272 * MiB;
constexpr size_t WS_E = 1336 * MiB;
constexpr size_t WS_XN = 1400 * MiB;
constexpr size_t WS_END = 1528 * MiB;
static_assert((size_t)MAXSLOTS * 2048 <= 272 * MiB, "slot buffers");
constexpr int CW_TMO = 0, CW_CODE = 1;
constexpr int CW_CNT = 1024;
constexpr int CW_BAR = 4096;

constexpr int RING_OFF = 0, RING_BYTES = 131072;
constexpr int LDSCTL_OFF = RING_BYTES, MISC_OFF = LDSCTL_OFF + 320;
constexpr int TAB_OFF = MISC_OFF + 128;
constexpr int TAB_CNT = TAB_OFF, TAB_SOFF = TAB_OFF + 128, TAB_TST = TAB_OFF + 256, TAB_TE = TAB_OFF + 512;
constexpr int LDS_BYTES = 147456;
static_assert(TAB_TE + MAXTILES * 4 <= LDS_BYTES, "LDS map");

#define GAS __attribute__((address_space(1)))
#define LAS __attribute__((address_space(3)))
typedef unsigned short bf16;
typedef unsigned v4u __attribute__((ext_vector_type(4)));
typedef float f32x4 __attribute__((ext_vector_type(4)));
typedef short bf16x8 __attribute__((ext_vector_type(8)));
typedef GAS unsigned gu32;
typedef GAS unsigned long long gu64;
#define RLX_AGENT __ATOMIC_RELAXED, __HIP_MEMORY_SCOPE_AGENT
#define LDS_WAIT() asm volatile("s_waitcnt lgkmcnt(0)" ::: "memory")
#define VM_WAIT() asm volatile("s_waitcnt vmcnt(0)" ::: "memory")
__device__ __forceinline__ unsigned long long rt() { return __builtin_amdgcn_s_memrealtime(); }
__device__ __forceinline__ unsigned f2bf(float f) { unsigned u = __builtin_bit_cast(unsigned, f); return (u + 0x7fffu + ((u >> 16) & 1u)) >> 16; }
__device__ __forceinline__ unsigned pk2(float lo, float hi) { return f2bf(lo) | (f2bf(hi) << 16); }
#define XB_TMO      128
#define XB_XCNT(j)  (256  + 64 * (j))
#define XB_XSUB(j)  (1280 + 64 * (j))
#define XB_XGEN(j)  (2304 + 64 * (j))
#define XB_TOP      3328
#define XB_TOPGEN   3392
#define XCD_BAR_WORDS 3456
#define XB_SPIN_CAP (1u << 22)

__device__ __forceinline__ unsigned xb_ld(unsigned* p)              { return __hip_atomic_load(p, __ATOMIC_RELAXED, __HIP_MEMORY_SCOPE_AGENT); }
__device__ __forceinline__ unsigned xb_add(unsigned* p, unsigned v) { return __hip_atomic_fetch_add(p, v, __ATOMIC_RELAXED, __HIP_MEMORY_SCOPE_AGENT); }
__device__ __forceinline__ unsigned xb_xcc_id() { return (unsigned)__builtin_amdgcn_s_getreg((3 << 11) | 20) & 0xFu; }
#define XB_SPIN(cond, bar) do { unsigned _sp = 0; while (cond) { __builtin_amdgcn_s_sleep(1); \
    if ((++_sp & 255u) == 0u) { if (xb_ld(&(bar)[XB_TMO])) break; if (_sp > XB_SPIN_CAP) { atomicAdd(&(bar)[XB_TMO], 1u); break; } } } } while (0)

struct XcdBarrier {
    unsigned* bar; unsigned x; int wave;
    volatile LAS unsigned* st;
};

__device__ __forceinline__ bool xb_thread0(int wave) { return wave == 0 && __builtin_amdgcn_mbcnt_hi(~0u, __builtin_amdgcn_mbcnt_lo(~0u, 0u)) == 0u; }
__device__ __forceinline__ XcdBarrier xcd_barrier_post(unsigned* bar, volatile LAS unsigned* st, int wave) {
    XcdBarrier b; b.bar = bar; b.x = xb_xcc_id(); b.st = st; b.wave = wave;
    if (xb_thread0(wave)) (void)xb_add(&bar[XB_XCNT(b.x)], 1u);
    return b;
}
__device__ __forceinline__ void xcd_barrier_complete(unsigned* bar, unsigned x, unsigned& nloc, unsigned& nx) {
    const unsigned G = gridDim.x * gridDim.y * gridDim.z;
    unsigned sum, cnt, mine, sp = 0u;
    for (;;) {
        sum = 0u; cnt = 0u; mine = 0u;
#pragma unroll
        for (unsigned j = 0; j < 16; ++j) { const unsigned c = xb_ld(&bar[XB_XCNT(j)]); sum += c; cnt += (c > 0u) ? 1u : 0u; mine = (j == x) ? c : mine; }
        if (sum == G) break;
        __builtin_amdgcn_s_sleep(1);
        if ((++sp & 255u) == 0u) { if (xb_ld(&bar[XB_TMO])) break; if (sp > XB_SPIN_CAP) { atomicAdd(&bar[XB_TMO], 1u); break; } }
    }
    nloc = mine > 0u ? mine : 1u; nx = cnt > 0u ? cnt : 1u;
}

__device__ __forceinline__ void xcd_barrier(const XcdBarrier& b) {
    asm volatile("s_waitcnt vmcnt(0)" ::: "memory");
    __syncthreads();
    if (xb_thread0(b.wave)) {
        unsigned* bar = b.bar;
        __builtin_amdgcn_s_waitcnt(0);
        unsigned nloc = b.st[0], nx = b.st[1];
        if (nloc == 0u) { xcd_barrier_complete(bar, b.x, nloc, nx); b.st[0] = nloc; b.st[1] = nx; }
        const unsigned old = xb_add(&bar[XB_XSUB(b.x)], 1u);
        const unsigned gen = old / nloc;
        if (old + 1u == (gen + 1u) * nloc) {
            __builtin_amdgcn_fence(__ATOMIC_RELEASE, "agent");
            asm volatile("s_waitcnt vmcnt(0)" ::: "memory");
            const unsigned og = xb_add(&bar[XB_TOP], 1u);
            const unsigned tg = og / nx;
            if (og + 1u == (tg + 1u) * nx) xb_add(&bar[XB_TOPGEN], 1u);
            else XB_SPIN(xb_ld(&bar[XB_TOPGEN]) == tg, bar);
            __builtin_amdgcn_fence(__ATOMIC_ACQUIRE, "agent");
            xb_add(&bar[XB_XGEN(b.x)], 1u);
            asm volatile("s_waitcnt vmcnt(0)" ::: "memory");
        } else {
            XB_SPIN(xb_ld(&bar[XB_XGEN(b.x)]) == gen, bar);
            __builtin_amdgcn_fence(__ATOMIC_ACQUIRE, "agent");
            asm volatile("s_waitcnt vmcnt(0)" ::: "memory");
        }
    }
    __syncthreads();
}

typedef float f32x16 __attribute__((ext_vector_type(16)));
typedef unsigned u32x2 __attribute__((ext_vector_type(2)));
struct Frame {
    LAS unsigned char* lds;
    volatile LAS unsigned* MISC;
    gu32* ctl;
    unsigned char* ws;
    int tid, lane, wave;
    int vcu, G;
};
__device__ __forceinline__ float wave_sum(float v) {
#pragma unroll
    for (int o = 1; o < 64; o <<= 1) v += __shfl_xor(v, o);
    return v;
}
__device__ __forceinline__ float sigm(float x) { return __builtin_amdgcn_rcpf(1.0f + __builtin_amdgcn_exp2f(-1.4426950408889634f * x)); }
__device__ __forceinline__ float bf_lo(unsigned w) { return __uint_as_float(w << 16); }
__device__ __forceinline__ float bf_hi(unsigned w) { return __uint_as_float(w & 0xffff0000u); }
__device__ __forceinline__ unsigned cvtpk(float lo, float hi) { typedef float f2 __attribute__((ext_vector_type(2))); typedef __bf16 b2 __attribute__((ext_vector_type(2))); f2 v = {lo, hi}; b2 b = __builtin_convertvector(v, b2); return __builtin_bit_cast(unsigned, b); }
__device__ __forceinline__ bf16x8 pack8(float a0, float a1, float a2, float a3, float a4, float a5, float a6, float a7) {
    v4u w; w.x = cvtpk(a0, a1); w.y = cvtpk(a2, a3); w.z = cvtpk(a4, a5); w.w = cvtpk(a6, a7); return __builtin_bit_cast(bf16x8, w);
}
__device__ __forceinline__ int crow(int r, int hi) { return (r & 3) + 8 * (r >> 2) + 4 * hi; }

struct MapId { __device__ __forceinline__ int operator()(int n) const { return n; } };
struct MapW1 { __device__ __forceinline__ int operator()(int n) const { return ((n >> 7) & 1) * 1024 + (n >> 8) * 128 + (n & 127); } };
struct MapWin {
    __device__ __forceinline__ int operator()(int n) const {
        if (n >= 2048) { const int i = n - 2048; return i < 24 ? 1280 + i : -1; }
        const int seg = n >> 7, q = n & 127, hd = q >> 6, pos = q & 63, g = pos >> 3, j = pos & 7;
        const int dlog = j < 4 ? 4 * g + j : 32 + 4 * g + (j - 4);
        const int hc = seg * 128 + hd * 64 + dlog;
        return hc < 1280 ? hc : hc + 24;
    }
};
template <class Map>
__device__ __forceinline__ void transpose_item(const float* W, int K, int Nsrc, bf16* WT, LAS float* scr, int kb, int nb, int lane, Map map) {
    const int k0 = 64 * kb, n0 = 32 * nb;
    const int src = map(n0 + (lane & 31));
#pragma unroll 8
    for (int i = 0; i < 32; ++i) { const int kk = 2 * i + (lane >> 5); scr[kk * 33 + (lane & 31)] = src >= 0 ? W[(size_t)(k0 + kk) * Nsrc + src] : 0.f; }
    LDS_WAIT(); asm volatile("" ::: "memory");
    const int c = lane & 7;
#pragma unroll
    for (int j = 0; j < 4; ++j) { const int n = (lane >> 3) + 8 * j; const LAS float* s = scr + (8 * c) * 33 + n;
        v4u o; o.x = pk2(s[0 * 33], s[1 * 33]); o.y = pk2(s[2 * 33], s[3 * 33]); o.z = pk2(s[4 * 33], s[5 * 33]); o.w = pk2(s[6 * 33], s[7 * 33]);
        *(GAS v4u*)(WT + (size_t)(n0 + n) * K + k0 + 8 * c) = o; }
    LDS_WAIT(); asm volatile("" ::: "memory");
}
struct PIn { const float *x, *p, *w_in, *b_in, *w_ck1, *w_ck2, *w_cv1, *w_cv2, *w_o, *w_r, *w_e1, *b_e1, *w_e2, *w_pg, *w_pp; const int* pos; };
__device__ __forceinline__ void p0_prologue(Frame& F, const PIn& I) {
    LAS float* scr = (LAS float*)(F.lds + RING_OFF + F.wave * 16384);
    const int gw = F.vcu * NWAVES + F.wave, NGW = F.G * NWAVES, lane = F.lane;
    unsigned char* ws = F.ws;
    constexpr int I_IN = 16 * 72, I_O = 16 * 32, I_PG = 16 * 32, I_PP = 4 * 32, I_C1 = 32 * 8, I_C2 = 4 * 2, I_E1 = 32 * 16 * 64, I_E2 = 32 * 16 * 32;
    constexpr int I_LAYER = I_IN + I_O + I_PG + I_PP + 2 * I_C1 + 2 * I_C2 + I_E1 + I_E2;
    for (int it = gw; it < NL * I_LAYER; it += NGW) {
        const int L = it / I_LAYER; int r = it % I_LAYER;
        if (r < I_IN) { transpose_item(I.w_in + (size_t)L * 1024 * 2072, 1024, 2072, (bf16*)(ws + WS_WIN) + (size_t)L * NIN * 1024, scr, r / 72, r % 72, lane, MapWin()); continue; } r -= I_IN;
        if (r < I_O) { transpose_item(I.w_o + (size_t)L * 1024 * 1024, 1024, 1024, (bf16*)(ws + WS_WO) + (size_t)L * 1024 * 1024, scr, r / 32, r % 32, lane, MapId()); continue; } r -= I_O;
        if (r < I_PG) { transpose_item(I.w_pg + (size_t)L * 1024 * 1024, 1024, 1024, (bf16*)(ws + WS_WPG) + (size_t)L * 1024 * 1024, scr, r / 32, r % 32, lane, MapId()); continue; } r -= I_PG;
        if (r < I_PP) { transpose_item(I.w_pp + (size_t)L * 256 * 1024, 256, 1024, (bf16*)(ws + WS_WPP) + (size_t)L * 1024 * 256, scr, r / 32, r % 32, lane, MapId()); continue; } r -= I_PP;
        if (r < I_C1) { transpose_item(I.w_ck1 + (size_t)L * 2048 * 256, 2048, 256, (bf16*)(ws + WS_WC1) + (size_t)(L * 2 + 0) * 256 * 2048, scr, r / 8, r % 8, lane, MapId()); continue; } r -= I_C1;
        if (r < I_C1) { transpose_item(I.w_cv1 + (size_t)L * 2048 * 256, 2048, 256, (bf16*)(ws + WS_WC1) + (size_t)(L * 2 + 1) * 256 * 2048, scr, r / 8, r % 8, lane, MapId()); continue; } r -= I_C1;
        if (r < I_C2) { transpose_item(I.w_ck2 + (size_t)L * 256 * 64, 256, 64, (bf16*)(ws + WS_WC2) + (size_t)(L * 2 + 0) * 64 * 256, scr, r / 2, r % 2, lane, MapId()); continue; } r -= I_C2;
        if (r < I_C2) { transpose_item(I.w_cv2 + (size_t)L * 256 * 64, 256, 64, (bf16*)(ws + WS_WC2) + (size_t)(L * 2 + 1) * 64 * 256, scr, r / 2, r % 2, lane, MapId()); continue; } r -= I_C2;
        if (r < I_E1) { const int e = r / 1024, q = r % 1024; transpose_item(I.w_e1 + ((size_t)L * 32 + e) * 1024 * 2048, 1024, 2048, (bf16*)(ws + WS_W1T) + ((size_t)L * 32 + e) * 2048 * 1024, scr, q / 64, q % 64, lane, MapW1()); continue; } r -= I_E1;
        { const int e = r / 512, q = r % 512; transpose_item(I.w_e2 + ((size_t)L * 32 + e) * 1024 * 1024, 1024, 1024, (bf16*)(ws + WS_W2T) + ((size_t)L * 32 + e) * 1024 * 1024, scr, q / 32, q % 32, lane, MapId()); }
    }
    const size_t gt = (size_t)F.vcu * (NWAVES * 64) + F.tid, NGT = (size_t)F.G * NWAVES * 64;
    for (size_t i = gt; i < (size_t)NL * 32 * 1024; i += NGT) {
        const int L = (int)(i / (32 * 1024)), e = (int)((i / 1024) % 32), k = (int)(i % 1024);
        const float w = I.w_r[((size_t)L * 1024 + k) * 32 + e];
        const unsigned h = f2bf(w); const float wl = w - __uint_as_float(h << 16);
        bf16* d = (bf16*)(ws + WS_WR) + (size_t)L * 2 * 32 * 1024 + (size_t)e * 1024 + k;
        d[0] = (bf16)h; d[32 * 1024] = (bf16)f2bf(wl);
    }
    for (size_t i = gt; i < (size_t)NL * NIN; i += NGT) { const int L = (int)(i / NIN), n = (int)(i % NIN); const int s = MapWin()(n); ((float*)(ws + WS_BINP))[i] = s >= 0 ? I.b_in[(size_t)L * 2072 + s] : 0.f; }
    for (size_t i = gt; i < (size_t)NL * 32 * 2048; i += NGT) { const int le = (int)(i / 2048), n = (int)(i % 2048); ((float*)(ws + WS_B1P))[i] = I.b_e1[(size_t)le * 2048 + MapW1()(n)]; }
    for (size_t i = gt; i < (size_t)M * D / 8; i += NGT) {
        const f32x4 a = *(const GAS f32x4*)(I.x + i * 8), b = *(const GAS f32x4*)(I.x + i * 8 + 4);
        v4u o; o.x = pk2(a.x, a.y); o.y = pk2(a.z, a.w); o.z = pk2(b.x, b.y); o.w = pk2(b.z, b.w);
        *(GAS v4u*)((bf16*)(ws + WS_XB) + i * 8) = o;
    }
    for (size_t i = gt; i < (size_t)NL * M * PD / 8; i += NGT) {
        const f32x4 a = *(const GAS f32x4*)(I.p + i * 8), b = *(const GAS f32x4*)(I.p + i * 8 + 4);
        v4u o; o.x = pk2(a.x, a.y); o.y = pk2(a.z, a.w); o.z = pk2(b.x, b.y); o.w = pk2(b.z, b.w);
        *(GAS v4u*)((bf16*)(ws + WS_PB) + i * 8) = o;
    }
    for (size_t i = gt; i < (size_t)M * 32; i += NGT) {
        const int row = (int)(i >> 5), d = (int)(i & 31);
        const float inv = 1.0f / powf(10000.0f, (float)(2 * d) / 64.0f);
        const float ang = (float)I.pos[row] * inv;
        float* rp = (float*)(ws + WS_ROPE) + (size_t)row * 64;
        rp[d] = cosf(ang); rp[32 + d] = sinf(ang);
    }
}

__device__ __forceinline__ float gelu_tanh(float x) {
    const float u = 0.7978845608028654f * (x + 0.044715f * x * x * x);
    const float e = __builtin_amdgcn_exp2f(2.0f * 1.4426950408889634f * u);
    const float t = 1.0f - 2.0f * __builtin_amdgcn_rcpf(e + 1.0f);
    return 0.5f * x * (1.0f + t);
}
__device__ __forceinline__ void phase_compress(Frame& F, int L, const float* ck_pe, const float* cv_pe) {
    const int lane = F.lane, wave = F.wave, q = lane & 31, hi = lane >> 5;
    unsigned char* ws = F.ws;
    const bf16* H = (const bf16*)(ws + WS_H);
    const float* rope = (const float*)(ws + WS_ROPE);
    LAS unsigned char* hid = F.lds + RING_OFF;
    for (int unit = blockIdx.x; unit < 256; unit += F.G) {
        const int b = unit >> 4, g = (unit >> 3) & 1, kv = (unit >> 2) & 1, cb = unit & 3;
        const bf16* w1t = (const bf16*)(ws + WS_WC1) + (size_t)(L * 2 + kv) * 256 * 2048;
        const bf16* w2t = (const bf16*)(ws + WS_WC2) + (size_t)(L * 2 + kv) * 64 * 256;
        const float* pe = (kv ? cv_pe : ck_pe) + (size_t)L * 32 * 64;
        const int scol = (kv ? C_VC : C_KC) + g * 64;
        const int c = 32 * cb + q, cc = c < 127 ? c : 126;
        const bf16* arow = H + ((size_t)b * T + 16 * cc) * HP + scol + 8 * hi;
        const bf16* brow = w1t + (size_t)(32 * wave + q) * 2048 + 8 * hi;
        f32x16 acc; for (int r = 0; r < 16; ++r) acc[r] = 0.f;
#pragma unroll 2
        for (int i = 0; i < 32; ++i) {
#pragma unroll
            for (int s = 0; s < 4; ++s) {
                const v4u av = *(const GAS v4u*)(arow + (size_t)i * HP + 16 * s);
                const f32x4 p0 = *(const GAS f32x4*)(pe + i * 64 + 16 * s + 8 * hi), p1 = *(const GAS f32x4*)(pe + i * 64 + 16 * s + 8 * hi + 4);
                const bf16x8 af = pack8(bf_lo(av.x) + p0.x, bf_hi(av.x) + p0.y, bf_lo(av.y) + p0.z, bf_hi(av.y) + p0.w, bf_lo(av.z) + p1.x, bf_hi(av.z) + p1.y, bf_lo(av.w) + p1.z, bf_hi(av.w) + p1.w);
                const bf16x8 bfr = *(const GAS bf16x8*)(brow + i * 64 + 16 * s);
                acc = __builtin_amdgcn_mfma_f32_32x32x16_bf16(af, bfr, acc, 0, 0, 0);
            }
        }
#pragma unroll
        for (int r = 0; r < 16; ++r) *(LAS bf16*)(hid + crow(r, hi) * 528 + (32 * wave + q) * 2) = (bf16)f2bf(gelu_tanh(acc[r]));
        __syncthreads();
        if (wave == 0) {
            f32x16 a0, a1; for (int r = 0; r < 16; ++r) { a0[r] = 0.f; a1[r] = 0.f; }
#pragma unroll
            for (int ks = 0; ks < 16; ++ks) {
                const bf16x8 af = *(const LAS bf16x8*)(hid + q * 528 + (16 * ks + 8 * hi) * 2);
                const bf16x8 b0 = *(const GAS bf16x8*)(w2t + (size_t)q * 256 + 16 * ks + 8 * hi), b1 = *(const GAS bf16x8*)(w2t + (size_t)(32 + q) * 256 + 16 * ks + 8 * hi);
                a0 = __builtin_amdgcn_mfma_f32_32x32x16_bf16(af, b0, a0, 0, 0, 0);
                a1 = __builtin_amdgcn_mfma_f32_32x32x16_bf16(af, b1, a1, 0, 0, 0);
            }
            bf16* outp = (bf16*)(ws + (kv ? WS_VCMP : WS_KCMP)) + (size_t)(b * 2 + g) * 128 * 64;
#pragma unroll
            for (int r = 0; r < 16; ++r) {
                const int cl = 32 * cb + crow(r, hi);
                float x1 = a0[r], x2 = a1[r];
                if (kv == 0) {
                    const int cr = cl < 127 ? cl : 126;
                    const float* rp = rope + ((size_t)b * T + 31 + 16 * cr) * 64;
                    const float cs = rp[q], sn = rp[32 + q];
                    const float o1 = x1 * cs - x2 * sn, o2 = x2 * cs + x1 * sn; x1 = o1; x2 = o2;
                }
                if (cl >= 127) { x1 = 0.f; x2 = 0.f; }
                outp[(size_t)cl * 64 + q] = (bf16)f2bf(x1); outp[(size_t)cl * 64 + 32 + q] = (bf16)f2bf(x2);
            }
        }
        __syncthreads();
    }
}

namespace att {
constexpr int KP = 144;
constexpr int L_K0 = 0, L_K1 = 9216, L_V0 = 18432, L_V1 = 27648;
constexpr int L_KC = 36864;
constexpr int VCP = 272;
constexpr int L_VC = 55296;
constexpr int L_IMP = 72704;
constexpr int L_SEL = 106496;
constexpr int L_OT = 36864;
static_assert(L_OT + 65536 <= L_SEL, "ot staging");
static_assert(L_VC + 64 * VCP <= L_IMP && L_IMP + 4 * 64 * 33 * 4 <= L_SEL && L_SEL + 256 <= RING_BYTES, "attention LDS map");

template <bool SEL>
__device__ __forceinline__ void stream(LAS unsigned char* lds, const bf16* Hb, int kcol, int vcol, int j0, int j1, int t, int W, unsigned selbits,
                                       const bf16x8 (&qf)[4], f32x16& o0, f32x16& o1, float& m_run, float& l_run, int tid, int lane, int wave) {
    const int q = lane & 31, hi = lane >> 5;
    const int krow = tid >> 3, kch = tid & 7, vrow = lane, vch = wave;
    __syncthreads();
    v4u kreg = *(const GAS v4u*)(Hb + (size_t)(64 * j0 + krow) * HP + kcol + kch * 8);
    v4u vreg = *(const GAS v4u*)(Hb + (size_t)(64 * j0 + vrow) * HP + vcol + vch * 8);
    for (int j = j0; j <= j1; ++j) {
        const int buf = (j - j0) & 1;
        LAS unsigned char* Kl = lds + (buf ? L_K1 : L_K0);
        LAS unsigned char* Vl = lds + (buf ? L_V1 : L_V0);
        *(LAS v4u*)(Kl + krow * KP + kch * 16) = kreg;
        {
            LAS unsigned char* vp = Vl + (8 * vch) * KP + vrow * 2;
            *(LAS bf16*)(vp + 0 * KP) = (bf16)(vreg.x & 0xffffu); *(LAS bf16*)(vp + 1 * KP) = (bf16)(vreg.x >> 16);
            *(LAS bf16*)(vp + 2 * KP) = (bf16)(vreg.y & 0xffffu); *(LAS bf16*)(vp + 3 * KP) = (bf16)(vreg.y >> 16);
            *(LAS bf16*)(vp + 4 * KP) = (bf16)(vreg.z & 0xffffu); *(LAS bf16*)(vp + 5 * KP) = (bf16)(vreg.z >> 16);
            *(LAS bf16*)(vp + 6 * KP) = (bf16)(vreg.w & 0xffffu); *(LAS bf16*)(vp + 7 * KP) = (bf16)(vreg.w >> 16);
        }
        if (j < j1) {
            kreg = *(const GAS v4u*)(Hb + (size_t)(64 * (j + 1) + krow) * HP + kcol + kch * 8);
            vreg = *(const GAS v4u*)(Hb + (size_t)(64 * (j + 1) + vrow) * HP + vcol + vch * 8);
        }
        __syncthreads();
        f32x16 s0, s1;
#pragma unroll
        for (int r = 0; r < 16; ++r) { s0[r] = 0.f; s1[r] = 0.f; }
#pragma unroll
        for (int s = 0; s < 4; ++s) {
            const bf16x8 a0 = *(const LAS bf16x8*)(Kl + q * KP + (16 * s + 8 * hi) * 2);
            const bf16x8 a1 = *(const LAS bf16x8*)(Kl + (32 + q) * KP + (16 * s + 8 * hi) * 2);
            s0 = __builtin_amdgcn_mfma_f32_32x32x16_bf16(a0, qf[s], s0, 0, 0, 0);
            s1 = __builtin_amdgcn_mfma_f32_32x32x16_bf16(a1, qf[s], s1, 0, 0, 0);
        }
        const bool lane_ok = SEL ? (((selbits >> j) & 1u) != 0u) : true;
        const int kb0 = 64 * j + 4 * hi;
        float mx = -INFINITY;
#pragma unroll
        for (int r = 0; r < 16; ++r) {
            const int kp = kb0 + (r & 3) + 8 * (r >> 2);
            const bool v0 = lane_ok && (kp <= t) && (kp > t - W);
            const bool v1 = lane_ok && (kp + 32 <= t) && (kp + 32 > t - W);
            s0[r] = v0 ? s0[r] * SC_LOG2E : -INFINITY;
            s1[r] = v1 ? s1[r] * SC_LOG2E : -INFINITY;
            mx = fmaxf(mx, fmaxf(s0[r], s1[r]));
        }
        mx = fmaxf(mx, __shfl_xor(mx, 32));
        const float m_new = fmaxf(m_run, mx);
        const float alpha = __builtin_amdgcn_exp2f(m_run - m_new);
        float ps = 0.f;
#pragma unroll
        for (int r = 0; r < 16; ++r) { s0[r] = __builtin_amdgcn_exp2f(s0[r] - m_new); s1[r] = __builtin_amdgcn_exp2f(s1[r] - m_new); ps += s0[r] + s1[r]; }
        l_run = l_run * alpha + ps; m_run = m_new;
#pragma unroll
        for (int r = 0; r < 16; ++r) { o0[r] *= alpha; o1[r] *= alpha; }
#pragma unroll
        for (int ks = 0; ks < 4; ++ks) {
            const int kb = ks >> 1, sp = ks & 1;
            const bf16x8 pf = kb ? pack8(s1[8 * sp + 0], s1[8 * sp + 1], s1[8 * sp + 2], s1[8 * sp + 3], s1[8 * sp + 4], s1[8 * sp + 5], s1[8 * sp + 6], s1[8 * sp + 7])
                                 : pack8(s0[8 * sp + 0], s0[8 * sp + 1], s0[8 * sp + 2], s0[8 * sp + 3], s0[8 * sp + 4], s0[8 * sp + 5], s0[8 * sp + 6], s0[8 * sp + 7]);
            const int kvoff = (32 * kb + 16 * sp + 4 * hi) * 2;
            {
                const u32x2 lo = *(const LAS u32x2*)(Vl + q * KP + kvoff), hh = *(const LAS u32x2*)(Vl + q * KP + kvoff + 16);
                v4u w; w.x = lo.x; w.y = lo.y; w.z = hh.x; w.w = hh.y;
                o0 = __builtin_amdgcn_mfma_f32_32x32x16_bf16(__builtin_bit_cast(bf16x8, w), pf, o0, 0, 0, 0);
            }
            {
                const u32x2 lo = *(const LAS u32x2*)(Vl + (32 + q) * KP + kvoff), hh = *(const LAS u32x2*)(Vl + (32 + q) * KP + kvoff + 16);
                v4u w; w.x = lo.x; w.y = lo.y; w.z = hh.x; w.w = hh.y;
                o1 = __builtin_amdgcn_mfma_f32_32x32x16_bf16(__builtin_bit_cast(bf16x8, w), pf, o1, 0, 0, 0);
            }
        }
    }
}

__device__ __forceinline__ void phase_attention(Frame& F, int L, const float* sinks_all) {
    const int tid = F.tid, lane = F.lane, wave = F.wave, q = lane & 31, hi = lane >> 5;
    const int rh = wave >> 1, th = wave & 1;
    unsigned char* ws = F.ws;
    LAS unsigned char* lds = F.lds + RING_OFF;
    const bf16* H = (const bf16*)(ws + WS_H);
    bf16* O = (bf16*)(ws + WS_O);
    const float* gates = (const float*)(ws + WS_GATES);
    const float* sinks = sinks_all + L * 8;
    LAS float* impb = (LAS float*)(lds + L_IMP);
    LAS unsigned* selm = (LAS unsigned*)(lds + L_SEL);
    const int NU = 2048;
    for (int i = 0;; ++i) {
        const int pos = (i & 1) ? (F.G - 1 - (int)blockIdx.x) : (int)blockIdx.x;
        const int n = i * F.G + pos;
        if (i * F.G >= NU) break;
        if (n >= NU) continue;
        const bool nsa = n < 1024;
        int b, g, qt;
        if (nsa) { qt = 31 - (n >> 5); b = (n & 31) >> 1; g = n & 1; }
        else { const int m2 = n - 1024; qt = 31 - (m2 >> 5); b = (m2 & 31) >> 1; g = m2 & 1; }
        const int hq = 4 * g + rh;
        const int t = 64 * qt + 32 * th + q;
        const size_t row = (size_t)b * T + t;
        const bf16* Hb = H + (size_t)b * T * HP;
        bf16x8 qf[4];
        {
            const bf16* qp = H + row * HP + (nsa ? C_QN : C_QS) + 64 * hq + 8 * hi;
#pragma unroll
            for (int s = 0; s < 4; ++s) qf[s] = *(const GAS bf16x8*)(qp + 16 * s);
        }
        f32x16 ot0, ot1;
        if (nsa) {
            const float* gp = gates + row * 32 + hq * 3;
            const float g_cmp = gp[0], g_slc = gp[1], g_win = gp[2];
            __syncthreads();
            {
                const bf16* kc = (const bf16*)(ws + WS_KCMP) + (size_t)(b * 2 + g) * 128 * 64;
                const bf16* vc = (const bf16*)(ws + WS_VCMP) + (size_t)(b * 2 + g) * 128 * 64;
#pragma unroll
                for (int it = 0; it < 2; ++it) {
                    const int ci = tid + 512 * it, r = ci >> 3, ch = ci & 7;
                    *(LAS v4u*)(lds + L_KC + r * KP + ch * 16) = *(const GAS v4u*)(kc + (size_t)r * 64 + ch * 8);
                    const int vr = lane + 64 * it;
                    const v4u vv = *(const GAS v4u*)(vc + (size_t)vr * 64 + wave * 8);
                    LAS unsigned char* vp = lds + L_VC + (8 * wave) * VCP + vr * 2;
                    *(LAS bf16*)(vp + 0 * VCP) = (bf16)(vv.x & 0xffffu); *(LAS bf16*)(vp + 1 * VCP) = (bf16)(vv.x >> 16);
                    *(LAS bf16*)(vp + 2 * VCP) = (bf16)(vv.y & 0xffffu); *(LAS bf16*)(vp + 3 * VCP) = (bf16)(vv.y >> 16);
                    *(LAS bf16*)(vp + 4 * VCP) = (bf16)(vv.z & 0xffffu); *(LAS bf16*)(vp + 5 * VCP) = (bf16)(vv.z >> 16);
                    *(LAS bf16*)(vp + 6 * VCP) = (bf16)(vv.w & 0xffffu); *(LAS bf16*)(vp + 7 * VCP) = (bf16)(vv.w >> 16);
                }
            }
            __syncthreads();
            f32x16 sc[4];
#pragma unroll
            for (int kb = 0; kb < 4; ++kb) {
#pragma unroll
                for (int r = 0; r < 16; ++r) sc[kb][r] = 0.f;
#pragma unroll
                for (int s = 0; s < 4; ++s) {
                    const bf16x8 a = *(const LAS bf16x8*)(lds + L_KC + (32 * kb + q) * KP + (16 * s + 8 * hi) * 2);
                    sc[kb] = __builtin_amdgcn_mfma_f32_32x32x16_bf16(a, qf[s], sc[kb], 0, 0, 0);
                }
            }
            float mx = -INFINITY;
#pragma unroll
            for (int kb = 0; kb < 4; ++kb)
#pragma unroll
                for (int r = 0; r < 16; ++r) {
                    const int c = 32 * kb + crow(r, hi);
                    const bool vis = (16 * c + 31 <= t) && (c < 127);
                    sc[kb][r] = vis ? sc[kb][r] * SC_LOG2E : -INFINITY;
                    mx = fmaxf(mx, sc[kb][r]);
                }
            mx = fmaxf(mx, __shfl_xor(mx, 32));
            mx = fmaxf(mx, -1e30f);
            float ps = 0.f;
#pragma unroll
            for (int kb = 0; kb < 4; ++kb)
#pragma unroll
                for (int r = 0; r < 16; ++r) { sc[kb][r] = __builtin_amdgcn_exp2f(sc[kb][r] - mx); ps += sc[kb][r]; }
            ps += __shfl_xor(ps, 32);
            const float inv = 1.0f / fmaxf(ps, 1e-30f);
#pragma unroll
            for (int kb = 0; kb < 4; ++kb)
#pragma unroll
                for (int r = 0; r < 16; ++r) sc[kb][r] *= inv;
#pragma unroll
            for (int kb = 0; kb < 4; ++kb)
#pragma unroll
                for (int ii = 0; ii < 4; ++ii)
                    impb[(rh * 64 + 32 * th + q) * 33 + 8 * kb + 2 * ii + hi] = (sc[kb][4 * ii] + sc[kb][4 * ii + 1]) + (sc[kb][4 * ii + 2] + sc[kb][4 * ii + 3]);
            f32x16 c0, c1;
#pragma unroll
            for (int r = 0; r < 16; ++r) { c0[r] = 0.f; c1[r] = 0.f; }
#pragma unroll
            for (int ks = 0; ks < 8; ++ks) {
                const int kb = ks >> 1, sp = ks & 1;
                const bf16x8 pf = pack8(sc[kb][8 * sp + 0], sc[kb][8 * sp + 1], sc[kb][8 * sp + 2], sc[kb][8 * sp + 3], sc[kb][8 * sp + 4], sc[kb][8 * sp + 5], sc[kb][8 * sp + 6], sc[kb][8 * sp + 7]);
                const int kvoff = (32 * kb + 16 * sp + 4 * hi) * 2;
                {
                    const u32x2 lo = *(const LAS u32x2*)(lds + L_VC + q * VCP + kvoff), hh = *(const LAS u32x2*)(lds + L_VC + q * VCP + kvoff + 16);
                    v4u w; w.x = lo.x; w.y = lo.y; w.z = hh.x; w.w = hh.y;
                    c0 = __builtin_amdgcn_mfma_f32_32x32x16_bf16(__builtin_bit_cast(bf16x8, w), pf, c0, 0, 0, 0);
                }
                {
                    const u32x2 lo = *(const LAS u32x2*)(lds + L_VC + (32 + q) * VCP + kvoff), hh = *(const LAS u32x2*)(lds + L_VC + (32 + q) * VCP + kvoff + 16);
                    v4u w; w.x = lo.x; w.y = lo.y; w.z = hh.x; w.w = hh.y;
                    c1 = __builtin_amdgcn_mfma_f32_32x32x16_bf16(__builtin_bit_cast(bf16x8, w), pf, c1, 0, 0, 0);
                }
            }
            __syncthreads();
            if (tid < 64) {
                unsigned mask;
                if (qt >= 8) {
                    for (int j = 1; j <= qt - 2; ++j) impb[tid * 33 + j] = (impb[tid * 33 + j] + impb[(64 + tid) * 33 + j]) + (impb[(128 + tid) * 33 + j] + impb[(192 + tid) * 33 + j]);
                    mask = 1u | (1u << qt) | (1u << (qt - 1));
                    for (int rnd = 0; rnd < 5; ++rnd) {
                        float best = -1.0f; int bj = 1;
                        for (int j = 1; j <= qt - 2; ++j) { const float v = impb[tid * 33 + j]; if (!((mask >> j) & 1u) && v > best) { best = v; bj = j; } }
                        mask |= 1u << bj;
                    }
                } else mask = (2u << qt) - 1u;
                selm[tid] = mask;
            }
            __syncthreads();
            const unsigned selbits = selm[32 * th + q];
            LAS float* otl = (LAS float*)(lds + L_OT + wave * 8192) + lane;
#pragma unroll
            for (int r = 0; r < 16; ++r) { otl[r * 64] = g_cmp * c0[r]; otl[(16 + r) * 64] = g_cmp * c1[r]; }
            {
                f32x16 a0, a1; float mr = -1e30f, lr = 0.f;
#pragma unroll
                for (int r = 0; r < 16; ++r) { a0[r] = 0.f; a1[r] = 0.f; }
                stream<true>(lds, Hb, C_KS + 64 * g, C_VS + 64 * g, 0, qt, t, 1 << 20, selbits, qf, a0, a1, mr, lr, tid, lane, wave);
                lr += __shfl_xor(lr, 32);
                const float f = g_slc / fmaxf(lr, 1e-30f);
#pragma unroll
                for (int r = 0; r < 16; ++r) { otl[r * 64] += f * a0[r]; otl[(16 + r) * 64] += f * a1[r]; }
            }
            {
                f32x16 a0, a1; float mr = -1e30f, lr = 0.f;
#pragma unroll
                for (int r = 0; r < 16; ++r) { a0[r] = 0.f; a1[r] = 0.f; }
                stream<false>(lds, Hb, C_KW + 64 * g, C_VW + 64 * g, qt >= 8 ? qt - 8 : 0, qt, t, 512, 0u, qf, a0, a1, mr, lr, tid, lane, wave);
                lr += __shfl_xor(lr, 32);
                const float f = g_win / fmaxf(lr, 1e-30f);
#pragma unroll
                for (int r = 0; r < 16; ++r) { ot0[r] = otl[r * 64] + f * a0[r]; ot1[r] = otl[(16 + r) * 64] + f * a1[r]; }
            }
        } else {
            f32x16 a0, a1; float mr = -1e30f, lr = 0.f;
#pragma unroll
            for (int r = 0; r < 16; ++r) { a0[r] = 0.f; a1[r] = 0.f; }
            stream<false>(lds, Hb, C_KSW + 64 * g, C_VSW + 64 * g, qt >= 2 ? qt - 2 : 0, qt, t, 128, 0u, qf, a0, a1, mr, lr, tid, lane, wave);
            lr += __shfl_xor(lr, 32);
            const float sk = sinks[hq] * 1.4426950408889634f;
            const float mf = fmaxf(mr, sk);
            const float sm = __builtin_amdgcn_exp2f(mr - mf);
            const float den = lr * sm + __builtin_amdgcn_exp2f(sk - mf);
            const float f = sm / fmaxf(den, 1e-30f);
#pragma unroll
            for (int r = 0; r < 16; ++r) { ot0[r] = f * a0[r]; ot1[r] = f * a1[r]; }
        }
        bf16* op = O + row * 1024 + (nsa ? 0 : 512) + 64 * hq + 4 * hi;
#pragma unroll
        for (int ii = 0; ii < 4; ++ii) {
            u32x2 w0, w1;
            w0.x = cvtpk(ot0[4 * ii], ot0[4 * ii + 1]); w0.y = cvtpk(ot0[4 * ii + 2], ot0[4 * ii + 3]);
            w1.x = cvtpk(ot1[4 * ii], ot1[4 * ii + 1]); w1.y = cvtpk(ot1[4 * ii + 2], ot1[4 * ii + 3]);
            *(GAS u32x2*)(op + 8 * ii) = w0; *(GAS u32x2*)(op + 32 + 8 * ii) = w1;
        }
    }
}
}

__device__ __forceinline__ void phase_ln1_router(Frame& F, int L, const float* ln_g, const float* ln_b, const float* b_r) {
    const int tid = F.tid, lane = F.lane, wave = F.wave;
    unsigned char* ws = F.ws;
    const float* Y1 = (const float*)(ws + WS_Y1);
    float* X1 = (float*)(ws + WS_X1);
    bf16* X1B = (bf16*)(ws + WS_X1B);
    const bf16* Wh = (const bf16*)(ws + WS_WR) + (size_t)L * 2 * 32 * 1024;
    const bf16* Wl = Wh + 32 * 1024;
    LAS float* scr = (LAS float*)(F.lds + RING_OFF + wave * 4096);
    LAS unsigned* cntl = (LAS unsigned*)(F.lds + RING_OFF + 65536);
    LAS unsigned* basel = cntl + 32;
    gu32* gcnt = F.ctl + CW_CNT + L * 32;
    f32x4 gam[4], bet[4];
#pragma unroll
    for (int j = 0; j < 4; ++j) { gam[j] = *(const GAS f32x4*)(ln_g + (size_t)L * D + 4 * lane + 256 * j); bet[j] = *(const GAS f32x4*)(ln_b + (size_t)L * D + 4 * lane + 256 * j); }
    for (int chunk = blockIdx.x; chunk < M / 128; chunk += F.G) {
        if (tid < 32) cntl[tid] = 0u;
        __syncthreads();
        const int tok0 = chunk * 128 + wave * 16;
        for (int rr = 0; rr < 16; ++rr) {
            const size_t row = (size_t)(tok0 + rr);
            f32x4 v[4]; float s = 0.f;
#pragma unroll
            for (int j = 0; j < 4; ++j) { v[j] = *(const GAS f32x4*)(Y1 + row * D + 4 * lane + 256 * j); s += (v[j].x + v[j].y) + (v[j].z + v[j].w); }
            const float mean = wave_sum(s) * (1.f / D); float s2 = 0.f;
#pragma unroll
            for (int j = 0; j < 4; ++j) { v[j] = v[j] - mean; s2 += (v[j].x * v[j].x + v[j].y * v[j].y) + (v[j].z * v[j].z + v[j].w * v[j].w); }
            const float rstd = 1.f / sqrtf(wave_sum(s2) * (1.f / D) + LN_EPS);
#pragma unroll
            for (int j = 0; j < 4; ++j) {
                const f32x4 o = v[j] * rstd * gam[j] + bet[j];
                *(GAS f32x4*)(X1 + row * D + 4 * lane + 256 * j) = o;
                u32x2 w; w.x = pk2(o.x, o.y); w.y = pk2(o.z, o.w);
                *(GAS u32x2*)(X1B + row * D + 4 * lane + 256 * j) = w;
            }
        }
        VM_WAIT();
        f32x4 acc0 = {0.f, 0.f, 0.f, 0.f}, acc1 = {0.f, 0.f, 0.f, 0.f};
        {
            const int ar = lane & 15, kg = lane >> 4;
            const float* xr = X1 + (size_t)(tok0 + ar) * D + 8 * kg;
            const bf16* wh0 = Wh + (size_t)ar * 1024 + 8 * kg; const bf16* wl0 = Wl + (size_t)ar * 1024 + 8 * kg;
#pragma unroll 4
            for (int ks = 0; ks < 32; ++ks) {
                const f32x4 xa = *(const GAS f32x4*)(xr + 32 * ks), xb = *(const GAS f32x4*)(xr + 32 * ks + 4);
                const float xv[8] = {xa.x, xa.y, xa.z, xa.w, xb.x, xb.y, xb.z, xb.w};
                unsigned hh[8], ll[8];
#pragma unroll
                for (int e = 0; e < 8; ++e) { hh[e] = f2bf(xv[e]); ll[e] = f2bf(xv[e] - __uint_as_float(hh[e] << 16)); }
                v4u ah, al;
                ah.x = hh[0] | (hh[1] << 16); ah.y = hh[2] | (hh[3] << 16); ah.z = hh[4] | (hh[5] << 16); ah.w = hh[6] | (hh[7] << 16);
                al.x = ll[0] | (ll[1] << 16); al.y = ll[2] | (ll[3] << 16); al.z = ll[4] | (ll[5] << 16); al.w = ll[6] | (ll[7] << 16);
                const bf16x8 fah = __builtin_bit_cast(bf16x8, ah), fal = __builtin_bit_cast(bf16x8, al);
                const bf16x8 w0h = *(const GAS bf16x8*)(wh0 + 32 * ks), w0l = *(const GAS bf16x8*)(wl0 + 32 * ks);
                const bf16x8 w1h = *(const GAS bf16x8*)(wh0 + 16 * 1024 + 32 * ks), w1l = *(const GAS bf16x8*)(wl0 + 16 * 1024 + 32 * ks);
                acc0 = __builtin_amdgcn_mfma_f32_16x16x32_bf16(fah, w0h, acc0, 0, 0, 0); acc0 = __builtin_amdgcn_mfma_f32_16x16x32_bf16(fal, w0h, acc0, 0, 0, 0); acc0 = __builtin_amdgcn_mfma_f32_16x16x32_bf16(fah, w0l, acc0, 0, 0, 0);
                acc1 = __builtin_amdgcn_mfma_f32_16x16x32_bf16(fah, w1h, acc1, 0, 0, 0); acc1 = __builtin_amdgcn_mfma_f32_16x16x32_bf16(fal, w1h, acc1, 0, 0, 0); acc1 = __builtin_amdgcn_mfma_f32_16x16x32_bf16(fah, w1l, acc1, 0, 0, 0);
            }
#pragma unroll
            for (int r = 0; r < 4; ++r) { scr[(4 * kg + r) * 33 + ar] = acc0[r]; scr[(4 * kg + r) * 33 + 16 + ar] = acc1[r]; }
        }
        LDS_WAIT(); asm volatile("" ::: "memory");
        int ek[4] = {0, 0, 0, 0}; float wk[4] = {0.f, 0.f, 0.f, 0.f}; unsigned lrk[4] = {0u, 0u, 0u, 0u};
        if (lane < 16) {
            float lv[32];
#pragma unroll
            for (int e = 0; e < 32; ++e) lv[e] = scr[lane * 33 + e] + b_r[(size_t)L * 32 + e];
            unsigned taken = 0u; float vk[4];
#pragma unroll
            for (int k = 0; k < 4; ++k) {
                float best = -INFINITY; int bi = 0;
#pragma unroll
                for (int e = 0; e < 32; ++e) { const bool ok = !((taken >> e) & 1u) && lv[e] > best; best = ok ? lv[e] : best; bi = ok ? e : bi; }
                taken |= 1u << bi; ek[k] = bi; vk[k] = best;
            }
            float den = 0.f;
#pragma unroll
            for (int k = 0; k < 4; ++k) { wk[k] = __expf(vk[k] - vk[0]); den += wk[k]; }
#pragma unroll
            for (int k = 0; k < 4; ++k) { wk[k] /= den; lrk[k] = atomicAdd((unsigned*)(cntl + ek[k]), 1u); }
        }
        __syncthreads();
        if (tid < 32) basel[tid] = __hip_atomic_fetch_add(gcnt + tid, cntl[tid], RLX_AGENT);
        __syncthreads();
        if (lane < 16) {
            const size_t tk = (size_t)(tok0 + lane) * 4;
#pragma unroll
            for (int k = 0; k < 4; ++k) {
                ((int*)(ws + WS_TOKE))[tk + k] = ek[k];
                ((int*)(ws + WS_TOKR))[tk + k] = (int)(basel[ek[k]] + lrk[k]);
                ((float*)(ws + WS_TOKW))[tk + k] = wk[k];
            }
        }
        __syncthreads();
    }
}

__device__ __forceinline__ void build_tables(Frame& F, int L) {
    LAS int* cnt = (LAS int*)(F.lds + TAB_CNT); LAS int* soff = (LAS int*)(F.lds + TAB_SOFF); LAS int* tst = (LAS int*)(F.lds + TAB_TST); LAS int* te = (LAS int*)(F.lds + TAB_TE);
    __syncthreads();
    if (F.tid < 32) { int c = (int)__hip_atomic_load(F.ctl + CW_CNT + L * 32 + F.tid, RLX_AGENT); cnt[F.tid] = c < 0 ? 0 : (c > M ? M : c); }
    __syncthreads();
    if (F.tid == 0) { int a = 0; for (int e = 0; e < 32; ++e) { tst[e] = a; a += (cnt[e] + 255) >> 8; if (a > MAXTILES) a = MAXTILES; } tst[32] = a; }
    __syncthreads();
    if (F.tid < 32) { soff[F.tid] = tst[F.tid] * 256; for (int mt = tst[F.tid]; mt < tst[F.tid + 1]; ++mt) te[mt] = F.tid; }
    __syncthreads();
}

__device__ __forceinline__ void phase_gather(Frame& F, int L) {
    build_tables(F, L);
    unsigned char* ws = F.ws;
    LAS int* cnt = (LAS int*)(F.lds + TAB_CNT); LAS int* soff = (LAS int*)(F.lds + TAB_SOFF); LAS int* tst = (LAS int*)(F.lds + TAB_TST);
    const bf16* X1B = (const bf16*)(ws + WS_X1B); bf16* XG = (bf16*)(ws + WS_XG);
    const int gw = F.vcu * NWAVES + F.wave, NGW = F.G * NWAVES, lane = F.lane;
    for (int tok = gw; tok < M; tok += NGW) {
        const v4u a = *(const GAS v4u*)(X1B + (size_t)tok * D + lane * 8), b = *(const GAS v4u*)(X1B + (size_t)tok * D + 512 + lane * 8);
#pragma unroll
        for (int k = 0; k < 4; ++k) {
            const int e = ((const int*)(ws + WS_TOKE))[(size_t)tok * 4 + k] & 31, r = ((const int*)(ws + WS_TOKR))[(size_t)tok * 4 + k];
            int slot = soff[e] + r; slot = slot < 0 ? 0 : (slot >= MAXSLOTS ? MAXSLOTS - 1 : slot);
            *(GAS v4u*)(XG + (size_t)slot * D + lane * 8) = a; *(GAS v4u*)(XG + (size_t)slot * D + 512 + lane * 8) = b;
            if (lane == 0) ((int*)(ws + WS_SLOT))[(size_t)tok * 4 + k] = slot;
        }
    }
    const v4u z = {0u, 0u, 0u, 0u};
    for (int e = 0; e < 32; ++e) {
        const int c = cnt[e], npad = (tst[e + 1] - tst[e]) * 256 - c, s0 = soff[e] + c;
        for (int p = gw; p < npad; p += NGW) { *(GAS v4u*)(XG + (size_t)(s0 + p) * D + lane * 8) = z; *(GAS v4u*)(XG + (size_t)(s0 + p) * D + 512 + lane * 8) = z; }
    }
}

__device__ __forceinline__ void phase_ln2(Frame& F, int L, const float* ln_g, const float* ln_b, float* outp) {
    unsigned char* ws = F.ws;
    const float* X1 = (const float*)(ws + WS_X1);
    const bf16* E = (const bf16*)(ws + WS_E); const bf16* YS = (const bf16*)(ws + WS_YS);
    bf16* XB = (bf16*)(ws + WS_XB);
    const int gw = F.vcu * NWAVES + F.wave, NGW = F.G * NWAVES, lane = F.lane;
    f32x4 gam[4], bet[4];
#pragma unroll
    for (int j = 0; j < 4; ++j) { gam[j] = *(const GAS f32x4*)(ln_g + (size_t)L * D + 4 * lane + 256 * j); bet[j] = *(const GAS f32x4*)(ln_b + (size_t)L * D + 4 * lane + 256 * j); }
    for (int tok = gw; tok < M; tok += NGW) {
        int sl[4]; float wk[4];
#pragma unroll
        for (int k = 0; k < 4; ++k) { sl[k] = ((const int*)(ws + WS_SLOT))[(size_t)tok * 4 + k]; wk[k] = ((const float*)(ws + WS_TOKW))[(size_t)tok * 4 + k]; }
        f32x4 v[4]; float s = 0.f;
#pragma unroll
        for (int j = 0; j < 4; ++j) {
            const int c = 4 * lane + 256 * j;
            f32x4 a = *(const GAS f32x4*)(X1 + (size_t)tok * D + c) * DN_ALPHA;
            const u32x2 ev = *(const GAS u32x2*)(E + (size_t)tok * D + c);
            a.x += bf_lo(ev.x); a.y += bf_hi(ev.x); a.z += bf_lo(ev.y); a.w += bf_hi(ev.y);
#pragma unroll
            for (int k = 0; k < 4; ++k) {
                const u32x2 yv = *(const GAS u32x2*)(YS + (size_t)sl[k] * D + c);
                a.x += wk[k] * bf_lo(yv.x); a.y += wk[k] * bf_hi(yv.x); a.z += wk[k] * bf_lo(yv.y); a.w += wk[k] * bf_hi(yv.y);
            }
            v[j] = a; s += (a.x + a.y) + (a.z + a.w);
        }
        const float mean = wave_sum(s) * (1.f / D); float s2 = 0.f;
#pragma unroll
        for (int j = 0; j < 4; ++j) { v[j] = v[j] - mean; s2 += (v[j].x * v[j].x + v[j].y * v[j].y) + (v[j].z * v[j].z + v[j].w * v[j].w); }
        const float rstd = 1.f / sqrtf(wave_sum(s2) * (1.f / D) + LN_EPS);
#pragma unroll
        for (int j = 0; j < 4; ++j) {
            const f32x4 o = v[j] * rstd * gam[j] + bet[j];
            *(GAS f32x4*)(outp + (size_t)tok * D + 4 * lane + 256 * j) = o;
            u32x2 w; w.x = pk2(o.x, o.y); w.y = pk2(o.z, o.w);
            *(GAS u32x2*)(XB + (size_t)tok * D + 4 * lane + 256 * j) = w;
        }
    }
}

#ifndef MK_ONE_LAUNCH
#define MK_ONE_LAUNCH 1
#endif
constexpr int PH_PER_LAYER = 9, NPH = 1 + NL * PH_PER_LAYER;
struct Args { const float* in[27]; float* out; unsigned char* ws; int ph_lo, ph_hi; };
typedef const __attribute__((address_space(4))) unsigned char* kptr_t;
__device__ __forceinline__ kptr_t karg_base() { kptr_t p = (kptr_t)__builtin_amdgcn_kernarg_segment_ptr(); asm volatile("" : "+s"(p)); return p; }
#define KIN(kb, i) (*(const float* const __attribute__((address_space(4)))*)((kb) + 8 * (i)))
#ifndef PH_MASK
#define PH_MASK 0x3ff
#endif
#define PHSEL(k) (((k) == 0) ? ((PH_MASK >> 9) & 1) : ((PH_MASK >> (((k) - 1) % PH_PER_LAYER)) & 1))
#define IN(k) (PHSEL(k) && lo <= (k) && (k) < hi)
#define SEAM(k) do { if (IN(k) && IN((k) + 1)) { if (MK_ONE_LAUNCH) xcd_barrier(bar); } } while (0)

#define RELAUNDER() do { F.lane = (int)__builtin_amdgcn_mbcnt_hi(~0u, __builtin_amdgcn_mbcnt_lo(~0u, 0u)); asm volatile("" : "+v"(F.lane)); F.wave = wave0; F.tid = F.wave * 64 + F.lane; } while (0)
template <int L>
__device__ __forceinline__ void layer_body(Frame& F, const XcdBarrier& bar, const int lo, const int hi, const int wave0) {
    unsigned char* ws = F.ws;
        const int pb = 1 + L * PH_PER_LAYER;
        if (IN(pb + 0)) {
            pg8::Gemm g{(const bf16*)(ws + WS_XB), (const bf16*)(ws + WS_WIN) + (size_t)L * NIN * 1024, M, NIN, D};
            pg8::StaticOrder S; S.init(M, NIN, F.G, (int)blockIdx.x);
            pg8::EpiIn E{(bf16*)(ws + WS_H), (float*)(ws + WS_GATES), (const float*)(ws + WS_BINP) + (size_t)L * NIN, (const float*)(ws + WS_ROPE)};
            pg8::gemm_phase<pg8::EpiIn, pg8::StaticOrder, true, true>(F.lds + RING_OFF, g, S, E, wave0);
        }
        SEAM(pb + 0);
        if (IN(pb + 1)) {
            { kptr_t kb = karg_base(); RELAUNDER(); phase_compress(F, L, KIN(kb, 5), KIN(kb, 8)); }
            {
                pg8::Gemm g{(const bf16*)(ws + WS_PB) + (size_t)L * M * PD, (const bf16*)(ws + WS_WPP) + (size_t)L * 1024 * PD, M, D, PD};
                pg8::StaticOrder S; S.init(M, D, F.G, (int)blockIdx.x);
                pg8::EpiPlain E{(bf16*)(ws + WS_PP)};
                pg8::gemm_phase<pg8::EpiPlain, pg8::StaticOrder, true, true>(F.lds + RING_OFF, g, S, E, wave0);
            }
        }
        SEAM(pb + 1);
        if (IN(pb + 2)) { kptr_t kb = karg_base(); RELAUNDER(); att::phase_attention(F, L, KIN(kb, 11)); }
        SEAM(pb + 2);
        if (IN(pb + 3)) {
            pg8::Gemm g{(const bf16*)(ws + WS_O), (const bf16*)(ws + WS_WO) + (size_t)L * 1024 * 1024, M, D, D};
            pg8::StaticOrder S; S.init(M, D, F.G, (int)blockIdx.x);
            kptr_t kb = karg_base();
            const float* xin = L == 0 ? KIN(kb, 0) : (const float*)(ws + WS_XN);
            pg8::EpiOut E{xin, (float*)(ws + WS_Y1), KIN(kb, 13) + (size_t)L * D, DN_ALPHA};
            pg8::gemm_phase<pg8::EpiOut, pg8::StaticOrder, true, true>(F.lds + RING_OFF, g, S, E, wave0);
        }
        SEAM(pb + 3);
        if (IN(pb + 4)) { kptr_t kb = karg_base(); RELAUNDER(); phase_ln1_router(F, L, KIN(kb, 14), KIN(kb, 15), KIN(kb, 17)); }
        SEAM(pb + 4);
        if (IN(pb + 5)) { RELAUNDER(); phase_gather(F, L); }
        SEAM(pb + 5);
        if (IN(pb + 6)) {
            RELAUNDER();
            if (!IN(pb + 5)) build_tables(F, L);
            {
                pg8::Gemm g{(const bf16*)(ws + WS_XG), (const bf16*)(ws + WS_W1T) + (size_t)L * 32 * 2048 * 1024, MAXSLOTS, 32 * 2048, D};
                pg8::MoeOrder S{(const LAS int*)(F.lds + TAB_TE), ((const LAS int*)(F.lds + TAB_TST))[32] * 8, 3, F.G, F.vcu};
                pg8::EpiUp E{(bf16*)(ws + WS_ACT), (const float*)(ws + WS_B1P) + (size_t)L * 32 * 2048};
                pg8::gemm_phase<pg8::EpiUp, pg8::MoeOrder, true, true>(F.lds + RING_OFF, g, S, E, wave0);
            }
        }
        SEAM(pb + 6);
        if (IN(pb + 7)) {
            kptr_t kb = karg_base(); RELAUNDER();
            if (!IN(pb + 6)) build_tables(F, L);
            {
                pg8::Gemm g{(const bf16*)(ws + WS_ACT), (const bf16*)(ws + WS_W2T) + (size_t)L * 32 * 1024 * 1024, MAXSLOTS, 32 * 1024, D};
                pg8::MoeOrder S{(const LAS int*)(F.lds + TAB_TE), ((const LAS int*)(F.lds + TAB_TST))[32] * 4, 2, F.G, F.vcu};
                pg8::EpiDown E{(bf16*)(ws + WS_YS), KIN(kb, 21) + (size_t)L * 32 * 1024};
                pg8::gemm_phase<pg8::EpiDown, pg8::MoeOrder, true, true>(F.lds + RING_OFF, g, S, E, wave0);
            }
            {
                pg8::Gemm g{(const bf16*)(ws + WS_X1B), (const bf16*)(ws + WS_WPG) + (size_t)L * 1024 * 1024, M, D, D};
                pg8::StaticOrder S; S.init(M, D, F.G, (int)blockIdx.x);
                pg8::EpiGate E{(const bf16*)(ws + WS_PP), (bf16*)(ws + WS_E), KIN(kb, 23) + (size_t)L * D};
                pg8::gemm_phase<pg8::EpiGate, pg8::StaticOrder, true, true>(F.lds + RING_OFF, g, S, E, wave0);
            }
        }
        SEAM(pb + 7);
        if (IN(pb + 8)) { kptr_t kb = karg_base(); RELAUNDER(); float* xout = L == NL - 1 ? (float*)KIN(kb, 27) : (float*)(ws + WS_XN); phase_ln2(F, L, KIN(kb, 25), KIN(kb, 26), xout); }
        SEAM(pb + 8);
    }
__global__ void __launch_bounds__(NWAVES * 64, 2) mk_fwd(Args args) {
    extern __shared__ __attribute__((aligned(16))) unsigned char lds[];
    Frame F;
    F.lds = (LAS unsigned char*)lds;
    F.MISC = (volatile LAS unsigned*)(F.lds + MISC_OFF);
    const int wave0 = __builtin_amdgcn_readfirstlane((int)threadIdx.x >> 6);
    F.wave = wave0; F.lane = (int)__builtin_amdgcn_mbcnt_hi(~0u, __builtin_amdgcn_mbcnt_lo(~0u, 0u)); F.tid = F.wave * 64 + F.lane;
    F.G = gridDim.x; { const int bx = blockIdx.x; F.vcu = (F.G % 8 == 0) ? (bx % 8) * (F.G / 8) + bx / 8 : bx; }
    F.ws = args.ws; F.ctl = (gu32*)(args.ws + WS_CTL);
    unsigned char* ws = args.ws;
    for (int u = F.tid; u < (LDS_BYTES - LDSCTL_OFF) / 4; u += NWAVES * 64) ((LAS unsigned*)(F.lds + LDSCTL_OFF))[u] = 0u;
    __syncthreads();
    XcdBarrier bar; bar.bar = (unsigned*)(F.ctl + CW_BAR); bar.x = 0; bar.st = nullptr; bar.wave = wave0;
    if (MK_ONE_LAUNCH) bar = xcd_barrier_post((unsigned*)(F.ctl + CW_BAR), F.MISC + 8, wave0);
    const int lo = args.ph_lo, hi = args.ph_hi;
    if (IN(0)) {
        kptr_t kb = karg_base(); RELAUNDER();
        PIn I{KIN(kb, 0), KIN(kb, 1), KIN(kb, 3), KIN(kb, 4), KIN(kb, 6), KIN(kb, 7), KIN(kb, 9), KIN(kb, 10), KIN(kb, 12), KIN(kb, 16), KIN(kb, 18), KIN(kb, 19), KIN(kb, 20), KIN(kb, 22), KIN(kb, 24), (const int*)KIN(kb, 2)};
        p0_prologue(F, I);
    }
    SEAM(0);
    layer_body<0>(F, bar, lo, hi, wave0);
    layer_body<1>(F, bar, lo, hi, wave0);
#undef IN
#undef SEAM
}

extern "C" void kernel_launch(void* const* d_in, const int* in_sizes, int n_in, void* d_out, int out_size, void* d_ws, size_t ws_size, hipStream_t stream) {
    static int grid = 0;
    if (grid == 0) {
        if (n_in != 27 || out_size != M * D || ws_size < WS_END) { fprintf(stderr, "kernel_launch: unexpected problem (n_in %d, out %d, ws %zu); nothing launched\n", n_in, out_size, ws_size); grid = -1; return; }
        int dev = 0, cus = 0, per_cu = 0;
        if (hipGetDevice(&dev) != hipSuccess || hipDeviceGetAttribute(&cus, hipDeviceAttributeMultiprocessorCount, dev) != hipSuccess) { grid = -1; return; }
        if (hipFuncSetAttribute((const void*)mk_fwd, hipFuncAttributeMaxDynamicSharedMemorySize, LDS_BYTES) != hipSuccess) { fprintf(stderr, "kernel_launch: hipFuncSetAttribute failed\n"); grid = -1; return; }
        if (hipOccupancyMaxActiveBlocksPerMultiprocessor(&per_cu, (const void*)mk_fwd, NWAVES * 64, LDS_BYTES) != hipSuccess || per_cu < 1) { fprintf(stderr, "kernel_launch: occupancy query says %d\n", per_cu); }
        (void)hipGetLastError();
        grid = cus;
    }
    if (grid < 0) return;
    (void)in_sizes;
    if (hipMemsetAsync((char*)d_ws + WS_CTL, 0, CTL_ZERO_BYTES, stream) != hipSuccess) return;
    Args a{};
    for (int i = 0; i < 27; ++i) a.in[i] = (const float*)d_in[i];
    a.out = (float*)d_out; a.ws = (unsigned char*)d_ws;
#if MK_ONE_LAUNCH
    a.ph_lo = 0; a.ph_hi = NPH;
    hipLaunchKernelGGL(mk_fwd, dim3(grid), dim3(NWAVES * 64), LDS_BYTES, stream, a);
#else
    for (int ph = 0; ph < NPH; ++ph) { a.ph_lo = ph; a.ph_hi = ph + 1; hipLaunchKernelGGL(mk_fwd, dim3(grid), dim3(NWAVES * 64), LDS_BYTES, stream, a); }
#endif
}
```

```cpp
#include <hip/hip_runtime.h>
#include <cstdio>
#include <cstdint>
#define MK_ONE_LAUNCH 1
namespace pg8 {
#define PG8_LAS __attribute__((address_space(3)))
typedef unsigned short bf16_t;
typedef short bf16x8 __attribute__((ext_vector_type(8)));
typedef float f32x4 __attribute__((ext_vector_type(4)));
typedef unsigned u32x4 __attribute__((ext_vector_type(4)));
constexpr int BM = 256, BK = 64, HALF = 128, HTB = HALF * BK * 2  , STAGE_BYTES = 8 * HTB, NXCD = 8, WGM = 8;

__host__ __device__ __forceinline__ int lds_byte(int r, int c) { const int st = (r >> 4) * 2 + (c >> 5), rr = r & 15, cc = c & 31, ob = rr * 64 + cc * 2; return st * 1024 + (ob ^ (((ob >> 9) & 1) << 5)); }
__host__ __device__ __forceinline__ void stage_rc(int b, int& R, int& C) { const int st = b / 1024, sb = b % 1024, swz = sb ^ (((sb >> 9) & 1) << 5); R = (st >> 1) * 16 + swz / 64; C = (st & 1) * 32 + (swz % 64) / 2; }
__host__ __device__ __forceinline__ int perm32(int rho) { const int n = rho >> 4, i = rho & 15; return 8 * (i >> 2) + 4 * n + (i & 3); }

struct Unit { int pm, pn; };
struct Gemm { const bf16_t* A; const bf16_t* Bt; int M, N, K; };

struct StaticOrder {
    int nM, nN, nwg, G, c;
    __host__ __device__ void init(int M, int N, int G_, int c_) { nM = M / BM; nN = N / BM; nwg = nM * nN; G = G_; c = c_; }
    __host__ __device__ bool next(int i, Unit& u) const {
        const long L = (long)i * G + c; if (L >= nwg) return false;
        int wgid = (int)L; { const int q = nwg / NXCD, r = nwg % NXCD, xcd = wgid % NXCD, off = wgid / NXCD; wgid = (xcd < r ? xcd * (q + 1) : r * (q + 1) + (xcd - r) * q) + off; }
        const int nig = WGM * nN, gid = wgid / nig, fm = gid * WGM, gsz = (nM - fm) < WGM ? (nM - fm) : WGM;
        u.pm = fm + ((wgid % nig) % gsz); u.pn = (wgid % nig) / gsz; return true;
    }
    __device__ __forceinline__ void a_ready(const Unit&) const {}
    __device__ __forceinline__ void done(const Unit&) const {}
};

__device__ __forceinline__ unsigned cvt_pk_bf16(float lo, float hi) { unsigned r; asm volatile("v_cvt_pk_bf16_f32 %0, %1, %2" : "=v"(r) : "v"(lo), "v"(hi)); return r; }
typedef float f32x2 __attribute__((ext_vector_type(2)));

typedef unsigned u32x2 __attribute__((ext_vector_type(2)));
__device__ __forceinline__ float sigm(float x) { return __builtin_amdgcn_rcpf(1.0f + __builtin_amdgcn_exp2f(-1.4426950408889634f * x)); }
__device__ __forceinline__ float bf_lo(unsigned w) { return __uint_as_float(w << 16); }
__device__ __forceinline__ float bf_hi(unsigned w) { return __uint_as_float(w & 0xffff0000u); }

constexpr unsigned ROPE_SEGS = 0x7D4Fu;
constexpr float QSCALE = 0.125f * 1.4426950408889634f;
struct EpiIn {
    static constexpr bool PERM = true, AFTER_DRAIN = false;
    bf16_t* H; float* gates; const float* bias; const float* rope;
    __device__ __forceinline__ const float* bias_slice(const Unit& u) const { return bias + u.pn * BM; }
    __device__ __forceinline__ void operator()(const f32x4 (&acc)[2][2][4][2], const Unit& u, int wr, int wc, int fr, int fq, const PG8_LAS float* bl) const {
        const int row0 = u.pm * BM + wr * 64 + fr;
#pragma unroll
        for (int bj = 0; bj < 2; ++bj) {
            const int seg = u.pn * 2 + bj;
            if (seg >= 17) continue;
            const int cl0 = bj * HALF + wc * 32 + 8 * fq;
            const f32x4 b0 = *(const PG8_LAS f32x4*)(bl + cl0), b1 = *(const PG8_LAS f32x4*)(bl + cl0 + 4);
            if (seg == 16) {
                const int gi = wc * 32 + 8 * fq;
                if (gi < 24) {
#pragma unroll
                    for (int ai = 0; ai < 2; ++ai)
#pragma unroll
                        for (int m = 0; m < 4; ++m) {
                            const int row = row0 + ai * HALF + m * 16;
                            f32x4 v0 = acc[ai][bj][m][0] + b0, v1 = acc[ai][bj][m][1] + b1;
                            v0 = (f32x4){sigm(v0[0]), sigm(v0[1]), sigm(v0[2]), sigm(v0[3])};
                            v1 = (f32x4){sigm(v1[0]), sigm(v1[1]), sigm(v1[2]), sigm(v1[3])};
                            float* gp = gates + (size_t)row * 32 + gi;
                            *(f32x4*)gp = v0; *(f32x4*)(gp + 4) = v1;
                        }
                }
            } else {
                const bool rope_on = (ROPE_SEGS >> seg) & 1u;
                const bool qseg = seg < 4 || (seg >= 10 && seg <= 13);
                const int g = 4 * (wc & 1) + fq;
                const int hc = seg * 128 + (wc >> 1) * 64 + 4 * g;
#pragma unroll
                for (int ai = 0; ai < 2; ++ai)
#pragma unroll
                    for (int m = 0; m < 4; ++m) {
                        const int row = row0 + ai * HALF + m * 16;
                        f32x4 v0 = acc[ai][bj][m][0] + b0, v1 = acc[ai][bj][m][1] + b1;
                        if (rope_on) {
                            const f32x4 c = *(const f32x4*)(rope + (size_t)row * 64 + 4 * g), s = *(const f32x4*)(rope + (size_t)row * 64 + 32 + 4 * g);
                            const f32x4 o0 = v0 * c - v1 * s, o1 = v1 * c + v0 * s; v0 = o0; v1 = o1;
                        }
                        if (qseg) { v0 = v0 * QSCALE; v1 = v1 * QSCALE; }
                        u32x2 w0, w1; w0.x = cvt_pk_bf16(v0[0], v0[1]); w0.y = cvt_pk_bf16(v0[2], v0[3]); w1.x = cvt_pk_bf16(v1[0], v1[1]); w1.y = cvt_pk_bf16(v1[2], v1[3]);
                        bf16_t* hp = H + (size_t)row * 2048 + hc;
                        *(u32x2*)hp = w0; *(u32x2*)(hp + 32) = w1;
                    }
            }
        }
    }
};
struct EpiOut {
    static constexpr bool PERM = true, AFTER_DRAIN = false;
    bf16_t* y; const float* bias;
    __device__ __forceinline__ const float* bias_slice(const Unit& u) const { return bias + u.pn * BM; }
    __device__ __forceinline__ void operator()(const f32x4 (&acc)[2][2][4][2], const Unit& u, int wr, int wc, int fr, int fq, const PG8_LAS float* bl) const {
        const int row0 = u.pm * BM + wr * 64 + fr, col0 = u.pn * BM + wc * 32 + 8 * fq;
        f32x4 bv[2][2];
#pragma unroll
        for (int bj = 0; bj < 2; ++bj)
#pragma unroll
            for (int n = 0; n < 2; ++n) bv[bj][n] = *(const PG8_LAS f32x4*)(bl + wc * 32 + 8 * fq + bj * HALF + 4 * n);
#pragma unroll
        for (int ai = 0; ai < 2; ++ai)
#pragma unroll
            for (int m = 0; m < 4; ++m) {
                bf16_t* rowp = y + (size_t)(row0 + ai * HALF + m * 16) * 1024 + col0;
#pragma unroll
                for (int bj = 0; bj < 2; ++bj) {
                    const f32x4 v0 = acc[ai][bj][m][0] + bv[bj][0], v1 = acc[ai][bj][m][1] + bv[bj][1];
                    u32x4 w; w.x = cvt_pk_bf16(v0[0], v0[1]); w.y = cvt_pk_bf16(v0[2], v0[3]); w.z = cvt_pk_bf16(v1[0], v1[1]); w.w = cvt_pk_bf16(v1[2], v1[3]);
                    *(u32x4*)(rowp + bj * HALF) = w;
                }
            }
    }
};
template <bool F8OUT>
struct EpiUp {
    static constexpr bool PERM = true, AFTER_DRAIN = false;
    bf16_t* act; const float* b1p; float ascale;
    __device__ __forceinline__ const float* bias_slice(const Unit& u) const { return b1p + (size_t)(u.pn >> 3) * 2048 + (u.pn & 7) * BM; }
    __device__ __forceinline__ void operator()(const f32x4 (&acc)[2][2][4][2], const Unit& u, int wr, int wc, int fr, int fq, const PG8_LAS float* bl) const {
        const int pn = u.pn & 7;
        const int row0 = u.pm * BM + wr * 64 + fr, ac0 = pn * 128 + wc * 32 + 8 * fq;
        const PG8_LAS float* bp = bl + wc * 32 + 8 * fq;
        const f32x4 bg0 = *(const PG8_LAS f32x4*)bp, bg1 = *(const PG8_LAS f32x4*)(bp + 4), bu0 = *(const PG8_LAS f32x4*)(bp + HALF), bu1 = *(const PG8_LAS f32x4*)(bp + HALF + 4);
#pragma unroll
        for (int ai = 0; ai < 2; ++ai)
#pragma unroll
            for (int m = 0; m < 4; ++m) {
                const f32x4 g0 = acc[ai][0][m][0] * ascale + bg0, g1 = acc[ai][0][m][1] * ascale + bg1, u0 = acc[ai][1][m][0] * ascale + bu0, u1 = acc[ai][1][m][1] * ascale + bu1;
                float o[8];
#pragma unroll
                for (int j = 0; j < 8; ++j) {
                    float gt = j < 4 ? g0[j & 3] : g1[j & 3], up = j < 4 ? u0[j & 3] : u1[j & 3];
                    gt = fminf(gt, 7.0f); up = fminf(fmaxf(up, -7.0f), 7.0f);
                    o[j] = (up + 1.0f) * gt * sigm(1.702f * gt);
                }
                if constexpr (F8OUT) {
                    int w0 = 0, w1 = 0;
                    w0 = __builtin_amdgcn_cvt_pk_fp8_f32(o[0], o[1], w0, false); w0 = __builtin_amdgcn_cvt_pk_fp8_f32(o[2], o[3], w0, true);
                    w1 = __builtin_amdgcn_cvt_pk_fp8_f32(o[4], o[5], w1, false); w1 = __builtin_amdgcn_cvt_pk_fp8_f32(o[6], o[7], w1, true);
                    u32x2 w; w.x = (unsigned)w0; w.y = (unsigned)w1;
                    *(u32x2*)((unsigned char*)act + (size_t)(row0 + ai * HALF + m * 16) * 1024 + ac0) = w;
                } else {
                    u32x4 w; w.x = cvt_pk_bf16(o[0], o[1]); w.y = cvt_pk_bf16(o[2], o[3]); w.z = cvt_pk_bf16(o[4], o[5]); w.w = cvt_pk_bf16(o[6], o[7]);
                    *(u32x4*)(act + (size_t)(row0 + ai * HALF + m * 16) * 1024 + ac0) = w;
                }
                asm volatile("" ::: "memory");
            }
    }
};
template <bool F8OUT>
struct EpiDown {
    static constexpr bool PERM = true, AFTER_DRAIN = false;
    bf16_t* ys; const float* b2; float ascale;
    __device__ __forceinline__ const float* bias_slice(const Unit& u) const { return b2 + (size_t)(u.pn >> 2) * 1024 + (u.pn & 3) * BM; }
    __device__ __forceinline__ void operator()(const f32x4 (&acc)[2][2][4][2], const Unit& u, int wr, int wc, int fr, int fq, const PG8_LAS float* bl) const {
        const int pn = u.pn & 3;
        const int row0 = u.pm * BM + wr * 64 + fr, col0 = pn * BM + wc * 32 + 8 * fq;
        f32x4 bv[2][2];
#pragma unroll
        for (int bj = 0; bj < 2; ++bj)
#pragma unroll
            for (int n = 0; n < 2; ++n) bv[bj][n] = *(const PG8_LAS f32x4*)(bl + wc * 32 + 8 * fq + bj * HALF + 4 * n);
#pragma unroll
        for (int ai = 0; ai < 2; ++ai)
#pragma unroll
            for (int m = 0; m < 4; ++m) {
                bf16_t* rowp = ys + (size_t)(row0 + ai * HALF + m * 16) * 1024 + col0;
#pragma unroll
                for (int bj = 0; bj < 2; ++bj) {
                    const f32x4 v0 = acc[ai][bj][m][0] * ascale + bv[bj][0], v1 = acc[ai][bj][m][1] * ascale + bv[bj][1];
                    if constexpr (F8OUT) {
                        int w0 = 0, w1 = 0;
                        w0 = __builtin_amdgcn_cvt_pk_fp8_f32(v0[0], v0[1], w0, false); w0 = __builtin_amdgcn_cvt_pk_fp8_f32(v0[2], v0[3], w0, true);
                        w1 = __builtin_amdgcn_cvt_pk_fp8_f32(v1[0], v1[1], w1, false); w1 = __builtin_amdgcn_cvt_pk_fp8_f32(v1[2], v1[3], w1, true);
                        u32x2 w; w.x = (unsigned)w0; w.y = (unsigned)w1;
                        *(u32x2*)((unsigned char*)ys + (size_t)(row0 + ai * HALF + m * 16) * 1024 + col0 + bj * HALF) = w;
                    } else {
                        u32x4 w; w.x = cvt_pk_bf16(v0[0], v0[1]); w.y = cvt_pk_bf16(v0[2], v0[3]); w.z = cvt_pk_bf16(v1[0], v1[1]); w.w = cvt_pk_bf16(v1[2], v1[3]);
                        *(u32x4*)(rowp + bj * HALF) = w;
                    }
                }
            }
    }
};
struct EpiPlain {
    static constexpr bool PERM = true, AFTER_DRAIN = false;
    bf16_t* O;
    __device__ __forceinline__ const float* bias_slice(const Unit&) const { return nullptr; }
    __device__ __forceinline__ void operator()(const f32x4 (&acc)[2][2][4][2], const Unit& u, int wr, int wc, int fr, int fq, const PG8_LAS float*) const {
        const int row0 = u.pm * BM + wr * 64 + fr, col0 = u.pn * BM + wc * 32 + 8 * fq;
#pragma unroll
        for (int ai = 0; ai < 2; ++ai)
#pragma unroll
            for (int m = 0; m < 4; ++m) {
                bf16_t* rowp = O + (size_t)(row0 + ai * HALF + m * 16) * 1024 + col0;
#pragma unroll
                for (int bj = 0; bj < 2; ++bj) {
                    const f32x4 v0 = acc[ai][bj][m][0], v1 = acc[ai][bj][m][1];
                    u32x4 w; w.x = cvt_pk_bf16(v0[0], v0[1]); w.y = cvt_pk_bf16(v0[2], v0[3]); w.z = cvt_pk_bf16(v1[0], v1[1]); w.w = cvt_pk_bf16(v1[2], v1[3]);
                    *(u32x4*)(rowp + bj * HALF) = w;
                }
            }
    }
};
struct EpiGate {
    static constexpr bool PERM = true, AFTER_DRAIN = false;
    const bf16_t* PP; bf16_t* E; const float* bias; float ascale;
    __device__ __forceinline__ const float* bias_slice(const Unit& u) const { return bias + u.pn * BM; }
    __device__ __forceinline__ void operator()(const f32x4 (&acc)[2][2][4][2], const Unit& u, int wr, int wc, int fr, int fq, const PG8_LAS float* bl) const {
        const int row0 = u.pm * BM + wr * 64 + fr, col0 = u.pn * BM + wc * 32 + 8 * fq;
        f32x4 bv[2][2];
#pragma unroll
        for (int bj = 0; bj < 2; ++bj)
#pragma unroll
            for (int n = 0; n < 2; ++n) bv[bj][n] = *(const PG8_LAS f32x4*)(bl + wc * 32 + 8 * fq + bj * HALF + 4 * n);
#pragma unroll
        for (int ai = 0; ai < 2; ++ai)
#pragma unroll
            for (int m = 0; m < 4; ++m) {
                const size_t off = (size_t)(row0 + ai * HALF + m * 16) * 1024 + col0;
#pragma unroll
                for (int bj = 0; bj < 2; ++bj) {
                    const u32x4 pv = *(const u32x4*)(PP + off + bj * HALF);
                    const f32x4 v0 = acc[ai][bj][m][0] * ascale + bv[bj][0], v1 = acc[ai][bj][m][1] * ascale + bv[bj][1];
                    u32x4 w;
                    w.x = cvt_pk_bf16(sigm(v0[0]) * bf_lo(pv.x), sigm(v0[1]) * bf_hi(pv.x)); w.y = cvt_pk_bf16(sigm(v0[2]) * bf_lo(pv.y), sigm(v0[3]) * bf_hi(pv.y));
                    w.z = cvt_pk_bf16(sigm(v1[0]) * bf_lo(pv.z), sigm(v1[1]) * bf_hi(pv.z)); w.w = cvt_pk_bf16(sigm(v1[2]) * bf_lo(pv.w), sigm(v1[3]) * bf_hi(pv.w));
                    *(u32x4*)(E + off + bj * HALF) = w;
                }
            }
    }
};
struct MoeOrder {
    const PG8_LAS int* tile_e; int nunits, lnt, G, c;
    const PG8_LAS int* tst; const PG8_LAS int* cnt; const int* list; int list_pitch;
    __device__ __forceinline__ const int* row_src(const Unit& u) const { const int e = tile_e[u.pm]; return list + (size_t)e * list_pitch + (u.pm - tst[e]) * 256; }
    __device__ __forceinline__ int nvalid(const Unit& u) const { const int e = tile_e[u.pm]; return cnt[e] - (u.pm - tst[e]) * 256; }
    __device__ __forceinline__ bool next(int i, Unit& u) const {
        const int L = i * G + c; if (L >= nunits) return false;
        const int mt = L >> lnt, pn = L & ((1 << lnt) - 1);
        u.pm = mt; u.pn = (tile_e[mt] << lnt) + pn; return true;
    }
    __device__ __forceinline__ void a_ready(const Unit&) const {}
    __device__ __forceinline__ void done(const Unit&) const {}
};

template <class Epi, class Sched, bool ALIGN_EPI = false, bool SP2 = false, bool F8 = false, bool GATHER = false>
__device__ __forceinline__ void gemm_phase(PG8_LAS unsigned char* lds, const Gemm g, const Sched& S, const Epi& E, const int wave_id, PG8_LAS float* biasl, PG8_LAS int* tokl = nullptr) {
    static_assert(!GATHER || SP2, "the gathered-A form is written for the SP2 loop");
    int tid_l = wave_id * 64 + (int)__builtin_amdgcn_mbcnt_hi(~0u, __builtin_amdgcn_mbcnt_lo(~0u, 0u)); asm volatile("" : "+v"(tid_l));     const int tid = tid_l, wid = __builtin_amdgcn_readfirstlane(tid >> 6), lane = tid & 63, wr = wid >> 2, wc = wid & 3, fr = lane & 15, fq = lane >> 4;
    int K_l = g.K; asm volatile("" : "+s"(K_l)); const int K = K_l, nt = K / BK;
    unsigned voffA[2], voffB[2];
    unsigned voffG[2][2] = {{0u, 0u}, {0u, 0u}};
#pragma unroll
    for (int i = 0; i < 2; ++i) { int R, C; stage_rc(tid * 16 + i * 8192, R, C); const int Rb = Epi::PERM ? ((R & ~31) + perm32(R & 31)) : R;
        voffA[i] = (unsigned)(R * K + C) * 2u; voffB[i] = (unsigned)(Rb * K + C) * 2u; }
    const size_t kstep = (size_t)(BK * 2);
    const size_t hstep = (size_t)HALF * K * 2;
    const size_t tstep = 2 * hstep;
    const unsigned ldsw = (unsigned)wid * 1024u;
    const int aoff = lds_byte(wr * 64 + fr, fq * 8), boff = lds_byte(wc * 32 + fr, fq * 8);
#define PG8_SA(b, h) (((b) * 2 + (h)) * HTB)
#define PG8_SB(b, h) ((4 + (b) * 2 + (h)) * HTB)
#define PG8_STAGE(bufoff, gbase, voff) do { _Pragma("unroll") for (int _i = 0; _i < 2; ++_i) \
        __builtin_amdgcn_global_load_lds((const unsigned*)((const char*)(gbase) + (voff)[_i]), (PG8_LAS unsigned*)(lds + (bufoff) + ldsw + _i * 8192), 16, 0, 0); } while (0)
#define PG8_STAGE_A(bufoff, base, h) do { if constexpr (GATHER) { PG8_STAGE(bufoff, base, voffG[h]); } else { PG8_STAGE(bufoff, (base) + (h) * hstep, voffA); } } while (0)
#define PG8_TOKSTAGE(u_, slot_) do { if (wid == 0) { const int* rp_ = S.row_src(u_); __builtin_amdgcn_global_load_lds((const unsigned*)(rp_ + lane * 4), (PG8_LAS unsigned*)(tokl + (slot_) * 256), 16, 0, 0); } } while (0)
#define PG8_TOKSET(slot_, nv_) do { const int nvv_ = (nv_); _Pragma("unroll") for (int h_ = 0; h_ < 2; ++h_) _Pragma("unroll") for (int i_ = 0; i_ < 2; ++i_) { int R_, C_; stage_rc(tid * 16 + i_ * 8192, R_, C_); \
        const int r_ = h_ * HALF + R_; int tk_ = tokl[(slot_) * 256 + r_]; tk_ = (r_ < nvv_ && tk_ >= 0 && tk_ < g.M) ? tk_ : 0; voffG[h_][i_] = (unsigned)tk_ * (unsigned)(K * 2) + (unsigned)(C_ * 2); } } while (0)
#define PG8_LDA(dst, b, h) do { _Pragma("unroll") for (int m = 0; m < 4; ++m) _Pragma("unroll") for (int k = 0; k < 2; ++k) dst[m][k] = *(const PG8_LAS bf16x8*)(lds + PG8_SA(b, h) + aoff + m * 2048 + k * 1024); } while (0)
#define PG8_LDB(dst, b, h) do { _Pragma("unroll") for (int n = 0; n < 2; ++n) _Pragma("unroll") for (int k = 0; k < 2; ++k) dst[n][k] = *(const PG8_LAS bf16x8*)(lds + PG8_SB(b, h) + boff + n * 2048 + k * 1024); } while (0)
#define PG8_MMA(ai, bj, At, Bt) do { __builtin_amdgcn_s_setprio(1); _Pragma("unroll") for (int m = 0; m < 4; ++m) _Pragma("unroll") for (int n = 0; n < 2; ++n) { \
        if constexpr (F8) { typedef int i32x4_ __attribute__((ext_vector_type(4))); \
              \
            asm volatile("v_mfma_f32_16x16x128_f8f6f4 %0, %1, %2, %0" : "+v"(acc[ai][bj][m][n]) : "v"(__builtin_shufflevector(__builtin_bit_cast(i32x4_, Bt[n][0]), __builtin_bit_cast(i32x4_, Bt[n][1]), 0, 1, 2, 3, 4, 5, 6, 7)), \
                "v"(__builtin_shufflevector(__builtin_bit_cast(i32x4_, At[m][0]), __builtin_bit_cast(i32x4_, At[m][1]), 0, 1, 2, 3, 4, 5, 6, 7))); } \
        else { _Pragma("unroll") for (int k = 0; k < 2; ++k) acc[ai][bj][m][n] = __builtin_amdgcn_mfma_f32_16x16x32_bf16(Bt[n][k], At[m][k], acc[ai][bj][m][n], 0, 0, 0); } } \
        __builtin_amdgcn_s_setprio(0); } while (0)
#define PG8_WAIT_V(n) asm volatile("s_waitcnt vmcnt(" #n ")" ::: "memory")
#define PG8_WAIT_L(n) asm volatile("s_waitcnt lgkmcnt(" #n ")" ::: "memory")
#define PG8_BAR __builtin_amdgcn_s_barrier()
#define PG8_SCHED __builtin_amdgcn_sched_barrier(0)
    Unit cur, nxt; int ui = 0;
    if (!S.next(0, cur)) return;
#define PG8_BIAS(u_, slot_) do { if (wid == 0) { const float* bp_ = E.bias_slice(u_); if (bp_) __builtin_amdgcn_global_load_lds((const unsigned*)(bp_ + lane * 4), (PG8_LAS unsigned*)(biasl + (slot_) * 256), 16, 0, 0); } } while (0)
    PG8_BIAS(cur, 0);
    if constexpr (GATHER) { PG8_TOKSTAGE(cur, 0); asm volatile("s_waitcnt vmcnt(0)" ::: "memory"); __builtin_amdgcn_s_barrier(); asm volatile("" ::: "memory"); PG8_TOKSET(0, S.nvalid(cur)); }
    f32x4 acc[2][2][4][2];
#pragma unroll
    for (int a = 0; a < 2; ++a)
#pragma unroll
        for (int b = 0; b < 2; ++b)
#pragma unroll
            for (int m = 0; m < 4; ++m)
#pragma unroll
                for (int n = 0; n < 2; ++n) acc[a][b][m][n] = (f32x4){0.f, 0.f, 0.f, 0.f};
    bf16x8 At[4][2], B0[2][2], B1[2][2];
    const char* cA = (const char*)g.A + (GATHER ? (size_t)0 : (size_t)cur.pm * tstep); const char* cB = (const char*)g.Bt + (size_t)cur.pn * tstep;
    S.a_ready(cur);
    if constexpr (SP2) {
        PG8_STAGE(PG8_SB(0, 0), cB, voffB); PG8_STAGE(PG8_SB(0, 1), cB + hstep, voffB); PG8_STAGE_A(PG8_SA(0, 0), cA, 0); PG8_STAGE_A(PG8_SA(0, 1), cA, 1);
        if (wr == 1) PG8_BAR;
        PG8_WAIT_V(2); PG8_BAR;
        PG8_STAGE(PG8_SB(1, 0), cB + kstep, voffB); PG8_STAGE_A(PG8_SA(1, 0), cA + kstep, 0); PG8_STAGE(PG8_SB(1, 1), cB + hstep + kstep, voffB);
        PG8_WAIT_V(6); PG8_BAR;
    } else {
        PG8_STAGE(PG8_SB(0, 0), cB, voffB); PG8_STAGE_A(PG8_SA(0, 0), cA, 0); PG8_STAGE(PG8_SB(0, 1), cB + hstep, voffB); PG8_STAGE_A(PG8_SA(0, 1), cA, 1);
        if (wr == 1) PG8_BAR;
        PG8_WAIT_V(4); PG8_BAR;
        PG8_STAGE(PG8_SB(1, 0), cB + kstep, voffB); PG8_STAGE_A(PG8_SA(1, 0), cA + kstep, 0); PG8_STAGE(PG8_SB(1, 1), cB + hstep + kstep, voffB);
        PG8_WAIT_V(6); PG8_BAR;
    }
    for (;;) {
        const bool has_next = S.next(ui + 1, nxt);
        const char* nA = (has_next && !GATHER) ? (const char*)g.A + (size_t)nxt.pm * tstep : cA;
        if constexpr (GATHER) { if (has_next) PG8_TOKSTAGE(nxt, (ui + 1) & 1); } const char* nB = has_next ? (const char*)g.Bt + (size_t)nxt.pn * tstep : cB;
        for (int t = 0; t < nt; t += 2) {
            const bool last = (t == nt - 2);
            const char* a1 = cA + (size_t)(t + 1) * kstep;
            const char* a2 = last ? nA : cA + (size_t)(t + 2) * kstep; const char* b2 = last ? nB : cB + (size_t)(t + 2) * kstep;
            const char* a3 = a2 + kstep; const char* b3 = b2 + kstep;
            if (last && has_next) S.a_ready(nxt);
            if constexpr (SP2) {
            PG8_LDB(B0, 0, 0); PG8_LDB(B1, 0, 1); PG8_SCHED; PG8_LDA(At, 0, 0); PG8_STAGE_A(PG8_SA(1, 1), a1, 1);
            if constexpr (GATHER) { if (last && has_next) PG8_TOKSET((ui + 1) & 1, S.nvalid(nxt)); }
            PG8_WAIT_V(8); PG8_WAIT_L(0); PG8_BAR; PG8_MMA(0, 0, At, B0); PG8_MMA(0, 1, At, B1); PG8_BAR; PG8_SCHED;
            PG8_LDA(At, 0, 1); PG8_STAGE(PG8_SB(0, 0), b2, voffB); PG8_STAGE(PG8_SB(0, 1), b2 + hstep, voffB); PG8_STAGE_A(PG8_SA(0, 0), a2, 0);
            PG8_WAIT_V(8); PG8_WAIT_L(0); PG8_BAR; PG8_MMA(1, 0, At, B0); PG8_MMA(1, 1, At, B1); PG8_BAR; PG8_SCHED;
            PG8_LDB(B0, 1, 0); PG8_LDB(B1, 1, 1); PG8_SCHED; PG8_LDA(At, 1, 0); PG8_STAGE_A(PG8_SA(0, 1), a2, 1);
            PG8_WAIT_V(8); PG8_WAIT_L(0); PG8_BAR; PG8_MMA(0, 0, At, B0); PG8_MMA(0, 1, At, B1); PG8_BAR; PG8_SCHED;
            PG8_LDA(At, 1, 1); PG8_STAGE(PG8_SB(1, 0), b3, voffB); PG8_STAGE(PG8_SB(1, 1), b3 + hstep, voffB); PG8_STAGE_A(PG8_SA(1, 0), a3, 0);
            PG8_WAIT_V(8); PG8_WAIT_L(0); PG8_BAR; PG8_MMA(1, 0, At, B0); PG8_MMA(1, 1, At, B1); PG8_BAR; PG8_SCHED;
            } else {
            PG8_LDB(B0, 0, 0); PG8_SCHED; PG8_LDA(At, 0, 0); PG8_STAGE_A(PG8_SA(1, 1), a1, 1);
            PG8_WAIT_L(8); PG8_BAR; PG8_WAIT_L(0); PG8_MMA(0, 0, At, B0); PG8_BAR; PG8_SCHED;
            PG8_LDB(B1, 0, 1); PG8_STAGE(PG8_SB(0, 0), b2, voffB);
            PG8_BAR; PG8_WAIT_L(0); PG8_MMA(0, 1, At, B1); PG8_BAR;
            PG8_LDA(At, 0, 1); PG8_STAGE_A(PG8_SA(0, 0), a2, 0);
            PG8_BAR; PG8_WAIT_L(0); PG8_MMA(1, 0, At, B0); PG8_BAR; PG8_SCHED;
            PG8_STAGE(PG8_SB(0, 1), b2 + hstep, voffB);
            PG8_WAIT_V(6); PG8_BAR; PG8_MMA(1, 1, At, B1); PG8_BAR;
            PG8_LDB(B0, 1, 0); PG8_SCHED; PG8_LDA(At, 1, 0); PG8_STAGE_A(PG8_SA(0, 1), a2, 1);
            PG8_WAIT_L(8); PG8_BAR; PG8_WAIT_L(0); PG8_MMA(0, 0, At, B0); PG8_BAR; PG8_SCHED;
            PG8_LDB(B1, 1, 1); PG8_STAGE(PG8_SB(1, 0), b3, voffB);
            PG8_BAR; PG8_WAIT_L(0); PG8_MMA(0, 1, At, B1); PG8_BAR;
            PG8_LDA(At, 1, 1); PG8_STAGE_A(PG8_SA(1, 0), a3, 0);
            PG8_BAR; PG8_WAIT_L(0); PG8_MMA(1, 0, At, B0); PG8_BAR; PG8_SCHED;
            PG8_STAGE(PG8_SB(1, 1), b3 + hstep, voffB);
            PG8_WAIT_V(6); PG8_BAR; PG8_MMA(1, 1, At, B1); PG8_BAR;
            }
        }
        if constexpr (F8) { asm volatile("s_nop 7\n\ts_nop 7\n\ts_nop 7\n\ts_nop 7" ::: "memory"); }
        if constexpr (ALIGN_EPI) { if (wr == 0) PG8_BAR; }
        if constexpr (!Epi::AFTER_DRAIN) { E(acc, cur, wr, wc, fr, fq, biasl + (ui & 1) * 256); S.done(cur); }
        if (!has_next) break;
#pragma unroll
        for (int a = 0; a < 2; ++a)
#pragma unroll
            for (int b = 0; b < 2; ++b)
#pragma unroll
                for (int m = 0; m < 4; ++m)
#pragma unroll
                    for (int n = 0; n < 2; ++n) acc[a][b][m][n] = (f32x4){0.f, 0.f, 0.f, 0.f};
        cur = nxt; cA = nA; cB = nB; ++ui;
        PG8_BIAS(cur, ui & 1);
        if constexpr (ALIGN_EPI) { if (wr == 1) PG8_BAR; }
    }
    PG8_WAIT_V(0);
    if constexpr (!ALIGN_EPI) { if (wr == 0) PG8_BAR; }
    PG8_BAR;
    if constexpr (Epi::AFTER_DRAIN) { E.fused(acc, cur, wr, wc, fr, fq, lds, wid, lane); S.done(cur); }
#undef PG8_SA
#undef PG8_SB
#undef PG8_STAGE
#undef PG8_LDA
#undef PG8_LDB
#undef PG8_MMA
#undef PG8_WAIT_V
#undef PG8_WAIT_L
#undef PG8_BAR
#undef PG8_SCHED
#undef PG8_BIAS
#undef PG8_STAGE_A
#undef PG8_TOKSTAGE
#undef PG8_TOKSET
}
}

constexpr int NWAVES = 8;
constexpr int NB = 16, T = 2048, D = 1024, M = NB * T, NL = 2;
constexpr int HP = 2048;
constexpr int NIN = 2304;
constexpr int PD = 256;
constexpr int NE = 32, TOPK = 4;
constexpr int MAXTILES = (M * TOPK) / 256 + NE;
constexpr int MAXSLOTS = MAXTILES * 256;
constexpr float LN_EPS = 1e-5f;
constexpr float DN_ALPHA = 1.4142135623730951f;
constexpr float SC_LOG2E = 0.125f * 1.4426950408889634f;
constexpr int C_QN = 0, C_KC = 512, C_VC = 640, C_KS = 768, C_VS = 896, C_KW = 1024, C_VW = 1152, C_QS = 1280, C_KSW = 1792, C_VSW = 1920;

constexpr size_t MiB = 1u << 20;
constexpr size_t WS_CTL = 0, CTL_ZERO_BYTES = 32768;
constexpr size_t WS_WIN = 2 * MiB;
constexpr size_t WS_WO = 12 * MiB;
constexpr size_t WS_WPG = 16 * MiB;
constexpr size_t WS_WPP = 20 * MiB;
constexpr size_t WS_WC1 = 22 * MiB;
constexpr size_t WS_WC2 = 26 * MiB;
constexpr size_t WS_WR = 27 * MiB;
constexpr size_t WS_BINP = 28 * MiB;
constexpr size_t WS_PBIAS = 28 * MiB + 32768;
constexpr size_t WS_B1P = 28 * MiB + 65536;
constexpr size_t WS_ROPE = 30 * MiB;
constexpr size_t WS_GATES = 38 * MiB;
constexpr size_t WS_KCMP = 42 * MiB;
constexpr size_t WS_VCMP = 42 * MiB + 512 * 1024;
constexpr size_t WS_TOKE = 43 * MiB;
constexpr size_t WS_TOKR = 43 * MiB + 512 * 1024;
constexpr size_t WS_TOKW = 44 * MiB;
constexpr size_t WS_SLOT = 44 * MiB + 512 * 1024;
constexpr size_t WS_W1T = 48 * MiB;
constexpr size_t WS_W2T = 304 * MiB;
constexpr size_t WS_XB = 432 * MiB;
constexpr size_t WS_PB = 496 * MiB;
constexpr size_t WS_R1 = 528 * MiB;
constexpr size_t WS_H = WS_R1, WS_O = WS_R1 + 128 * MiB, WS_YS = WS_R1;
constexpr size_t WS_LIST = WS_R1;

constexpr size_t WS_R2 = 808 * MiB;
constexpr size_t WS_Y1 = WS_R2, WS_ACT = WS_R2;
constexpr size_t WS_X1 = 1080 * MiB;
constexpr size_t WS_X1B = 1208 * MiB;
constexpr size_t WS_PP = 1272 * MiB;
constexpr size_t WS_E = 1336 * MiB;
constexpr size_t WS_XN = 1400 * MiB;
constexpr size_t WS_X1F8 = WS_XB;
constexpr size_t WS_END = 1528 * MiB;
static_assert((size_t)MAXSLOTS * 2048 <= 272 * MiB, "slot buffers");
constexpr int CW_TMO = 0, CW_CODE = 1;
constexpr int CW_CNT = 1024;
constexpr int CW_BAR = 4096;

constexpr int RING_OFF = 0, RING_BYTES = 131072;
constexpr int SCRATCH_BYTES = 139264;
constexpr int LDSCTL_OFF = SCRATCH_BYTES, MISC_OFF = LDSCTL_OFF + 320;
constexpr int TAB_OFF = MISC_OFF + 128;
constexpr int TAB_CNT = TAB_OFF, TAB_SOFF = TAB_OFF + 128, TAB_TST = TAB_OFF + 256, TAB_TE = TAB_OFF + 512;
constexpr int BIAS_OFF = 143360;
constexpr int TOKL_OFF = BIAS_OFF + 2048;
constexpr int LDS_BYTES = 147456;
static_assert(TAB_TE + MAXTILES * 4 <= BIAS_OFF && TOKL_OFF + 2048 <= LDS_BYTES, "LDS map");

static_assert((CW_BAR + 3456) * 4 <= (int)CTL_ZERO_BYTES && (CW_CNT + NL * 32) * 4 <= (int)CTL_ZERO_BYTES, "control words inside the memset region");
#define GAS __attribute__((address_space(1)))
#define LAS __attribute__((address_space(3)))
typedef unsigned short bf16;
typedef unsigned v4u __attribute__((ext_vector_type(4)));
typedef float f32x4 __attribute__((ext_vector_type(4)));
typedef short bf16x8 __attribute__((ext_vector_type(8)));
typedef GAS unsigned gu32;
typedef GAS unsigned long long gu64;
#define RLX_AGENT __ATOMIC_RELAXED, __HIP_MEMORY_SCOPE_AGENT
#define LDS_WAIT() asm volatile("s_waitcnt lgkmcnt(0)" ::: "memory")
#define VM_WAIT() asm volatile("s_waitcnt vmcnt(0)" ::: "memory")
__device__ __forceinline__ unsigned long long rt() { return __builtin_amdgcn_s_memrealtime(); }
__device__ __forceinline__ unsigned f2bf(float f) { unsigned u = __builtin_bit_cast(unsigned, f); return (u + 0x7fffu + ((u >> 16) & 1u)) >> 16; }
__device__ __forceinline__ unsigned pk2(float lo, float hi) { return f2bf(lo) | (f2bf(hi) << 16); }
#define XB_TMO      128
#define XB_XCNT(j)  (256  + 64 * (j))
#define XB_XSUB(j)  (1280 + 64 * (j))
#define XB_XGEN(j)  (2304 + 64 * (j))
#define XB_TOP      3328
#define XB_TOPGEN   3392
#define XCD_BAR_WORDS 3456
#define XB_SPIN_CAP (1u << 22)

__device__ __forceinline__ unsigned xb_ld(unsigned* p)              { return __hip_atomic_load(p, __ATOMIC_RELAXED, __HIP_MEMORY_SCOPE_AGENT); }
__device__ __forceinline__ unsigned xb_add(unsigned* p, unsigned v) { return __hip_atomic_fetch_add(p, v, __ATOMIC_RELAXED, __HIP_MEMORY_SCOPE_AGENT); }
__device__ __forceinline__ unsigned xb_xcc_id() { return (unsigned)__builtin_amdgcn_s_getreg((3 << 11) | 20) & 0xFu; }
#define XB_SPIN(cond, bar) do { unsigned _sp = 0; while (cond) { __builtin_amdgcn_s_sleep(1); \
    if ((++_sp & 255u) == 0u) { if (xb_ld(&(bar)[XB_TMO])) break; if (_sp > XB_SPIN_CAP) { atomicAdd(&(bar)[XB_TMO], 1u); break; } } } } while (0)

struct XcdBarrier {
    unsigned* bar; unsigned x; int wave;
    volatile LAS unsigned* st;
};

__device__ __forceinline__ bool xb_thread0(int wave) { return wave == 0 && __builtin_amdgcn_mbcnt_hi(~0u, __builtin_amdgcn_mbcnt_lo(~0u, 0u)) == 0u; }
__device__ __forceinline__ XcdBarrier xcd_barrier_post(unsigned* bar, volatile LAS unsigned* st, int wave) {
    XcdBarrier b; b.bar = bar; b.x = xb_xcc_id(); b.st = st; b.wave = wave;
    if (xb_thread0(wave)) (void)xb_add(&bar[XB_XCNT(b.x)], 1u);
    return b;
}
__device__ __forceinline__ void xcd_barrier_complete(unsigned* bar, unsigned x, unsigned& nloc, unsigned& nx) {
    const unsigned G = gridDim.x * gridDim.y * gridDim.z;
    unsigned sum, cnt, mine, sp = 0u;
    for (;;) {
        sum = 0u; cnt = 0u; mine = 0u;
#pragma unroll
        for (unsigned j = 0; j < 16; ++j) { const unsigned c = xb_ld(&bar[XB_XCNT(j)]); sum += c; cnt += (c > 0u) ? 1u : 0u; mine = (j == x) ? c : mine; }
        if (sum == G) break;
        __builtin_amdgcn_s_sleep(1);
        if ((++sp & 255u) == 0u) { if (xb_ld(&bar[XB_TMO])) break; if (sp > XB_SPIN_CAP) { atomicAdd(&bar[XB_TMO], 1u); break; } }
    }
    nloc = mine > 0u ? mine : 1u; nx = cnt > 0u ? cnt : 1u;
}

__device__ __forceinline__ void xcd_barrier(const XcdBarrier& b) {
    asm volatile("s_waitcnt vmcnt(0)" ::: "memory");
    __syncthreads();
    if (xb_thread0(b.wave)) {
        unsigned* bar = b.bar;
        __builtin_amdgcn_s_waitcnt(0);
        unsigned nloc = b.st[0], nx = b.st[1];
        if (nloc == 0u) { xcd_barrier_complete(bar, b.x, nloc, nx); b.st[0] = nloc; b.st[1] = nx; }
        const unsigned old = xb_add(&bar[XB_XSUB(b.x)], 1u);
        const unsigned gen = old / nloc;
        if (old + 1u == (gen + 1u) * nloc) {
            __builtin_amdgcn_fence(__ATOMIC_RELEASE, "agent");
            asm volatile("s_waitcnt vmcnt(0)" ::: "memory");
            const unsigned og = xb_add(&bar[XB_TOP], 1u);
            const unsigned tg = og / nx;
            if (og + 1u == (tg + 1u) * nx) xb_add(&bar[XB_TOPGEN], 1u);
            else XB_SPIN(xb_ld(&bar[XB_TOPGEN]) == tg, bar);
            __builtin_amdgcn_fence(__ATOMIC_ACQUIRE, "agent");
            xb_add(&bar[XB_XGEN(b.x)], 1u);
            asm volatile("s_waitcnt vmcnt(0)" ::: "memory");
        } else {
            XB_SPIN(xb_ld(&bar[XB_XGEN(b.x)]) == gen, bar);
            __builtin_amdgcn_fence(__ATOMIC_ACQUIRE, "agent");
            asm volatile("s_waitcnt vmcnt(0)" ::: "memory");
        }
    }
    __syncthreads();
}

typedef float f32x16 __attribute__((ext_vector_type(16)));
typedef unsigned u32x2 __attribute__((ext_vector_type(2)));
struct Frame {
    LAS unsigned char* lds;
    volatile LAS unsigned* MISC;
    gu32* ctl;
    unsigned char* ws;
    int tid, lane, wave;
    int vcu, G;
};
__device__ __forceinline__ float wave_sum(float v) {
#pragma unroll
    for (int o = 1; o < 64; o <<= 1) v += __shfl_xor(v, o);
    return v;
}
__device__ __forceinline__ float sigm(float x) { return __builtin_amdgcn_rcpf(1.0f + __builtin_amdgcn_exp2f(-1.4426950408889634f * x)); }
__device__ __forceinline__ float bf_lo(unsigned w) { return __uint_as_float(w << 16); }
__device__ __forceinline__ float bf_hi(unsigned w) { return __uint_as_float(w & 0xffff0000u); }
__device__ __forceinline__ unsigned cvtpk(float lo, float hi) { typedef float f2 __attribute__((ext_vector_type(2))); typedef __bf16 b2 __attribute__((ext_vector_type(2))); f2 v = {lo, hi}; b2 b = __builtin_convertvector(v, b2); return __builtin_bit_cast(unsigned, b); }
__device__ __forceinline__ bf16x8 pack8(float a0, float a1, float a2, float a3, float a4, float a5, float a6, float a7) {
    v4u w; w.x = cvtpk(a0, a1); w.y = cvtpk(a2, a3); w.z = cvtpk(a4, a5); w.w = cvtpk(a6, a7); return __builtin_bit_cast(bf16x8, w);
}
__device__ __forceinline__ int crow(int r, int hi) { return (r & 3) + 8 * (r >> 2) + 4 * hi; }

struct MapId { __device__ __forceinline__ int operator()(int n) const { return n; } };
struct MapW1 { __device__ __forceinline__ int operator()(int n) const { return ((n >> 7) & 1) * 1024 + (n >> 8) * 128 + (n & 127); } };
struct MapWin {
    __device__ __forceinline__ int operator()(int n) const {
        if (n >= 2048) { const int i = n - 2048; return i < 24 ? 1280 + i : -1; }
        const int seg = n >> 7, q = n & 127, hd = q >> 6, pos = q & 63, g = pos >> 3, j = pos & 7;
        const int dlog = j < 4 ? 4 * g + j : 32 + 4 * g + (j - 4);
        const int hc = seg * 128 + hd * 64 + dlog;
        return hc < 1280 ? hc : hc + 24;
    }
};
template <class Map>
__device__ __forceinline__ void transpose_item(const float* W, int K, int Nsrc, bf16* WT, LAS float* scr, int kb, int nb, int lane, Map map) {
    const int k0 = 64 * kb, n0 = 32 * nb;
    const int src = map(n0 + (lane & 31));
    float wv[32];
#pragma unroll
    for (int i = 0; i < 32; ++i) { const int kk = 2 * i + (lane >> 5); wv[i] = src >= 0 ? W[(size_t)(k0 + kk) * Nsrc + src] : 0.f; }
#pragma unroll
    for (int i = 0; i < 32; ++i) { const int kk = 2 * i + (lane >> 5); scr[kk * 33 + (lane & 31)] = wv[i]; }
    LDS_WAIT(); asm volatile("" ::: "memory");
    const int c = lane & 7;
#pragma unroll
    for (int j = 0; j < 4; ++j) { const int n = (lane >> 3) + 8 * j; const LAS float* s = scr + (8 * c) * 33 + n;
        v4u o; o.x = pk2(s[0 * 33], s[1 * 33]); o.y = pk2(s[2 * 33], s[3 * 33]); o.z = pk2(s[4 * 33], s[5 * 33]); o.w = pk2(s[6 * 33], s[7 * 33]);
        *(GAS v4u*)(WT + (size_t)(n0 + n) * K + k0 + 8 * c) = o; }
    LDS_WAIT(); asm volatile("" ::: "memory");
}
__device__ __forceinline__ unsigned pk4_fp8(float a, float b, float c, float d) { int w = 0; w = __builtin_amdgcn_cvt_pk_fp8_f32(a, b, w, false); w = __builtin_amdgcn_cvt_pk_fp8_f32(c, d, w, true); return (unsigned)w; }
template <class Map>
__device__ __forceinline__ void transpose_item_f8(const float* W, int K, int Nsrc, unsigned char* WT, LAS float* scr, int kb, int nb, int lane, Map map, float wscale) {
    const int k0 = 64 * kb, n0 = 32 * nb;
    const int src = map(n0 + (lane & 31));
    float wv[32];
#pragma unroll
    for (int i = 0; i < 32; ++i) { const int kk = 2 * i + (lane >> 5); wv[i] = src >= 0 ? W[(size_t)(k0 + kk) * Nsrc + src] * wscale : 0.f; }
#pragma unroll
    for (int i = 0; i < 32; ++i) { const int kk = 2 * i + (lane >> 5); scr[kk * 33 + (lane & 31)] = wv[i]; }
    LDS_WAIT(); asm volatile("" ::: "memory");
    const int c = lane & 7;
#pragma unroll
    for (int j = 0; j < 4; ++j) { const int n = (lane >> 3) + 8 * j; const LAS float* s = scr + (8 * c) * 33 + n;
        u32x2 o; o.x = pk4_fp8(s[0 * 33], s[1 * 33], s[2 * 33], s[3 * 33]); o.y = pk4_fp8(s[4 * 33], s[5 * 33], s[6 * 33], s[7 * 33]);
        *(GAS u32x2*)(WT + (size_t)(n0 + n) * K + k0 + 8 * c) = o; }
    LDS_WAIT(); asm volatile("" ::: "memory");
}
constexpr float W1_F8_SCALE = 64.0f, W2_F8_SCALE = 128.0f, WPG_F8_SCALE = 64.0f;
struct PIn { const float *x, *p, *w_in, *b_in, *w_ck1, *w_ck2, *w_cv1, *w_cv2, *w_o, *w_r, *w_e1, *b_e1, *w_e2, *w_pg, *w_pp; const int* pos; };
__device__ __forceinline__ void p0_prologue(Frame& F, const PIn& I) {
    LAS float* scr = (LAS float*)(F.lds + RING_OFF + F.wave * 16384);
    const int gw = F.vcu * NWAVES + F.wave, NGW = F.G * NWAVES, lane = F.lane;
    unsigned char* ws = F.ws;
    constexpr int I_IN = 16 * 72, I_O = 16 * 32, I_PG = 16 * 32, I_PP = 4 * 32, I_C1 = 32 * 8, I_C2 = 4 * 2, I_E1 = 32 * 16 * 64, I_E2 = 32 * 16 * 32;
    constexpr int I_LAYER = I_IN + I_O + I_PG + I_PP + 2 * I_C1 + 2 * I_C2 + I_E1 + I_E2;
    for (int it = gw; it < NL * I_LAYER; it += NGW) {
        const int L = it / I_LAYER; int r = it % I_LAYER;
        if (r < I_IN) { transpose_item(I.w_in + (size_t)L * 1024 * 2072, 1024, 2072, (bf16*)(ws + WS_WIN) + (size_t)L * NIN * 1024, scr, r / 72, r % 72, lane, MapWin()); continue; } r -= I_IN;
        if (r < I_O) { transpose_item(I.w_o + (size_t)L * 1024 * 1024, 1024, 1024, (bf16*)(ws + WS_WO) + (size_t)L * 1024 * 1024, scr, r / 32, r % 32, lane, MapId()); continue; } r -= I_O;
        if (r < I_PG) {
            if (L == NL - 1) transpose_item_f8(I.w_pg + (size_t)L * 1024 * 1024, 1024, 1024, ws + WS_WPG + (size_t)L * 1024 * 1024 * 2, scr, r / 32, r % 32, lane, MapId(), WPG_F8_SCALE);
            else transpose_item(I.w_pg + (size_t)L * 1024 * 1024, 1024, 1024, (bf16*)(ws + WS_WPG) + (size_t)L * 1024 * 1024, scr, r / 32, r % 32, lane, MapId());
            continue; } r -= I_PG;
        if (r < I_PP) { transpose_item(I.w_pp + (size_t)L * 256 * 1024, 256, 1024, (bf16*)(ws + WS_WPP) + (size_t)L * 1024 * 256, scr, r / 32, r % 32, lane, MapId()); continue; } r -= I_PP;
        if (r < I_C1) { transpose_item(I.w_ck1 + (size_t)L * 2048 * 256, 2048, 256, (bf16*)(ws + WS_WC1) + (size_t)(L * 2 + 0) * 256 * 2048, scr, r / 8, r % 8, lane, MapId()); continue; } r -= I_C1;
        if (r < I_C1) { transpose_item(I.w_cv1 + (size_t)L * 2048 * 256, 2048, 256, (bf16*)(ws + WS_WC1) + (size_t)(L * 2 + 1) * 256 * 2048, scr, r / 8, r % 8, lane, MapId()); continue; } r -= I_C1;
        if (r < I_C2) { transpose_item(I.w_ck2 + (size_t)L * 256 * 64, 256, 64, (bf16*)(ws + WS_WC2) + (size_t)(L * 2 + 0) * 64 * 256, scr, r / 2, r % 2, lane, MapId()); continue; } r -= I_C2;
        if (r < I_C2) { transpose_item(I.w_cv2 + (size_t)L * 256 * 64, 256, 64, (bf16*)(ws + WS_WC2) + (size_t)(L * 2 + 1) * 64 * 256, scr, r / 2, r % 2, lane, MapId()); continue; } r -= I_C2;
        if (r < I_E1) { const int e = r / 1024, q = r % 1024;
            if (L == NL - 1) transpose_item_f8(I.w_e1 + ((size_t)L * 32 + e) * 1024 * 2048, 1024, 2048, ws + WS_W1T + (size_t)L * 32 * 2048 * 1024 * 2 + (size_t)e * 2048 * 1024, scr, q / 64, q % 64, lane, MapW1(), W1_F8_SCALE);
            else transpose_item(I.w_e1 + ((size_t)L * 32 + e) * 1024 * 2048, 1024, 2048, (bf16*)(ws + WS_W1T) + ((size_t)L * 32 + e) * 2048 * 1024, scr, q / 64, q % 64, lane, MapW1());
            continue; } r -= I_E1;
        { const int e = r / 512, q = r % 512;
          if (L == NL - 1) transpose_item_f8(I.w_e2 + ((size_t)L * 32 + e) * 1024 * 1024, 1024, 1024, ws + WS_W2T + (size_t)L * 32 * 1024 * 1024 * 2 + (size_t)e * 1024 * 1024, scr, q / 32, q % 32, lane, MapId(), W2_F8_SCALE);
          else transpose_item(I.w_e2 + ((size_t)L * 32 + e) * 1024 * 1024, 1024, 1024, (bf16*)(ws + WS_W2T) + ((size_t)L * 32 + e) * 1024 * 1024, scr, q / 32, q % 32, lane, MapId()); }
    }
    const size_t gt = (size_t)F.vcu * (NWAVES * 64) + F.tid, NGT = (size_t)F.G * NWAVES * 64;
    for (size_t i = gt; i < (size_t)NL * 32 * 1024; i += NGT) {
        const int L = (int)(i / (32 * 1024)), e = (int)((i / 1024) % 32), k = (int)(i % 1024);
        const float w = I.w_r[((size_t)L * 1024 + k) * 32 + e];
        const unsigned h = f2bf(w); const float wl = w - __uint_as_float(h << 16);
        bf16* d = (bf16*)(ws + WS_WR) + (size_t)L * 2 * 32 * 1024 + (size_t)e * 1024 + k;
        d[0] = (bf16)h; d[32 * 1024] = (bf16)f2bf(wl);
    }
    for (size_t i = gt; i < (size_t)NL * NIN; i += NGT) { const int L = (int)(i / NIN), n = (int)(i % NIN); const int s = MapWin()(n); ((float*)(ws + WS_BINP))[i] = s >= 0 ? I.b_in[(size_t)L * 2072 + s] : 0.f; }
    for (size_t i = gt; i < (size_t)NL * 32 * 2048; i += NGT) { const int le = (int)(i / 2048), n = (int)(i % 2048); ((float*)(ws + WS_B1P))[i] = I.b_e1[(size_t)le * 2048 + MapW1()(n)]; }
    for (size_t i = gt; i < (size_t)M * D / 8; i += NGT) {
        const f32x4 a = *(const GAS f32x4*)(I.x + i * 8), b = *(const GAS f32x4*)(I.x + i * 8 + 4);
        v4u o; o.x = pk2(a.x, a.y); o.y = pk2(a.z, a.w); o.z = pk2(b.x, b.y); o.w = pk2(b.z, b.w);
        *(GAS v4u*)((bf16*)(ws + WS_XB) + i * 8) = o;
    }
    for (size_t i = gt; i < (size_t)NL * M * PD / 8; i += NGT) {
        const f32x4 a = *(const GAS f32x4*)(I.p + i * 8), b = *(const GAS f32x4*)(I.p + i * 8 + 4);
        v4u o; o.x = pk2(a.x, a.y); o.y = pk2(a.z, a.w); o.z = pk2(b.x, b.y); o.w = pk2(b.z, b.w);
        *(GAS v4u*)((bf16*)(ws + WS_PB) + i * 8) = o;
    }
    for (size_t i = gt; i < (size_t)M * 32; i += NGT) {
        const int row = (int)(i >> 5), d = (int)(i & 31);
        const float inv = 1.0f / powf(10000.0f, (float)(2 * d) / 64.0f);
        const float ang = (float)I.pos[row] * inv;
        float* rp = (float*)(ws + WS_ROPE) + (size_t)row * 64;
        rp[d] = cosf(ang); rp[32 + d] = sinf(ang);
    }
}

__device__ __forceinline__ float gelu_tanh(float x) {
    const float u = 0.7978845608028654f * (x + 0.044715f * x * x * x);
    const float e = __builtin_amdgcn_exp2f(2.0f * 1.4426950408889634f * u);
    const float t = 1.0f - 2.0f * __builtin_amdgcn_rcpf(e + 1.0f);
    return 0.5f * x * (1.0f + t);
}
__device__ __forceinline__ void compress_bias(Frame& F, int L, int kv, const float* pe_all) {
    const int lane = F.lane, wave = F.wave, q = lane & 31, hi = lane >> 5;
    unsigned char* ws = F.ws;
    const bf16* w1t = (const bf16*)(ws + WS_WC1) + (size_t)(L * 2 + kv) * 256 * 2048;
    const float* pe = pe_all + (size_t)L * 32 * 64;
    const bf16* brow = w1t + (size_t)(32 * wave + q) * 2048 + 8 * hi;
    f32x16 acc; for (int r = 0; r < 16; ++r) acc[r] = 0.f;
#pragma unroll 2
    for (int i = 0; i < 32; ++i) {
#pragma unroll
        for (int s = 0; s < 4; ++s) {
            const f32x4 p0 = *(const GAS f32x4*)(pe + i * 64 + 16 * s + 8 * hi), p1 = *(const GAS f32x4*)(pe + i * 64 + 16 * s + 8 * hi + 4);
            const bf16x8 af = pack8(p0.x, p0.y, p0.z, p0.w, p1.x, p1.y, p1.z, p1.w);
            const bf16x8 bfr = *(const GAS bf16x8*)(brow + i * 64 + 16 * s);
            acc = __builtin_amdgcn_mfma_f32_32x32x16_bf16(af, bfr, acc, 0, 0, 0);
        }
    }
    if (hi == 0) ((float*)(ws + WS_PBIAS))[(size_t)(L * 2 + kv) * 256 + 32 * wave + q] = acc[0];
}
__device__ __forceinline__ void phase_compress(Frame& F, int L) {
    const int lane = F.lane, wave = F.wave, tid = F.tid;
    unsigned char* ws = F.ws;
    const bf16* H = (const bf16*)(ws + WS_H);
    const float* rope = (const float*)(ws + WS_ROPE);
    LAS unsigned char* hid = F.lds + RING_OFF;
    LAS unsigned char* atok = F.lds + RING_OFF + 16896;
    constexpr int AP = 144, AIS = 33 * AP;
    for (int unit = blockIdx.x; unit < 256; unit += F.G) {
        int lane_v = lane; asm volatile("" : "+v"(lane_v));
        const int q = lane_v & 31, hi = lane_v >> 5;
        const int b = unit >> 4, g = (unit >> 3) & 1, kv = (unit >> 2) & 1, cb = unit & 3;
        const bf16* w1t = (const bf16*)(ws + WS_WC1) + (size_t)(L * 2 + kv) * 256 * 2048;
        const bf16* w2t = (const bf16*)(ws + WS_WC2) + (size_t)(L * 2 + kv) * 64 * 256;
        const float pbv = ((const float*)(ws + WS_PBIAS))[(size_t)(L * 2 + kv) * 256 + 32 * wave + q];
        const int scol = (kv ? C_VC : C_KC) + g * 64;
        const int tok0 = 512 * cb;
        __syncthreads();
        for (int ci = tid; ci < 528 * 8; ci += NWAVES * 64) {
            const int tk = ci >> 3, ch = ci & 7; int tg = tok0 + tk; tg = tg < T ? tg : T - 1;
            *(LAS v4u*)(atok + (tk & 15) * AIS + (tk >> 4) * AP + ch * 16) = *(const GAS v4u*)(H + ((size_t)b * T + tg) * HP + scol + ch * 8);
        }
        const bf16* brow = w1t + (size_t)(32 * wave + q) * 2048 + 8 * hi;
        bf16x8 bcur[8], bnxt[8], bnx2[8];
#pragma unroll
        for (int u = 0; u < 8; ++u) { bcur[u] = *(const GAS bf16x8*)(brow + u * 16); bnxt[u] = *(const GAS bf16x8*)(brow + 128 + u * 16); }
        __syncthreads();
        f32x16 acc; for (int r = 0; r < 16; ++r) acc[r] = 0.f;
        for (int i2 = 0; i2 < 16; ++i2) {
            if (i2 < 14) {
#pragma unroll
                for (int u = 0; u < 8; ++u) bnx2[u] = *(const GAS bf16x8*)(brow + (i2 + 2) * 128 + u * 16);
            }
#pragma unroll
            for (int u = 0; u < 8; ++u) {
                const int i = 2 * i2 + (u >> 2), s4 = u & 3;
                const bf16x8 af = *(const LAS bf16x8*)(atok + (i & 15) * AIS + (q + (i >> 4)) * AP + (16 * s4 + 8 * hi) * 2);
                acc = __builtin_amdgcn_mfma_f32_32x32x16_bf16(af, bcur[u], acc, 0, 0, 0);
            }
#pragma unroll
            for (int u = 0; u < 8; ++u) { bcur[u] = bnxt[u]; bnxt[u] = bnx2[u]; }
        }
#pragma unroll
        for (int r = 0; r < 16; ++r) *(LAS bf16*)(hid + crow(r, hi) * 528 + (32 * wave + q) * 2) = (bf16)f2bf(gelu_tanh(acc[r] + pbv));
        __syncthreads();
        if (wave == 0) {
            f32x16 a0, a1; for (int r = 0; r < 16; ++r) { a0[r] = 0.f; a1[r] = 0.f; }
#pragma unroll
            for (int ks = 0; ks < 16; ++ks) {
                const bf16x8 af = *(const LAS bf16x8*)(hid + q * 528 + (16 * ks + 8 * hi) * 2);
                const bf16x8 b0 = *(const GAS bf16x8*)(w2t + (size_t)q * 256 + 16 * ks + 8 * hi), b1 = *(const GAS bf16x8*)(w2t + (size_t)(32 + q) * 256 + 16 * ks + 8 * hi);
                a0 = __builtin_amdgcn_mfma_f32_32x32x16_bf16(af, b0, a0, 0, 0, 0);
                a1 = __builtin_amdgcn_mfma_f32_32x32x16_bf16(af, b1, a1, 0, 0, 0);
            }
            bf16* outp = (bf16*)(ws + (kv ? WS_VCMP : WS_KCMP)) + (size_t)(b * 2 + g) * 128 * 64;
#pragma unroll
            for (int r = 0; r < 16; ++r) {
                const int cl = 32 * cb + crow(r, hi);
                float x1 = a0[r], x2 = a1[r];
                if (kv == 0) {
                    const int cr = cl < 127 ? cl : 126;
                    const float* rp = rope + ((size_t)b * T + 31 + 16 * cr) * 64;
                    const float cs = rp[q], sn = rp[32 + q];
                    const float o1 = x1 * cs - x2 * sn, o2 = x2 * cs + x1 * sn; x1 = o1; x2 = o2;
                }
                if (cl >= 127) { x1 = 0.f; x2 = 0.f; }
                outp[(size_t)cl * 64 + q] = (bf16)f2bf(x1); outp[(size_t)cl * 64 + 32 + q] = (bf16)f2bf(x2);
            }
        }
    }
    __syncthreads();
}

namespace att {
constexpr float ATT_THR = 6.0f;
constexpr int KP = 144;
constexpr int KTB = 64 * KP, VTB = 8192;
constexpr int L_K = 0;
constexpr int L_V = 4 * KTB;
constexpr int L_KC = 0;
constexpr int L_VC = 128 * KP;
constexpr int L_IMP = L_VC + 16384;
constexpr int L_OT = 4 * KTB + 4 * VTB;
constexpr int L_SEL = L_OT + 65536;
static_assert(L_IMP + 4 * 64 * 33 * 4 <= L_OT && L_SEL + 256 <= SCRATCH_BYTES, "attention LDS map");

__device__ __forceinline__ float max3f(float a, float b, float c) { float r; asm("v_max3_f32 %0, %1, %2, %3" : "=v"(r) : "v"(a), "v"(b), "v"(c)); return r; }
__device__ __forceinline__ float max2f(float a, float b) { float r; asm("v_max_f32_e32 %0, %1, %2" : "=v"(r) : "v"(a), "v"(b)); return r; }
typedef short v4i16_t __attribute__((ext_vector_type(4)));
__device__ __forceinline__ u32x2 vtr(const LAS unsigned char* p) { return __builtin_bit_cast(u32x2, __builtin_amdgcn_ds_read_tr16_b64_v4i16((LAS v4i16_t*)p)); }
__device__ __forceinline__ float xhalf_max(float v) { auto rr = __builtin_amdgcn_permlane32_swap(__float_as_uint(v), __float_as_uint(v), false, false); return fmaxf(__uint_as_float(rr[0]), __uint_as_float(rr[1])); }
__device__ __forceinline__ float xhalf_sum(float v) { auto rr = __builtin_amdgcn_permlane32_swap(__float_as_uint(v), __float_as_uint(v), false, false); return __uint_as_float(rr[0]) + __uint_as_float(rr[1]); }
template <bool SEL>
__device__ __forceinline__ void att_tile(LAS unsigned char* Kl, LAS unsigned char* Vl, int j, int qt, int jlo, int t, int W, unsigned selbits, const bf16x8 (&qf)[4],
                                         f32x16& o0, f32x16& o1, f32x16& negm, float& m_run, float& l_run, int q, int hi) {
        bf16x8 ka[4], kb2[4]; u32x2 va[4][2], vb[4][2];
#pragma unroll
        for (int s = 0; s < 4; ++s) { ka[s] = *(const LAS bf16x8*)(Kl + q * KP + (16 * s + 8 * hi) * 2); kb2[s] = *(const LAS bf16x8*)(Kl + (32 + q) * KP + (16 * s + 8 * hi) * 2); }
        {
            const LAS unsigned char* vp = Vl + ((q >> 4) & 1) * 32 + (q & 3) * 8 + (4 * hi + ((q & 15) >> 2)) * 64;
#pragma unroll
            for (int ks = 0; ks < 4; ++ks) {
                va[ks][0] = vtr(vp + ks * 1024); va[ks][1] = vtr(vp + ks * 1024 + 512);
                vb[ks][0] = vtr(vp + 4096 + ks * 1024); vb[ks][1] = vtr(vp + 4096 + ks * 1024 + 512);
            }
        }
        __builtin_amdgcn_sched_barrier(0);
        f32x16 s0 = __builtin_amdgcn_mfma_f32_32x32x16_bf16(ka[0], qf[0], negm, 0, 0, 0);
        f32x16 s1 = __builtin_amdgcn_mfma_f32_32x32x16_bf16(kb2[0], qf[0], negm, 0, 0, 0);
#pragma unroll
        for (int s = 1; s < 4; ++s) {
            s0 = __builtin_amdgcn_mfma_f32_32x32x16_bf16(ka[s], qf[s], s0, 0, 0, 0);
            s1 = __builtin_amdgcn_mfma_f32_32x32x16_bf16(kb2[s], qf[s], s1, 0, 0, 0);
        }
        const bool lane_ok = SEL ? (((selbits >> j) & 1u) != 0u) : true;
        if (j == qt || j == jlo) {
            const int d0 = t - 64 * j - 4 * hi;
#pragma unroll
            for (int r = 0; r < 16; ++r) {
                s0[r] = ((unsigned)(d0 - ((r & 3) + 8 * (r >> 2))) < (unsigned)W) ? s0[r] : -INFINITY;
                s1[r] = ((unsigned)(d0 - (32 + (r & 3) + 8 * (r >> 2))) < (unsigned)W) ? s1[r] : -INFINITY;
            }
        }
        float mx = fmaxf(s0[0], s1[0]), mx2 = fmaxf(s0[1], s1[1]);
#pragma unroll
        for (int r = 2; r < 16; r += 2) { mx = max3f(mx, s0[r], s1[r]); mx2 = max3f(mx2, s0[r + 1], s1[r + 1]); }
        mx = max2f(mx, mx2);
        mx = lane_ok ? mx : -INFINITY;
        mx = xhalf_max(mx);
        typedef float f32x2_ __attribute__((ext_vector_type(2)));
        f32x2_ ps2 = {0.f, 0.f};
#pragma unroll
        for (int r = 0; r < 16; ++r) { s0[r] = __builtin_amdgcn_exp2f(s0[r]); s1[r] = __builtin_amdgcn_exp2f(s1[r]); ps2 += (f32x2_){s0[r], s1[r]}; }
        const float ps = ps2.x + ps2.y;
        const unsigned okm = lane_ok ? 0xffffffffu : 0u;
        l_run += lane_ok ? ps : 0.f;
#pragma unroll
        for (int ks = 0; ks < 4; ++ks) {
            const int kb = ks >> 1, sp = ks & 1;
            bf16x8 pf = kb ? pack8(s1[8 * sp + 0], s1[8 * sp + 1], s1[8 * sp + 2], s1[8 * sp + 3], s1[8 * sp + 4], s1[8 * sp + 5], s1[8 * sp + 6], s1[8 * sp + 7])
                           : pack8(s0[8 * sp + 0], s0[8 * sp + 1], s0[8 * sp + 2], s0[8 * sp + 3], s0[8 * sp + 4], s0[8 * sp + 5], s0[8 * sp + 6], s0[8 * sp + 7]);
            if (SEL) { v4u pw = __builtin_bit_cast(v4u, pf); pw.x &= okm; pw.y &= okm; pw.z &= okm; pw.w &= okm; pf = __builtin_bit_cast(bf16x8, pw); }
            {
                v4u w; w.x = va[ks][0].x; w.y = va[ks][0].y; w.z = va[ks][1].x; w.w = va[ks][1].y;
                o0 = __builtin_amdgcn_mfma_f32_32x32x16_bf16(__builtin_bit_cast(bf16x8, w), pf, o0, 0, 0, 0);
            }
            {
                v4u w; w.x = vb[ks][0].x; w.y = vb[ks][0].y; w.z = vb[ks][1].x; w.w = vb[ks][1].y;
                o1 = __builtin_amdgcn_mfma_f32_32x32x16_bf16(__builtin_bit_cast(bf16x8, w), pf, o1, 0, 0, 0);
            }
        }
        if (__builtin_amdgcn_ballot_w64(mx > ATT_THR) != 0ull) {
            const float gmx = fmaxf(mx, 0.f);
            const float alpha = __builtin_amdgcn_exp2f(-gmx);
            l_run *= alpha; m_run += gmx;
#pragma unroll
            for (int r = 0; r < 16; ++r) { o0[r] *= alpha; o1[r] *= alpha; negm[r] -= gmx; }
        }
}
template <bool SEL>
__device__ __forceinline__ void stream(LAS unsigned char* lds, const bf16* Hb, int kcol, int vcol, int j0, int j1, int qt, int t, int W, unsigned selbits,
                                       const bf16x8 (&qf)[4], f32x16& o0, f32x16& o1, float& m_run, float& l_run, int tid, int lane, int wave) {
    const int q = lane & 31, hi = lane >> 5;
    const int krow = tid >> 3, kch = tid & 7, vrow = krow, vch = kch;
    const int vdst = (kch >> 2) * 4096 + (krow >> 3) * 512 + (krow & 7) * 64 + (kch & 3) * 16;
    const int jlo = qt - (W >> 6);
    f32x16 negm;
#pragma unroll
    for (int r = 0; r < 16; ++r) negm[r] = -m_run;
    __syncthreads();
    const bf16* kp0 = Hb + (size_t)(64 * j0 + krow) * HP + kcol + kch * 8;
    const bf16* vp0 = Hb + (size_t)(64 * j0 + vrow) * HP + vcol + vch * 8;
    v4u kA = *(const GAS v4u*)kp0, vA = *(const GAS v4u*)vp0, kB = kA, vB = vA;
    if (j0 + 1 <= j1) { kB = *(const GAS v4u*)(kp0 + (size_t)64 * HP); vB = *(const GAS v4u*)(vp0 + (size_t)64 * HP); }
    int pp = 0;
    for (int jp = j0; jp <= j1; jp += 2, pp ^= 1) {
        const bool has2 = jp + 1 <= j1;
        LAS unsigned char* Kl0 = lds + L_K + pp * (2 * KTB); LAS unsigned char* Kl1 = Kl0 + KTB;
        LAS unsigned char* Vl0 = lds + L_V + pp * (2 * VTB); LAS unsigned char* Vl1 = Vl0 + VTB;
        *(LAS v4u*)(Kl0 + krow * KP + kch * 16) = kA;
        *(LAS v4u*)(Vl0 + vdst) = vA;
        if (has2) { *(LAS v4u*)(Kl1 + krow * KP + kch * 16) = kB; *(LAS v4u*)(Vl1 + vdst) = vB; }
        if (jp + 2 <= j1) { kA = *(const GAS v4u*)(kp0 + (size_t)(64 * (jp + 2 - j0)) * HP); vA = *(const GAS v4u*)(vp0 + (size_t)(64 * (jp + 2 - j0)) * HP); }
        if (jp + 3 <= j1) { kB = *(const GAS v4u*)(kp0 + (size_t)(64 * (jp + 3 - j0)) * HP); vB = *(const GAS v4u*)(vp0 + (size_t)(64 * (jp + 3 - j0)) * HP); }
        __syncthreads();
        att_tile<SEL>(Kl0, Vl0, jp, qt, jlo, t, W, selbits, qf, o0, o1, negm, m_run, l_run, q, hi);
        if (has2) att_tile<SEL>(Kl1, Vl1, jp + 1, qt, jlo, t, W, selbits, qf, o0, o1, negm, m_run, l_run, q, hi);
    }
}

__device__ __forceinline__ void phase_attention(Frame& F, int L, const float* sinks_all) {
    const int tid = F.tid, lane = F.lane, wave = F.wave;
    const int rh = wave >> 1, th = wave & 1;
    unsigned char* ws = F.ws;
    LAS unsigned char* lds = F.lds + RING_OFF;
    const bf16* H = (const bf16*)(ws + WS_H);
    bf16* O = (bf16*)(ws + WS_O);
    const float* gates = (const float*)(ws + WS_GATES);
    const float* sinks = sinks_all + L * 8;
    LAS float* impb = (LAS float*)(lds + L_IMP);
    LAS unsigned* selm = (LAS unsigned*)(lds + L_SEL);
    const int NU = 2048;
    if (wave >= 4) __builtin_amdgcn_s_setprio(1);
    for (int i = 0;; ++i) {
        const int pos = (i & 1) ? (F.G - 1 - (int)blockIdx.x) : (int)blockIdx.x;
        const int n = i * F.G + pos;
        if (i * F.G >= NU) break;
        if (n >= NU) continue;
        const bool nsa = n < 1024;
        int b, g, qt;
        if (nsa) { qt = 31 - (n >> 5); b = (n & 31) >> 1; g = n & 1; }
        else { const int m2 = n - 1024; qt = 31 - (m2 >> 5); b = (m2 & 31) >> 1; g = m2 & 1; }
        int lane_v = lane; asm volatile("" : "+v"(lane_v));
        const int q = lane_v & 31, hi = lane_v >> 5;
        const int hq = 4 * g + rh;
        const int t = 64 * qt + 32 * th + q;
        const size_t row = (size_t)b * T + t;
        const bf16* Hb = H + (size_t)b * T * HP;
        bf16x8 qf[4];
        {
            const bf16* qp = H + row * HP + (nsa ? C_QN : C_QS) + 64 * hq + 8 * hi;
#pragma unroll
            for (int s = 0; s < 4; ++s) qf[s] = *(const GAS bf16x8*)(qp + 16 * s);
        }
        f32x16 ot0, ot1;
        if (nsa) {
            const float* gp = gates + row * 32 + hq * 3;
            const float g_cmp = gp[0], g_slc = gp[1], g_win = gp[2];
            __syncthreads();
            {
                const bf16* kc = (const bf16*)(ws + WS_KCMP) + (size_t)(b * 2 + g) * 128 * 64;
                const bf16* vc = (const bf16*)(ws + WS_VCMP) + (size_t)(b * 2 + g) * 128 * 64;
#pragma unroll
                for (int it = 0; it < 2; ++it) {
                    const int ci = tid + 512 * it, r = ci >> 3, ch = ci & 7;
                    *(LAS v4u*)(lds + L_KC + r * KP + ch * 16) = *(const GAS v4u*)(kc + (size_t)r * 64 + ch * 8);
                    *(LAS v4u*)(lds + L_VC + (ch >> 2) * 8192 + (r >> 3) * 512 + (r & 7) * 64 + (ch & 3) * 16) = *(const GAS v4u*)(vc + (size_t)r * 64 + ch * 8);
                }
            }
            __syncthreads();
            f32x16 sc[4];
#pragma unroll
            for (int kb = 0; kb < 4; ++kb) {
#pragma unroll
                for (int r = 0; r < 16; ++r) sc[kb][r] = 0.f;
#pragma unroll
                for (int s = 0; s < 4; ++s) {
                    const bf16x8 a = *(const LAS bf16x8*)(lds + L_KC + (32 * kb + q) * KP + (16 * s + 8 * hi) * 2);
                    sc[kb] = __builtin_amdgcn_mfma_f32_32x32x16_bf16(a, qf[s], sc[kb], 0, 0, 0);
                }
                __builtin_amdgcn_sched_barrier(0);
            }
            float mx = -INFINITY;
            const int cth = (((t - 31) >> 4) < 126 ? ((t - 31) >> 4) : 126) - 4 * hi;
#pragma unroll
            for (int kb = 0; kb < 4; ++kb)
#pragma unroll
                for (int r = 0; r < 16; ++r) {
                    const bool vis = (32 * kb + (r & 3) + 8 * (r >> 2)) <= cth;
                    sc[kb][r] = vis ? sc[kb][r] : -INFINITY;
                    mx = fmaxf(mx, sc[kb][r]);
                }
            mx = xhalf_max(mx);
            mx = fmaxf(mx, -1e30f);
            float ps = 0.f;
#pragma unroll
            for (int kb = 0; kb < 4; ++kb)
#pragma unroll
                for (int r = 0; r < 16; ++r) { sc[kb][r] = __builtin_amdgcn_exp2f(sc[kb][r] - mx); ps += sc[kb][r]; }
            ps = xhalf_sum(ps);
            const float inv = 1.0f / fmaxf(ps, 1e-30f);
#pragma unroll
            for (int kb = 0; kb < 4; ++kb)
#pragma unroll
                for (int r = 0; r < 16; ++r) sc[kb][r] *= inv;
#pragma unroll
            for (int kb = 0; kb < 4; ++kb)
#pragma unroll
                for (int ii = 0; ii < 4; ++ii)
                    impb[(rh * 64 + 32 * th + q) * 33 + 8 * kb + 2 * ii + hi] = (sc[kb][4 * ii] + sc[kb][4 * ii + 1]) + (sc[kb][4 * ii + 2] + sc[kb][4 * ii + 3]);
            f32x16 c0, c1;
#pragma unroll
            for (int r = 0; r < 16; ++r) { c0[r] = 0.f; c1[r] = 0.f; }
#pragma unroll
            for (int ks = 0; ks < 8; ++ks) {
                const int kb = ks >> 1, sp = ks & 1;
                const bf16x8 pf = pack8(sc[kb][8 * sp + 0], sc[kb][8 * sp + 1], sc[kb][8 * sp + 2], sc[kb][8 * sp + 3], sc[kb][8 * sp + 4], sc[kb][8 * sp + 5], sc[kb][8 * sp + 6], sc[kb][8 * sp + 7]);
                const LAS unsigned char* vp = lds + L_VC + ((q >> 4) & 1) * 32 + (q & 3) * 8 + (4 * hi + ((q & 15) >> 2)) * 64 + ks * 1024;
                {
                    const u32x2 lo = vtr(vp), hh = vtr(vp + 512);
                    v4u w; w.x = lo.x; w.y = lo.y; w.z = hh.x; w.w = hh.y;
                    c0 = __builtin_amdgcn_mfma_f32_32x32x16_bf16(__builtin_bit_cast(bf16x8, w), pf, c0, 0, 0, 0);
                }
                {
                    const u32x2 lo = vtr(vp + 8192), hh = vtr(vp + 8192 + 512);
                    v4u w; w.x = lo.x; w.y = lo.y; w.z = hh.x; w.w = hh.y;
                    c1 = __builtin_amdgcn_mfma_f32_32x32x16_bf16(__builtin_bit_cast(bf16x8, w), pf, c1, 0, 0, 0);
                }
                if (ks & 1) __builtin_amdgcn_sched_barrier(0);
            }
            __syncthreads();
            if (qt >= 8) {
                const int tok = tid >> 3, sub = tid & 7;
                unsigned key[4];
#pragma unroll
                for (int ii = 0; ii < 4; ++ii) {
                    const int j = 4 * sub + ii;
                    const float sum = (impb[tok * 33 + j] + impb[(64 + tok) * 33 + j]) + (impb[(128 + tok) * 33 + j] + impb[(192 + tok) * 33 + j]);
                    const unsigned kb = (__float_as_uint(sum) & ~31u) | (unsigned)(31 - j);
                    key[ii] = (j >= 1 && j <= qt - 2) ? kb : 0u;
                }
                unsigned mask = 1u | (1u << qt) | (1u << (qt - 1));
#pragma unroll
                for (int rnd = 0; rnd < 5; ++rnd) {
                    unsigned bk = key[0] > key[1] ? key[0] : key[1]; const unsigned b2 = key[2] > key[3] ? key[2] : key[3]; bk = bk > b2 ? bk : b2;
                    unsigned o1 = (unsigned)__shfl_xor((int)bk, 1); bk = bk > o1 ? bk : o1;
                    o1 = (unsigned)__shfl_xor((int)bk, 2); bk = bk > o1 ? bk : o1;
                    o1 = (unsigned)__shfl_xor((int)bk, 4); bk = bk > o1 ? bk : o1;
                    mask |= 1u << (31u - (bk & 31u));
#pragma unroll
                    for (int ii = 0; ii < 4; ++ii) key[ii] = key[ii] == bk ? 0u : key[ii];
                }
                if (sub == 0) selm[tok] = mask;
            } else if (tid < 64) selm[tid] = (2u << qt) - 1u;
            __syncthreads();
            const unsigned selbits = selm[32 * th + q];
            LAS float* otl = (LAS float*)(lds + L_OT + wave * 8192) + lane_v;
#pragma unroll
            for (int r = 0; r < 16; ++r) { otl[r * 64] = g_cmp * c0[r]; otl[(16 + r) * 64] = g_cmp * c1[r]; }
            {
                f32x16 a0, a1; float mr = 0.f, lr = 0.f;
#pragma unroll
                for (int r = 0; r < 16; ++r) { a0[r] = 0.f; a1[r] = 0.f; }
                stream<true>(lds, Hb, C_KS + 64 * g, C_VS + 64 * g, 0, qt, qt, t, 1 << 20, selbits, qf, a0, a1, mr, lr, tid, lane_v, wave);
                lr = xhalf_sum(lr);
                const float f = g_slc / fmaxf(lr, 1e-30f);
#pragma unroll
                for (int r = 0; r < 16; ++r) { otl[r * 64] += f * a0[r]; otl[(16 + r) * 64] += f * a1[r]; }
            }
            {
                f32x16 a0, a1; float mr = 0.f, lr = 0.f;
#pragma unroll
                for (int r = 0; r < 16; ++r) { a0[r] = 0.f; a1[r] = 0.f; }
                stream<false>(lds, Hb, C_KW + 64 * g, C_VW + 64 * g, qt >= 8 ? qt - 8 : 0, qt, qt, t, 512, 0u, qf, a0, a1, mr, lr, tid, lane_v, wave);
                lr = xhalf_sum(lr);
                const float f = g_win / fmaxf(lr, 1e-30f);
#pragma unroll
                for (int r = 0; r < 16; ++r) { ot0[r] = otl[r * 64] + f * a0[r]; ot1[r] = otl[(16 + r) * 64] + f * a1[r]; }
            }
        } else {
            f32x16 a0, a1; float mr = 0.f, lr = 0.f;
#pragma unroll
            for (int r = 0; r < 16; ++r) { a0[r] = 0.f; a1[r] = 0.f; }
            stream<false>(lds, Hb, C_KSW + 64 * g, C_VSW + 64 * g, qt >= 2 ? qt - 2 : 0, qt, qt, t, 128, 0u, qf, a0, a1, mr, lr, tid, lane_v, wave);
            lr = xhalf_sum(lr);
            const float sk = sinks[hq] * 1.4426950408889634f;
            const float mf = fmaxf(mr, sk);
            const float sm = __builtin_amdgcn_exp2f(mr - mf);
            const float den = lr * sm + __builtin_amdgcn_exp2f(sk - mf);
            const float f = sm / fmaxf(den, 1e-30f);
#pragma unroll
            for (int r = 0; r < 16; ++r) { ot0[r] = f * a0[r]; ot1[r] = f * a1[r]; }
        }
        bf16* op = O + row * 1024 + (nsa ? 0 : 512) + 64 * hq + 4 * hi;
#pragma unroll
        for (int ii = 0; ii < 4; ++ii) {
            u32x2 w0, w1;
            w0.x = cvtpk(ot0[4 * ii], ot0[4 * ii + 1]); w0.y = cvtpk(ot0[4 * ii + 2], ot0[4 * ii + 3]);
            w1.x = cvtpk(ot1[4 * ii], ot1[4 * ii + 1]); w1.y = cvtpk(ot1[4 * ii + 2], ot1[4 * ii + 3]);
            *(GAS u32x2*)(op + 8 * ii) = w0; *(GAS u32x2*)(op + 32 + 8 * ii) = w1;
        }
    }
    __builtin_amdgcn_s_setprio(0);
}
}

template <bool F8>
__device__ __forceinline__ void phase_ln1_router(Frame& F, int L, const float* xres, const float* ln_g, const float* ln_b, const float* b_r) {
    const int tid = F.tid, lane = F.lane, wave = F.wave;
    unsigned char* ws = F.ws;
    const bf16* A1 = (const bf16*)(ws + WS_Y1);
    float* X1 = (float*)(ws + WS_X1);
    bf16* X1B = (bf16*)(ws + WS_X1B);
    const bf16* Wh = (const bf16*)(ws + WS_WR) + (size_t)L * 2 * 32 * 1024;
    const bf16* Wl = Wh + 32 * 1024;
    LAS float* scr = (LAS float*)(F.lds + RING_OFF + wave * 4096);
    LAS unsigned* cntl = (LAS unsigned*)(F.lds + RING_OFF + 65536);
    LAS unsigned* basel = cntl + 32;
    gu32* gcnt = F.ctl + CW_CNT + L * 32;
    f32x4 gam[4], bet[4];
#pragma unroll
    for (int j = 0; j < 4; ++j) { gam[j] = *(const GAS f32x4*)(ln_g + (size_t)L * D + 4 * lane + 256 * j); bet[j] = *(const GAS f32x4*)(ln_b + (size_t)L * D + 4 * lane + 256 * j); }
    for (int chunk = blockIdx.x; chunk < M / 128; chunk += F.G) {
        if (tid < 32) cntl[tid] = 0u;
        __syncthreads();
        const int tok0 = chunk * 128 + wave * 16;
        for (int rr = 0; rr < 16; ++rr) {
            const size_t row = (size_t)(tok0 + rr);
            f32x4 v[4]; float s = 0.f;
#pragma unroll
            for (int j = 0; j < 4; ++j) {
                const u32x2 av = *(const GAS u32x2*)(A1 + row * D + 4 * lane + 256 * j);
                v[j] = *(const GAS f32x4*)(xres + row * D + 4 * lane + 256 * j) * DN_ALPHA + (f32x4){bf_lo(av.x), bf_hi(av.x), bf_lo(av.y), bf_hi(av.y)};
                s += (v[j].x + v[j].y) + (v[j].z + v[j].w);
            }
            const float mean = wave_sum(s) * (1.f / D); float s2 = 0.f;
#pragma unroll
            for (int j = 0; j < 4; ++j) { v[j] = v[j] - mean; s2 += (v[j].x * v[j].x + v[j].y * v[j].y) + (v[j].z * v[j].z + v[j].w * v[j].w); }
            const float rstd = 1.f / sqrtf(wave_sum(s2) * (1.f / D) + LN_EPS);
#pragma unroll
            for (int j = 0; j < 4; ++j) {
                const f32x4 o = v[j] * rstd * gam[j] + bet[j];
                if constexpr (!F8) *(GAS f32x4*)(X1 + row * D + 4 * lane + 256 * j) = o;
                u32x2 w; w.x = pk2(o.x, o.y); w.y = pk2(o.z, o.w);
                *(GAS u32x2*)(X1B + row * D + 4 * lane + 256 * j) = w;
                if constexpr (F8) *(GAS unsigned*)(ws + WS_X1F8 + row * D + 4 * lane + 256 * j) = pk4_fp8(o.x, o.y, o.z, o.w);
            }
            if constexpr (F8) { if (lane == 0) { scr[16 * 33 + 2 * rr] = mean; scr[16 * 33 + 2 * rr + 1] = rstd; } }
        }
        VM_WAIT(); LDS_WAIT();
        f32x4 acc0 = {0.f, 0.f, 0.f, 0.f}, acc1 = {0.f, 0.f, 0.f, 0.f};
        {
            const int ar = lane & 15, kg = lane >> 4;
            const float* xr = (F8 ? xres : (const float*)X1) + (size_t)(tok0 + ar) * D + 8 * kg;
            const bf16* ar1 = A1 + (size_t)(tok0 + ar) * D + 8 * kg;
            float rmean = 0.f, rrstd = 1.f;
            if constexpr (F8) { rmean = scr[16 * 33 + 2 * ar]; rrstd = scr[16 * 33 + 2 * ar + 1]; }
            const bf16* wh0 = Wh + (size_t)ar * 1024 + 8 * kg; const bf16* wl0 = Wl + (size_t)ar * 1024 + 8 * kg;
#pragma unroll 4
            for (int ks = 0; ks < 32; ++ks) {
                f32x4 xa = *(const GAS f32x4*)(xr + 32 * ks), xb = *(const GAS f32x4*)(xr + 32 * ks + 4);
                if constexpr (F8) {
                    const v4u aw = *(const GAS v4u*)(ar1 + 32 * ks);
                    xa = xa * DN_ALPHA + (f32x4){bf_lo(aw.x), bf_hi(aw.x), bf_lo(aw.y), bf_hi(aw.y)}; xb = xb * DN_ALPHA + (f32x4){bf_lo(aw.z), bf_hi(aw.z), bf_lo(aw.w), bf_hi(aw.w)};
                    const float* gp = ln_g + (size_t)L * D + 32 * ks + 8 * kg; const float* bp = ln_b + (size_t)L * D + 32 * ks + 8 * kg;
                    xa = (xa - rmean) * rrstd * *(const GAS f32x4*)gp + *(const GAS f32x4*)bp; xb = (xb - rmean) * rrstd * *(const GAS f32x4*)(gp + 4) + *(const GAS f32x4*)(bp + 4);
                }
                const float xv[8] = {xa.x, xa.y, xa.z, xa.w, xb.x, xb.y, xb.z, xb.w};
                unsigned hh[8], ll[8];
#pragma unroll
                for (int e = 0; e < 8; ++e) { hh[e] = f2bf(xv[e]); ll[e] = f2bf(xv[e] - __uint_as_float(hh[e] << 16)); }
                v4u ah, al;
                ah.x = hh[0] | (hh[1] << 16); ah.y = hh[2] | (hh[3] << 16); ah.z = hh[4] | (hh[5] << 16); ah.w = hh[6] | (hh[7] << 16);
                al.x = ll[0] | (ll[1] << 16); al.y = ll[2] | (ll[3] << 16); al.z = ll[4] | (ll[5] << 16); al.w = ll[6] | (ll[7] << 16);
                const bf16x8 fah = __builtin_bit_cast(bf16x8, ah), fal = __builtin_bit_cast(bf16x8, al);
                const bf16x8 w0h = *(const GAS bf16x8*)(wh0 + 32 * ks), w0l = *(const GAS bf16x8*)(wl0 + 32 * ks);
                const bf16x8 w1h = *(const GAS bf16x8*)(wh0 + 16 * 1024 + 32 * ks), w1l = *(const GAS bf16x8*)(wl0 + 16 * 1024 + 32 * ks);
                acc0 = __builtin_amdgcn_mfma_f32_16x16x32_bf16(fah, w0h, acc0, 0, 0, 0); acc0 = __builtin_amdgcn_mfma_f32_16x16x32_bf16(fal, w0h, acc0, 0, 0, 0); acc0 = __builtin_amdgcn_mfma_f32_16x16x32_bf16(fah, w0l, acc0, 0, 0, 0);
                acc1 = __builtin_amdgcn_mfma_f32_16x16x32_bf16(fah, w1h, acc1, 0, 0, 0); acc1 = __builtin_amdgcn_mfma_f32_16x16x32_bf16(fal, w1h, acc1, 0, 0, 0); acc1 = __builtin_amdgcn_mfma_f32_16x16x32_bf16(fah, w1l, acc1, 0, 0, 0);
            }
#pragma unroll
            for (int r = 0; r < 4; ++r) { scr[(4 * kg + r) * 33 + ar] = acc0[r]; scr[(4 * kg + r) * 33 + 16 + ar] = acc1[r]; }
        }
        LDS_WAIT(); asm volatile("" ::: "memory");
        int ek[4] = {0, 0, 0, 0}; float wk[4] = {0.f, 0.f, 0.f, 0.f}; unsigned lrk[4] = {0u, 0u, 0u, 0u};
        if (lane < 16) {
            float lv[32];
#pragma unroll
            for (int e = 0; e < 32; ++e) lv[e] = scr[lane * 33 + e] + b_r[(size_t)L * 32 + e];
            unsigned taken = 0u; float vk[4];
#pragma unroll
            for (int k = 0; k < 4; ++k) {
                float best = -INFINITY; int bi = 0;
#pragma unroll
                for (int e = 0; e < 32; ++e) { const bool ok = !((taken >> e) & 1u) && lv[e] > best; best = ok ? lv[e] : best; bi = ok ? e : bi; }
                taken |= 1u << bi; ek[k] = bi; vk[k] = best;
            }
            float den = 0.f;
#pragma unroll
            for (int k = 0; k < 4; ++k) { wk[k] = __expf(vk[k] - vk[0]); den += wk[k]; }
#pragma unroll
            for (int k = 0; k < 4; ++k) { wk[k] /= den; lrk[k] = atomicAdd((unsigned*)(cntl + ek[k]), 1u); }
        }
        __syncthreads();
        if (tid < 32) basel[tid] = __hip_atomic_fetch_add(gcnt + tid, cntl[tid], RLX_AGENT);
        __syncthreads();
        if (lane < 16) {
            const size_t tk = (size_t)(tok0 + lane) * 4;
#pragma unroll
            for (int k = 0; k < 4; ++k) {
                const int rank = (int)(basel[ek[k]] + lrk[k]);
                ((int*)(ws + WS_TOKE))[tk + k] = ek[k];
                ((int*)(ws + WS_TOKR))[tk + k] = rank;
                ((float*)(ws + WS_TOKW))[tk + k] = wk[k];
                if (rank < M) ((int*)(ws + WS_LIST))[(size_t)ek[k] * M + rank] = tok0 + lane;
            }
        }
        __syncthreads();
    }
}

__device__ __forceinline__ void build_tables(Frame& F, int L) {
    LAS int* cnt = (LAS int*)(F.lds + TAB_CNT); LAS int* soff = (LAS int*)(F.lds + TAB_SOFF); LAS int* tst = (LAS int*)(F.lds + TAB_TST); LAS int* te = (LAS int*)(F.lds + TAB_TE);
    __syncthreads();
    if (F.tid < 32) { int c = (int)__hip_atomic_load(F.ctl + CW_CNT + L * 32 + F.tid, RLX_AGENT); cnt[F.tid] = c < 0 ? 0 : (c > M ? M : c); }
    __syncthreads();
    if (F.tid == 0) { int a = 0; for (int e = 0; e < 32; ++e) { tst[e] = a; a += (cnt[e] + 255) >> 8; if (a > MAXTILES) a = MAXTILES; } tst[32] = a; }
    __syncthreads();
    if (F.tid < 32) { soff[F.tid] = tst[F.tid] * 256; for (int mt = tst[F.tid]; mt < tst[F.tid + 1]; ++mt) te[mt] = F.tid; }
    __syncthreads();
}

template <bool LAST>
__device__ __forceinline__ void phase_ln2(Frame& F, int L, const float* ln_g, const float* ln_b, float* outp) {
    unsigned char* ws = F.ws;
    const float* X1 = (const float*)(ws + WS_X1); const bf16* X1B = (const bf16*)(ws + WS_X1B);
    const bf16* E = (const bf16*)(ws + WS_E); const bf16* YS = (const bf16*)(ws + WS_YS);
    bf16* XB = (bf16*)(ws + WS_XB);
    const LAS int* soff = (const LAS int*)(F.lds + TAB_SOFF);
    const int gw = F.vcu * NWAVES + F.wave, NGW = F.G * NWAVES, lane = F.lane;
    f32x4 gam[4], bet[4];
#pragma unroll
    for (int j = 0; j < 4; ++j) { gam[j] = *(const GAS f32x4*)(ln_g + (size_t)L * D + 4 * lane + 256 * j); bet[j] = *(const GAS f32x4*)(ln_b + (size_t)L * D + 4 * lane + 256 * j); }
    for (int tok = gw; tok < M; tok += NGW) {
        int sl[4]; float wk[4];
#pragma unroll
        for (int k = 0; k < 4; ++k) {
            const int e = ((const int*)(ws + WS_TOKE))[(size_t)tok * 4 + k] & 31, r = ((const int*)(ws + WS_TOKR))[(size_t)tok * 4 + k];
            int s = soff[e] + r; s = s < 0 ? 0 : (s >= MAXSLOTS ? MAXSLOTS - 1 : s);
            sl[k] = s; wk[k] = ((const float*)(ws + WS_TOKW))[(size_t)tok * 4 + k];
        }
        f32x4 v[4]; float s = 0.f;
#pragma unroll
        for (int j = 0; j < 4; ++j) {
            const int c = 4 * lane + 256 * j;
            f32x4 a;
            if constexpr (LAST) { const u32x2 xv = *(const GAS u32x2*)(X1B + (size_t)tok * D + c); a = (f32x4){bf_lo(xv.x), bf_hi(xv.x), bf_lo(xv.y), bf_hi(xv.y)} * DN_ALPHA; }
            else a = *(const GAS f32x4*)(X1 + (size_t)tok * D + c) * DN_ALPHA;
            const u32x2 ev = *(const GAS u32x2*)(E + (size_t)tok * D + c);
            a.x += bf_lo(ev.x); a.y += bf_hi(ev.x); a.z += bf_lo(ev.y); a.w += bf_hi(ev.y);
#pragma unroll
            for (int k = 0; k < 4; ++k) {
                if constexpr (LAST) {
                    typedef float f32x2_ __attribute__((ext_vector_type(2)));
                    const unsigned yw = *(const GAS unsigned*)((const unsigned char*)YS + (size_t)sl[k] * D + c);
                    const f32x2_ y01 = __builtin_amdgcn_cvt_pk_f32_fp8((int)yw, false), y23 = __builtin_amdgcn_cvt_pk_f32_fp8((int)yw, true);
                    a.x += wk[k] * y01.x; a.y += wk[k] * y01.y; a.z += wk[k] * y23.x; a.w += wk[k] * y23.y;
                } else {
                    const u32x2 yv = *(const GAS u32x2*)(YS + (size_t)sl[k] * D + c);
                    a.x += wk[k] * bf_lo(yv.x); a.y += wk[k] * bf_hi(yv.x); a.z += wk[k] * bf_lo(yv.y); a.w += wk[k] * bf_hi(yv.y);
                }
            }
            v[j] = a; s += (a.x + a.y) + (a.z + a.w);
        }
        const float mean = wave_sum(s) * (1.f / D); float s2 = 0.f;
#pragma unroll
        for (int j = 0; j < 4; ++j) { v[j] = v[j] - mean; s2 += (v[j].x * v[j].x + v[j].y * v[j].y) + (v[j].z * v[j].z + v[j].w * v[j].w); }
        const float rstd = 1.f / sqrtf(wave_sum(s2) * (1.f / D) + LN_EPS);
#pragma unroll
        for (int j = 0; j < 4; ++j) {
            const f32x4 o = v[j] * rstd * gam[j] + bet[j];
            *(GAS f32x4*)(outp + (size_t)tok * D + 4 * lane + 256 * j) = o;
            if constexpr (!LAST) { u32x2 w; w.x = pk2(o.x, o.y); w.y = pk2(o.z, o.w); *(GAS u32x2*)(XB + (size_t)tok * D + 4 * lane + 256 * j) = w; }
        }
    }
}

#ifndef MK_ONE_LAUNCH
#define MK_ONE_LAUNCH 1
#endif
constexpr int PH_PER_LAYER = 9, NPH = 1 + NL * PH_PER_LAYER;
struct Args { const float* in[27]; float* out; unsigned char* ws; int ph_lo, ph_hi; };
typedef const __attribute__((address_space(4))) unsigned char* kptr_t;
__device__ __forceinline__ kptr_t karg_base() { kptr_t p = (kptr_t)__builtin_amdgcn_kernarg_segment_ptr(); asm volatile("" : "+s"(p)); return p; }
#define KIN(kb, i) (*(const float* const __attribute__((address_space(4)))*)((kb) + 8 * (i)))
#ifndef PH_MASK
#define PH_MASK 0x3ff
#endif
#define PHSEL(k) (((k) == 0) ? ((PH_MASK >> 9) & 1) : ((PH_MASK >> (((k) - 1) % PH_PER_LAYER)) & 1))
#define IN(k) (PHSEL(k) && lo <= (k) && (k) < hi)
#ifndef PROBE_PHASE
#define PROBE_PHASE -1
#endif
#ifndef PROBE_EXTRA
#define PROBE_EXTRA 0
#endif
#define NREP(k) (((k) == PROBE_PHASE) ? 1 + PROBE_EXTRA : 1)
#define PHASE(k) if (IN(k)) for (int rep_ = 0; rep_ < NREP(k); ++rep_)
#define SEAM(k) do { if (IN(k) && IN((k) + 1)) { if (MK_ONE_LAUNCH) xcd_barrier(bar); } } while (0)

#define RELAUNDER() do { F.lane = (int)__builtin_amdgcn_mbcnt_hi(~0u, __builtin_amdgcn_mbcnt_lo(~0u, 0u)); asm volatile("" : "+v"(F.lane)); F.wave = wave0; F.tid = F.wave * 64 + F.lane; } while (0)
template <int L>
__device__ __forceinline__ void layer_body(Frame& F, const XcdBarrier& bar, const int lo, const int hi, const int wave0) {
    unsigned char* ws = F.ws;
        const int pb = 1 + L * PH_PER_LAYER;
        PHASE(pb + 0) {
            pg8::Gemm g{(const bf16*)(ws + WS_XB), (const bf16*)(ws + WS_WIN) + (size_t)L * NIN * 1024, M, NIN, D};
            pg8::StaticOrder S; S.init(M, NIN, F.G, (int)blockIdx.x);
            pg8::EpiIn E{(bf16*)(ws + WS_H), (float*)(ws + WS_GATES), (const float*)(ws + WS_BINP) + (size_t)L * NIN, (const float*)(ws + WS_ROPE)};
            pg8::gemm_phase<pg8::EpiIn, pg8::StaticOrder, true, true>(F.lds + RING_OFF, g, S, E, wave0, (LAS float*)(F.lds + BIAS_OFF));
            { const int bx = (int)blockIdx.x, gsz = (int)F.G;
              if (bx == gsz - 1 || bx == gsz - 2) { kptr_t kb = karg_base(); RELAUNDER(); compress_bias(F, L, bx == gsz - 1 ? 0 : 1, bx == gsz - 1 ? KIN(kb, 5) : KIN(kb, 8)); } }
        }
        SEAM(pb + 0);
        PHASE(pb + 1) {
            { RELAUNDER(); phase_compress(F, L); }
            {
                pg8::Gemm g{(const bf16*)(ws + WS_PB) + (size_t)L * M * PD, (const bf16*)(ws + WS_WPP) + (size_t)L * 1024 * PD, M, D, PD};
                pg8::StaticOrder S; S.init(M, D, F.G, (int)blockIdx.x);
                pg8::EpiPlain E{(bf16*)(ws + WS_PP)};
                pg8::gemm_phase<pg8::EpiPlain, pg8::StaticOrder, true, true>(F.lds + RING_OFF, g, S, E, wave0, (LAS float*)(F.lds + BIAS_OFF));
            }
        }
        SEAM(pb + 1);
        PHASE(pb + 2) { kptr_t kb = karg_base(); RELAUNDER(); att::phase_attention(F, L, KIN(kb, 11)); }
        SEAM(pb + 2);
        PHASE(pb + 3) {
            pg8::Gemm g{(const bf16*)(ws + WS_O), (const bf16*)(ws + WS_WO) + (size_t)L * 1024 * 1024, M, D, D};
            pg8::StaticOrder S; S.init(M, D, F.G, (int)blockIdx.x);
            kptr_t kb = karg_base();
            pg8::EpiOut E{(bf16*)(ws + WS_Y1), KIN(kb, 13) + (size_t)L * D};
            pg8::gemm_phase<pg8::EpiOut, pg8::StaticOrder, true, true>(F.lds + RING_OFF, g, S, E, wave0, (LAS float*)(F.lds + BIAS_OFF));
        }
        SEAM(pb + 3);
        PHASE(pb + 4) { kptr_t kb = karg_base(); RELAUNDER(); phase_ln1_router<(L == NL - 1)>(F, L, L == 0 ? KIN(kb, 0) : (const float*)(ws + WS_XN), KIN(kb, 14), KIN(kb, 15), KIN(kb, 17)); }
        SEAM(pb + 4);
        PHASE(pb + 6) {
            RELAUNDER();
            build_tables(F, L);
            {
                constexpr bool F8 = (L == NL - 1);
                pg8::Gemm g{F8 ? (const bf16*)(ws + WS_X1F8) : (const bf16*)(ws + WS_X1B), (const bf16*)(ws + WS_W1T) + (size_t)L * 32 * 2048 * 1024, M, 32 * 2048, F8 ? D / 2 : D};
                pg8::MoeOrder S{(const LAS int*)(F.lds + TAB_TE), ((const LAS int*)(F.lds + TAB_TST))[32] * 8, 3, F.G, F.vcu, (const LAS int*)(F.lds + TAB_TST), (const LAS int*)(F.lds + TAB_CNT), (const int*)(ws + WS_LIST), M};
                pg8::EpiUp<F8> E{(bf16*)(ws + WS_ACT), (const float*)(ws + WS_B1P) + (size_t)L * 32 * 2048, F8 ? 1.0f / W1_F8_SCALE : 1.0f};
                pg8::gemm_phase<pg8::EpiUp<F8>, pg8::MoeOrder, true, true, F8, true>(F.lds + RING_OFF, g, S, E, wave0, (LAS float*)(F.lds + BIAS_OFF), (LAS int*)(F.lds + TOKL_OFF));
            }
        }
        SEAM(pb + 6);
        PHASE(pb + 7) {
            kptr_t kb = karg_base(); RELAUNDER();
            if (!IN(pb + 6)) build_tables(F, L);
            {
                constexpr bool F8 = (L == NL - 1);
                pg8::Gemm g{(const bf16*)(ws + WS_ACT), (const bf16*)(ws + WS_W2T) + (size_t)L * 32 * 1024 * 1024, MAXSLOTS, 32 * 1024, F8 ? D / 2 : D};
                pg8::MoeOrder S{(const LAS int*)(F.lds + TAB_TE), ((const LAS int*)(F.lds + TAB_TST))[32] * 4, 2, F.G, F.vcu, (const LAS int*)(F.lds + TAB_TST), (const LAS int*)(F.lds + TAB_CNT), nullptr, 0};
                pg8::EpiDown<F8> E{(bf16*)(ws + WS_YS), KIN(kb, 21) + (size_t)L * 32 * 1024, F8 ? 1.0f / W2_F8_SCALE : 1.0f};
                pg8::gemm_phase<pg8::EpiDown<F8>, pg8::MoeOrder, true, true, F8>(F.lds + RING_OFF, g, S, E, wave0, (LAS float*)(F.lds + BIAS_OFF));
            }
            {
                constexpr bool F8 = (L == NL - 1);
                pg8::Gemm g{F8 ? (const bf16*)(ws + WS_X1F8) : (const bf16*)(ws + WS_X1B), (const bf16*)(ws + WS_WPG) + (size_t)L * 1024 * 1024, M, D, F8 ? D / 2 : D};
                pg8::StaticOrder S; S.init(M, D, F.G, (int)blockIdx.x);
                pg8::EpiGate E{(const bf16*)(ws + WS_PP), (bf16*)(ws + WS_E), KIN(kb, 23) + (size_t)L * D, F8 ? 1.0f / WPG_F8_SCALE : 1.0f};
                pg8::gemm_phase<pg8::EpiGate, pg8::StaticOrder, true, true, F8>(F.lds + RING_OFF, g, S, E, wave0, (LAS float*)(F.lds + BIAS_OFF));
            }
        }
        SEAM(pb + 7);
        PHASE(pb + 8) { kptr_t kb = karg_base(); RELAUNDER(); if (!IN(pb + 7)) build_tables(F, L); float* xout = L == NL - 1 ? (float*)KIN(kb, 27) : (float*)(ws + WS_XN); phase_ln2<(L == NL - 1)>(F, L, KIN(kb, 25), KIN(kb, 26), xout); }
        SEAM(pb + 8);
    }
__global__ void __launch_bounds__(NWAVES * 64, 2) mk_fwd(Args args) {
    extern __shared__ __attribute__((aligned(16))) unsigned char lds[];
    Frame F;
    F.lds = (LAS unsigned char*)lds;
    F.MISC = (volatile LAS unsigned*)(F.lds + MISC_OFF);
    const int wave0 = __builtin_amdgcn_readfirstlane((int)threadIdx.x >> 6);
    F.wave = wave0; F.lane = (int)__builtin_amdgcn_mbcnt_hi(~0u, __builtin_amdgcn_mbcnt_lo(~0u, 0u)); F.tid = F.wave * 64 + F.lane;
    F.G = gridDim.x; { const int bx = blockIdx.x; F.vcu = (F.G % 8 == 0) ? (bx % 8) * (F.G / 8) + bx / 8 : bx; }
    F.ws = args.ws; F.ctl = (gu32*)(args.ws + WS_CTL);
    unsigned char* ws = args.ws;
    for (int u = F.tid; u < (LDS_BYTES - LDSCTL_OFF) / 4; u += NWAVES * 64) ((LAS unsigned*)(F.lds + LDSCTL_OFF))[u] = 0u;
    __syncthreads();
    XcdBarrier bar; bar.bar = (unsigned*)(F.ctl + CW_BAR); bar.x = 0; bar.st = nullptr; bar.wave = wave0;
    if (MK_ONE_LAUNCH) bar = xcd_barrier_post((unsigned*)(F.ctl + CW_BAR), F.MISC + 8, wave0);
    const int lo = args.ph_lo, hi = args.ph_hi;
    PHASE(0) {
        kptr_t kb = karg_base(); RELAUNDER();
        PIn I{KIN(kb, 0), KIN(kb, 1), KIN(kb, 3), KIN(kb, 4), KIN(kb, 6), KIN(kb, 7), KIN(kb, 9), KIN(kb, 10), KIN(kb, 12), KIN(kb, 16), KIN(kb, 18), KIN(kb, 19), KIN(kb, 20), KIN(kb, 22), KIN(kb, 24), (const int*)KIN(kb, 2)};
        p0_prologue(F, I);
    }
    SEAM(0);
    layer_body<0>(F, bar, lo, hi, wave0);
    layer_body<1>(F, bar, lo, hi, wave0);
#undef IN
#undef SEAM
}

extern "C" void kernel_launch(void* const* d_in, const int* in_sizes, int n_in, void* d_out, int out_size, void* d_ws, size_t ws_size, hipStream_t stream) {
    static int grid = 0;
    if (grid == 0) {
        if (n_in != 27 || out_size != M * D || ws_size < WS_END) { fprintf(stderr, "kernel_launch: unexpected problem (n_in %d, out %d, ws %zu); nothing launched\n", n_in, out_size, ws_size); grid = -1; return; }
        int dev = 0, cus = 0, per_cu = 0;
        if (hipGetDevice(&dev) != hipSuccess || hipDeviceGetAttribute(&cus, hipDeviceAttributeMultiprocessorCount, dev) != hipSuccess) { grid = -1; return; }
        if (hipFuncSetAttribute((const void*)mk_fwd, hipFuncAttributeMaxDynamicSharedMemorySize, LDS_BYTES) != hipSuccess) { fprintf(stderr, "kernel_launch: hipFuncSetAttribute failed\n"); grid = -1; return; }
        if (hipOccupancyMaxActiveBlocksPerMultiprocessor(&per_cu, (const void*)mk_fwd, NWAVES * 64, LDS_BYTES) != hipSuccess || per_cu < 1) { fprintf(stderr, "kernel_launch: occupancy query says %d\n", per_cu); }
        (void)hipGetLastError();
        grid = cus;
    }
    if (grid < 0) return;
    (void)in_sizes;
    if (hipMemsetAsync((char*)d_ws + WS_CTL, 0, CTL_ZERO_BYTES, stream) != hipSuccess) return;
    Args a{};
    for (int i = 0; i < 27; ++i) a.in[i] = (const float*)d_in[i];
    a.out = (float*)d_out; a.ws = (unsigned char*)d_ws;
#if MK_ONE_LAUNCH
    a.ph_lo = 0; a.ph_hi = NPH;
    hipLaunchKernelGGL(mk_fwd, dim3(grid), dim3(NWAVES * 64), LDS_BYTES, stream, a);
#else
    for (int ph = 0; ph < NPH; ++ph) { a.ph_lo = ph; a.ph_hi = ph + 1; hipLaunchKernelGGL(mk_fwd, dim3(grid), dim3(NWAVES * 64), LDS_BYTES, stream, a); }
#endif
}
```

```cpp
#include <hip/hip_runtime.h>
#include <cstdio>
#include <cstdint>
#define MK_ONE_LAUNCH 1
namespace pg8 {
#define PG8_LAS __attribute__((address_space(3)))
typedef unsigned short bf16_t;
typedef short bf16x8 __attribute__((ext_vector_type(8)));
typedef float f32x4 __attribute__((ext_vector_type(4)));
typedef unsigned u32x4 __attribute__((ext_vector_type(4)));
constexpr int BM = 256, BK = 64, HALF = 128, HTB = HALF * BK * 2  , STAGE_BYTES = 8 * HTB, NXCD = 8, WGM = 8;

__host__ __device__ __forceinline__ int lds_byte(int r, int c) { const int st = (r >> 4) * 2 + (c >> 5), rr = r & 15, cc = c & 31, ob = rr * 64 + cc * 2; return st * 1024 + (ob ^ (((ob >> 9) & 1) << 5)); }
__host__ __device__ __forceinline__ void stage_rc(int b, int& R, int& C) { const int st = b / 1024, sb = b % 1024, swz = sb ^ (((sb >> 9) & 1) << 5); R = (st >> 1) * 16 + swz / 64; C = (st & 1) * 32 + (swz % 64) / 2; }
__host__ __device__ __forceinline__ int perm32(int rho) { const int n = rho >> 4, i = rho & 15; return 8 * (i >> 2) + 4 * n + (i & 3); }

struct Unit { int pm, pn; };
struct Gemm { const bf16_t* A; const bf16_t* Bt; int M, N, K; };

struct StaticOrder {
    int nM, nN, nwg, G, c;
    __host__ __device__ void init(int M, int N, int G_, int c_) { nM = M / BM; nN = N / BM; nwg = nM * nN; G = G_; c = c_; }
    __host__ __device__ bool next(int i, Unit& u) const {
        const long L = (long)i * G + c; if (L >= nwg) return false;
        int wgid = (int)L; { const int q = nwg / NXCD, r = nwg % NXCD, xcd = wgid % NXCD, off = wgid / NXCD; wgid = (xcd < r ? xcd * (q + 1) : r * (q + 1) + (xcd - r) * q) + off; }
        const int nig = WGM * nN, gid = wgid / nig, fm = gid * WGM, gsz = (nM - fm) < WGM ? (nM - fm) : WGM;
        u.pm = fm + ((wgid % nig) % gsz); u.pn = (wgid % nig) / gsz; return true;
    }
    __device__ __forceinline__ void a_ready(const Unit&) const {}
    __device__ __forceinline__ void done(const Unit&) const {}
};

__device__ __forceinline__ unsigned cvt_pk_bf16(float lo, float hi) { unsigned r; asm volatile("v_cvt_pk_bf16_f32 %0, %1, %2" : "=v"(r) : "v"(lo), "v"(hi)); return r; }
typedef float f32x2 __attribute__((ext_vector_type(2)));

typedef unsigned u32x2 __attribute__((ext_vector_type(2)));
__device__ __forceinline__ float sigm(float x) { return __builtin_amdgcn_rcpf(1.0f + __builtin_amdgcn_exp2f(-1.4426950408889634f * x)); }
__device__ __forceinline__ float bf_lo(unsigned w) { return __uint_as_float(w << 16); }
__device__ __forceinline__ float bf_hi(unsigned w) { return __uint_as_float(w & 0xffff0000u); }

constexpr unsigned ROPE_SEGS = 0x7D4Fu;
constexpr float QSCALE = 0.125f * 1.4426950408889634f;
struct EpiIn {
    static constexpr bool PERM = true, AFTER_DRAIN = false;
    bf16_t* H; float* gates; const float* bias; const float* rope;
    __device__ __forceinline__ const float* bias_slice(const Unit& u) const { return bias + u.pn * BM; }
    __device__ __forceinline__ void operator()(const f32x4 (&acc)[2][2][4][2], const Unit& u, int wr, int wc, int fr, int fq, const PG8_LAS float* bl) const {
        const int row0 = u.pm * BM + wr * 64 + fr;
#pragma unroll
        for (int bj = 0; bj < 2; ++bj) {
            const int seg = u.pn * 2 + bj;
            if (seg >= 17) continue;
            const int cl0 = bj * HALF + wc * 32 + 8 * fq;
            const f32x4 b0 = *(const PG8_LAS f32x4*)(bl + cl0), b1 = *(const PG8_LAS f32x4*)(bl + cl0 + 4);
            if (seg == 16) {
                const int gi = wc * 32 + 8 * fq;
                if (gi < 24) {
#pragma unroll
                    for (int ai = 0; ai < 2; ++ai)
#pragma unroll
                        for (int m = 0; m < 4; ++m) {
                            const int row = row0 + ai * HALF + m * 16;
                            f32x4 v0 = acc[ai][bj][m][0] + b0, v1 = acc[ai][bj][m][1] + b1;
                            v0 = (f32x4){sigm(v0[0]), sigm(v0[1]), sigm(v0[2]), sigm(v0[3])};
                            v1 = (f32x4){sigm(v1[0]), sigm(v1[1]), sigm(v1[2]), sigm(v1[3])};
                            float* gp = gates + (size_t)row * 32 + gi;
                            *(f32x4*)gp = v0; *(f32x4*)(gp + 4) = v1;
                        }
                }
            } else {
                const bool rope_on = (ROPE_SEGS >> seg) & 1u;
                const bool qseg = seg < 4 || (seg >= 10 && seg <= 13);
                const int g = 4 * (wc & 1) + fq;
                const int hc = seg * 128 + (wc >> 1) * 64 + 4 * g;
#pragma unroll
                for (int ai = 0; ai < 2; ++ai)
#pragma unroll
                    for (int m = 0; m < 4; ++m) {
                        const int row = row0 + ai * HALF + m * 16;
                        f32x4 v0 = acc[ai][bj][m][0] + b0, v1 = acc[ai][bj][m][1] + b1;
                        if (rope_on) {
                            const f32x4 c = *(const f32x4*)(rope + (size_t)row * 64 + 4 * g), s = *(const f32x4*)(rope + (size_t)row * 64 + 32 + 4 * g);
                            const f32x4 o0 = v0 * c - v1 * s, o1 = v1 * c + v0 * s; v0 = o0; v1 = o1;
                        }
                        if (qseg) { v0 = v0 * QSCALE; v1 = v1 * QSCALE; }
                        u32x2 w0, w1; w0.x = cvt_pk_bf16(v0[0], v0[1]); w0.y = cvt_pk_bf16(v0[2], v0[3]); w1.x = cvt_pk_bf16(v1[0], v1[1]); w1.y = cvt_pk_bf16(v1[2], v1[3]);
                        bf16_t* hp = H + (size_t)row * 2048 + hc;
                        *(u32x2*)hp = w0; *(u32x2*)(hp + 32) = w1;
                    }
            }
        }
    }
};
struct EpiOut {
    static constexpr bool PERM = true, AFTER_DRAIN = false;
    bf16_t* y; const float* bias;
    __device__ __forceinline__ const float* bias_slice(const Unit& u) const { return bias + u.pn * BM; }
    __device__ __forceinline__ void operator()(const f32x4 (&acc)[2][2][4][2], const Unit& u, int wr, int wc, int fr, int fq, const PG8_LAS float* bl) const {
        const int row0 = u.pm * BM + wr * 64 + fr, col0 = u.pn * BM + wc * 32 + 8 * fq;
        f32x4 bv[2][2];
#pragma unroll
        for (int bj = 0; bj < 2; ++bj)
#pragma unroll
            for (int n = 0; n < 2; ++n) bv[bj][n] = *(const PG8_LAS f32x4*)(bl + wc * 32 + 8 * fq + bj * HALF + 4 * n);
#pragma unroll
        for (int ai = 0; ai < 2; ++ai)
#pragma unroll
            for (int m = 0; m < 4; ++m) {
                bf16_t* rowp = y + (size_t)(row0 + ai * HALF + m * 16) * 1024 + col0;
#pragma unroll
                for (int bj = 0; bj < 2; ++bj) {
                    const f32x4 v0 = acc[ai][bj][m][0] + bv[bj][0], v1 = acc[ai][bj][m][1] + bv[bj][1];
                    u32x4 w; w.x = cvt_pk_bf16(v0[0], v0[1]); w.y = cvt_pk_bf16(v0[2], v0[3]); w.z = cvt_pk_bf16(v1[0], v1[1]); w.w = cvt_pk_bf16(v1[2], v1[3]);
                    *(u32x4*)(rowp + bj * HALF) = w;
                }
            }
    }
};
template <bool F8OUT>
struct EpiUp {
    static constexpr bool PERM = true, AFTER_DRAIN = false;
    bf16_t* act; const float* b1p; float ascale;
    __device__ __forceinline__ const float* bias_slice(const Unit& u) const { return b1p + (size_t)(u.pn >> 3) * 2048 + (u.pn & 7) * BM; }
    __device__ __forceinline__ void operator()(const f32x4 (&acc)[2][2][4][2], const Unit& u, int wr, int wc, int fr, int fq, const PG8_LAS float* bl) const {
        const int pn = u.pn & 7;
        const int row0 = u.pm * BM + wr * 64 + fr, ac0 = pn * 128 + wc * 32 + 8 * fq;
        const PG8_LAS float* bp = bl + wc * 32 + 8 * fq;
        const f32x4 bg0 = *(const PG8_LAS f32x4*)bp, bg1 = *(const PG8_LAS f32x4*)(bp + 4), bu0 = *(const PG8_LAS f32x4*)(bp + HALF), bu1 = *(const PG8_LAS f32x4*)(bp + HALF + 4);
#pragma unroll
        for (int ai = 0; ai < 2; ++ai)
#pragma unroll
            for (int m = 0; m < 4; ++m) {
                const f32x4 g0 = acc[ai][0][m][0] * ascale + bg0, g1 = acc[ai][0][m][1] * ascale + bg1, u0 = acc[ai][1][m][0] * ascale + bu0, u1 = acc[ai][1][m][1] * ascale + bu1;
                float o[8];
#pragma unroll
                for (int j = 0; j < 8; ++j) {
                    float gt = j < 4 ? g0[j & 3] : g1[j & 3], up = j < 4 ? u0[j & 3] : u1[j & 3];
                    gt = fminf(gt, 7.0f); up = fminf(fmaxf(up, -7.0f), 7.0f);
                    o[j] = (up + 1.0f) * gt * sigm(1.702f * gt);
                }
                if constexpr (F8OUT) {
                    int w0 = 0, w1 = 0;
                    w0 = __builtin_amdgcn_cvt_pk_fp8_f32(o[0], o[1], w0, false); w0 = __builtin_amdgcn_cvt_pk_fp8_f32(o[2], o[3], w0, true);
                    w1 = __builtin_amdgcn_cvt_pk_fp8_f32(o[4], o[5], w1, false); w1 = __builtin_amdgcn_cvt_pk_fp8_f32(o[6], o[7], w1, true);
                    u32x2 w; w.x = (unsigned)w0; w.y = (unsigned)w1;
                    *(u32x2*)((unsigned char*)act + (size_t)(row0 + ai * HALF + m * 16) * 1024 + ac0) = w;
                } else {
                    u32x4 w; w.x = cvt_pk_bf16(o[0], o[1]); w.y = cvt_pk_bf16(o[2], o[3]); w.z = cvt_pk_bf16(o[4], o[5]); w.w = cvt_pk_bf16(o[6], o[7]);
                    *(u32x4*)(act + (size_t)(row0 + ai * HALF + m * 16) * 1024 + ac0) = w;
                }
                asm volatile("" ::: "memory");
            }
    }
};
template <bool F8OUT>
struct EpiDown {
    static constexpr bool PERM = true, AFTER_DRAIN = false;
    bf16_t* ys; const float* b2; float ascale;
    __device__ __forceinline__ const float* bias_slice(const Unit& u) const { return b2 + (size_t)(u.pn >> 2) * 1024 + (u.pn & 3) * BM; }
    __device__ __forceinline__ void operator()(const f32x4 (&acc)[2][2][4][2], const Unit& u, int wr, int wc, int fr, int fq, const PG8_LAS float* bl) const {
        const int pn = u.pn & 3;
        const int row0 = u.pm * BM + wr * 64 + fr, col0 = pn * BM + wc * 32 + 8 * fq;
        f32x4 bv[2][2];
#pragma unroll
        for (int bj = 0; bj < 2; ++bj)
#pragma unroll
            for (int n = 0; n < 2; ++n) bv[bj][n] = *(const PG8_LAS f32x4*)(bl + wc * 32 + 8 * fq + bj * HALF + 4 * n);
#pragma unroll
        for (int ai = 0; ai < 2; ++ai)
#pragma unroll
            for (int m = 0; m < 4; ++m) {
                bf16_t* rowp = ys + (size_t)(row0 + ai * HALF + m * 16) * 1024 + col0;
#pragma unroll
                for (int bj = 0; bj < 2; ++bj) {
                    const f32x4 v0 = acc[ai][bj][m][0] * ascale + bv[bj][0], v1 = acc[ai][bj][m][1] * ascale + bv[bj][1];
                    if constexpr (F8OUT) {
                        int w0 = 0, w1 = 0;
                        w0 = __builtin_amdgcn_cvt_pk_fp8_f32(v0[0], v0[1], w0, false); w0 = __builtin_amdgcn_cvt_pk_fp8_f32(v0[2], v0[3], w0, true);
                        w1 = __builtin_amdgcn_cvt_pk_fp8_f32(v1[0], v1[1], w1, false); w1 = __builtin_amdgcn_cvt_pk_fp8_f32(v1[2], v1[3], w1, true);
                        u32x2 w; w.x = (unsigned)w0; w.y = (unsigned)w1;
                        *(u32x2*)((unsigned char*)ys + (size_t)(row0 + ai * HALF + m * 16) * 1024 + col0 + bj * HALF) = w;
                    } else {
                        u32x4 w; w.x = cvt_pk_bf16(v0[0], v0[1]); w.y = cvt_pk_bf16(v0[2], v0[3]); w.z = cvt_pk_bf16(v1[0], v1[1]); w.w = cvt_pk_bf16(v1[2], v1[3]);
                        *(u32x4*)(rowp + bj * HALF) = w;
                    }
                }
            }
    }
};
struct EpiPlain {
    static constexpr bool PERM = true, AFTER_DRAIN = false;
    bf16_t* O;
    __device__ __forceinline__ const float* bias_slice(const Unit&) const { return nullptr; }
    __device__ __forceinline__ void operator()(const f32x4 (&acc)[2][2][4][2], const Unit& u, int wr, int wc, int fr, int fq, const PG8_LAS float*) const {
        const int row0 = u.pm * BM + wr * 64 + fr, col0 = u.pn * BM + wc * 32 + 8 * fq;
#pragma unroll
        for (int ai = 0; ai < 2; ++ai)
#pragma unroll
            for (int m = 0; m < 4; ++m) {
                bf16_t* rowp = O + (size_t)(row0 + ai * HALF + m * 16) * 1024 + col0;
#pragma unroll
                for (int bj = 0; bj < 2; ++bj) {
                    const f32x4 v0 = acc[ai][bj][m][0], v1 = acc[ai][bj][m][1];
                    u32x4 w; w.x = cvt_pk_bf16(v0[0], v0[1]); w.y = cvt_pk_bf16(v0[2], v0[3]); w.z = cvt_pk_bf16(v1[0], v1[1]); w.w = cvt_pk_bf16(v1[2], v1[3]);
                    *(u32x4*)(rowp + bj * HALF) = w;
                }
            }
    }
};
struct EpiGate {
    static constexpr bool PERM = true, AFTER_DRAIN = false;
    const bf16_t* PP; bf16_t* E; const float* bias; float ascale;
    __device__ __forceinline__ const float* bias_slice(const Unit& u) const { return bias + u.pn * BM; }
    __device__ __forceinline__ void operator()(const f32x4 (&acc)[2][2][4][2], const Unit& u, int wr, int wc, int fr, int fq, const PG8_LAS float* bl) const {
        const int row0 = u.pm * BM + wr * 64 + fr, col0 = u.pn * BM + wc * 32 + 8 * fq;
        f32x4 bv[2][2];
#pragma unroll
        for (int bj = 0; bj < 2; ++bj)
#pragma unroll
            for (int n = 0; n < 2; ++n) bv[bj][n] = *(const PG8_LAS f32x4*)(bl + wc * 32 + 8 * fq + bj * HALF + 4 * n);
#pragma unroll
        for (int ai = 0; ai < 2; ++ai)
#pragma unroll
            for (int m = 0; m < 4; ++m) {
                const size_t off = (size_t)(row0 + ai * HALF + m * 16) * 1024 + col0;
#pragma unroll
                for (int bj = 0; bj < 2; ++bj) {
                    const u32x4 pv = *(const u32x4*)(PP + off + bj * HALF);
                    const f32x4 v0 = acc[ai][bj][m][0] * ascale + bv[bj][0], v1 = acc[ai][bj][m][1] * ascale + bv[bj][1];
                    u32x4 w;
                    w.x = cvt_pk_bf16(sigm(v0[0]) * bf_lo(pv.x), sigm(v0[1]) * bf_hi(pv.x)); w.y = cvt_pk_bf16(sigm(v0[2]) * bf_lo(pv.y), sigm(v0[3]) * bf_hi(pv.y));
                    w.z = cvt_pk_bf16(sigm(v1[0]) * bf_lo(pv.z), sigm(v1[1]) * bf_hi(pv.z)); w.w = cvt_pk_bf16(sigm(v1[2]) * bf_lo(pv.w), sigm(v1[3]) * bf_hi(pv.w));
                    *(u32x4*)(E + off + bj * HALF) = w;
                }
            }
    }
};
struct GateOrder {
    int first, count, stride;
    __device__ __forceinline__ bool next(int i, Unit& u) const { if (i >= count) return false; const int idx = first + i * stride; u.pm = idx >> 2; u.pn = idx & 3; return true; }
    __device__ __forceinline__ void a_ready(const Unit&) const {}
    __device__ __forceinline__ void done(const Unit&) const {}
};
struct MoeOrder {
    const PG8_LAS int* tile_e; int nunits, lnt, G, c;
    const PG8_LAS int* tst; const PG8_LAS int* cnt; const int* list; int list_pitch;
    __device__ __forceinline__ const int* row_src(const Unit& u) const { const int e = tile_e[u.pm]; return list + (size_t)e * list_pitch + (u.pm - tst[e]) * 256; }
    __device__ __forceinline__ int nvalid(const Unit& u) const { const int e = tile_e[u.pm]; return cnt[e] - (u.pm - tst[e]) * 256; }
    __device__ __forceinline__ bool next(int i, Unit& u) const {
        const int L = i * G + c; if (L >= nunits) return false;
        const int mt = L >> lnt, pn = L & ((1 << lnt) - 1);
        u.pm = mt; u.pn = (tile_e[mt] << lnt) + pn; return true;
    }
    __device__ __forceinline__ void a_ready(const Unit&) const {}
    __device__ __forceinline__ void done(const Unit&) const {}
};

template <class Epi, class Sched, bool ALIGN_EPI = false, bool SP2 = false, bool F8 = false, bool GATHER = false>
__device__ __forceinline__ void gemm_phase(PG8_LAS unsigned char* lds, const Gemm g, const Sched& S, const Epi& E, const int wave_id, PG8_LAS float* biasl, PG8_LAS int* tokl = nullptr) {
    static_assert(!GATHER || SP2, "the gathered-A form is written for the SP2 loop");
    int tid_l = wave_id * 64 + (int)__builtin_amdgcn_mbcnt_hi(~0u, __builtin_amdgcn_mbcnt_lo(~0u, 0u)); asm volatile("" : "+v"(tid_l));     const int tid = tid_l, wid = __builtin_amdgcn_readfirstlane(tid >> 6), lane = tid & 63, wr = wid >> 2, wc = wid & 3, fr = lane & 15, fq = lane >> 4;
    int K_l = g.K; asm volatile("" : "+s"(K_l)); const int K = K_l, nt = K / BK;
    unsigned voffA[2], voffB[2];
    unsigned voffG[2][2] = {{0u, 0u}, {0u, 0u}};
#pragma unroll
    for (int i = 0; i < 2; ++i) { int R, C; stage_rc(tid * 16 + i * 8192, R, C); const int Rb = Epi::PERM ? ((R & ~31) + perm32(R & 31)) : R;
        voffA[i] = (unsigned)(R * K + C) * 2u; voffB[i] = (unsigned)(Rb * K + C) * 2u; }
    const size_t kstep = (size_t)(BK * 2);
    const size_t hstep = (size_t)HALF * K * 2;
    const size_t tstep = 2 * hstep;
    const unsigned ldsw = (unsigned)wid * 1024u;
    const int aoff = lds_byte(wr * 64 + fr, fq * 8), boff = lds_byte(wc * 32 + fr, fq * 8);
#define PG8_SA(b, h) (((b) * 2 + (h)) * HTB)
#define PG8_SB(b, h) ((4 + (b) * 2 + (h)) * HTB)
#define PG8_STAGE(bufoff, gbase, voff) do { _Pragma("unroll") for (int _i = 0; _i < 2; ++_i) \
        __builtin_amdgcn_global_load_lds((const unsigned*)((const char*)(gbase) + (voff)[_i]), (PG8_LAS unsigned*)(lds + (bufoff) + ldsw + _i * 8192), 16, 0, 0); } while (0)
#define PG8_STAGE_A(bufoff, base, h) do { if constexpr (GATHER) { PG8_STAGE(bufoff, base, voffG[h]); } else { PG8_STAGE(bufoff, (base) + (h) * hstep, voffA); } } while (0)
#define PG8_TOKSTAGE(u_, slot_) do { if (wid == 0) { const int* rp_ = S.row_src(u_); __builtin_amdgcn_global_load_lds((const unsigned*)(rp_ + lane * 4), (PG8_LAS unsigned*)(tokl + (slot_) * 256), 16, 0, 0); } } while (0)
#define PG8_TOKSET(slot_, nv_) do { const int nvv_ = (nv_); _Pragma("unroll") for (int h_ = 0; h_ < 2; ++h_) _Pragma("unroll") for (int i_ = 0; i_ < 2; ++i_) { int R_, C_; stage_rc(tid * 16 + i_ * 8192, R_, C_); \
        const int r_ = h_ * HALF + R_; int tk_ = tokl[(slot_) * 256 + r_]; tk_ = (r_ < nvv_ && tk_ >= 0 && tk_ < g.M) ? tk_ : 0; voffG[h_][i_] = (unsigned)tk_ * (unsigned)(K * 2) + (unsigned)(C_ * 2); } } while (0)
#define PG8_LDA(dst, b, h) do { _Pragma("unroll") for (int m = 0; m < 4; ++m) _Pragma("unroll") for (int k = 0; k < 2; ++k) dst[m][k] = *(const PG8_LAS bf16x8*)(lds + PG8_SA(b, h) + aoff + m * 2048 + k * 1024); } while (0)
#define PG8_LDB(dst, b, h) do { _Pragma("unroll") for (int n = 0; n < 2; ++n) _Pragma("unroll") for (int k = 0; k < 2; ++k) dst[n][k] = *(const PG8_LAS bf16x8*)(lds + PG8_SB(b, h) + boff + n * 2048 + k * 1024); } while (0)
#define PG8_MMA(ai, bj, At, Bt) do { __builtin_amdgcn_s_setprio(1); _Pragma("unroll") for (int m = 0; m < 4; ++m) _Pragma("unroll") for (int n = 0; n < 2; ++n) { \
        if constexpr (F8) { typedef int i32x4_ __attribute__((ext_vector_type(4))); \
              \
            asm volatile("v_mfma_f32_16x16x128_f8f6f4 %0, %1, %2, %0" : "+v"(acc[ai][bj][m][n]) : "v"(__builtin_shufflevector(__builtin_bit_cast(i32x4_, Bt[n][0]), __builtin_bit_cast(i32x4_, Bt[n][1]), 0, 1, 2, 3, 4, 5, 6, 7)), \
                "v"(__builtin_shufflevector(__builtin_bit_cast(i32x4_, At[m][0]), __builtin_bit_cast(i32x4_, At[m][1]), 0, 1, 2, 3, 4, 5, 6, 7))); } \
        else { _Pragma("unroll") for (int k = 0; k < 2; ++k) acc[ai][bj][m][n] = __builtin_amdgcn_mfma_f32_16x16x32_bf16(Bt[n][k], At[m][k], acc[ai][bj][m][n], 0, 0, 0); } } \
        __builtin_amdgcn_s_setprio(0); } while (0)
#define PG8_WAIT_V(n) asm volatile("s_waitcnt vmcnt(" #n ")" ::: "memory")
#define PG8_WAIT_L(n) asm volatile("s_waitcnt lgkmcnt(" #n ")" ::: "memory")
#define PG8_BAR __builtin_amdgcn_s_barrier()
#define PG8_SCHED __builtin_amdgcn_sched_barrier(0)
    Unit cur, nxt; int ui = 0;
    if (!S.next(0, cur)) return;
#define PG8_BIAS(u_, slot_) do { if (wid == 0) { const float* bp_ = E.bias_slice(u_); if (bp_) __builtin_amdgcn_global_load_lds((const unsigned*)(bp_ + lane * 4), (PG8_LAS unsigned*)(biasl + (slot_) * 256), 16, 0, 0); } } while (0)
    PG8_BIAS(cur, 0);
    if constexpr (GATHER) { PG8_TOKSTAGE(cur, 0); asm volatile("s_waitcnt vmcnt(0)" ::: "memory"); __builtin_amdgcn_s_barrier(); asm volatile("" ::: "memory"); PG8_TOKSET(0, S.nvalid(cur)); }
    f32x4 acc[2][2][4][2];
#pragma unroll
    for (int a = 0; a < 2; ++a)
#pragma unroll
        for (int b = 0; b < 2; ++b)
#pragma unroll
            for (int m = 0; m < 4; ++m)
#pragma unroll
                for (int n = 0; n < 2; ++n) acc[a][b][m][n] = (f32x4){0.f, 0.f, 0.f, 0.f};
    bf16x8 At[4][2], B0[2][2], B1[2][2];
    const char* cA = (const char*)g.A + (GATHER ? (size_t)0 : (size_t)cur.pm * tstep); const char* cB = (const char*)g.Bt + (size_t)cur.pn * tstep;
    S.a_ready(cur);
    if constexpr (SP2) {
        PG8_STAGE(PG8_SB(0, 0), cB, voffB); PG8_STAGE(PG8_SB(0, 1), cB + hstep, voffB); PG8_STAGE_A(PG8_SA(0, 0), cA, 0); PG8_STAGE_A(PG8_SA(0, 1), cA, 1);
        if (wr == 1) PG8_BAR;
        PG8_WAIT_V(2); PG8_BAR;
        PG8_STAGE(PG8_SB(1, 0), cB + kstep, voffB); PG8_STAGE_A(PG8_SA(1, 0), cA + kstep, 0); PG8_STAGE(PG8_SB(1, 1), cB + hstep + kstep, voffB);
        PG8_WAIT_V(6); PG8_BAR;
    } else {
        PG8_STAGE(PG8_SB(0, 0), cB, voffB); PG8_STAGE_A(PG8_SA(0, 0), cA, 0); PG8_STAGE(PG8_SB(0, 1), cB + hstep, voffB); PG8_STAGE_A(PG8_SA(0, 1), cA, 1);
        if (wr == 1) PG8_BAR;
        PG8_WAIT_V(4); PG8_BAR;
        PG8_STAGE(PG8_SB(1, 0), cB + kstep, voffB); PG8_STAGE_A(PG8_SA(1, 0), cA + kstep, 0); PG8_STAGE(PG8_SB(1, 1), cB + hstep + kstep, voffB);
        PG8_WAIT_V(6); PG8_BAR;
    }
    for (;;) {
        const bool has_next = S.next(ui + 1, nxt);
        const char* nA = (has_next && !GATHER) ? (const char*)g.A + (size_t)nxt.pm * tstep : cA;
        if constexpr (GATHER) { if (has_next) PG8_TOKSTAGE(nxt, (ui + 1) & 1); } const char* nB = has_next ? (const char*)g.Bt + (size_t)nxt.pn * tstep : cB;
        for (int t = 0; t < nt; t += 2) {
            const bool last = (t == nt - 2);
            const char* a1 = cA + (size_t)(t + 1) * kstep;
            const char* a2 = last ? nA : cA + (size_t)(t + 2) * kstep; const char* b2 = last ? nB : cB + (size_t)(t + 2) * kstep;
            const char* a3 = a2 + kstep; const char* b3 = b2 + kstep;
            if (last && has_next) S.a_ready(nxt);
            if constexpr (SP2) {
            PG8_LDB(B0, 0, 0); PG8_LDB(B1, 0, 1); PG8_SCHED; PG8_LDA(At, 0, 0); PG8_STAGE_A(PG8_SA(1, 1), a1, 1);
            if constexpr (GATHER) { if (last && has_next) PG8_TOKSET((ui + 1) & 1, S.nvalid(nxt)); }
            PG8_WAIT_V(8); PG8_WAIT_L(0); PG8_BAR; PG8_MMA(0, 0, At, B0); PG8_MMA(0, 1, At, B1); PG8_BAR; PG8_SCHED;
            PG8_LDA(At, 0, 1); PG8_STAGE(PG8_SB(0, 0), b2, voffB); PG8_STAGE(PG8_SB(0, 1), b2 + hstep, voffB); PG8_STAGE_A(PG8_SA(0, 0), a2, 0);
            PG8_WAIT_V(8); PG8_WAIT_L(0); PG8_BAR; PG8_MMA(1, 0, At, B0); PG8_MMA(1, 1, At, B1); PG8_BAR; PG8_SCHED;
            PG8_LDB(B0, 1, 0); PG8_LDB(B1, 1, 1); PG8_SCHED; PG8_LDA(At, 1, 0); PG8_STAGE_A(PG8_SA(0, 1), a2, 1);
            PG8_WAIT_V(8); PG8_WAIT_L(0); PG8_BAR; PG8_MMA(0, 0, At, B0); PG8_MMA(0, 1, At, B1); PG8_BAR; PG8_SCHED;
            PG8_LDA(At, 1, 1); PG8_STAGE(PG8_SB(1, 0), b3, voffB); PG8_STAGE(PG8_SB(1, 1), b3 + hstep, voffB); PG8_STAGE_A(PG8_SA(1, 0), a3, 0);
            PG8_WAIT_V(8); PG8_WAIT_L(0); PG8_BAR; PG8_MMA(1, 0, At, B0); PG8_MMA(1, 1, At, B1); PG8_BAR; PG8_SCHED;
            } else {
            PG8_LDB(B0, 0, 0); PG8_SCHED; PG8_LDA(At, 0, 0); PG8_STAGE_A(PG8_SA(1, 1), a1, 1);
            PG8_WAIT_L(8); PG8_BAR; PG8_WAIT_L(0); PG8_MMA(0, 0, At, B0); PG8_BAR; PG8_SCHED;
            PG8_LDB(B1, 0, 1); PG8_STAGE(PG8_SB(0, 0), b2, voffB);
            PG8_BAR; PG8_WAIT_L(0); PG8_MMA(0, 1, At, B1); PG8_BAR;
            PG8_LDA(At, 0, 1); PG8_STAGE_A(PG8_SA(0, 0), a2, 0);
            PG8_BAR; PG8_WAIT_L(0); PG8_MMA(1, 0, At, B0); PG8_BAR; PG8_SCHED;
            PG8_STAGE(PG8_SB(0, 1), b2 + hstep, voffB);
            PG8_WAIT_V(6); PG8_BAR; PG8_MMA(1, 1, At, B1); PG8_BAR;
            PG8_LDB(B0, 1, 0); PG8_SCHED; PG8_LDA(At, 1, 0); PG8_STAGE_A(PG8_SA(0, 1), a2, 1);
            PG8_WAIT_L(8); PG8_BAR; PG8_WAIT_L(0); PG8_MMA(0, 0, At, B0); PG8_BAR; PG8_SCHED;
            PG8_LDB(B1, 1, 1); PG8_STAGE(PG8_SB(1, 0), b3, voffB);
            PG8_BAR; PG8_WAIT_L(0); PG8_MMA(0, 1, At, B1); PG8_BAR;
            PG8_LDA(At, 1, 1); PG8_STAGE_A(PG8_SA(1, 0), a3, 0);
            PG8_BAR; PG8_WAIT_L(0); PG8_MMA(1, 0, At, B0); PG8_BAR; PG8_SCHED;
            PG8_STAGE(PG8_SB(1, 1), b3 + hstep, voffB);
            PG8_WAIT_V(6); PG8_BAR; PG8_MMA(1, 1, At, B1); PG8_BAR;
            }
        }
        if constexpr (F8) { asm volatile("s_nop 7\n\ts_nop 7\n\ts_nop 7\n\ts_nop 7" ::: "memory"); }
        if constexpr (ALIGN_EPI) { if (wr == 0) PG8_BAR; }
        if constexpr (!Epi::AFTER_DRAIN) { E(acc, cur, wr, wc, fr, fq, biasl + (ui & 1) * 256); S.done(cur); }
        if (!has_next) break;
#pragma unroll
        for (int a = 0; a < 2; ++a)
#pragma unroll
            for (int b = 0; b < 2; ++b)
#pragma unroll
                for (int m = 0; m < 4; ++m)
#pragma unroll
                    for (int n = 0; n < 2; ++n) acc[a][b][m][n] = (f32x4){0.f, 0.f, 0.f, 0.f};
        cur = nxt; cA = nA; cB = nB; ++ui;
        PG8_BIAS(cur, ui & 1);
        if constexpr (ALIGN_EPI) { if (wr == 1) PG8_BAR; }
    }
    PG8_WAIT_V(0);
    if constexpr (!ALIGN_EPI) { if (wr == 0) PG8_BAR; }
    PG8_BAR;
    if constexpr (Epi::AFTER_DRAIN) { E.fused(acc, cur, wr, wc, fr, fq, lds, wid, lane); S.done(cur); }
#undef PG8_SA
#undef PG8_SB
#undef PG8_STAGE
#undef PG8_LDA
#undef PG8_LDB
#undef PG8_MMA
#undef PG8_WAIT_V
#undef PG8_WAIT_L
#undef PG8_BAR
#undef PG8_SCHED
#undef PG8_BIAS
#undef PG8_STAGE_A
#undef PG8_TOKSTAGE
#undef PG8_TOKSET
}
}

constexpr int NWAVES = 8;
constexpr int NB = 16, T = 2048, D = 1024, M = NB * T, NL = 2;
constexpr int HP = 2048;
constexpr int NIN = 2304;
constexpr int PD = 256;
constexpr int NE = 32, TOPK = 4;
constexpr int MAXTILES = (M * TOPK) / 256 + NE;
constexpr int MAXSLOTS = MAXTILES * 256;
constexpr float LN_EPS = 1e-5f;
constexpr float DN_ALPHA = 1.4142135623730951f;
constexpr float SC_LOG2E = 0.125f * 1.4426950408889634f;
constexpr int C_QN = 0, C_KC = 512, C_VC = 640, C_KS = 768, C_VS = 896, C_KW = 1024, C_VW = 1152, C_QS = 1280, C_KSW = 1792, C_VSW = 1920;

constexpr size_t MiB = 1u << 20;
constexpr size_t WS_CTL = 0, CTL_ZERO_BYTES = 32768;
constexpr size_t WS_WIN = 2 * MiB;
constexpr size_t WS_WO = 12 * MiB;
constexpr size_t WS_WPG = 16 * MiB;
constexpr size_t WS_WPP = 20 * MiB;
constexpr size_t WS_WC1 = 22 * MiB;
constexpr size_t WS_WC2 = 26 * MiB;
constexpr size_t WS_WR = 27 * MiB;
constexpr size_t WS_BINP = 28 * MiB;
constexpr size_t WS_B1P = 28 * MiB + 65536;
constexpr size_t WS_ROPE = 30 * MiB;
constexpr size_t WS_GATES = 38 * MiB;
constexpr size_t WS_KCMP = 42 * MiB;
constexpr size_t WS_VCMP = 42 * MiB + 512 * 1024;
constexpr size_t WS_TOKE = 43 * MiB;
constexpr size_t WS_TOKR = 43 * MiB + 512 * 1024;
constexpr size_t WS_TOKW = 44 * MiB;
constexpr size_t WS_SLOT = 44 * MiB + 512 * 1024;
constexpr size_t WS_W1T = 48 * MiB;
constexpr size_t WS_W2T = 304 * MiB;
constexpr size_t WS_XB = 432 * MiB;
constexpr size_t WS_PB = 496 * MiB;
constexpr size_t WS_R1 = 528 * MiB;
constexpr size_t WS_H = WS_R1, WS_O = WS_R1 + 128 * MiB, WS_YS = WS_R1;
constexpr size_t WS_LIST = WS_R1;

constexpr size_t WS_R2 = 808 * MiB;
constexpr size_t WS_Y1 = WS_R2, WS_ACT = WS_R2;
constexpr size_t WS_X1 = 1080 * MiB;
constexpr size_t WS_X1B = 1208 * MiB;
constexpr size_t WS_PP = 1272 * MiB;
constexpr size_t WS_E = 1336 * MiB;
constexpr size_t WS_XN = 1400 * MiB;
constexpr size_t WS_X1F8 = WS_XB;
constexpr size_t WS_END = 1528 * MiB;
static_assert((size_t)MAXSLOTS * 2048 <= 272 * MiB, "slot buffers");
constexpr int CW_TMO = 0, CW_CODE = 1;
constexpr int CW_CNT = 1024;
constexpr int CW_BAR = 4096;

constexpr int RING_OFF = 0, RING_BYTES = 131072;
constexpr int SCRATCH_BYTES = 139264;
constexpr int LDSCTL_OFF = SCRATCH_BYTES, MISC_OFF = LDSCTL_OFF + 320;
constexpr int TAB_OFF = MISC_OFF + 128;
constexpr int TAB_CNT = TAB_OFF, TAB_SOFF = TAB_OFF + 128, TAB_TST = TAB_OFF + 256, TAB_TE = TAB_OFF + 512;
constexpr int BIAS_OFF = 143360;
constexpr int TOKL_OFF = BIAS_OFF + 2048;
constexpr int LDS_BYTES = 147456;
static_assert(TAB_TE + MAXTILES * 4 <= BIAS_OFF && TOKL_OFF + 2048 <= LDS_BYTES, "LDS map");

static_assert((CW_BAR + 3456) * 4 <= (int)CTL_ZERO_BYTES && (CW_CNT + NL * 32) * 4 <= (int)CTL_ZERO_BYTES, "control words inside the memset region");
#define GAS __attribute__((address_space(1)))
#define LAS __attribute__((address_space(3)))
typedef unsigned short bf16;
typedef unsigned v4u __attribute__((ext_vector_type(4)));
typedef float f32x4 __attribute__((ext_vector_type(4)));
typedef short bf16x8 __attribute__((ext_vector_type(8)));
typedef GAS unsigned gu32;
typedef GAS unsigned long long gu64;
#define RLX_AGENT __ATOMIC_RELAXED, __HIP_MEMORY_SCOPE_AGENT
#define LDS_WAIT() asm volatile("s_waitcnt lgkmcnt(0)" ::: "memory")
#define VM_WAIT() asm volatile("s_waitcnt vmcnt(0)" ::: "memory")
__device__ __forceinline__ unsigned long long rt() { return __builtin_amdgcn_s_memrealtime(); }
__device__ __forceinline__ unsigned f2bf(float f) { unsigned u = __builtin_bit_cast(unsigned, f); return (u + 0x7fffu + ((u >> 16) & 1u)) >> 16; }
__device__ __forceinline__ unsigned pk2(float lo, float hi) { return f2bf(lo) | (f2bf(hi) << 16); }
#define XB_TMO      128
#define XB_XCNT(j)  (256  + 64 * (j))
#define XB_XSUB(j)  (1280 + 64 * (j))
#define XB_XGEN(j)  (2304 + 64 * (j))
#define XB_TOP      3328
#define XB_TOPGEN   3392
#define XCD_BAR_WORDS 3456
#define XB_SPIN_CAP (1u << 22)

__device__ __forceinline__ unsigned xb_ld(unsigned* p)              { return __hip_atomic_load(p, __ATOMIC_RELAXED, __HIP_MEMORY_SCOPE_AGENT); }
__device__ __forceinline__ unsigned xb_add(unsigned* p, unsigned v) { return __hip_atomic_fetch_add(p, v, __ATOMIC_RELAXED, __HIP_MEMORY_SCOPE_AGENT); }
__device__ __forceinline__ unsigned xb_xcc_id() { return (unsigned)__builtin_amdgcn_s_getreg((3 << 11) | 20) & 0xFu; }
#define XB_SPIN(cond, bar) do { unsigned _sp = 0; while (cond) { __builtin_amdgcn_s_sleep(1); \
    if ((++_sp & 255u) == 0u) { if (xb_ld(&(bar)[XB_TMO])) break; if (_sp > XB_SPIN_CAP) { atomicAdd(&(bar)[XB_TMO], 1u); break; } } } } while (0)

struct XcdBarrier {
    unsigned* bar; unsigned x; int wave;
    volatile LAS unsigned* st;
};

__device__ __forceinline__ bool xb_thread0(int wave) { return wave == 0 && __builtin_amdgcn_mbcnt_hi(~0u, __builtin_amdgcn_mbcnt_lo(~0u, 0u)) == 0u; }
__device__ __forceinline__ XcdBarrier xcd_barrier_post(unsigned* bar, volatile LAS unsigned* st, int wave) {
    XcdBarrier b; b.bar = bar; b.x = xb_xcc_id(); b.st = st; b.wave = wave;
    if (xb_thread0(wave)) (void)xb_add(&bar[XB_XCNT(b.x)], 1u);
    return b;
}
__device__ __forceinline__ void xcd_barrier_complete(unsigned* bar, unsigned x, unsigned& nloc, unsigned& nx) {
    const unsigned G = gridDim.x * gridDim.y * gridDim.z;
    unsigned sum, cnt, mine, sp = 0u;
    for (;;) {
        sum = 0u; cnt = 0u; mine = 0u;
#pragma unroll
        for (unsigned j = 0; j < 16; ++j) { const unsigned c = xb_ld(&bar[XB_XCNT(j)]); sum += c; cnt += (c > 0u) ? 1u : 0u; mine = (j == x) ? c : mine; }
        if (sum == G) break;
        __builtin_amdgcn_s_sleep(1);
        if ((++sp & 255u) == 0u) { if (xb_ld(&bar[XB_TMO])) break; if (sp > XB_SPIN_CAP) { atomicAdd(&bar[XB_TMO], 1u); break; } }
    }
    nloc = mine > 0u ? mine : 1u; nx = cnt > 0u ? cnt : 1u;
}

__device__ __forceinline__ void xcd_barrier(const XcdBarrier& b) {
    asm volatile("s_waitcnt vmcnt(0)" ::: "memory");
    __syncthreads();
    if (xb_thread0(b.wave)) {
        unsigned* bar = b.bar;
        __builtin_amdgcn_s_waitcnt(0);
        unsigned nloc = b.st[0], nx = b.st[1];
        if (nloc == 0u) { xcd_barrier_complete(bar, b.x, nloc, nx); b.st[0] = nloc; b.st[1] = nx; }
        const unsigned old = xb_add(&bar[XB_XSUB(b.x)], 1u);
        const unsigned gen = old / nloc;
        if (old + 1u == (gen + 1u) * nloc) {
            __builtin_amdgcn_fence(__ATOMIC_RELEASE, "agent");
            asm volatile("s_waitcnt vmcnt(0)" ::: "memory");
            const unsigned og = xb_add(&bar[XB_TOP], 1u);
            const unsigned tg = og / nx;
            if (og + 1u == (tg + 1u) * nx) xb_add(&bar[XB_TOPGEN], 1u);
            else XB_SPIN(xb_ld(&bar[XB_TOPGEN]) == tg, bar);
            __builtin_amdgcn_fence(__ATOMIC_ACQUIRE, "agent");
            xb_add(&bar[XB_XGEN(b.x)], 1u);
            asm volatile("s_waitcnt vmcnt(0)" ::: "memory");
        } else {
            XB_SPIN(xb_ld(&bar[XB_XGEN(b.x)]) == gen, bar);
            __builtin_amdgcn_fence(__ATOMIC_ACQUIRE, "agent");
            asm volatile("s_waitcnt vmcnt(0)" ::: "memory");
        }
    }
    __syncthreads();
}

typedef float f32x16 __attribute__((ext_vector_type(16)));
typedef unsigned u32x2 __attribute__((ext_vector_type(2)));
struct Frame {
    LAS unsigned char* lds;
    volatile LAS unsigned* MISC;
    gu32* ctl;
    unsigned char* ws;
    int tid, lane, wave;
    int vcu, G;
};
__device__ __forceinline__ float wave_sum(float v) {
#pragma unroll
    for (int o = 1; o < 64; o <<= 1) v += __shfl_xor(v, o);
    return v;
}
__device__ __forceinline__ float sigm(float x) { return __builtin_amdgcn_rcpf(1.0f + __builtin_amdgcn_exp2f(-1.4426950408889634f * x)); }
__device__ __forceinline__ float bf_lo(unsigned w) { return __uint_as_float(w << 16); }
__device__ __forceinline__ float bf_hi(unsigned w) { return __uint_as_float(w & 0xffff0000u); }
__device__ __forceinline__ unsigned cvtpk(float lo, float hi) { typedef float f2 __attribute__((ext_vector_type(2))); typedef __bf16 b2 __attribute__((ext_vector_type(2))); f2 v = {lo, hi}; b2 b = __builtin_convertvector(v, b2); return __builtin_bit_cast(unsigned, b); }
__device__ __forceinline__ bf16x8 pack8(float a0, float a1, float a2, float a3, float a4, float a5, float a6, float a7) {
    v4u w; w.x = cvtpk(a0, a1); w.y = cvtpk(a2, a3); w.z = cvtpk(a4, a5); w.w = cvtpk(a6, a7); return __builtin_bit_cast(bf16x8, w);
}
__device__ __forceinline__ int crow(int r, int hi) { return (r & 3) + 8 * (r >> 2) + 4 * hi; }

struct MapId { __device__ __forceinline__ int operator()(int n) const { return n; } };
struct MapW1 { __device__ __forceinline__ int operator()(int n) const { return ((n >> 7) & 1) * 1024 + (n >> 8) * 128 + (n & 127); } };
struct MapWin {
    __device__ __forceinline__ int operator()(int n) const {
        if (n >= 2048) { const int i = n - 2048; return i < 24 ? 1280 + i : -1; }
        const int seg = n >> 7, q = n & 127, hd = q >> 6, pos = q & 63, g = pos >> 3, j = pos & 7;
        const int dlog = j < 4 ? 4 * g + j : 32 + 4 * g + (j - 4);
        const int hc = seg * 128 + hd * 64 + dlog;
        return hc < 1280 ? hc : hc + 24;
    }
};
template <class Map>
__device__ __forceinline__ void transpose_item(const float* W, int K, int Nsrc, bf16* WT, LAS float* scr, int kb, int nb, int lane, Map map) {
    const int k0 = 64 * kb, n0 = 32 * nb;
    const int src = map(n0 + (lane & 31));
    float wv[32];
#pragma unroll
    for (int i = 0; i < 32; ++i) { const int kk = 2 * i + (lane >> 5); wv[i] = src >= 0 ? W[(size_t)(k0 + kk) * Nsrc + src] : 0.f; }
#pragma unroll
    for (int i = 0; i < 32; ++i) { const int kk = 2 * i + (lane >> 5); scr[kk * 33 + (lane & 31)] = wv[i]; }
    LDS_WAIT(); asm volatile("" ::: "memory");
    const int c = lane & 7;
#pragma unroll
    for (int j = 0; j < 4; ++j) { const int n = (lane >> 3) + 8 * j; const LAS float* s = scr + (8 * c) * 33 + n;
        v4u o; o.x = pk2(s[0 * 33], s[1 * 33]); o.y = pk2(s[2 * 33], s[3 * 33]); o.z = pk2(s[4 * 33], s[5 * 33]); o.w = pk2(s[6 * 33], s[7 * 33]);
        *(GAS v4u*)(WT + (size_t)(n0 + n) * K + k0 + 8 * c) = o; }
    LDS_WAIT(); asm volatile("" ::: "memory");
}
__device__ __forceinline__ unsigned pk4_fp8(float a, float b, float c, float d) { int w = 0; w = __builtin_amdgcn_cvt_pk_fp8_f32(a, b, w, false); w = __builtin_amdgcn_cvt_pk_fp8_f32(c, d, w, true); return (unsigned)w; }
template <class Map>
__device__ __forceinline__ void transpose_item_f8(const float* W, int K, int Nsrc, unsigned char* WT, LAS float* scr, int kb, int nb, int lane, Map map, float wscale) {
    const int k0 = 64 * kb, n0 = 32 * nb;
    const int src = map(n0 + (lane & 31));
    float wv[32];
#pragma unroll
    for (int i = 0; i < 32; ++i) { const int kk = 2 * i + (lane >> 5); wv[i] = src >= 0 ? W[(size_t)(k0 + kk) * Nsrc + src] * wscale : 0.f; }
#pragma unroll
    for (int i = 0; i < 32; ++i) { const int kk = 2 * i + (lane >> 5); scr[kk * 33 + (lane & 31)] = wv[i]; }
    LDS_WAIT(); asm volatile("" ::: "memory");
    const int c = lane & 7;
#pragma unroll
    for (int j = 0; j < 4; ++j) { const int n = (lane >> 3) + 8 * j; const LAS float* s = scr + (8 * c) * 33 + n;
        u32x2 o; o.x = pk4_fp8(s[0 * 33], s[1 * 33], s[2 * 33], s[3 * 33]); o.y = pk4_fp8(s[4 * 33], s[5 * 33], s[6 * 33], s[7 * 33]);
        *(GAS u32x2*)(WT + (size_t)(n0 + n) * K + k0 + 8 * c) = o; }
    LDS_WAIT(); asm volatile("" ::: "memory");
}
constexpr float W1_F8_SCALE = 64.0f, W2_F8_SCALE = 128.0f, WPG_F8_SCALE = 64.0f;
struct PIn { const float *x, *p, *w_in, *b_in, *w_ck1, *w_ck2, *w_cv1, *w_cv2, *w_o, *w_r, *w_e1, *b_e1, *w_e2, *w_pg, *w_pp; const int* pos; };
__device__ __forceinline__ void p0_prologue(Frame& F, const PIn& I) {
    LAS float* scr = (LAS float*)(F.lds + RING_OFF + F.wave * 16384);
    const int gw = F.vcu * NWAVES + F.wave, NGW = F.G * NWAVES, lane = F.lane;
    unsigned char* ws = F.ws;
    constexpr int I_IN = 16 * 72, I_O = 16 * 32, I_PG = 16 * 32, I_PP = 4 * 32, I_C1 = 32 * 8, I_C2 = 4 * 2, I_E1 = 32 * 16 * 64, I_E2 = 32 * 16 * 32;
    constexpr int I_LAYER = I_IN + I_O + I_PG + I_PP + 2 * I_C1 + 2 * I_C2 + I_E1 + I_E2;
    for (int it = gw; it < NL * I_LAYER; it += NGW) {
        const int L = it / I_LAYER; int r = it % I_LAYER;
        if (r < I_IN) { transpose_item(I.w_in + (size_t)L * 1024 * 2072, 1024, 2072, (bf16*)(ws + WS_WIN) + (size_t)L * NIN * 1024, scr, r / 72, r % 72, lane, MapWin()); continue; } r -= I_IN;
        if (r < I_O) { transpose_item(I.w_o + (size_t)L * 1024 * 1024, 1024, 1024, (bf16*)(ws + WS_WO) + (size_t)L * 1024 * 1024, scr, r / 32, r % 32, lane, MapId()); continue; } r -= I_O;
        if (r < I_PG) {
            if (L == NL - 1) transpose_item_f8(I.w_pg + (size_t)L * 1024 * 1024, 1024, 1024, ws + WS_WPG + (size_t)L * 1024 * 1024 * 2, scr, r / 32, r % 32, lane, MapId(), WPG_F8_SCALE);
            else transpose_item(I.w_pg + (size_t)L * 1024 * 1024, 1024, 1024, (bf16*)(ws + WS_WPG) + (size_t)L * 1024 * 1024, scr, r / 32, r % 32, lane, MapId());
            continue; } r -= I_PG;
        if (r < I_PP) { transpose_item(I.w_pp + (size_t)L * 256 * 1024, 256, 1024, (bf16*)(ws + WS_WPP) + (size_t)L * 1024 * 256, scr, r / 32, r % 32, lane, MapId()); continue; } r -= I_PP;
        if (r < I_C1) { transpose_item(I.w_ck1 + (size_t)L * 2048 * 256, 2048, 256, (bf16*)(ws + WS_WC1) + (size_t)(L * 2 + 0) * 256 * 2048, scr, r / 8, r % 8, lane, MapId()); continue; } r -= I_C1;
        if (r < I_C1) { transpose_item(I.w_cv1 + (size_t)L * 2048 * 256, 2048, 256, (bf16*)(ws + WS_WC1) + (size_t)(L * 2 + 1) * 256 * 2048, scr, r / 8, r % 8, lane, MapId()); continue; } r -= I_C1;
        if (r < I_C2) { transpose_item(I.w_ck2 + (size_t)L * 256 * 64, 256, 64, (bf16*)(ws + WS_WC2) + (size_t)(L * 2 + 0) * 64 * 256, scr, r / 2, r % 2, lane, MapId()); continue; } r -= I_C2;
        if (r < I_C2) { transpose_item(I.w_cv2 + (size_t)L * 256 * 64, 256, 64, (bf16*)(ws + WS_WC2) + (size_t)(L * 2 + 1) * 64 * 256, scr, r / 2, r % 2, lane, MapId()); continue; } r -= I_C2;
        if (r < I_E1) { const int e = r / 1024, q = r % 1024;
            if (L == NL - 1) transpose_item_f8(I.w_e1 + ((size_t)L * 32 + e) * 1024 * 2048, 1024, 2048, ws + WS_W1T + (size_t)L * 32 * 2048 * 1024 * 2 + (size_t)e * 2048 * 1024, scr, q / 64, q % 64, lane, MapW1(), W1_F8_SCALE);
            else transpose_item(I.w_e1 + ((size_t)L * 32 + e) * 1024 * 2048, 1024, 2048, (bf16*)(ws + WS_W1T) + ((size_t)L * 32 + e) * 2048 * 1024, scr, q / 64, q % 64, lane, MapW1());
            continue; } r -= I_E1;
        { const int e = r / 512, q = r % 512;
          if (L == NL - 1) transpose_item_f8(I.w_e2 + ((size_t)L * 32 + e) * 1024 * 1024, 1024, 1024, ws + WS_W2T + (size_t)L * 32 * 1024 * 1024 * 2 + (size_t)e * 1024 * 1024, scr, q / 32, q % 32, lane, MapId(), W2_F8_SCALE);
          else transpose_item(I.w_e2 + ((size_t)L * 32 + e) * 1024 * 1024, 1024, 1024, (bf16*)(ws + WS_W2T) + ((size_t)L * 32 + e) * 1024 * 1024, scr, q / 32, q % 32, lane, MapId()); }
    }
    const size_t gt = (size_t)F.vcu * (NWAVES * 64) + F.tid, NGT = (size_t)F.G * NWAVES * 64;
    for (size_t i = gt; i < (size_t)NL * 32 * 1024; i += NGT) {
        const int L = (int)(i / (32 * 1024)), e = (int)((i / 1024) % 32), k = (int)(i % 1024);
        const float w = I.w_r[((size_t)L * 1024 + k) * 32 + e];
        const unsigned h = f2bf(w); const float wl = w - __uint_as_float(h << 16);
        bf16* d = (bf16*)(ws + WS_WR) + (size_t)L * 2 * 32 * 1024 + (size_t)e * 1024 + k;
        d[0] = (bf16)h; d[32 * 1024] = (bf16)f2bf(wl);
    }
    for (size_t i = gt; i < (size_t)NL * NIN; i += NGT) { const int L = (int)(i / NIN), n = (int)(i % NIN); const int s = MapWin()(n); ((float*)(ws + WS_BINP))[i] = s >= 0 ? I.b_in[(size_t)L * 2072 + s] : 0.f; }
    for (size_t i = gt; i < (size_t)NL * 32 * 2048; i += NGT) { const int le = (int)(i / 2048), n = (int)(i % 2048); ((float*)(ws + WS_B1P))[i] = I.b_e1[(size_t)le * 2048 + MapW1()(n)]; }
    for (size_t i = gt; i < (size_t)M * D / 8; i += NGT) {
        const f32x4 a = *(const GAS f32x4*)(I.x + i * 8), b = *(const GAS f32x4*)(I.x + i * 8 + 4);
        v4u o; o.x = pk2(a.x, a.y); o.y = pk2(a.z, a.w); o.z = pk2(b.x, b.y); o.w = pk2(b.z, b.w);
        *(GAS v4u*)((bf16*)(ws + WS_XB) + i * 8) = o;
    }
    for (size_t i = gt; i < (size_t)NL * M * PD / 8; i += NGT) {
        const f32x4 a = *(const GAS f32x4*)(I.p + i * 8), b = *(const GAS f32x4*)(I.p + i * 8 + 4);
        v4u o; o.x = pk2(a.x, a.y); o.y = pk2(a.z, a.w); o.z = pk2(b.x, b.y); o.w = pk2(b.z, b.w);
        *(GAS v4u*)((bf16*)(ws + WS_PB) + i * 8) = o;
    }
    for (size_t i = gt; i < (size_t)M * 32; i += NGT) {
        const int row = (int)(i >> 5), d = (int)(i & 31);
        const float inv = 1.0f / powf(10000.0f, (float)(2 * d) / 64.0f);
        const float ang = (float)I.pos[row] * inv;
        float* rp = (float*)(ws + WS_ROPE) + (size_t)row * 64;
        rp[d] = cosf(ang); rp[32 + d] = sinf(ang);
    }
}

__device__ __forceinline__ float gelu_tanh(float x) {
    const float u = 0.7978845608028654f * (x + 0.044715f * x * x * x);
    const float e = __builtin_amdgcn_exp2f(2.0f * 1.4426950408889634f * u);
    const float t = 1.0f - 2.0f * __builtin_amdgcn_rcpf(e + 1.0f);
    return 0.5f * x * (1.0f + t);
}
__device__ __forceinline__ void phase_compress(Frame& F, int L, const float* ck_pe, const float* cv_pe) {
    const int lane = F.lane, wave = F.wave, tid = F.tid;
    unsigned char* ws = F.ws;
    const bf16* H = (const bf16*)(ws + WS_H);
    const float* rope = (const float*)(ws + WS_ROPE);
    LAS unsigned char* hid = F.lds + RING_OFF;
    LAS float* pel = (LAS float*)(F.lds + RING_OFF + 16896);
    LAS unsigned char* atok = F.lds + RING_OFF + 16896 + 8192;
    constexpr int AP = 144, AIS = 33 * AP;
    for (int unit = blockIdx.x; unit < 256; unit += F.G) {
        int lane_v = lane; asm volatile("" : "+v"(lane_v));
        const int q = lane_v & 31, hi = lane_v >> 5;
        const int b = unit >> 4, g = (unit >> 3) & 1, kv = (unit >> 2) & 1, cb = unit & 3;
        const bf16* w1t = (const bf16*)(ws + WS_WC1) + (size_t)(L * 2 + kv) * 256 * 2048;
        const bf16* w2t = (const bf16*)(ws + WS_WC2) + (size_t)(L * 2 + kv) * 64 * 256;
        const float* pe = (kv ? cv_pe : ck_pe) + (size_t)L * 32 * 64;
        const int scol = (kv ? C_VC : C_KC) + g * 64;
        const int tok0 = 512 * cb;
        __syncthreads();
        for (int ci = tid; ci < 528 * 8; ci += NWAVES * 64) {
            const int tk = ci >> 3, ch = ci & 7; int tg = tok0 + tk; tg = tg < T ? tg : T - 1;
            *(LAS v4u*)(atok + (tk & 15) * AIS + (tk >> 4) * AP + ch * 16) = *(const GAS v4u*)(H + ((size_t)b * T + tg) * HP + scol + ch * 8);
        }
        for (int ci = tid; ci < 32 * 64 / 4; ci += NWAVES * 64) *(LAS f32x4*)(pel + ci * 4) = *(const GAS f32x4*)(pe + ci * 4);
        __syncthreads();
        const bf16* brow = w1t + (size_t)(32 * wave + q) * 2048 + 8 * hi;
        f32x16 acc; for (int r = 0; r < 16; ++r) acc[r] = 0.f;
        bf16x8 bcur[8], bnxt[8];
#pragma unroll
        for (int u = 0; u < 8; ++u) bcur[u] = *(const GAS bf16x8*)(brow + u * 16);
        for (int i2 = 0; i2 < 16; ++i2) {
            if (i2 < 15) {
#pragma unroll
                for (int u = 0; u < 8; ++u) bnxt[u] = *(const GAS bf16x8*)(brow + (i2 + 1) * 128 + u * 16);
            }
#pragma unroll
            for (int u = 0; u < 8; ++u) {
                const int i = 2 * i2 + (u >> 2), s4 = u & 3;
                const v4u av = *(const LAS v4u*)(atok + (i & 15) * AIS + (q + (i >> 4)) * AP + (16 * s4 + 8 * hi) * 2);
                const f32x4 p0 = *(const LAS f32x4*)(pel + i * 64 + 16 * s4 + 8 * hi), p1 = *(const LAS f32x4*)(pel + i * 64 + 16 * s4 + 8 * hi + 4);
                const bf16x8 af = pack8(bf_lo(av.x) + p0.x, bf_hi(av.x) + p0.y, bf_lo(av.y) + p0.z, bf_hi(av.y) + p0.w, bf_lo(av.z) + p1.x, bf_hi(av.z) + p1.y, bf_lo(av.w) + p1.z, bf_hi(av.w) + p1.w);
                acc = __builtin_amdgcn_mfma_f32_32x32x16_bf16(af, bcur[u], acc, 0, 0, 0);
            }
#pragma unroll
            for (int u = 0; u < 8; ++u) bcur[u] = bnxt[u];
        }
#pragma unroll
        for (int r = 0; r < 16; ++r) *(LAS bf16*)(hid + crow(r, hi) * 528 + (32 * wave + q) * 2) = (bf16)f2bf(gelu_tanh(acc[r]));
        __syncthreads();
        if (wave == 0) {
            f32x16 a0, a1; for (int r = 0; r < 16; ++r) { a0[r] = 0.f; a1[r] = 0.f; }
#pragma unroll
            for (int ks = 0; ks < 16; ++ks) {
                const bf16x8 af = *(const LAS bf16x8*)(hid + q * 528 + (16 * ks + 8 * hi) * 2);
                const bf16x8 b0 = *(const GAS bf16x8*)(w2t + (size_t)q * 256 + 16 * ks + 8 * hi), b1 = *(const GAS bf16x8*)(w2t + (size_t)(32 + q) * 256 + 16 * ks + 8 * hi);
                a0 = __builtin_amdgcn_mfma_f32_32x32x16_bf16(af, b0, a0, 0, 0, 0);
                a1 = __builtin_amdgcn_mfma_f32_32x32x16_bf16(af, b1, a1, 0, 0, 0);
            }
            bf16* outp = (bf16*)(ws + (kv ? WS_VCMP : WS_KCMP)) + (size_t)(b * 2 + g) * 128 * 64;
#pragma unroll
            for (int r = 0; r < 16; ++r) {
                const int cl = 32 * cb + crow(r, hi);
                float x1 = a0[r], x2 = a1[r];
                if (kv == 0) {
                    const int cr = cl < 127 ? cl : 126;
                    const float* rp = rope + ((size_t)b * T + 31 + 16 * cr) * 64;
                    const float cs = rp[q], sn = rp[32 + q];
                    const float o1 = x1 * cs - x2 * sn, o2 = x2 * cs + x1 * sn; x1 = o1; x2 = o2;
                }
                if (cl >= 127) { x1 = 0.f; x2 = 0.f; }
                outp[(size_t)cl * 64 + q] = (bf16)f2bf(x1); outp[(size_t)cl * 64 + 32 + q] = (bf16)f2bf(x2);
            }
        }
    }
    __syncthreads();
}

namespace att {
constexpr float ATT_THR = 6.0f;
constexpr int KP = 144;
constexpr int KTB = 64 * KP, VTB = 8192;
constexpr int L_K = 0;
constexpr int L_V = 4 * KTB;
constexpr int L_KC = 0;
constexpr int L_VC = 128 * KP;
constexpr int L_IMP = L_VC + 16384;
constexpr int L_OT = 4 * KTB + 4 * VTB;
constexpr int L_SEL = L_OT + 65536;
static_assert(L_IMP + 4 * 64 * 33 * 4 <= L_OT && L_SEL + 256 <= SCRATCH_BYTES, "attention LDS map");

__device__ __forceinline__ float max3f(float a, float b, float c) { float r; asm("v_max3_f32 %0, %1, %2, %3" : "=v"(r) : "v"(a), "v"(b), "v"(c)); return r; }
__device__ __forceinline__ float max2f(float a, float b) { float r; asm("v_max_f32_e32 %0, %1, %2" : "=v"(r) : "v"(a), "v"(b)); return r; }
typedef short v4i16_t __attribute__((ext_vector_type(4)));
__device__ __forceinline__ u32x2 vtr(const LAS unsigned char* p) { return __builtin_bit_cast(u32x2, __builtin_amdgcn_ds_read_tr16_b64_v4i16((LAS v4i16_t*)p)); }
__device__ __forceinline__ float xhalf_max(float v) { auto rr = __builtin_amdgcn_permlane32_swap(__float_as_uint(v), __float_as_uint(v), false, false); return fmaxf(__uint_as_float(rr[0]), __uint_as_float(rr[1])); }
__device__ __forceinline__ float xhalf_sum(float v) { auto rr = __builtin_amdgcn_permlane32_swap(__float_as_uint(v), __float_as_uint(v), false, false); return __uint_as_float(rr[0]) + __uint_as_float(rr[1]); }
template <bool SEL>
__device__ __forceinline__ void att_tile(LAS unsigned char* Kl, LAS unsigned char* Vl, int j, int qt, int jlo, int t, int W, unsigned selbits, const bf16x8 (&qf)[4],
                                         f32x16& o0, f32x16& o1, f32x16& negm, float& m_run, float& l_run, int q, int hi) {
        bf16x8 ka[4], kb2[4]; u32x2 va[4][2], vb[4][2];
#pragma unroll
        for (int s = 0; s < 4; ++s) { ka[s] = *(const LAS bf16x8*)(Kl + q * KP + (16 * s + 8 * hi) * 2); kb2[s] = *(const LAS bf16x8*)(Kl + (32 + q) * KP + (16 * s + 8 * hi) * 2); }
        {
            const LAS unsigned char* vp = Vl + ((q >> 4) & 1) * 32 + (q & 3) * 8 + (4 * hi + ((q & 15) >> 2)) * 64;
#pragma unroll
            for (int ks = 0; ks < 4; ++ks) {
                va[ks][0] = vtr(vp + ks * 1024); va[ks][1] = vtr(vp + ks * 1024 + 512);
                vb[ks][0] = vtr(vp + 4096 + ks * 1024); vb[ks][1] = vtr(vp + 4096 + ks * 1024 + 512);
            }
        }
        __builtin_amdgcn_sched_barrier(0);
        f32x16 s0 = __builtin_amdgcn_mfma_f32_32x32x16_bf16(ka[0], qf[0], negm, 0, 0, 0);
        f32x16 s1 = __builtin_amdgcn_mfma_f32_32x32x16_bf16(kb2[0], qf[0], negm, 0, 0, 0);
#pragma unroll
        for (int s = 1; s < 4; ++s) {
            s0 = __builtin_amdgcn_mfma_f32_32x32x16_bf16(ka[s], qf[s], s0, 0, 0, 0);
            s1 = __builtin_amdgcn_mfma_f32_32x32x16_bf16(kb2[s], qf[s], s1, 0, 0, 0);
        }
        const bool lane_ok = SEL ? (((selbits >> j) & 1u) != 0u) : true;
        if (j == qt || j == jlo) {
            const int d0 = t - 64 * j - 4 * hi;
#pragma unroll
            for (int r = 0; r < 16; ++r) {
                s0[r] = ((unsigned)(d0 - ((r & 3) + 8 * (r >> 2))) < (unsigned)W) ? s0[r] : -INFINITY;
                s1[r] = ((unsigned)(d0 - (32 + (r & 3) + 8 * (r >> 2))) < (unsigned)W) ? s1[r] : -INFINITY;
            }
        }
        float mx = fmaxf(s0[0], s1[0]), mx2 = fmaxf(s0[1], s1[1]);
#pragma unroll
        for (int r = 2; r < 16; r += 2) { mx = max3f(mx, s0[r], s1[r]); mx2 = max3f(mx2, s0[r + 1], s1[r + 1]); }
        mx = max2f(mx, mx2);
        mx = lane_ok ? mx : -INFINITY;
        mx = xhalf_max(mx);
        typedef float f32x2_ __attribute__((ext_vector_type(2)));
        f32x2_ ps2 = {0.f, 0.f};
#pragma unroll
        for (int r = 0; r < 16; ++r) { s0[r] = __builtin_amdgcn_exp2f(s0[r]); s1[r] = __builtin_amdgcn_exp2f(s1[r]); ps2 += (f32x2_){s0[r], s1[r]}; }
        const float ps = ps2.x + ps2.y;
        const unsigned okm = lane_ok ? 0xffffffffu : 0u;
        l_run += lane_ok ? ps : 0.f;
#pragma unroll
        for (int ks = 0; ks < 4; ++ks) {
            const int kb = ks >> 1, sp = ks & 1;
            bf16x8 pf = kb ? pack8(s1[8 * sp + 0], s1[8 * sp + 1], s1[8 * sp + 2], s1[8 * sp + 3], s1[8 * sp + 4], s1[8 * sp + 5], s1[8 * sp + 6], s1[8 * sp + 7])
                           : pack8(s0[8 * sp + 0], s0[8 * sp + 1], s0[8 * sp + 2], s0[8 * sp + 3], s0[8 * sp + 4], s0[8 * sp + 5], s0[8 * sp + 6], s0[8 * sp + 7]);
            if (SEL) { v4u pw = __builtin_bit_cast(v4u, pf); pw.x &= okm; pw.y &= okm; pw.z &= okm; pw.w &= okm; pf = __builtin_bit_cast(bf16x8, pw); }
            {
                v4u w; w.x = va[ks][0].x; w.y = va[ks][0].y; w.z = va[ks][1].x; w.w = va[ks][1].y;
                o0 = __builtin_amdgcn_mfma_f32_32x32x16_bf16(__builtin_bit_cast(bf16x8, w), pf, o0, 0, 0, 0);
            }
            {
                v4u w; w.x = vb[ks][0].x; w.y = vb[ks][0].y; w.z = vb[ks][1].x; w.w = vb[ks][1].y;
                o1 = __builtin_amdgcn_mfma_f32_32x32x16_bf16(__builtin_bit_cast(bf16x8, w), pf, o1, 0, 0, 0);
            }
        }
        if (__builtin_amdgcn_ballot_w64(mx > ATT_THR) != 0ull) {
            const float gmx = fmaxf(mx, 0.f);
            const float alpha = __builtin_amdgcn_exp2f(-gmx);
            l_run *= alpha; m_run += gmx;
#pragma unroll
            for (int r = 0; r < 16; ++r) { o0[r] *= alpha; o1[r] *= alpha; negm[r] -= gmx; }
        }
}
template <bool SEL>
__device__ __forceinline__ void stream(LAS unsigned char* lds, const bf16* Hb, int kcol, int vcol, int j0, int j1, int qt, int t, int W, unsigned selbits,
                                       const bf16x8 (&qf)[4], f32x16& o0, f32x16& o1, float& m_run, float& l_run, int tid, int lane, int wave) {
    const int q = lane & 31, hi = lane >> 5;
    const int krow = tid >> 3, kch = tid & 7, vrow = krow, vch = kch;
    const int vdst = (kch >> 2) * 4096 + (krow >> 3) * 512 + (krow & 7) * 64 + (kch & 3) * 16;
    const int jlo = qt - (W >> 6);
    f32x16 negm;
#pragma unroll
    for (int r = 0; r < 16; ++r) negm[r] = -m_run;
    __syncthreads();
    const bf16* kp0 = Hb + (size_t)(64 * j0 + krow) * HP + kcol + kch * 8;
    const bf16* vp0 = Hb + (size_t)(64 * j0 + vrow) * HP + vcol + vch * 8;
    v4u kA = *(const GAS v4u*)kp0, vA = *(const GAS v4u*)vp0, kB = kA, vB = vA;
    if (j0 + 1 <= j1) { kB = *(const GAS v4u*)(kp0 + (size_t)64 * HP); vB = *(const GAS v4u*)(vp0 + (size_t)64 * HP); }
    int pp = 0;
    for (int jp = j0; jp <= j1; jp += 2, pp ^= 1) {
        const bool has2 = jp + 1 <= j1;
        LAS unsigned char* Kl0 = lds + L_K + pp * (2 * KTB); LAS unsigned char* Kl1 = Kl0 + KTB;
        LAS unsigned char* Vl0 = lds + L_V + pp * (2 * VTB); LAS unsigned char* Vl1 = Vl0 + VTB;
        *(LAS v4u*)(Kl0 + krow * KP + kch * 16) = kA;
        *(LAS v4u*)(Vl0 + vdst) = vA;
        if (has2) { *(LAS v4u*)(Kl1 + krow * KP + kch * 16) = kB; *(LAS v4u*)(Vl1 + vdst) = vB; }
        if (jp + 2 <= j1) { kA = *(const GAS v4u*)(kp0 + (size_t)(64 * (jp + 2 - j0)) * HP); vA = *(const GAS v4u*)(vp0 + (size_t)(64 * (jp + 2 - j0)) * HP); }
        if (jp + 3 <= j1) { kB = *(const GAS v4u*)(kp0 + (size_t)(64 * (jp + 3 - j0)) * HP); vB = *(const GAS v4u*)(vp0 + (size_t)(64 * (jp + 3 - j0)) * HP); }
        __syncthreads();
        att_tile<SEL>(Kl0, Vl0, jp, qt, jlo, t, W, selbits, qf, o0, o1, negm, m_run, l_run, q, hi);
        if (has2) att_tile<SEL>(Kl1, Vl1, jp + 1, qt, jlo, t, W, selbits, qf, o0, o1, negm, m_run, l_run, q, hi);
    }
}

__device__ __forceinline__ void phase_attention(Frame& F, int L, const float* sinks_all) {
    const int tid = F.tid, lane = F.lane, wave = F.wave;
    const int rh = wave >> 1, th = wave & 1;
    unsigned char* ws = F.ws;
    LAS unsigned char* lds = F.lds + RING_OFF;
    const bf16* H = (const bf16*)(ws + WS_H);
    bf16* O = (bf16*)(ws + WS_O);
    const float* gates = (const float*)(ws + WS_GATES);
    const float* sinks = sinks_all + L * 8;
    LAS float* impb = (LAS float*)(lds + L_IMP);
    LAS unsigned* selm = (LAS unsigned*)(lds + L_SEL);
    const int NU = 2048;
    if (wave >= 4) __builtin_amdgcn_s_setprio(1);
    for (int i = 0;; ++i) {
        const int pos = (i & 1) ? (F.G - 1 - (int)blockIdx.x) : (int)blockIdx.x;
        const int n = i * F.G + pos;
        if (i * F.G >= NU) break;
        if (n >= NU) continue;
        const bool nsa = n < 1024;
        int b, g, qt;
        if (nsa) { qt = 31 - (n >> 5); b = (n & 31) >> 1; g = n & 1; }
        else { const int m2 = n - 1024; qt = 31 - (m2 >> 5); b = (m2 & 31) >> 1; g = m2 & 1; }
        int lane_v = lane; asm volatile("" : "+v"(lane_v));
        const int q = lane_v & 31, hi = lane_v >> 5;
        const int hq = 4 * g + rh;
        const int t = 64 * qt + 32 * th + q;
        const size_t row = (size_t)b * T + t;
        const bf16* Hb = H + (size_t)b * T * HP;
        bf16x8 qf[4];
        {
            const bf16* qp = H + row * HP + (nsa ? C_QN : C_QS) + 64 * hq + 8 * hi;
#pragma unroll
            for (int s = 0; s < 4; ++s) qf[s] = *(const GAS bf16x8*)(qp + 16 * s);
        }
        f32x16 ot0, ot1;
        if (nsa) {
            const float* gp = gates + row * 32 + hq * 3;
            const float g_cmp = gp[0], g_slc = gp[1], g_win = gp[2];
            __syncthreads();
            {
                const bf16* kc = (const bf16*)(ws + WS_KCMP) + (size_t)(b * 2 + g) * 128 * 64;
                const bf16* vc = (const bf16*)(ws + WS_VCMP) + (size_t)(b * 2 + g) * 128 * 64;
#pragma unroll
                for (int it = 0; it < 2; ++it) {
                    const int ci = tid + 512 * it, r = ci >> 3, ch = ci & 7;
                    *(LAS v4u*)(lds + L_KC + r * KP + ch * 16) = *(const GAS v4u*)(kc + (size_t)r * 64 + ch * 8);
                    *(LAS v4u*)(lds + L_VC + (ch >> 2) * 8192 + (r >> 3) * 512 + (r & 7) * 64 + (ch & 3) * 16) = *(const GAS v4u*)(vc + (size_t)r * 64 + ch * 8);
                }
            }
            __syncthreads();
            f32x16 sc[4];
#pragma unroll
            for (int kb = 0; kb < 4; ++kb) {
#pragma unroll
                for (int r = 0; r < 16; ++r) sc[kb][r] = 0.f;
#pragma unroll
                for (int s = 0; s < 4; ++s) {
                    const bf16x8 a = *(const LAS bf16x8*)(lds + L_KC + (32 * kb + q) * KP + (16 * s + 8 * hi) * 2);
                    sc[kb] = __builtin_amdgcn_mfma_f32_32x32x16_bf16(a, qf[s], sc[kb], 0, 0, 0);
                }
                __builtin_amdgcn_sched_barrier(0);
            }
            float mx = -INFINITY;
            const int cth = (((t - 31) >> 4) < 126 ? ((t - 31) >> 4) : 126) - 4 * hi;
#pragma unroll
            for (int kb = 0; kb < 4; ++kb)
#pragma unroll
                for (int r = 0; r < 16; ++r) {
                    const bool vis = (32 * kb + (r & 3) + 8 * (r >> 2)) <= cth;
                    sc[kb][r] = vis ? sc[kb][r] : -INFINITY;
                    mx = fmaxf(mx, sc[kb][r]);
                }
            mx = xhalf_max(mx);
            mx = fmaxf(mx, -1e30f);
            float ps = 0.f;
#pragma unroll
            for (int kb = 0; kb < 4; ++kb)
#pragma unroll
                for (int r = 0; r < 16; ++r) { sc[kb][r] = __builtin_amdgcn_exp2f(sc[kb][r] - mx); ps += sc[kb][r]; }
            ps = xhalf_sum(ps);
            const float inv = 1.0f / fmaxf(ps, 1e-30f);
#pragma unroll
            for (int kb = 0; kb < 4; ++kb)
#pragma unroll
                for (int r = 0; r < 16; ++r) sc[kb][r] *= inv;
#pragma unroll
            for (int kb = 0; kb < 4; ++kb)
#pragma unroll
                for (int ii = 0; ii < 4; ++ii)
                    impb[(rh * 64 + 32 * th + q) * 33 + 8 * kb + 2 * ii + hi] = (sc[kb][4 * ii] + sc[kb][4 * ii + 1]) + (sc[kb][4 * ii + 2] + sc[kb][4 * ii + 3]);
            f32x16 c0, c1;
#pragma unroll
            for (int r = 0; r < 16; ++r) { c0[r] = 0.f; c1[r] = 0.f; }
#pragma unroll
            for (int ks = 0; ks < 8; ++ks) {
                const int kb = ks >> 1, sp = ks & 1;
                const bf16x8 pf = pack8(sc[kb][8 * sp + 0], sc[kb][8 * sp + 1], sc[kb][8 * sp + 2], sc[kb][8 * sp + 3], sc[kb][8 * sp + 4], sc[kb][8 * sp + 5], sc[kb][8 * sp + 6], sc[kb][8 * sp + 7]);
                const LAS unsigned char* vp = lds + L_VC + ((q >> 4) & 1) * 32 + (q & 3) * 8 + (4 * hi + ((q & 15) >> 2)) * 64 + ks * 1024;
                {
                    const u32x2 lo = vtr(vp), hh = vtr(vp + 512);
                    v4u w; w.x = lo.x; w.y = lo.y; w.z = hh.x; w.w = hh.y;
                    c0 = __builtin_amdgcn_mfma_f32_32x32x16_bf16(__builtin_bit_cast(bf16x8, w), pf, c0, 0, 0, 0);
                }
                {
                    const u32x2 lo = vtr(vp + 8192), hh = vtr(vp + 8192 + 512);
                    v4u w; w.x = lo.x; w.y = lo.y; w.z = hh.x; w.w = hh.y;
                    c1 = __builtin_amdgcn_mfma_f32_32x32x16_bf16(__builtin_bit_cast(bf16x8, w), pf, c1, 0, 0, 0);
                }
                if (ks & 1) __builtin_amdgcn_sched_barrier(0);
            }
            __syncthreads();
            if (qt >= 8) {
                const int tok = tid >> 3, sub = tid & 7;
                unsigned key[4];
#pragma unroll
                for (int ii = 0; ii < 4; ++ii) {
                    const int j = 4 * sub + ii;
                    const float sum = (impb[tok * 33 + j] + impb[(64 + tok) * 33 + j]) + (impb[(128 + tok) * 33 + j] + impb[(192 + tok) * 33 + j]);
                    const unsigned kb = (__float_as_uint(sum) & ~31u) | (unsigned)(31 - j);
                    key[ii] = (j >= 1 && j <= qt - 2) ? kb : 0u;
                }
                unsigned mask = 1u | (1u << qt) | (1u << (qt - 1));
#pragma unroll
                for (int rnd = 0; rnd < 5; ++rnd) {
                    unsigned bk = key[0] > key[1] ? key[0] : key[1]; const unsigned b2 = key[2] > key[3] ? key[2] : key[3]; bk = bk > b2 ? bk : b2;
                    unsigned o1 = (unsigned)__shfl_xor((int)bk, 1); bk = bk > o1 ? bk : o1;
                    o1 = (unsigned)__shfl_xor((int)bk, 2); bk = bk > o1 ? bk : o1;
                    o1 = (unsigned)__shfl_xor((int)bk, 4); bk = bk > o1 ? bk : o1;
                    mask |= 1u << (31u - (bk & 31u));
#pragma unroll
                    for (int ii = 0; ii < 4; ++ii) key[ii] = key[ii] == bk ? 0u : key[ii];
                }
                if (sub == 0) selm[tok] = mask;
            } else if (tid < 64) selm[tid] = (2u << qt) - 1u;
            __syncthreads();
            const unsigned selbits = selm[32 * th + q];
            LAS float* otl = (LAS float*)(lds + L_OT + wave * 8192) + lane_v;
#pragma unroll
            for (int r = 0; r < 16; ++r) { otl[r * 64] = g_cmp * c0[r]; otl[(16 + r) * 64] = g_cmp * c1[r]; }
            {
                f32x16 a0, a1; float mr = 0.f, lr = 0.f;
#pragma unroll
                for (int r = 0; r < 16; ++r) { a0[r] = 0.f; a1[r] = 0.f; }
                stream<true>(lds, Hb, C_KS + 64 * g, C_VS + 64 * g, 0, qt, qt, t, 1 << 20, selbits, qf, a0, a1, mr, lr, tid, lane_v, wave);
                lr = xhalf_sum(lr);
                const float f = g_slc / fmaxf(lr, 1e-30f);
#pragma unroll
                for (int r = 0; r < 16; ++r) { otl[r * 64] += f * a0[r]; otl[(16 + r) * 64] += f * a1[r]; }
            }
            {
                f32x16 a0, a1; float mr = 0.f, lr = 0.f;
#pragma unroll
                for (int r = 0; r < 16; ++r) { a0[r] = 0.f; a1[r] = 0.f; }
                stream<false>(lds, Hb, C_KW + 64 * g, C_VW + 64 * g, qt >= 8 ? qt - 8 : 0, qt, qt, t, 512, 0u, qf, a0, a1, mr, lr, tid, lane_v, wave);
                lr = xhalf_sum(lr);
                const float f = g_win / fmaxf(lr, 1e-30f);
#pragma unroll
                for (int r = 0; r < 16; ++r) { ot0[r] = otl[r * 64] + f * a0[r]; ot1[r] = otl[(16 + r) * 64] + f * a1[r]; }
            }
        } else {
            f32x16 a0, a1; float mr = 0.f, lr = 0.f;
#pragma unroll
            for (int r = 0; r < 16; ++r) { a0[r] = 0.f; a1[r] = 0.f; }
            stream<false>(lds, Hb, C_KSW + 64 * g, C_VSW + 64 * g, qt >= 2 ? qt - 2 : 0, qt, qt, t, 128, 0u, qf, a0, a1, mr, lr, tid, lane_v, wave);
            lr = xhalf_sum(lr);
            const float sk = sinks[hq] * 1.4426950408889634f;
            const float mf = fmaxf(mr, sk);
            const float sm = __builtin_amdgcn_exp2f(mr - mf);
            const float den = lr * sm + __builtin_amdgcn_exp2f(sk - mf);
            const float f = sm / fmaxf(den, 1e-30f);
#pragma unroll
            for (int r = 0; r < 16; ++r) { ot0[r] = f * a0[r]; ot1[r] = f * a1[r]; }
        }
        bf16* op = O + row * 1024 + (nsa ? 0 : 512) + 64 * hq + 4 * hi;
#pragma unroll
        for (int ii = 0; ii < 4; ++ii) {
            u32x2 w0, w1;
            w0.x = cvtpk(ot0[4 * ii], ot0[4 * ii + 1]); w0.y = cvtpk(ot0[4 * ii + 2], ot0[4 * ii + 3]);
            w1.x = cvtpk(ot1[4 * ii], ot1[4 * ii + 1]); w1.y = cvtpk(ot1[4 * ii + 2], ot1[4 * ii + 3]);
            *(GAS u32x2*)(op + 8 * ii) = w0; *(GAS u32x2*)(op + 32 + 8 * ii) = w1;
        }
    }
    __builtin_amdgcn_s_setprio(0);
}
}

template <bool F8>
__device__ __forceinline__ void phase_ln1_router(Frame& F, int L, const float* xres, const float* ln_g, const float* ln_b, const float* b_r) {
    const int tid = F.tid, lane = F.lane, wave = F.wave;
    unsigned char* ws = F.ws;
    const bf16* A1 = (const bf16*)(ws + WS_Y1);
    float* X1 = (float*)(ws + WS_X1);
    bf16* X1B = (bf16*)(ws + WS_X1B);
    const bf16* Wh = (const bf16*)(ws + WS_WR) + (size_t)L * 2 * 32 * 1024;
    const bf16* Wl = Wh + 32 * 1024;
    LAS float* scr = (LAS float*)(F.lds + RING_OFF + wave * 4096);
    LAS unsigned* cntl = (LAS unsigned*)(F.lds + RING_OFF + 65536);
    LAS unsigned* basel = cntl + 32;
    gu32* gcnt = F.ctl + CW_CNT + L * 32;
    f32x4 gam[4], bet[4];
#pragma unroll
    for (int j = 0; j < 4; ++j) { gam[j] = *(const GAS f32x4*)(ln_g + (size_t)L * D + 4 * lane + 256 * j); bet[j] = *(const GAS f32x4*)(ln_b + (size_t)L * D + 4 * lane + 256 * j); }
    for (int chunk = blockIdx.x; chunk < M / 128; chunk += F.G) {
        if (tid < 32) cntl[tid] = 0u;
        __syncthreads();
        const int tok0 = chunk * 128 + wave * 16;
        for (int rr = 0; rr < 16; ++rr) {
            const size_t row = (size_t)(tok0 + rr);
            f32x4 v[4]; float s = 0.f;
#pragma unroll
            for (int j = 0; j < 4; ++j) {
                const u32x2 av = *(const GAS u32x2*)(A1 + row * D + 4 * lane + 256 * j);
                v[j] = *(const GAS f32x4*)(xres + row * D + 4 * lane + 256 * j) * DN_ALPHA + (f32x4){bf_lo(av.x), bf_hi(av.x), bf_lo(av.y), bf_hi(av.y)};
                s += (v[j].x + v[j].y) + (v[j].z + v[j].w);
            }
            const float mean = wave_sum(s) * (1.f / D); float s2 = 0.f;
#pragma unroll
            for (int j = 0; j < 4; ++j) { v[j] = v[j] - mean; s2 += (v[j].x * v[j].x + v[j].y * v[j].y) + (v[j].z * v[j].z + v[j].w * v[j].w); }
            const float rstd = 1.f / sqrtf(wave_sum(s2) * (1.f / D) + LN_EPS);
#pragma unroll
            for (int j = 0; j < 4; ++j) {
                const f32x4 o = v[j] * rstd * gam[j] + bet[j];
                if constexpr (!F8) *(GAS f32x4*)(X1 + row * D + 4 * lane + 256 * j) = o;
                u32x2 w; w.x = pk2(o.x, o.y); w.y = pk2(o.z, o.w);
                *(GAS u32x2*)(X1B + row * D + 4 * lane + 256 * j) = w;
                if constexpr (F8) *(GAS unsigned*)(ws + WS_X1F8 + row * D + 4 * lane + 256 * j) = pk4_fp8(o.x, o.y, o.z, o.w);
            }
            if constexpr (F8) { if (lane == 0) { scr[16 * 33 + 2 * rr] = mean; scr[16 * 33 + 2 * rr + 1] = rstd; } }
        }
        VM_WAIT(); LDS_WAIT();
        f32x4 acc0 = {0.f, 0.f, 0.f, 0.f}, acc1 = {0.f, 0.f, 0.f, 0.f};
        {
            const int ar = lane & 15, kg = lane >> 4;
            const float* xr = (F8 ? xres : (const float*)X1) + (size_t)(tok0 + ar) * D + 8 * kg;
            const bf16* ar1 = A1 + (size_t)(tok0 + ar) * D + 8 * kg;
            float rmean = 0.f, rrstd = 1.f;
            if constexpr (F8) { rmean = scr[16 * 33 + 2 * ar]; rrstd = scr[16 * 33 + 2 * ar + 1]; }
            const bf16* wh0 = Wh + (size_t)ar * 1024 + 8 * kg; const bf16* wl0 = Wl + (size_t)ar * 1024 + 8 * kg;
#pragma unroll 4
            for (int ks = 0; ks < 32; ++ks) {
                f32x4 xa = *(const GAS f32x4*)(xr + 32 * ks), xb = *(const GAS f32x4*)(xr + 32 * ks + 4);
                if constexpr (F8) {
                    const v4u aw = *(const GAS v4u*)(ar1 + 32 * ks);
                    xa = xa * DN_ALPHA + (f32x4){bf_lo(aw.x), bf_hi(aw.x), bf_lo(aw.y), bf_hi(aw.y)}; xb = xb * DN_ALPHA + (f32x4){bf_lo(aw.z), bf_hi(aw.z), bf_lo(aw.w), bf_hi(aw.w)};
                    const float* gp = ln_g + (size_t)L * D + 32 * ks + 8 * kg; const float* bp = ln_b + (size_t)L * D + 32 * ks + 8 * kg;
                    xa = (xa - rmean) * rrstd * *(const GAS f32x4*)gp + *(const GAS f32x4*)bp; xb = (xb - rmean) * rrstd * *(const GAS f32x4*)(gp + 4) + *(const GAS f32x4*)(bp + 4);
                }
                const float xv[8] = {xa.x, xa.y, xa.z, xa.w, xb.x, xb.y, xb.z, xb.w};
                unsigned hh[8], ll[8];
#pragma unroll
                for (int e = 0; e < 8; ++e) { hh[e] = f2bf(xv[e]); ll[e] = f2bf(xv[e] - __uint_as_float(hh[e] << 16)); }
                v4u ah, al;
                ah.x = hh[0] | (hh[1] << 16); ah.y = hh[2] | (hh[3] << 16); ah.z = hh[4] | (hh[5] << 16); ah.w = hh[6] | (hh[7] << 16);
                al.x = ll[0] | (ll[1] << 16); al.y = ll[2] | (ll[3] << 16); al.z = ll[4] | (ll[5] << 16); al.w = ll[6] | (ll[7] << 16);
                const bf16x8 fah = __builtin_bit_cast(bf16x8, ah), fal = __builtin_bit_cast(bf16x8, al);
                const bf16x8 w0h = *(const GAS bf16x8*)(wh0 + 32 * ks), w0l = *(const GAS bf16x8*)(wl0 + 32 * ks);
                const bf16x8 w1h = *(const GAS bf16x8*)(wh0 + 16 * 1024 + 32 * ks), w1l = *(const GAS bf16x8*)(wl0 + 16 * 1024 + 32 * ks);
                acc0 = __builtin_amdgcn_mfma_f32_16x16x32_bf16(fah, w0h, acc0, 0, 0, 0); acc0 = __builtin_amdgcn_mfma_f32_16x16x32_bf16(fal, w0h, acc0, 0, 0, 0); acc0 = __builtin_amdgcn_mfma_f32_16x16x32_bf16(fah, w0l, acc0, 0, 0, 0);
                acc1 = __builtin_amdgcn_mfma_f32_16x16x32_bf16(fah, w1h, acc1, 0, 0, 0); acc1 = __builtin_amdgcn_mfma_f32_16x16x32_bf16(fal, w1h, acc1, 0, 0, 0); acc1 = __builtin_amdgcn_mfma_f32_16x16x32_bf16(fah, w1l, acc1, 0, 0, 0);
            }
#pragma unroll
            for (int r = 0; r < 4; ++r) { scr[(4 * kg + r) * 33 + ar] = acc0[r]; scr[(4 * kg + r) * 33 + 16 + ar] = acc1[r]; }
        }
        LDS_WAIT(); asm volatile("" ::: "memory");
        int ek[4] = {0, 0, 0, 0}; float wk[4] = {0.f, 0.f, 0.f, 0.f}; unsigned lrk[4] = {0u, 0u, 0u, 0u};
        if (lane < 16) {
            float lv[32];
#pragma unroll
            for (int e = 0; e < 32; ++e) lv[e] = scr[lane * 33 + e] + b_r[(size_t)L * 32 + e];
            unsigned taken = 0u; float vk[4];
#pragma unroll
            for (int k = 0; k < 4; ++k) {
                float best = -INFINITY; int bi = 0;
#pragma unroll
                for (int e = 0; e < 32; ++e) { const bool ok = !((taken >> e) & 1u) && lv[e] > best; best = ok ? lv[e] : best; bi = ok ? e : bi; }
                taken |= 1u << bi; ek[k] = bi; vk[k] = best;
            }
            float den = 0.f;
#pragma unroll
            for (int k = 0; k < 4; ++k) { wk[k] = __expf(vk[k] - vk[0]); den += wk[k]; }
#pragma unroll
            for (int k = 0; k < 4; ++k) { wk[k] /= den; lrk[k] = atomicAdd((unsigned*)(cntl + ek[k]), 1u); }
        }
        __syncthreads();
        if (tid < 32) basel[tid] = __hip_atomic_fetch_add(gcnt + tid, cntl[tid], RLX_AGENT);
        __syncthreads();
        if (lane < 16) {
            const size_t tk = (size_t)(tok0 + lane) * 4;
#pragma unroll
            for (int k = 0; k < 4; ++k) {
                const int rank = (int)(basel[ek[k]] + lrk[k]);
                ((int*)(ws + WS_TOKE))[tk + k] = ek[k];
                ((int*)(ws + WS_TOKR))[tk + k] = rank;
                ((float*)(ws + WS_TOKW))[tk + k] = wk[k];
                if (rank < M) ((int*)(ws + WS_LIST))[(size_t)ek[k] * M + rank] = tok0 + lane;
            }
        }
        __syncthreads();
    }
}

__device__ __forceinline__ void build_tables(Frame& F, int L) {
    LAS int* cnt = (LAS int*)(F.lds + TAB_CNT); LAS int* soff = (LAS int*)(F.lds + TAB_SOFF); LAS int* tst = (LAS int*)(F.lds + TAB_TST); LAS int* te = (LAS int*)(F.lds + TAB_TE);
    __syncthreads();
    if (F.tid < 32) { int c = (int)__hip_atomic_load(F.ctl + CW_CNT + L * 32 + F.tid, RLX_AGENT); cnt[F.tid] = c < 0 ? 0 : (c > M ? M : c); }
    __syncthreads();
    if (F.tid == 0) { int a = 0; for (int e = 0; e < 32; ++e) { tst[e] = a; a += (cnt[e] + 255) >> 8; if (a > MAXTILES) a = MAXTILES; } tst[32] = a; }
    __syncthreads();
    if (F.tid < 32) { soff[F.tid] = tst[F.tid] * 256; for (int mt = tst[F.tid]; mt < tst[F.tid + 1]; ++mt) te[mt] = F.tid; }
    __syncthreads();
}

template <bool LAST>
__device__ __forceinline__ void phase_ln2(Frame& F, int L, const float* ln_g, const float* ln_b, float* outp) {
    unsigned char* ws = F.ws;
    const float* X1 = (const float*)(ws + WS_X1); const bf16* X1B = (const bf16*)(ws + WS_X1B);
    const bf16* E = (const bf16*)(ws + WS_E); const bf16* YS = (const bf16*)(ws + WS_YS);
    bf16* XB = (bf16*)(ws + WS_XB);
    const LAS int* soff = (const LAS int*)(F.lds + TAB_SOFF);
    const int gw = F.vcu * NWAVES + F.wave, NGW = F.G * NWAVES, lane = F.lane;
    f32x4 gam[4], bet[4];
#pragma unroll
    for (int j = 0; j < 4; ++j) { gam[j] = *(const GAS f32x4*)(ln_g + (size_t)L * D + 4 * lane + 256 * j); bet[j] = *(const GAS f32x4*)(ln_b + (size_t)L * D + 4 * lane + 256 * j); }
    for (int tok = gw; tok < M; tok += NGW) {
        int sl[4]; float wk[4];
#pragma unroll
        for (int k = 0; k < 4; ++k) {
            const int e = ((const int*)(ws + WS_TOKE))[(size_t)tok * 4 + k] & 31, r = ((const int*)(ws + WS_TOKR))[(size_t)tok * 4 + k];
            int s = soff[e] + r; s = s < 0 ? 0 : (s >= MAXSLOTS ? MAXSLOTS - 1 : s);
            sl[k] = s; wk[k] = ((const float*)(ws + WS_TOKW))[(size_t)tok * 4 + k];
        }
        f32x4 v[4]; float s = 0.f;
#pragma unroll
        for (int j = 0; j < 4; ++j) {
            const int c = 4 * lane + 256 * j;
            f32x4 a;
            if constexpr (LAST) { const u32x2 xv = *(const GAS u32x2*)(X1B + (size_t)tok * D + c); a = (f32x4){bf_lo(xv.x), bf_hi(xv.x), bf_lo(xv.y), bf_hi(xv.y)} * DN_ALPHA; }
            else a = *(const GAS f32x4*)(X1 + (size_t)tok * D + c) * DN_ALPHA;
            const u32x2 ev = *(const GAS u32x2*)(E + (size_t)tok * D + c);
            a.x += bf_lo(ev.x); a.y += bf_hi(ev.x); a.z += bf_lo(ev.y); a.w += bf_hi(ev.y);
#pragma unroll
            for (int k = 0; k < 4; ++k) {
                if constexpr (LAST) {
                    typedef float f32x2_ __attribute__((ext_vector_type(2)));
                    const unsigned yw = *(const GAS unsigned*)((const unsigned char*)YS + (size_t)sl[k] * D + c);
                    const f32x2_ y01 = __builtin_amdgcn_cvt_pk_f32_fp8((int)yw, false), y23 = __builtin_amdgcn_cvt_pk_f32_fp8((int)yw, true);
                    a.x += wk[k] * y01.x; a.y += wk[k] * y01.y; a.z += wk[k] * y23.x; a.w += wk[k] * y23.y;
                } else {
                    const u32x2 yv = *(const GAS u32x2*)(YS + (size_t)sl[k] * D + c);
                    a.x += wk[k] * bf_lo(yv.x); a.y += wk[k] * bf_hi(yv.x); a.z += wk[k] * bf_lo(yv.y); a.w += wk[k] * bf_hi(yv.y);
                }
            }
            v[j] = a; s += (a.x + a.y) + (a.z + a.w);
        }
        const float mean = wave_sum(s) * (1.f / D); float s2 = 0.f;
#pragma unroll
        for (int j = 0; j < 4; ++j) { v[j] = v[j] - mean; s2 += (v[j].x * v[j].x + v[j].y * v[j].y) + (v[j].z * v[j].z + v[j].w * v[j].w); }
        const float rstd = 1.f / sqrtf(wave_sum(s2) * (1.f / D) + LN_EPS);
#pragma unroll
        for (int j = 0; j < 4; ++j) {
            const f32x4 o = v[j] * rstd * gam[j] + bet[j];
            *(GAS f32x4*)(outp + (size_t)tok * D + 4 * lane + 256 * j) = o;
            if constexpr (!LAST) { u32x2 w; w.x = pk2(o.x, o.y); w.y = pk2(o.z, o.w); *(GAS u32x2*)(XB + (size_t)tok * D + 4 * lane + 256 * j) = w; }
        }
    }
}

#ifndef MK_ONE_LAUNCH
#define MK_ONE_LAUNCH 1
#endif
constexpr int PH_PER_LAYER = 9, NPH = 1 + NL * PH_PER_LAYER;
struct Args { const float* in[27]; float* out; unsigned char* ws; int ph_lo, ph_hi; };
typedef const __attribute__((address_space(4))) unsigned char* kptr_t;
__device__ __forceinline__ kptr_t karg_base() { kptr_t p = (kptr_t)__builtin_amdgcn_kernarg_segment_ptr(); asm volatile("" : "+s"(p)); return p; }
#define KIN(kb, i) (*(const float* const __attribute__((address_space(4)))*)((kb) + 8 * (i)))
#ifndef PH_MASK
#define PH_MASK 0x3ff
#endif
#define PHSEL(k) (((k) == 0) ? ((PH_MASK >> 9) & 1) : ((PH_MASK >> (((k) - 1) % PH_PER_LAYER)) & 1))
#define IN(k) (PHSEL(k) && lo <= (k) && (k) < hi)
#ifndef PROBE_PHASE
#define PROBE_PHASE -1
#endif
#ifndef PROBE_EXTRA
#define PROBE_EXTRA 0
#endif
#define NREP(k) (((k) == PROBE_PHASE) ? 1 + PROBE_EXTRA : 1)
#define PHASE(k) if (IN(k)) for (int rep_ = 0; rep_ < NREP(k); ++rep_)
#define SEAM(k) do { if (IN(k) && IN((k) + 1)) { if (MK_ONE_LAUNCH) xcd_barrier(bar); } } while (0)

#define RELAUNDER() do { F.lane = (int)__builtin_amdgcn_mbcnt_hi(~0u, __builtin_amdgcn_mbcnt_lo(~0u, 0u)); asm volatile("" : "+v"(F.lane)); F.wave = wave0; F.tid = F.wave * 64 + F.lane; } while (0)
template <int L>
__device__ __forceinline__ void layer_body(Frame& F, const XcdBarrier& bar, const int lo, const int hi, const int wave0) {
    unsigned char* ws = F.ws;
        const int pb = 1 + L * PH_PER_LAYER;
        PHASE(pb + 0) {
            pg8::Gemm g{(const bf16*)(ws + WS_XB), (const bf16*)(ws + WS_WIN) + (size_t)L * NIN * 1024, M, NIN, D};
            pg8::StaticOrder S; S.init(M, NIN, F.G, (int)blockIdx.x);
            pg8::EpiIn E{(bf16*)(ws + WS_H), (float*)(ws + WS_GATES), (const float*)(ws + WS_BINP) + (size_t)L * NIN, (const float*)(ws + WS_ROPE)};
            pg8::gemm_phase<pg8::EpiIn, pg8::StaticOrder, true, true>(F.lds + RING_OFF, g, S, E, wave0, (LAS float*)(F.lds + BIAS_OFF));
        }
        SEAM(pb + 0);
        PHASE(pb + 1) {
            { kptr_t kb = karg_base(); RELAUNDER(); phase_compress(F, L, KIN(kb, 5), KIN(kb, 8)); }
            {
                pg8::Gemm g{(const bf16*)(ws + WS_PB) + (size_t)L * M * PD, (const bf16*)(ws + WS_WPP) + (size_t)L * 1024 * PD, M, D, PD};
                pg8::StaticOrder S; S.init(M, D, F.G, (int)blockIdx.x);
                pg8::EpiPlain E{(bf16*)(ws + WS_PP)};
                pg8::gemm_phase<pg8::EpiPlain, pg8::StaticOrder, true, true>(F.lds + RING_OFF, g, S, E, wave0, (LAS float*)(F.lds + BIAS_OFF));
            }
        }
        SEAM(pb + 1);
        PHASE(pb + 2) { kptr_t kb = karg_base(); RELAUNDER(); att::phase_attention(F, L, KIN(kb, 11)); }
        SEAM(pb + 2);
        PHASE(pb + 3) {
            pg8::Gemm g{(const bf16*)(ws + WS_O), (const bf16*)(ws + WS_WO) + (size_t)L * 1024 * 1024, M, D, D};
            pg8::StaticOrder S; S.init(M, D, F.G, (int)blockIdx.x);
            kptr_t kb = karg_base();
            pg8::EpiOut E{(bf16*)(ws + WS_Y1), KIN(kb, 13) + (size_t)L * D};
            pg8::gemm_phase<pg8::EpiOut, pg8::StaticOrder, true, true>(F.lds + RING_OFF, g, S, E, wave0, (LAS float*)(F.lds + BIAS_OFF));
        }
        SEAM(pb + 3);
        PHASE(pb + 4) { kptr_t kb = karg_base(); RELAUNDER(); phase_ln1_router<(L == NL - 1)>(F, L, L == 0 ? KIN(kb, 0) : (const float*)(ws + WS_XN), KIN(kb, 14), KIN(kb, 15), KIN(kb, 17)); }
        SEAM(pb + 4);
        PHASE(pb + 6) {
            RELAUNDER();
            build_tables(F, L);
            {
                constexpr bool F8 = (L == NL - 1);
                pg8::Gemm g{F8 ? (const bf16*)(ws + WS_X1F8) : (const bf16*)(ws + WS_X1B), (const bf16*)(ws + WS_W1T) + (size_t)L * 32 * 2048 * 1024, M, 32 * 2048, F8 ? D / 2 : D};
                pg8::MoeOrder S{(const LAS int*)(F.lds + TAB_TE), ((const LAS int*)(F.lds + TAB_TST))[32] * 8, 3, F.G, F.vcu, (const LAS int*)(F.lds + TAB_TST), (const LAS int*)(F.lds + TAB_CNT), (const int*)(ws + WS_LIST), M};
                pg8::EpiUp<F8> E{(bf16*)(ws + WS_ACT), (const float*)(ws + WS_B1P) + (size_t)L * 32 * 2048, F8 ? 1.0f / W1_F8_SCALE : 1.0f};
                pg8::gemm_phase<pg8::EpiUp<F8>, pg8::MoeOrder, true, true, F8, true>(F.lds + RING_OFF, g, S, E, wave0, (LAS float*)(F.lds + BIAS_OFF), (LAS int*)(F.lds + TOKL_OFF));
            }
            {
                kptr_t kb = karg_base();
                constexpr bool F8 = (L == NL - 1);
                const int ntl = ((const LAS int*)(F.lds + TAB_TST))[32];
                int heavy6 = 8 * ntl - (8 * ntl / (int)F.G) * (int)F.G;
                const int k6 = F.vcu - heavy6;
                pg8::Gemm g{F8 ? (const bf16*)(ws + WS_X1F8) : (const bf16*)(ws + WS_X1B), (const bf16*)(ws + WS_WPG) + (size_t)L * 1024 * 1024, M, D, F8 ? D / 2 : D};
                pg8::GateOrder S{k6, (k6 >= 0 && k6 < 512) ? 1 : 0, 0};
                pg8::EpiGate E{(const bf16*)(ws + WS_PP), (bf16*)(ws + WS_E), KIN(kb, 23) + (size_t)L * D, F8 ? 1.0f / WPG_F8_SCALE : 1.0f};
                pg8::gemm_phase<pg8::EpiGate, pg8::GateOrder, true, true, F8>(F.lds + RING_OFF, g, S, E, wave0, (LAS float*)(F.lds + BIAS_OFF));
            }
        }
        SEAM(pb + 6);
        PHASE(pb + 7) {
            kptr_t kb = karg_base(); RELAUNDER();
            if (!IN(pb + 6)) build_tables(F, L);
            {
                constexpr bool F8 = (L == NL - 1);
                pg8::Gemm g{(const bf16*)(ws + WS_ACT), (const bf16*)(ws + WS_W2T) + (size_t)L * 32 * 1024 * 1024, MAXSLOTS, 32 * 1024, F8 ? D / 2 : D};
                pg8::MoeOrder S{(const LAS int*)(F.lds + TAB_TE), ((const LAS int*)(F.lds + TAB_TST))[32] * 4, 2, F.G, F.vcu, (const LAS int*)(F.lds + TAB_TST), (const LAS int*)(F.lds + TAB_CNT), nullptr, 0};
                pg8::EpiDown<F8> E{(bf16*)(ws + WS_YS), KIN(kb, 21) + (size_t)L * 32 * 1024, F8 ? 1.0f / W2_F8_SCALE : 1.0f};
                pg8::gemm_phase<pg8::EpiDown<F8>, pg8::MoeOrder, true, true, F8>(F.lds + RING_OFF, g, S, E, wave0, (LAS float*)(F.lds + BIAS_OFF));
            }
            {
                constexpr bool F8 = (L == NL - 1);
                pg8::Gemm g{F8 ? (const bf16*)(ws + WS_X1F8) : (const bf16*)(ws + WS_X1B), (const bf16*)(ws + WS_WPG) + (size_t)L * 1024 * 1024, M, D, F8 ? D / 2 : D};
                const int ntl = ((const LAS int*)(F.lds + TAB_TST))[32], Gs = (int)F.G;
                const int heavy6 = 8 * ntl - (8 * ntl / Gs) * Gs, nA = (Gs - heavy6) < 512 ? (Gs - heavy6) : 512, R = 512 - nA;
                const int heavy7 = 4 * ntl - (4 * ntl / Gs) * Gs;
                const int pos = F.vcu >= heavy7 ? F.vcu - heavy7 : (Gs - heavy7) + F.vcu;
                int cnt7 = 0; for (int r = pos; r < R; r += Gs) ++cnt7;
                pg8::GateOrder S{nA + pos, cnt7, Gs};
                pg8::EpiGate E{(const bf16*)(ws + WS_PP), (bf16*)(ws + WS_E), KIN(kb, 23) + (size_t)L * D, F8 ? 1.0f / WPG_F8_SCALE : 1.0f};
                pg8::gemm_phase<pg8::EpiGate, pg8::GateOrder, true, true, F8>(F.lds + RING_OFF, g, S, E, wave0, (LAS float*)(F.lds + BIAS_OFF));
            }
        }
        SEAM(pb + 7);
        PHASE(pb + 8) { kptr_t kb = karg_base(); RELAUNDER(); if (!IN(pb + 7)) build_tables(F, L); float* xout = L == NL - 1 ? (float*)KIN(kb, 27) : (float*)(ws + WS_XN); phase_ln2<(L == NL - 1)>(F, L, KIN(kb, 25), KIN(kb, 26), xout); }
        SEAM(pb + 8);
    }
__global__ void __launch_bounds__(NWAVES * 64, 2) mk_fwd(Args args) {
    extern __shared__ __attribute__((aligned(16))) unsigned char lds[];
    Frame F;
    F.lds = (LAS unsigned char*)lds;
    F.MISC = (volatile LAS unsigned*)(F.lds + MISC_OFF);
    const int wave0 = __builtin_amdgcn_readfirstlane((int)threadIdx.x >> 6);
    F.wave = wave0; F.lane = (int)__builtin_amdgcn_mbcnt_hi(~0u, __builtin_amdgcn_mbcnt_lo(~0u, 0u)); F.tid = F.wave * 64 + F.lane;
    F.G = gridDim.x; { const int bx = blockIdx.x; F.vcu = (F.G % 8 == 0) ? (bx % 8) * (F.G / 8) + bx / 8 : bx; }
    F.ws = args.ws; F.ctl = (gu32*)(args.ws + WS_CTL);
    unsigned char* ws = args.ws;
    for (int u = F.tid; u < (LDS_BYTES - LDSCTL_OFF) / 4; u += NWAVES * 64) ((LAS unsigned*)(F.lds + LDSCTL_OFF))[u] = 0u;
    __syncthreads();
    XcdBarrier bar; bar.bar = (unsigned*)(F.ctl + CW_BAR); bar.x = 0; bar.st = nullptr; bar.wave = wave0;
    if (MK_ONE_LAUNCH) bar = xcd_barrier_post((unsigned*)(F.ctl + CW_BAR), F.MISC + 8, wave0);
    const int lo = args.ph_lo, hi = args.ph_hi;
    PHASE(0) {
        kptr_t kb = karg_base(); RELAUNDER();
        PIn I{KIN(kb, 0), KIN(kb, 1), KIN(kb, 3), KIN(kb, 4), KIN(kb, 6), KIN(kb, 7), KIN(kb, 9), KIN(kb, 10), KIN(kb, 12), KIN(kb, 16), KIN(kb, 18), KIN(kb, 19), KIN(kb, 20), KIN(kb, 22), KIN(kb, 24), (const int*)KIN(kb, 2)};
        p0_prologue(F, I);
    }
    SEAM(0);
    layer_body<0>(F, bar, lo, hi, wave0);
    layer_body<1>(F, bar, lo, hi, wave0);
#undef IN
#undef SEAM
}

extern "C" void kernel_launch(void* const* d_in, const int* in_sizes, int n_in, void* d_out, int out_size, void* d_ws, size_t ws_size, hipStream_t stream) {
    static int grid = 0;
    if (grid == 0) {
        if (n_in != 27 || out_size != M * D || ws_size < WS_END) { fprintf(stderr, "kernel_launch: unexpected problem (n_in %d, out %d, ws %zu); nothing launched\n", n_in, out_size, ws_size); grid = -1; return; }
        int dev = 0, cus = 0, per_cu = 0;
        if (hipGetDevice(&dev) != hipSuccess || hipDeviceGetAttribute(&cus, hipDeviceAttributeMultiprocessorCount, dev) != hipSuccess) { grid = -1; return; }
        if (hipFuncSetAttribute((const void*)mk_fwd, hipFuncAttributeMaxDynamicSharedMemorySize, LDS_BYTES) != hipSuccess) { fprintf(stderr, "kernel_launch: hipFuncSetAttribute failed\n"); grid = -1; return; }
        if (hipOccupancyMaxActiveBlocksPerMultiprocessor(&per_cu, (const void*)mk_fwd, NWAVES * 64, LDS_BYTES) != hipSuccess || per_cu < 1) { fprintf(stderr, "kernel_launch: occupancy query says %d\n", per_cu); }
        (void)hipGetLastError();
        grid = cus;
    }
    if (grid < 0) return;
    (void)in_sizes;
    if (hipMemsetAsync((char*)d_ws + WS_CTL, 0, CTL_ZERO_BYTES, stream) != hipSuccess) return;
    Args a{};
    for (int i = 0; i < 27; ++i) a.in[i] = (const float*)d_in[i];
    a.out = (float*)d_out; a.ws = (unsigned char*)d_ws;
#if MK_ONE_LAUNCH
    a.ph_lo = 0; a.ph_hi = NPH;
    hipLaunchKernelGGL(mk_fwd, dim3(grid), dim3(NWAVES * 64), LDS_BYTES, stream, a);
#else
    for (int ph = 0; ph < NPH; ++ph) { a.ph_lo = ph; a.ph_hi = ph + 1; hipLaunchKernelGGL(mk_fwd, dim3(grid), dim3(NWAVES * 64), LDS_BYTES, stream, a); }
#endif
}
```

```cpp
#include <hip/hip_runtime.h>
#include <cstdio>
#include <cstdint>
#define MK_ONE_LAUNCH 1
namespace pg8 {
#define PG8_LAS __attribute__((address_space(3)))
typedef unsigned short bf16_t;
typedef short bf16x8 __attribute__((ext_vector_type(8)));
typedef float f32x4 __attribute__((ext_vector_type(4)));
typedef unsigned u32x4 __attribute__((ext_vector_type(4)));
constexpr int BM = 256, BK = 64, HALF = 128, HTB = HALF * BK * 2  , STAGE_BYTES = 8 * HTB, NXCD = 8, WGM = 8;

__host__ __device__ __forceinline__ int lds_byte(int r, int c) { const int st = (r >> 4) * 2 + (c >> 5), rr = r & 15, cc = c & 31, ob = rr * 64 + cc * 2; return st * 1024 + (ob ^ (((ob >> 9) & 1) << 5)); }
__host__ __device__ __forceinline__ void stage_rc(int b, int& R, int& C) { const int st = b / 1024, sb = b % 1024, swz = sb ^ (((sb >> 9) & 1) << 5); R = (st >> 1) * 16 + swz / 64; C = (st & 1) * 32 + (swz % 64) / 2; }
__host__ __device__ __forceinline__ int perm32(int rho) { const int n = rho >> 4, i = rho & 15; return 8 * (i >> 2) + 4 * n + (i & 3); }

struct Unit { int pm, pn; };
struct Gemm { const bf16_t* A; const bf16_t* Bt; int M, N, K; };

struct StaticOrder {
    int nM, nN, nwg, G, c;
    __host__ __device__ void init(int M, int N, int G_, int c_) { nM = M / BM; nN = N / BM; nwg = nM * nN; G = G_; c = c_; }
    __host__ __device__ bool next(int i, Unit& u) const {
        const long L = (long)i * G + c; if (L >= nwg) return false;
        int wgid = (int)L; { const int q = nwg / NXCD, r = nwg % NXCD, xcd = wgid % NXCD, off = wgid / NXCD; wgid = (xcd < r ? xcd * (q + 1) : r * (q + 1) + (xcd - r) * q) + off; }
        const int nig = WGM * nN, gid = wgid / nig, fm = gid * WGM, gsz = (nM - fm) < WGM ? (nM - fm) : WGM;
        u.pm = fm + ((wgid % nig) % gsz); u.pn = (wgid % nig) / gsz; return true;
    }
    __device__ __forceinline__ void a_ready(const Unit&) const {}
    __device__ __forceinline__ void done(const Unit&) const {}
    __attribute__((address_space(1))) unsigned* tailw = nullptr;
    __device__ __forceinline__ void tail(int wid, int lane) const { if (tailw && wid == 0 && lane == 0) (void)__hip_atomic_fetch_add(tailw, 1u, __ATOMIC_RELAXED, __HIP_MEMORY_SCOPE_AGENT); }
};

__device__ __forceinline__ unsigned cvt_pk_bf16(float lo, float hi) { unsigned r; asm volatile("v_cvt_pk_bf16_f32 %0, %1, %2" : "=v"(r) : "v"(lo), "v"(hi)); return r; }
typedef float f32x2 __attribute__((ext_vector_type(2)));

typedef unsigned u32x2 __attribute__((ext_vector_type(2)));
__device__ __forceinline__ float sigm(float x) { return __builtin_amdgcn_rcpf(1.0f + __builtin_amdgcn_exp2f(-1.4426950408889634f * x)); }
__device__ __forceinline__ float bf_lo(unsigned w) { return __uint_as_float(w << 16); }
__device__ __forceinline__ float bf_hi(unsigned w) { return __uint_as_float(w & 0xffff0000u); }

constexpr unsigned ROPE_SEGS = 0x7D4Fu;
constexpr float QSCALE = 0.125f * 1.4426950408889634f;
struct EpiIn {
    static constexpr bool PERM = true, AFTER_DRAIN = false;
    bf16_t* H; float* gates; const float* bias; const float* rope;
    __device__ __forceinline__ const float* bias_slice(const Unit& u) const { return bias + u.pn * BM; }
    __device__ __forceinline__ void operator()(const f32x4 (&acc)[2][2][4][2], const Unit& u, int wr, int wc, int fr, int fq, const PG8_LAS float* bl) const {
        const int row0 = u.pm * BM + wr * 64 + fr;
#pragma unroll
        for (int bj = 0; bj < 2; ++bj) {
            const int seg = u.pn * 2 + bj;
            if (seg >= 17) continue;
            const int cl0 = bj * HALF + wc * 32 + 8 * fq;
            const f32x4 b0 = *(const PG8_LAS f32x4*)(bl + cl0), b1 = *(const PG8_LAS f32x4*)(bl + cl0 + 4);
            if (seg == 16) {
                const int gi = wc * 32 + 8 * fq;
                if (gi < 24) {
#pragma unroll
                    for (int ai = 0; ai < 2; ++ai)
#pragma unroll
                        for (int m = 0; m < 4; ++m) {
                            const int row = row0 + ai * HALF + m * 16;
                            f32x4 v0 = acc[ai][bj][m][0] + b0, v1 = acc[ai][bj][m][1] + b1;
                            v0 = (f32x4){sigm(v0[0]), sigm(v0[1]), sigm(v0[2]), sigm(v0[3])};
                            v1 = (f32x4){sigm(v1[0]), sigm(v1[1]), sigm(v1[2]), sigm(v1[3])};
                            float* gp = gates + (size_t)row * 32 + gi;
                            *(f32x4*)gp = v0; *(f32x4*)(gp + 4) = v1;
                        }
                }
            } else {
                const bool rope_on = (ROPE_SEGS >> seg) & 1u;
                const bool qseg = seg < 4 || (seg >= 10 && seg <= 13);
                const int g = 4 * (wc & 1) + fq;
                const int hc = seg * 128 + (wc >> 1) * 64 + 4 * g;
#pragma unroll
                for (int ai = 0; ai < 2; ++ai)
#pragma unroll
                    for (int m = 0; m < 4; ++m) {
                        const int row = row0 + ai * HALF + m * 16;
                        f32x4 v0 = acc[ai][bj][m][0] + b0, v1 = acc[ai][bj][m][1] + b1;
                        if (rope_on) {
                            const f32x4 c = *(const f32x4*)(rope + (size_t)row * 64 + 4 * g), s = *(const f32x4*)(rope + (size_t)row * 64 + 32 + 4 * g);
                            const f32x4 o0 = v0 * c - v1 * s, o1 = v1 * c + v0 * s; v0 = o0; v1 = o1;
                        }
                        if (qseg) { v0 = v0 * QSCALE; v1 = v1 * QSCALE; }
                        u32x2 w0, w1; w0.x = cvt_pk_bf16(v0[0], v0[1]); w0.y = cvt_pk_bf16(v0[2], v0[3]); w1.x = cvt_pk_bf16(v1[0], v1[1]); w1.y = cvt_pk_bf16(v1[2], v1[3]);
                        bf16_t* hp = H + (size_t)row * 2048 + hc;
                        *(u32x2*)hp = w0; *(u32x2*)(hp + 32) = w1;
                    }
            }
        }
    }
};
struct EpiOut {
    static constexpr bool PERM = true, AFTER_DRAIN = false;
    bf16_t* y; const float* bias;
    __device__ __forceinline__ const float* bias_slice(const Unit& u) const { return bias + u.pn * BM; }
    __device__ __forceinline__ void operator()(const f32x4 (&acc)[2][2][4][2], const Unit& u, int wr, int wc, int fr, int fq, const PG8_LAS float* bl) const {
        const int row0 = u.pm * BM + wr * 64 + fr, col0 = u.pn * BM + wc * 32 + 8 * fq;
        f32x4 bv[2][2];
#pragma unroll
        for (int bj = 0; bj < 2; ++bj)
#pragma unroll
            for (int n = 0; n < 2; ++n) bv[bj][n] = *(const PG8_LAS f32x4*)(bl + wc * 32 + 8 * fq + bj * HALF + 4 * n);
#pragma unroll
        for (int ai = 0; ai < 2; ++ai)
#pragma unroll
            for (int m = 0; m < 4; ++m) {
                bf16_t* rowp = y + (size_t)(row0 + ai * HALF + m * 16) * 1024 + col0;
#pragma unroll
                for (int bj = 0; bj < 2; ++bj) {
                    const f32x4 v0 = acc[ai][bj][m][0] + bv[bj][0], v1 = acc[ai][bj][m][1] + bv[bj][1];
                    u32x4 w; w.x = cvt_pk_bf16(v0[0], v0[1]); w.y = cvt_pk_bf16(v0[2], v0[3]); w.z = cvt_pk_bf16(v1[0], v1[1]); w.w = cvt_pk_bf16(v1[2], v1[3]);
                    *(u32x4*)(rowp + bj * HALF) = w;
                }
            }
    }
};
template <bool F8OUT>
struct EpiUp {
    static constexpr bool PERM = true, AFTER_DRAIN = false;
    bf16_t* act; const float* b1p; float ascale;
    __device__ __forceinline__ const float* bias_slice(const Unit& u) const { return b1p + (size_t)(u.pn >> 3) * 2048 + (u.pn & 7) * BM; }
    __device__ __forceinline__ void operator()(const f32x4 (&acc)[2][2][4][2], const Unit& u, int wr, int wc, int fr, int fq, const PG8_LAS float* bl) const {
        const int pn = u.pn & 7;
        const int row0 = u.pm * BM + wr * 64 + fr, ac0 = pn * 128 + wc * 32 + 8 * fq;
        const PG8_LAS float* bp = bl + wc * 32 + 8 * fq;
        const f32x4 bg0 = *(const PG8_LAS f32x4*)bp, bg1 = *(const PG8_LAS f32x4*)(bp + 4), bu0 = *(const PG8_LAS f32x4*)(bp + HALF), bu1 = *(const PG8_LAS f32x4*)(bp + HALF + 4);
#pragma unroll
        for (int ai = 0; ai < 2; ++ai)
#pragma unroll
            for (int m = 0; m < 4; ++m) {
                const f32x4 g0 = acc[ai][0][m][0] * ascale + bg0, g1 = acc[ai][0][m][1] * ascale + bg1, u0 = acc[ai][1][m][0] * ascale + bu0, u1 = acc[ai][1][m][1] * ascale + bu1;
                float o[8];
#pragma unroll
                for (int j = 0; j < 8; ++j) {
                    float gt = j < 4 ? g0[j & 3] : g1[j & 3], up = j < 4 ? u0[j & 3] : u1[j & 3];
                    gt = fminf(gt, 7.0f); up = fminf(fmaxf(up, -7.0f), 7.0f);
                    o[j] = (up + 1.0f) * gt * sigm(1.702f * gt);
                }
                if constexpr (F8OUT) {
                    int w0 = 0, w1 = 0;
                    w0 = __builtin_amdgcn_cvt_pk_fp8_f32(o[0], o[1], w0, false); w0 = __builtin_amdgcn_cvt_pk_fp8_f32(o[2], o[3], w0, true);
                    w1 = __builtin_amdgcn_cvt_pk_fp8_f32(o[4], o[5], w1, false); w1 = __builtin_amdgcn_cvt_pk_fp8_f32(o[6], o[7], w1, true);
                    u32x2 w; w.x = (unsigned)w0; w.y = (unsigned)w1;
                    *(u32x2*)((unsigned char*)act + (size_t)(row0 + ai * HALF + m * 16) * 1024 + ac0) = w;
                } else {
                    u32x4 w; w.x = cvt_pk_bf16(o[0], o[1]); w.y = cvt_pk_bf16(o[2], o[3]); w.z = cvt_pk_bf16(o[4], o[5]); w.w = cvt_pk_bf16(o[6], o[7]);
                    *(u32x4*)(act + (size_t)(row0 + ai * HALF + m * 16) * 1024 + ac0) = w;
                }
                asm volatile("" ::: "memory");
            }
    }
};
template <bool F8OUT>
struct EpiDown {
    static constexpr bool PERM = true, AFTER_DRAIN = false;
    bf16_t* ys; const float* b2; float ascale;
    __device__ __forceinline__ const float* bias_slice(const Unit& u) const { return b2 + (size_t)(u.pn >> 2) * 1024 + (u.pn & 3) * BM; }
    __device__ __forceinline__ void operator()(const f32x4 (&acc)[2][2][4][2], const Unit& u, int wr, int wc, int fr, int fq, const PG8_LAS float* bl) const {
        const int pn = u.pn & 3;
        const int row0 = u.pm * BM + wr * 64 + fr, col0 = pn * BM + wc * 32 + 8 * fq;
        f32x4 bv[2][2];
#pragma unroll
        for (int bj = 0; bj < 2; ++bj)
#pragma unroll
            for (int n = 0; n < 2; ++n) bv[bj][n] = *(const PG8_LAS f32x4*)(bl + wc * 32 + 8 * fq + bj * HALF + 4 * n);
#pragma unroll
        for (int ai = 0; ai < 2; ++ai)
#pragma unroll
            for (int m = 0; m < 4; ++m) {
                bf16_t* rowp = ys + (size_t)(row0 + ai * HALF + m * 16) * 1024 + col0;
#pragma unroll
                for (int bj = 0; bj < 2; ++bj) {
                    const f32x4 v0 = acc[ai][bj][m][0] * ascale + bv[bj][0], v1 = acc[ai][bj][m][1] * ascale + bv[bj][1];
                    if constexpr (F8OUT) {
                        int w0 = 0, w1 = 0;
                        w0 = __builtin_amdgcn_cvt_pk_fp8_f32(v0[0], v0[1], w0, false); w0 = __builtin_amdgcn_cvt_pk_fp8_f32(v0[2], v0[3], w0, true);
                        w1 = __builtin_amdgcn_cvt_pk_fp8_f32(v1[0], v1[1], w1, false); w1 = __builtin_amdgcn_cvt_pk_fp8_f32(v1[2], v1[3], w1, true);
                        u32x2 w; w.x = (unsigned)w0; w.y = (unsigned)w1;
                        *(u32x2*)((unsigned char*)ys + (size_t)(row0 + ai * HALF + m * 16) * 1024 + col0 + bj * HALF) = w;
                    } else {
                        u32x4 w; w.x = cvt_pk_bf16(v0[0], v0[1]); w.y = cvt_pk_bf16(v0[2], v0[3]); w.z = cvt_pk_bf16(v1[0], v1[1]); w.w = cvt_pk_bf16(v1[2], v1[3]);
                        *(u32x4*)(rowp + bj * HALF) = w;
                    }
                }
            }
    }
};
struct EpiPlain {
    static constexpr bool PERM = true, AFTER_DRAIN = false;
    bf16_t* O;
    __device__ __forceinline__ const float* bias_slice(const Unit&) const { return nullptr; }
    __device__ __forceinline__ void operator()(const f32x4 (&acc)[2][2][4][2], const Unit& u, int wr, int wc, int fr, int fq, const PG8_LAS float*) const {
        const int row0 = u.pm * BM + wr * 64 + fr, col0 = u.pn * BM + wc * 32 + 8 * fq;
#pragma unroll
        for (int ai = 0; ai < 2; ++ai)
#pragma unroll
            for (int m = 0; m < 4; ++m) {
                bf16_t* rowp = O + (size_t)(row0 + ai * HALF + m * 16) * 1024 + col0;
#pragma unroll
                for (int bj = 0; bj < 2; ++bj) {
                    const f32x4 v0 = acc[ai][bj][m][0], v1 = acc[ai][bj][m][1];
                    u32x4 w; w.x = cvt_pk_bf16(v0[0], v0[1]); w.y = cvt_pk_bf16(v0[2], v0[3]); w.z = cvt_pk_bf16(v1[0], v1[1]); w.w = cvt_pk_bf16(v1[2], v1[3]);
                    *(u32x4*)(rowp + bj * HALF) = w;
                }
            }
    }
};
struct EpiGate {
    static constexpr bool PERM = true, AFTER_DRAIN = false;
    const bf16_t* PP; bf16_t* E; const float* bias; float ascale;
    __device__ __forceinline__ const float* bias_slice(const Unit& u) const { return bias + u.pn * BM; }
    __device__ __forceinline__ void operator()(const f32x4 (&acc)[2][2][4][2], const Unit& u, int wr, int wc, int fr, int fq, const PG8_LAS float* bl) const {
        const int row0 = u.pm * BM + wr * 64 + fr, col0 = u.pn * BM + wc * 32 + 8 * fq;
        f32x4 bv[2][2];
#pragma unroll
        for (int bj = 0; bj < 2; ++bj)
#pragma unroll
            for (int n = 0; n < 2; ++n) bv[bj][n] = *(const PG8_LAS f32x4*)(bl + wc * 32 + 8 * fq + bj * HALF + 4 * n);
#pragma unroll
        for (int ai = 0; ai < 2; ++ai)
#pragma unroll
            for (int m = 0; m < 4; ++m) {
                const size_t off = (size_t)(row0 + ai * HALF + m * 16) * 1024 + col0;
#pragma unroll
                for (int bj = 0; bj < 2; ++bj) {
                    const u32x4 pv = *(const u32x4*)(PP + off + bj * HALF);
                    const f32x4 v0 = acc[ai][bj][m][0] * ascale + bv[bj][0], v1 = acc[ai][bj][m][1] * ascale + bv[bj][1];
                    u32x4 w;
                    w.x = cvt_pk_bf16(sigm(v0[0]) * bf_lo(pv.x), sigm(v0[1]) * bf_hi(pv.x)); w.y = cvt_pk_bf16(sigm(v0[2]) * bf_lo(pv.y), sigm(v0[3]) * bf_hi(pv.y));
                    w.z = cvt_pk_bf16(sigm(v1[0]) * bf_lo(pv.z), sigm(v1[1]) * bf_hi(pv.z)); w.w = cvt_pk_bf16(sigm(v1[2]) * bf_lo(pv.w), sigm(v1[3]) * bf_hi(pv.w));
                    *(u32x4*)(E + off + bj * HALF) = w;
                }
            }
    }
};
struct MoeOrder {
    const PG8_LAS int* tile_e; int nunits, lnt, G, c;
    const PG8_LAS int* tst; const PG8_LAS int* cnt; const int* list; int list_pitch;
    __device__ __forceinline__ const int* row_src(const Unit& u) const { const int e = tile_e[u.pm]; return list + (size_t)e * list_pitch + (u.pm - tst[e]) * 256; }
    __device__ __forceinline__ int nvalid(const Unit& u) const { const int e = tile_e[u.pm]; return cnt[e] - (u.pm - tst[e]) * 256; }
    __device__ __forceinline__ bool next(int i, Unit& u) const {
        const int L = i * G + c; if (L >= nunits) return false;
        const int mt = L >> lnt, pn = L & ((1 << lnt) - 1);
        u.pm = mt; u.pn = (tile_e[mt] << lnt) + pn; return true;
    }
    __device__ __forceinline__ void a_ready(const Unit&) const {}
    __device__ __forceinline__ void done(const Unit&) const {}
    __attribute__((address_space(1))) unsigned* tailw = nullptr;
    __device__ __forceinline__ void tail(int wid, int lane) const { if (tailw && wid == 0 && lane == 0) (void)__hip_atomic_fetch_add(tailw, 1u, __ATOMIC_RELAXED, __HIP_MEMORY_SCOPE_AGENT); }
};

template <class Epi, class Sched, bool ALIGN_EPI = false, bool SP2 = false, bool F8 = false, bool GATHER = false>
__device__ __forceinline__ void gemm_phase(PG8_LAS unsigned char* lds, const Gemm g, const Sched& S, const Epi& E, const int wave_id, PG8_LAS float* biasl, PG8_LAS int* tokl = nullptr) {
    static_assert(!GATHER || SP2, "the gathered-A form is written for the SP2 loop");
    int tid_l = wave_id * 64 + (int)__builtin_amdgcn_mbcnt_hi(~0u, __builtin_amdgcn_mbcnt_lo(~0u, 0u)); asm volatile("" : "+v"(tid_l));     const int tid = tid_l, wid = __builtin_amdgcn_readfirstlane(tid >> 6), lane = tid & 63, wr = wid >> 2, wc = wid & 3, fr = lane & 15, fq = lane >> 4;
    int K_l = g.K; asm volatile("" : "+s"(K_l)); const int K = K_l, nt = K / BK;
    unsigned voffA[2], voffB[2];
    unsigned voffG[2][2] = {{0u, 0u}, {0u, 0u}};
#pragma unroll
    for (int i = 0; i < 2; ++i) { int R, C; stage_rc(tid * 16 + i * 8192, R, C); const int Rb = Epi::PERM ? ((R & ~31) + perm32(R & 31)) : R;
        voffA[i] = (unsigned)(R * K + C) * 2u; voffB[i] = (unsigned)(Rb * K + C) * 2u; }
    const size_t kstep = (size_t)(BK * 2);
    const size_t hstep = (size_t)HALF * K * 2;
    const size_t tstep = 2 * hstep;
    const unsigned ldsw = (unsigned)wid * 1024u;
    const int aoff = lds_byte(wr * 64 + fr, fq * 8), boff = lds_byte(wc * 32 + fr, fq * 8);
#define PG8_SA(b, h) (((b) * 2 + (h)) * HTB)
#define PG8_SB(b, h) ((4 + (b) * 2 + (h)) * HTB)
#define PG8_STAGE(bufoff, gbase, voff) do { _Pragma("unroll") for (int _i = 0; _i < 2; ++_i) \
        __builtin_amdgcn_global_load_lds((const unsigned*)((const char*)(gbase) + (voff)[_i]), (PG8_LAS unsigned*)(lds + (bufoff) + ldsw + _i * 8192), 16, 0, 0); } while (0)
#define PG8_STAGE_A(bufoff, base, h) do { if constexpr (GATHER) { PG8_STAGE(bufoff, base, voffG[h]); } else { PG8_STAGE(bufoff, (base) + (h) * hstep, voffA); } } while (0)
#define PG8_TOKSTAGE(u_, slot_) do { if (wid == 0) { const int* rp_ = S.row_src(u_); __builtin_amdgcn_global_load_lds((const unsigned*)(rp_ + lane * 4), (PG8_LAS unsigned*)(tokl + (slot_) * 256), 16, 0, 0); } } while (0)
#define PG8_TOKSET(slot_, nv_) do { const int nvv_ = (nv_); _Pragma("unroll") for (int h_ = 0; h_ < 2; ++h_) _Pragma("unroll") for (int i_ = 0; i_ < 2; ++i_) { int R_, C_; stage_rc(tid * 16 + i_ * 8192, R_, C_); \
        const int r_ = h_ * HALF + R_; int tk_ = tokl[(slot_) * 256 + r_]; tk_ = (r_ < nvv_ && tk_ >= 0 && tk_ < g.M) ? tk_ : 0; voffG[h_][i_] = (unsigned)tk_ * (unsigned)(K * 2) + (unsigned)(C_ * 2); } } while (0)
#define PG8_LDA(dst, b, h) do { _Pragma("unroll") for (int m = 0; m < 4; ++m) _Pragma("unroll") for (int k = 0; k < 2; ++k) dst[m][k] = *(const PG8_LAS bf16x8*)(lds + PG8_SA(b, h) + aoff + m * 2048 + k * 1024); } while (0)
#define PG8_LDB(dst, b, h) do { _Pragma("unroll") for (int n = 0; n < 2; ++n) _Pragma("unroll") for (int k = 0; k < 2; ++k) dst[n][k] = *(const PG8_LAS bf16x8*)(lds + PG8_SB(b, h) + boff + n * 2048 + k * 1024); } while (0)
#define PG8_MMA(ai, bj, At, Bt) do { __builtin_amdgcn_s_setprio(1); _Pragma("unroll") for (int m = 0; m < 4; ++m) _Pragma("unroll") for (int n = 0; n < 2; ++n) { \
        if constexpr (F8) { typedef int i32x4_ __attribute__((ext_vector_type(4))); \
              \
            asm volatile("v_mfma_f32_16x16x128_f8f6f4 %0, %1, %2, %0" : "+v"(acc[ai][bj][m][n]) : "v"(__builtin_shufflevector(__builtin_bit_cast(i32x4_, Bt[n][0]), __builtin_bit_cast(i32x4_, Bt[n][1]), 0, 1, 2, 3, 4, 5, 6, 7)), \
                "v"(__builtin_shufflevector(__builtin_bit_cast(i32x4_, At[m][0]), __builtin_bit_cast(i32x4_, At[m][1]), 0, 1, 2, 3, 4, 5, 6, 7))); } \
        else { _Pragma("unroll") for (int k = 0; k < 2; ++k) acc[ai][bj][m][n] = __builtin_amdgcn_mfma_f32_16x16x32_bf16(Bt[n][k], At[m][k], acc[ai][bj][m][n], 0, 0, 0); } } \
        __builtin_amdgcn_s_setprio(0); } while (0)
#define PG8_WAIT_V(n) asm volatile("s_waitcnt vmcnt(" #n ")" ::: "memory")
#define PG8_WAIT_L(n) asm volatile("s_waitcnt lgkmcnt(" #n ")" ::: "memory")
#define PG8_BAR __builtin_amdgcn_s_barrier()
#define PG8_SCHED __builtin_amdgcn_sched_barrier(0)
    Unit cur, nxt; int ui = 0;
    if (!S.next(0, cur)) return;
#define PG8_BIAS(u_, slot_) do { if (wid == 0) { const float* bp_ = E.bias_slice(u_); if (bp_) __builtin_amdgcn_global_load_lds((const unsigned*)(bp_ + lane * 4), (PG8_LAS unsigned*)(biasl + (slot_) * 256), 16, 0, 0); } } while (0)
    PG8_BIAS(cur, 0);
    if constexpr (GATHER) { PG8_TOKSTAGE(cur, 0); asm volatile("s_waitcnt vmcnt(0)" ::: "memory"); __builtin_amdgcn_s_barrier(); asm volatile("" ::: "memory"); PG8_TOKSET(0, S.nvalid(cur)); }
    f32x4 acc[2][2][4][2];
#pragma unroll
    for (int a = 0; a < 2; ++a)
#pragma unroll
        for (int b = 0; b < 2; ++b)
#pragma unroll
            for (int m = 0; m < 4; ++m)
#pragma unroll
                for (int n = 0; n < 2; ++n) acc[a][b][m][n] = (f32x4){0.f, 0.f, 0.f, 0.f};
    bf16x8 At[4][2], B0[2][2], B1[2][2];
    const char* cA = (const char*)g.A + (GATHER ? (size_t)0 : (size_t)cur.pm * tstep); const char* cB = (const char*)g.Bt + (size_t)cur.pn * tstep;
    S.a_ready(cur);
    if constexpr (SP2) {
        PG8_STAGE(PG8_SB(0, 0), cB, voffB); PG8_STAGE(PG8_SB(0, 1), cB + hstep, voffB); PG8_STAGE_A(PG8_SA(0, 0), cA, 0); PG8_STAGE_A(PG8_SA(0, 1), cA, 1);
        if (wr == 1) PG8_BAR;
        PG8_WAIT_V(2); PG8_BAR;
        PG8_STAGE(PG8_SB(1, 0), cB + kstep, voffB); PG8_STAGE_A(PG8_SA(1, 0), cA + kstep, 0); PG8_STAGE(PG8_SB(1, 1), cB + hstep + kstep, voffB);
        PG8_WAIT_V(6); PG8_BAR;
    } else {
        PG8_STAGE(PG8_SB(0, 0), cB, voffB); PG8_STAGE_A(PG8_SA(0, 0), cA, 0); PG8_STAGE(PG8_SB(0, 1), cB + hstep, voffB); PG8_STAGE_A(PG8_SA(0, 1), cA, 1);
        if (wr == 1) PG8_BAR;
        PG8_WAIT_V(4); PG8_BAR;
        PG8_STAGE(PG8_SB(1, 0), cB + kstep, voffB); PG8_STAGE_A(PG8_SA(1, 0), cA + kstep, 0); PG8_STAGE(PG8_SB(1, 1), cB + hstep + kstep, voffB);
        PG8_WAIT_V(6); PG8_BAR;
    }
    for (;;) {
        const bool has_next = S.next(ui + 1, nxt);
        if (!has_next) S.tail(wid, lane);
        const char* nA = (has_next && !GATHER) ? (const char*)g.A + (size_t)nxt.pm * tstep : cA;
        if constexpr (GATHER) { if (has_next) PG8_TOKSTAGE(nxt, (ui + 1) & 1); } const char* nB = has_next ? (const char*)g.Bt + (size_t)nxt.pn * tstep : cB;
        for (int t = 0; t < nt; t += 2) {
            const bool last = (t == nt - 2);
            const char* a1 = cA + (size_t)(t + 1) * kstep;
            const char* a2 = last ? nA : cA + (size_t)(t + 2) * kstep; const char* b2 = last ? nB : cB + (size_t)(t + 2) * kstep;
            const char* a3 = a2 + kstep; const char* b3 = b2 + kstep;
            if (last && has_next) S.a_ready(nxt);
            if constexpr (SP2) {
            PG8_LDB(B0, 0, 0); PG8_LDB(B1, 0, 1); PG8_SCHED; PG8_LDA(At, 0, 0); PG8_STAGE_A(PG8_SA(1, 1), a1, 1);
            if constexpr (GATHER) { if (last && has_next) PG8_TOKSET((ui + 1) & 1, S.nvalid(nxt)); }
            PG8_WAIT_V(8); PG8_WAIT_L(0); PG8_BAR; PG8_MMA(0, 0, At, B0); PG8_MMA(0, 1, At, B1); PG8_BAR; PG8_SCHED;
            PG8_LDA(At, 0, 1); PG8_STAGE(PG8_SB(0, 0), b2, voffB); PG8_STAGE(PG8_SB(0, 1), b2 + hstep, voffB); PG8_STAGE_A(PG8_SA(0, 0), a2, 0);
            PG8_WAIT_V(8); PG8_WAIT_L(0); PG8_BAR; PG8_MMA(1, 0, At, B0); PG8_MMA(1, 1, At, B1); PG8_BAR; PG8_SCHED;
            PG8_LDB(B0, 1, 0); PG8_LDB(B1, 1, 1); PG8_SCHED; PG8_LDA(At, 1, 0); PG8_STAGE_A(PG8_SA(0, 1), a2, 1);
            PG8_WAIT_V(8); PG8_WAIT_L(0); PG8_BAR; PG8_MMA(0, 0, At, B0); PG8_MMA(0, 1, At, B1); PG8_BAR; PG8_SCHED;
            PG8_LDA(At, 1, 1); PG8_STAGE(PG8_SB(1, 0), b3, voffB); PG8_STAGE(PG8_SB(1, 1), b3 + hstep, voffB); PG8_STAGE_A(PG8_SA(1, 0), a3, 0);
            PG8_WAIT_V(8); PG8_WAIT_L(0); PG8_BAR; PG8_MMA(1, 0, At, B0); PG8_MMA(1, 1, At, B1); PG8_BAR; PG8_SCHED;
            } else {
            PG8_LDB(B0, 0, 0); PG8_SCHED; PG8_LDA(At, 0, 0); PG8_STAGE_A(PG8_SA(1, 1), a1, 1);
            PG8_WAIT_L(8); PG8_BAR; PG8_WAIT_L(0); PG8_MMA(0, 0, At, B0); PG8_BAR; PG8_SCHED;
            PG8_LDB(B1, 0, 1); PG8_STAGE(PG8_SB(0, 0), b2, voffB);
            PG8_BAR; PG8_WAIT_L(0); PG8_MMA(0, 1, At, B1); PG8_BAR;
            PG8_LDA(At, 0, 1); PG8_STAGE_A(PG8_SA(0, 0), a2, 0);
            PG8_BAR; PG8_WAIT_L(0); PG8_MMA(1, 0, At, B0); PG8_BAR; PG8_SCHED;
            PG8_STAGE(PG8_SB(0, 1), b2 + hstep, voffB);
            PG8_WAIT_V(6); PG8_BAR; PG8_MMA(1, 1, At, B1); PG8_BAR;
            PG8_LDB(B0, 1, 0); PG8_SCHED; PG8_LDA(At, 1, 0); PG8_STAGE_A(PG8_SA(0, 1), a2, 1);
            PG8_WAIT_L(8); PG8_BAR; PG8_WAIT_L(0); PG8_MMA(0, 0, At, B0); PG8_BAR; PG8_SCHED;
            PG8_LDB(B1, 1, 1); PG8_STAGE(PG8_SB(1, 0), b3, voffB);
            PG8_BAR; PG8_WAIT_L(0); PG8_MMA(0, 1, At, B1); PG8_BAR;
            PG8_LDA(At, 1, 1); PG8_STAGE_A(PG8_SA(1, 0), a3, 0);
            PG8_BAR; PG8_WAIT_L(0); PG8_MMA(1, 0, At, B0); PG8_BAR; PG8_SCHED;
            PG8_STAGE(PG8_SB(1, 1), b3 + hstep, voffB);
            PG8_WAIT_V(6); PG8_BAR; PG8_MMA(1, 1, At, B1); PG8_BAR;
            }
        }
        if constexpr (F8) { asm volatile("s_nop 7\n\ts_nop 7\n\ts_nop 7\n\ts_nop 7" ::: "memory"); }
        if constexpr (ALIGN_EPI) { if (wr == 0) PG8_BAR; }
        if constexpr (!Epi::AFTER_DRAIN) { E(acc, cur, wr, wc, fr, fq, biasl + (ui & 1) * 256); S.done(cur); }
        if (!has_next) break;
#pragma unroll
        for (int a = 0; a < 2; ++a)
#pragma unroll
            for (int b = 0; b < 2; ++b)
#pragma unroll
                for (int m = 0; m < 4; ++m)
#pragma unroll
                    for (int n = 0; n < 2; ++n) acc[a][b][m][n] = (f32x4){0.f, 0.f, 0.f, 0.f};
        cur = nxt; cA = nA; cB = nB; ++ui;
        PG8_BIAS(cur, ui & 1);
        if constexpr (ALIGN_EPI) { if (wr == 1) PG8_BAR; }
    }
    PG8_WAIT_V(0);
    if constexpr (!ALIGN_EPI) { if (wr == 0) PG8_BAR; }
    PG8_BAR;
    if constexpr (Epi::AFTER_DRAIN) { E.fused(acc, cur, wr, wc, fr, fq, lds, wid, lane); S.done(cur); }
#undef PG8_SA
#undef PG8_SB
#undef PG8_STAGE
#undef PG8_LDA
#undef PG8_LDB
#undef PG8_MMA
#undef PG8_WAIT_V
#undef PG8_WAIT_L
#undef PG8_BAR
#undef PG8_SCHED
#undef PG8_BIAS
#undef PG8_STAGE_A
#undef PG8_TOKSTAGE
#undef PG8_TOKSET
}
}

constexpr int NWAVES = 8;
constexpr int NB = 16, T = 2048, D = 1024, M = NB * T, NL = 2;
constexpr int HP = 2048;
constexpr int NIN = 2304;
constexpr int PD = 256;
constexpr int NE = 32, TOPK = 4;
constexpr int MAXTILES = (M * TOPK) / 256 + NE;
constexpr int MAXSLOTS = MAXTILES * 256;
constexpr float LN_EPS = 1e-5f;
constexpr float DN_ALPHA = 1.4142135623730951f;
constexpr float SC_LOG2E = 0.125f * 1.4426950408889634f;
constexpr int C_QN = 0, C_KC = 512, C_VC = 640, C_KS = 768, C_VS = 896, C_KW = 1024, C_VW = 1152, C_QS = 1280, C_KSW = 1792, C_VSW = 1920;

constexpr size_t MiB = 1u << 20;
constexpr size_t WS_CTL = 0, CTL_ZERO_BYTES = 32768;
constexpr size_t WS_WIN = 2 * MiB;
constexpr size_t WS_WO = 12 * MiB;
constexpr size_t WS_WPG = 16 * MiB;
constexpr size_t WS_WPP = 20 * MiB;
constexpr size_t WS_WC1 = 22 * MiB;
constexpr size_t WS_WC2 = 26 * MiB;
constexpr size_t WS_WR = 27 * MiB;
constexpr size_t WS_BINP = 28 * MiB;
constexpr size_t WS_B1P = 28 * MiB + 65536;
constexpr size_t WS_ROPE = 30 * MiB;
constexpr size_t WS_GATES = 38 * MiB;
constexpr size_t WS_KCMP = 42 * MiB;
constexpr size_t WS_VCMP = 42 * MiB + 512 * 1024;
constexpr size_t WS_TOKE = 43 * MiB;
constexpr size_t WS_TOKR = 43 * MiB + 512 * 1024;
constexpr size_t WS_TOKW = 44 * MiB;
constexpr size_t WS_SLOT = 44 * MiB + 512 * 1024;
constexpr size_t WS_W1T = 48 * MiB;
constexpr size_t WS_W2T = 304 * MiB;
constexpr size_t WS_XB = 432 * MiB;
constexpr size_t WS_PB = 496 * MiB;
constexpr size_t WS_R1 = 528 * MiB;
constexpr size_t WS_H = WS_R1, WS_O = WS_R1 + 128 * MiB, WS_YS = WS_R1;
constexpr size_t WS_LIST = WS_R1;

constexpr size_t WS_R2 = 808 * MiB;
constexpr size_t WS_Y1 = WS_R2, WS_ACT = WS_R2;
constexpr size_t WS_X1 = 1080 * MiB;
constexpr size_t WS_X1B = 1208 * MiB;
constexpr size_t WS_PP = 1272 * MiB;
constexpr size_t WS_E = 1336 * MiB;
constexpr size_t WS_XN = 1400 * MiB;
constexpr size_t WS_X1F8 = WS_XB;
constexpr size_t WS_END = 1528 * MiB;
static_assert((size_t)MAXSLOTS * 2048 <= 272 * MiB, "slot buffers");
constexpr int CW_TMO = 0, CW_CODE = 1;
constexpr int CW_CNT = 1024;
constexpr int CW_BAR = 4096;

constexpr int RING_OFF = 0, RING_BYTES = 131072;
constexpr int SCRATCH_BYTES = 139264;
constexpr int LDSCTL_OFF = SCRATCH_BYTES, MISC_OFF = LDSCTL_OFF + 320;
constexpr int TAB_OFF = MISC_OFF + 128;
constexpr int TAB_CNT = TAB_OFF, TAB_SOFF = TAB_OFF + 128, TAB_TST = TAB_OFF + 256, TAB_TE = TAB_OFF + 512;
constexpr int BIAS_OFF = 143360;
constexpr int TOKL_OFF = BIAS_OFF + 2048;
constexpr int LDS_BYTES = 147456;
static_assert(TAB_TE + MAXTILES * 4 <= BIAS_OFF && TOKL_OFF + 2048 <= LDS_BYTES, "LDS map");

static_assert((CW_BAR + 3456) * 4 <= (int)CTL_ZERO_BYTES && (CW_CNT + NL * 32) * 4 <= (int)CTL_ZERO_BYTES, "control words inside the memset region");
#define GAS __attribute__((address_space(1)))
#define LAS __attribute__((address_space(3)))
typedef unsigned short bf16;
typedef unsigned v4u __attribute__((ext_vector_type(4)));
typedef float f32x4 __attribute__((ext_vector_type(4)));
typedef short bf16x8 __attribute__((ext_vector_type(8)));
typedef GAS unsigned gu32;
typedef GAS unsigned long long gu64;
#define RLX_AGENT __ATOMIC_RELAXED, __HIP_MEMORY_SCOPE_AGENT
#define LDS_WAIT() asm volatile("s_waitcnt lgkmcnt(0)" ::: "memory")
#define VM_WAIT() asm volatile("s_waitcnt vmcnt(0)" ::: "memory")
__device__ __forceinline__ unsigned long long rt() { return __builtin_amdgcn_s_memrealtime(); }
__device__ __forceinline__ unsigned f2bf(float f) { unsigned u = __builtin_bit_cast(unsigned, f); return (u + 0x7fffu + ((u >> 16) & 1u)) >> 16; }
__device__ __forceinline__ unsigned pk2(float lo, float hi) { return f2bf(lo) | (f2bf(hi) << 16); }
#define XB_TMO      128
#define XB_XCNT(j)  (256  + 64 * (j))
#define XB_XSUB(j)  (1280 + 64 * (j))
#define XB_XGEN(j)  (2304 + 64 * (j))
#define XB_TOP      3328
#define XB_TOPGEN   3392
#define XCD_BAR_WORDS 3456
#define XB_SPIN_CAP (1u << 22)

__device__ __forceinline__ unsigned xb_ld(unsigned* p)              { return __hip_atomic_load(p, __ATOMIC_RELAXED, __HIP_MEMORY_SCOPE_AGENT); }
__device__ __forceinline__ unsigned xb_add(unsigned* p, unsigned v) { return __hip_atomic_fetch_add(p, v, __ATOMIC_RELAXED, __HIP_MEMORY_SCOPE_AGENT); }
__device__ __forceinline__ unsigned xb_xcc_id() { return (unsigned)__builtin_amdgcn_s_getreg((3 << 11) | 20) & 0xFu; }
#define XB_SPIN(cond, bar) do { unsigned _sp = 0; while (cond) { __builtin_amdgcn_s_sleep(1); \
    if ((++_sp & 255u) == 0u) { if (xb_ld(&(bar)[XB_TMO])) break; if (_sp > XB_SPIN_CAP) { atomicAdd(&(bar)[XB_TMO], 1u); break; } } } } while (0)

struct XcdBarrier {
    unsigned* bar; unsigned x; int wave;
    volatile LAS unsigned* st;
};

__device__ __forceinline__ bool xb_thread0(int wave) { return wave == 0 && __builtin_amdgcn_mbcnt_hi(~0u, __builtin_amdgcn_mbcnt_lo(~0u, 0u)) == 0u; }
__device__ __forceinline__ XcdBarrier xcd_barrier_post(unsigned* bar, volatile LAS unsigned* st, int wave) {
    XcdBarrier b; b.bar = bar; b.x = xb_xcc_id(); b.st = st; b.wave = wave;
    if (xb_thread0(wave)) (void)xb_add(&bar[XB_XCNT(b.x)], 1u);
    return b;
}
__device__ __forceinline__ void xcd_barrier_complete(unsigned* bar, unsigned x, unsigned& nloc, unsigned& nx) {
    const unsigned G = gridDim.x * gridDim.y * gridDim.z;
    unsigned sum, cnt, mine, sp = 0u;
    for (;;) {
        sum = 0u; cnt = 0u; mine = 0u;
#pragma unroll
        for (unsigned j = 0; j < 16; ++j) { const unsigned c = xb_ld(&bar[XB_XCNT(j)]); sum += c; cnt += (c > 0u) ? 1u : 0u; mine = (j == x) ? c : mine; }
        if (sum == G) break;
        __builtin_amdgcn_s_sleep(1);
        if ((++sp & 255u) == 0u) { if (xb_ld(&bar[XB_TMO])) break; if (sp > XB_SPIN_CAP) { atomicAdd(&bar[XB_TMO], 1u); break; } }
    }
    nloc = mine > 0u ? mine : 1u; nx = cnt > 0u ? cnt : 1u;
}

__device__ __forceinline__ void xcd_barrier(const XcdBarrier& b) {
    asm volatile("s_waitcnt vmcnt(0)" ::: "memory");
    __syncthreads();
    if (xb_thread0(b.wave)) {
        unsigned* bar = b.bar;
        __builtin_amdgcn_s_waitcnt(0);
        unsigned nloc = b.st[0], nx = b.st[1];
        if (nloc == 0u) { xcd_barrier_complete(bar, b.x, nloc, nx); b.st[0] = nloc; b.st[1] = nx; }
        const unsigned old = xb_add(&bar[XB_XSUB(b.x)], 1u);
        const unsigned gen = old / nloc;
        if (old + 1u == (gen + 1u) * nloc) {
            __builtin_amdgcn_fence(__ATOMIC_RELEASE, "agent");
            asm volatile("s_waitcnt vmcnt(0)" ::: "memory");
            const unsigned og = xb_add(&bar[XB_TOP], 1u);
            const unsigned tg = og / nx;
            if (og + 1u == (tg + 1u) * nx) xb_add(&bar[XB_TOPGEN], 1u);
            else XB_SPIN(xb_ld(&bar[XB_TOPGEN]) == tg, bar);
            __builtin_amdgcn_fence(__ATOMIC_ACQUIRE, "agent");
            xb_add(&bar[XB_XGEN(b.x)], 1u);
            asm volatile("s_waitcnt vmcnt(0)" ::: "memory");
        } else {
            XB_SPIN(xb_ld(&bar[XB_XGEN(b.x)]) == gen, bar);
            __builtin_amdgcn_fence(__ATOMIC_ACQUIRE, "agent");
            asm volatile("s_waitcnt vmcnt(0)" ::: "memory");
        }
    }
    __syncthreads();
}

typedef float f32x16 __attribute__((ext_vector_type(16)));
typedef unsigned u32x2 __attribute__((ext_vector_type(2)));
struct Frame {
    LAS unsigned char* lds;
    volatile LAS unsigned* MISC;
    gu32* ctl;
    unsigned char* ws;
    int tid, lane, wave;
    int vcu, G;
};
__device__ __forceinline__ float wave_sum(float v) {
#pragma unroll
    for (int o = 1; o < 64; o <<= 1) v += __shfl_xor(v, o);
    return v;
}
__device__ __forceinline__ float sigm(float x) { return __builtin_amdgcn_rcpf(1.0f + __builtin_amdgcn_exp2f(-1.4426950408889634f * x)); }
__device__ __forceinline__ float bf_lo(unsigned w) { return __uint_as_float(w << 16); }
__device__ __forceinline__ float bf_hi(unsigned w) { return __uint_as_float(w & 0xffff0000u); }
__device__ __forceinline__ unsigned cvtpk(float lo, float hi) { typedef float f2 __attribute__((ext_vector_type(2))); typedef __bf16 b2 __attribute__((ext_vector_type(2))); f2 v = {lo, hi}; b2 b = __builtin_convertvector(v, b2); return __builtin_bit_cast(unsigned, b); }
__device__ __forceinline__ bf16x8 pack8(float a0, float a1, float a2, float a3, float a4, float a5, float a6, float a7) {
    v4u w; w.x = cvtpk(a0, a1); w.y = cvtpk(a2, a3); w.z = cvtpk(a4, a5); w.w = cvtpk(a6, a7); return __builtin_bit_cast(bf16x8, w);
}
__device__ __forceinline__ int crow(int r, int hi) { return (r & 3) + 8 * (r >> 2) + 4 * hi; }

struct MapId { __device__ __forceinline__ int operator()(int n) const { return n; } };
struct MapW1 { __device__ __forceinline__ int operator()(int n) const { return ((n >> 7) & 1) * 1024 + (n >> 8) * 128 + (n & 127); } };
struct MapWin {
    __device__ __forceinline__ int operator()(int n) const {
        if (n >= 2048) { const int i = n - 2048; return i < 24 ? 1280 + i : -1; }
        const int seg = n >> 7, q = n & 127, hd = q >> 6, pos = q & 63, g = pos >> 3, j = pos & 7;
        const int dlog = j < 4 ? 4 * g + j : 32 + 4 * g + (j - 4);
        const int hc = seg * 128 + hd * 64 + dlog;
        return hc < 1280 ? hc : hc + 24;
    }
};
template <class Map>
__device__ __forceinline__ void transpose_item(const float* W, int K, int Nsrc, bf16* WT, LAS float* scr, int kb, int nb, int lane, Map map) {
    const int k0 = 64 * kb, n0 = 32 * nb;
    const int src = map(n0 + (lane & 31));
    float wv[32];
#pragma unroll
    for (int i = 0; i < 32; ++i) { const int kk = 2 * i + (lane >> 5); wv[i] = src >= 0 ? W[(size_t)(k0 + kk) * Nsrc + src] : 0.f; }
#pragma unroll
    for (int i = 0; i < 32; ++i) { const int kk = 2 * i + (lane >> 5); scr[kk * 33 + (lane & 31)] = wv[i]; }
    LDS_WAIT(); asm volatile("" ::: "memory");
    const int c = lane & 7;
#pragma unroll
    for (int j = 0; j < 4; ++j) { const int n = (lane >> 3) + 8 * j; const LAS float* s = scr + (8 * c) * 33 + n;
        v4u o; o.x = pk2(s[0 * 33], s[1 * 33]); o.y = pk2(s[2 * 33], s[3 * 33]); o.z = pk2(s[4 * 33], s[5 * 33]); o.w = pk2(s[6 * 33], s[7 * 33]);
        *(GAS v4u*)(WT + (size_t)(n0 + n) * K + k0 + 8 * c) = o; }
    LDS_WAIT(); asm volatile("" ::: "memory");
}
__device__ __forceinline__ unsigned pk4_fp8(float a, float b, float c, float d) { int w = 0; w = __builtin_amdgcn_cvt_pk_fp8_f32(a, b, w, false); w = __builtin_amdgcn_cvt_pk_fp8_f32(c, d, w, true); return (unsigned)w; }
template <class Map>
__device__ __forceinline__ void transpose_item_f8(const float* W, int K, int Nsrc, unsigned char* WT, LAS float* scr, int kb, int nb, int lane, Map map, float wscale) {
    const int k0 = 64 * kb, n0 = 32 * nb;
    const int src = map(n0 + (lane & 31));
    float wv[32];
#pragma unroll
    for (int i = 0; i < 32; ++i) { const int kk = 2 * i + (lane >> 5); wv[i] = src >= 0 ? W[(size_t)(k0 + kk) * Nsrc + src] * wscale : 0.f; }
#pragma unroll
    for (int i = 0; i < 32; ++i) { const int kk = 2 * i + (lane >> 5); scr[kk * 33 + (lane & 31)] = wv[i]; }
    LDS_WAIT(); asm volatile("" ::: "memory");
    const int c = lane & 7;
#pragma unroll
    for (int j = 0; j < 4; ++j) { const int n = (lane >> 3) + 8 * j; const LAS float* s = scr + (8 * c) * 33 + n;
        u32x2 o; o.x = pk4_fp8(s[0 * 33], s[1 * 33], s[2 * 33], s[3 * 33]); o.y = pk4_fp8(s[4 * 33], s[5 * 33], s[6 * 33], s[7 * 33]);
        *(GAS u32x2*)(WT + (size_t)(n0 + n) * K + k0 + 8 * c) = o; }
    LDS_WAIT(); asm volatile("" ::: "memory");
}
constexpr float W1_F8_SCALE = 64.0f, W2_F8_SCALE = 128.0f, WPG_F8_SCALE = 64.0f;
struct PIn { const float *x, *p, *w_in, *b_in, *w_ck1, *w_ck2, *w_cv1, *w_cv2, *w_o, *w_r, *w_e1, *b_e1, *w_e2, *w_pg, *w_pp; const int* pos; };
__device__ __forceinline__ void p0_prologue(Frame& F, const PIn& I) {
    LAS float* scr = (LAS float*)(F.lds + RING_OFF + F.wave * 16384);
    const int gw = F.vcu * NWAVES + F.wave, NGW = F.G * NWAVES, lane = F.lane;
    unsigned char* ws = F.ws;
    constexpr int I_IN = 16 * 72, I_O = 16 * 32, I_PG = 16 * 32, I_PP = 4 * 32, I_C1 = 32 * 8, I_C2 = 4 * 2;
    constexpr int I_LAYER = I_IN + I_O + I_PG + I_PP + 2 * I_C1 + 2 * I_C2;
    for (int it = gw; it < NL * I_LAYER; it += NGW) {
        const int L = it / I_LAYER; int r = it % I_LAYER;
        if (r < I_IN) { transpose_item(I.w_in + (size_t)L * 1024 * 2072, 1024, 2072, (bf16*)(ws + WS_WIN) + (size_t)L * NIN * 1024, scr, r / 72, r % 72, lane, MapWin()); continue; } r -= I_IN;
        if (r < I_O) { transpose_item(I.w_o + (size_t)L * 1024 * 1024, 1024, 1024, (bf16*)(ws + WS_WO) + (size_t)L * 1024 * 1024, scr, r / 32, r % 32, lane, MapId()); continue; } r -= I_O;
        if (r < I_PG) {
            if (L == NL - 1) transpose_item_f8(I.w_pg + (size_t)L * 1024 * 1024, 1024, 1024, ws + WS_WPG + (size_t)L * 1024 * 1024 * 2, scr, r / 32, r % 32, lane, MapId(), WPG_F8_SCALE);
            else transpose_item(I.w_pg + (size_t)L * 1024 * 1024, 1024, 1024, (bf16*)(ws + WS_WPG) + (size_t)L * 1024 * 1024, scr, r / 32, r % 32, lane, MapId());
            continue; } r -= I_PG;
        if (r < I_PP) { transpose_item(I.w_pp + (size_t)L * 256 * 1024, 256, 1024, (bf16*)(ws + WS_WPP) + (size_t)L * 1024 * 256, scr, r / 32, r % 32, lane, MapId()); continue; } r -= I_PP;
        if (r < I_C1) { transpose_item(I.w_ck1 + (size_t)L * 2048 * 256, 2048, 256, (bf16*)(ws + WS_WC1) + (size_t)(L * 2 + 0) * 256 * 2048, scr, r / 8, r % 8, lane, MapId()); continue; } r -= I_C1;
        if (r < I_C1) { transpose_item(I.w_cv1 + (size_t)L * 2048 * 256, 2048, 256, (bf16*)(ws + WS_WC1) + (size_t)(L * 2 + 1) * 256 * 2048, scr, r / 8, r % 8, lane, MapId()); continue; } r -= I_C1;
        if (r < I_C2) { transpose_item(I.w_ck2 + (size_t)L * 256 * 64, 256, 64, (bf16*)(ws + WS_WC2) + (size_t)(L * 2 + 0) * 64 * 256, scr, r / 2, r % 2, lane, MapId()); continue; } r -= I_C2;
        { transpose_item(I.w_cv2 + (size_t)L * 256 * 64, 256, 64, (bf16*)(ws + WS_WC2) + (size_t)(L * 2 + 1) * 64 * 256, scr, r / 2, r % 2, lane, MapId()); }
    }
    const size_t gt = (size_t)F.vcu * (NWAVES * 64) + F.tid, NGT = (size_t)F.G * NWAVES * 64;
    for (size_t i = gt; i < (size_t)NL * 32 * 1024; i += NGT) {
        const int L = (int)(i / (32 * 1024)), e = (int)((i / 1024) % 32), k = (int)(i % 1024);
        const float w = I.w_r[((size_t)L * 1024 + k) * 32 + e];
        const unsigned h = f2bf(w); const float wl = w - __uint_as_float(h << 16);
        bf16* d = (bf16*)(ws + WS_WR) + (size_t)L * 2 * 32 * 1024 + (size_t)e * 1024 + k;
        d[0] = (bf16)h; d[32 * 1024] = (bf16)f2bf(wl);
    }
    for (size_t i = gt; i < (size_t)NL * NIN; i += NGT) { const int L = (int)(i / NIN), n = (int)(i % NIN); const int s = MapWin()(n); ((float*)(ws + WS_BINP))[i] = s >= 0 ? I.b_in[(size_t)L * 2072 + s] : 0.f; }
    for (size_t i = gt; i < (size_t)NL * 32 * 2048; i += NGT) { const int le = (int)(i / 2048), n = (int)(i % 2048); ((float*)(ws + WS_B1P))[i] = I.b_e1[(size_t)le * 2048 + MapW1()(n)]; }
    for (size_t i = gt; i < (size_t)M * D / 8; i += NGT) {
        const f32x4 a = *(const GAS f32x4*)(I.x + i * 8), b = *(const GAS f32x4*)(I.x + i * 8 + 4);
        v4u o; o.x = pk2(a.x, a.y); o.y = pk2(a.z, a.w); o.z = pk2(b.x, b.y); o.w = pk2(b.z, b.w);
        *(GAS v4u*)((bf16*)(ws + WS_XB) + i * 8) = o;
    }
    for (size_t i = gt; i < (size_t)NL * M * PD / 8; i += NGT) {
        const f32x4 a = *(const GAS f32x4*)(I.p + i * 8), b = *(const GAS f32x4*)(I.p + i * 8 + 4);
        v4u o; o.x = pk2(a.x, a.y); o.y = pk2(a.z, a.w); o.z = pk2(b.x, b.y); o.w = pk2(b.z, b.w);
        *(GAS v4u*)((bf16*)(ws + WS_PB) + i * 8) = o;
    }
    for (size_t i = gt; i < (size_t)M * 32; i += NGT) {
        const int row = (int)(i >> 5), d = (int)(i & 31);
        const float inv = 1.0f / powf(10000.0f, (float)(2 * d) / 64.0f);
        const float ang = (float)I.pos[row] * inv;
        float* rp = (float*)(ws + WS_ROPE) + (size_t)row * 64;
        rp[d] = cosf(ang); rp[32 + d] = sinf(ang);
    }
}

static_assert(NL == 2, "the conversion queues are laid out for two layers");
constexpr int I_E1 = 32 * 16 * 32, I_E2 = 32 * 16 * 16;
constexpr int QCH = 2;
constexpr int CW_Q = 2048, CW_STOP = 2080;
constexpr int CV_PITCH = 65, CV_WAVE_BYTES = 17408;
static_assert(8 * CV_WAVE_BYTES <= SCRATCH_BYTES && 64 * CV_PITCH * 4 <= CV_WAVE_BYTES, "conversion tiles");
struct CvItem { const float* W; unsigned char* WT; int Nsrc, K, kb, nb, w1; float scale; };
template <int Q>
__device__ __forceinline__ CvItem cv_item(unsigned char* ws, const float* w_e1, const float* w_e2, int item) {
    CvItem d;
    constexpr int L = (Q == 2) ? NL - 1 : 0;
    const bool is1 = (Q == 0) || (Q == 2 && item < I_E1);
    const int r = (Q == 2 && !is1) ? item - I_E1 : item;
    if (is1) { const int e = r / 512, q = r % 512; d.W = w_e1 + ((size_t)L * 32 + e) * 1024 * 2048; d.Nsrc = 2048; d.kb = q / 32; d.nb = q % 32; d.w1 = 1; d.scale = W1_F8_SCALE;
        d.WT = (Q == 2) ? ws + WS_W1T + (size_t)L * 32 * 2048 * 1024 * 2 + (size_t)e * 2048 * 1024 : ws + WS_W1T + (size_t)e * 2048 * 1024 * 2; }
    else { const int e = r / 256, q = r % 256; d.W = w_e2 + ((size_t)L * 32 + e) * 1024 * 1024; d.Nsrc = 1024; d.kb = q / 16; d.nb = q % 16; d.w1 = 0; d.scale = W2_F8_SCALE;
        d.WT = (Q == 2) ? ws + WS_W2T + (size_t)L * 32 * 1024 * 1024 * 2 + (size_t)e * 1024 * 1024 : ws + WS_W2T + (size_t)e * 1024 * 1024 * 2; }
    d.K = 1024;
    return d;
}
__device__ __forceinline__ void cv_load(f32x4 (&r)[16], const CvItem& d, int lane) {
    const int kl = lane >> 4, c = lane & 15, n = 64 * d.nb + 4 * c;
    const int src = d.w1 ? MapW1()(n) : n;
    const float* p = d.W + (size_t)(64 * d.kb + kl) * d.Nsrc + src;
#pragma unroll
    for (int i = 0; i < 16; ++i) r[i] = __builtin_nontemporal_load((const GAS f32x4*)(p + (size_t)(4 * i) * d.Nsrc));
}
template <bool F8>
__device__ __forceinline__ void cv_store(const f32x4 (&r)[16], const CvItem& d, LAS float* scr, int lane) {
    const int kl = lane >> 4, c = lane & 15;
#pragma unroll
    for (int i = 0; i < 16; ++i) { LAS float* t = scr + (4 * i + kl) * CV_PITCH + 4 * c; t[0] = r[i].x; t[1] = r[i].y; t[2] = r[i].z; t[3] = r[i].w; }
    LDS_WAIT(); asm volatile("" ::: "memory");
    const int c8 = lane & 7, nl = lane >> 3;
#pragma unroll
    for (int jj = 0; jj < 8; ++jj) { const int n = nl + 8 * jj; const LAS float* s = scr + (8 * c8) * CV_PITCH + n;
        const float a0 = s[0 * CV_PITCH], a1 = s[1 * CV_PITCH], a2 = s[2 * CV_PITCH], a3 = s[3 * CV_PITCH], a4 = s[4 * CV_PITCH], a5 = s[5 * CV_PITCH], a6 = s[6 * CV_PITCH], a7 = s[7 * CV_PITCH];
        const size_t o = (size_t)(64 * d.nb + n) * d.K + 64 * d.kb + 8 * c8;
        if constexpr (F8) { const float w = d.scale; u32x2 v; v.x = pk4_fp8(a0 * w, a1 * w, a2 * w, a3 * w); v.y = pk4_fp8(a4 * w, a5 * w, a6 * w, a7 * w); __builtin_nontemporal_store(v, (GAS u32x2*)(d.WT + o)); }
        else { v4u v; v.x = pk2(a0, a1); v.y = pk2(a2, a3); v.z = pk2(a4, a5); v.w = pk2(a6, a7); __builtin_nontemporal_store(v, (GAS v4u*)((bf16*)d.WT + o)); } }
    LDS_WAIT(); asm volatile("" ::: "memory");
}
template <int Q>
__device__ __forceinline__ void conv_run(Frame& F, const float* w_e1, const float* w_e2, int stop_word, unsigned stop_thr = 1u, int stat = -1) {
    static_assert(QCH == 2, "one loop trip = one chunk = items A, B");
    constexpr int NCH = (Q == 0 ? I_E1 : Q == 1 ? I_E2 : I_E1 + I_E2) / QCH;
    constexpr bool F8 = (Q == 2);
    LAS float* scr = (LAS float*)(F.lds + RING_OFF + F.wave * CV_WAVE_BYTES);
    gu32* head = F.ctl + CW_Q + Q;
    const int lane = F.lane;
    if (__builtin_amdgcn_readfirstlane(__hip_atomic_load(head, RLX_AGENT)) >= (unsigned)NCH) return;
    if (stop_word >= 0 && __builtin_amdgcn_readfirstlane(__hip_atomic_load(F.ctl + stop_word, RLX_AGENT)) >= stop_thr) return;
    const __amdgpu_buffer_rsrc_t rs = __builtin_amdgcn_make_buffer_rsrc((unsigned*)head, 0, 4, 0x00020000);
    const int own = lane == 0 ? 0 : 0x40000000;
    unsigned c = (unsigned)__builtin_amdgcn_readfirstlane(__builtin_amdgcn_raw_ptr_buffer_atomic_add_i32(1, rs, own, 0, 0));
    if (c >= (unsigned)NCH) return;
    int pend = __builtin_amdgcn_raw_ptr_buffer_atomic_add_i32(1, rs, own, 0, 0);
    unsigned stp = 0u; bool last = false;
    if (stop_word >= 0) stp = __hip_atomic_load(F.ctl + stop_word, RLX_AGENT);
#ifdef PRB_SEL
    unsigned ndone = 0u;
#endif
    f32x4 ra[16], rb[16];
    CvItem da = cv_item<Q>(F.ws, w_e1, w_e2, (int)c * QCH), db;
    cv_load(ra, da, lane);
    for (;;) {
        db = cv_item<Q>(F.ws, w_e1, w_e2, (int)c * QCH + 1); cv_load(rb, db, lane);
        cv_store<F8>(ra, da, scr, lane);
        const unsigned cn = (unsigned)__builtin_amdgcn_readfirstlane(pend);
        const bool stopped = stop_word >= 0 && (unsigned)__builtin_amdgcn_readfirstlane(stp) >= stop_thr;
        const bool more = !last && cn < (unsigned)NCH;
        if (more) {
            pend = __builtin_amdgcn_raw_ptr_buffer_atomic_add_i32(1, rs, stopped ? 0x40000000 : own, 0, 0);
            last = stopped;
            if (stop_word >= 0) stp = __hip_atomic_load(F.ctl + stop_word, RLX_AGENT);
            da = cv_item<Q>(F.ws, w_e1, w_e2, (int)cn * QCH); cv_load(ra, da, lane);
        }
        cv_store<F8>(rb, db, scr, lane);
#ifdef PRB_SEL
        ++ndone;
#endif
        if (!more) break;
        c = cn;
    }
#ifdef PRB_SEL
    if (stat >= 0 && lane == 0) (void)__hip_atomic_fetch_add((gu32*)(F.ws + WS_TOKE + 3 * MiB) + stat, ndone, RLX_AGENT);
#endif
}

__device__ __forceinline__ float gelu_tanh(float x) {
    const float u = 0.7978845608028654f * (x + 0.044715f * x * x * x);
    const float e = __builtin_amdgcn_exp2f(2.0f * 1.4426950408889634f * u);
    const float t = 1.0f - 2.0f * __builtin_amdgcn_rcpf(e + 1.0f);
    return 0.5f * x * (1.0f + t);
}
__device__ __forceinline__ void phase_compress(Frame& F, int L, const float* ck_pe, const float* cv_pe) {
    const int lane = F.lane, wave = F.wave, tid = F.tid;
    unsigned char* ws = F.ws;
    const bf16* H = (const bf16*)(ws + WS_H);
    const float* rope = (const float*)(ws + WS_ROPE);
    LAS unsigned char* hid = F.lds + RING_OFF;
    LAS float* pel = (LAS float*)(F.lds + RING_OFF + 16896);
    LAS unsigned char* atok = F.lds + RING_OFF + 16896 + 8192;
    constexpr int AP = 144, AIS = 33 * AP;
    for (int unit = blockIdx.x; unit < 256; unit += F.G) {
        int lane_v = lane; asm volatile("" : "+v"(lane_v));
        const int q = lane_v & 31, hi = lane_v >> 5;
        const int b = unit >> 4, g = (unit >> 3) & 1, kv = (unit >> 2) & 1, cb = unit & 3;
        const bf16* w1t = (const bf16*)(ws + WS_WC1) + (size_t)(L * 2 + kv) * 256 * 2048;
        const bf16* w2t = (const bf16*)(ws + WS_WC2) + (size_t)(L * 2 + kv) * 64 * 256;
        const float* pe = (kv ? cv_pe : ck_pe) + (size_t)L * 32 * 64;
        const int scol = (kv ? C_VC : C_KC) + g * 64;
        const int tok0 = 512 * cb;
        __syncthreads();
        for (int ci = tid; ci < 528 * 8; ci += NWAVES * 64) {
            const int tk = ci >> 3, ch = ci & 7; int tg = tok0 + tk; tg = tg < T ? tg : T - 1;
            *(LAS v4u*)(atok + (tk & 15) * AIS + (tk >> 4) * AP + ch * 16) = *(const GAS v4u*)(H + ((size_t)b * T + tg) * HP + scol + ch * 8);
        }
        for (int ci = tid; ci < 32 * 64 / 4; ci += NWAVES * 64) *(LAS f32x4*)(pel + ci * 4) = *(const GAS f32x4*)(pe + ci * 4);
        __syncthreads();
        const bf16* brow = w1t + (size_t)(32 * wave + q) * 2048 + 8 * hi;
        f32x16 acc; for (int r = 0; r < 16; ++r) acc[r] = 0.f;
        bf16x8 bcur[8], bnxt[8];
#pragma unroll
        for (int u = 0; u < 8; ++u) bcur[u] = *(const GAS bf16x8*)(brow + u * 16);
        for (int i2 = 0; i2 < 16; ++i2) {
            if (i2 < 15) {
#pragma unroll
                for (int u = 0; u < 8; ++u) bnxt[u] = *(const GAS bf16x8*)(brow + (i2 + 1) * 128 + u * 16);
            }
#pragma unroll
            for (int u = 0; u < 8; ++u) {
                const int i = 2 * i2 + (u >> 2), s4 = u & 3;
                const v4u av = *(const LAS v4u*)(atok + (i & 15) * AIS + (q + (i >> 4)) * AP + (16 * s4 + 8 * hi) * 2);
                const f32x4 p0 = *(const LAS f32x4*)(pel + i * 64 + 16 * s4 + 8 * hi), p1 = *(const LAS f32x4*)(pel + i * 64 + 16 * s4 + 8 * hi + 4);
                const bf16x8 af = pack8(bf_lo(av.x) + p0.x, bf_hi(av.x) + p0.y, bf_lo(av.y) + p0.z, bf_hi(av.y) + p0.w, bf_lo(av.z) + p1.x, bf_hi(av.z) + p1.y, bf_lo(av.w) + p1.z, bf_hi(av.w) + p1.w);
                acc = __builtin_amdgcn_mfma_f32_32x32x16_bf16(af, bcur[u], acc, 0, 0, 0);
            }
#pragma unroll
            for (int u = 0; u < 8; ++u) bcur[u] = bnxt[u];
        }
#pragma unroll
        for (int r = 0; r < 16; ++r) *(LAS bf16*)(hid + crow(r, hi) * 528 + (32 * wave + q) * 2) = (bf16)f2bf(gelu_tanh(acc[r]));
        __syncthreads();
        if (wave == 0) {
            f32x16 a0, a1; for (int r = 0; r < 16; ++r) { a0[r] = 0.f; a1[r] = 0.f; }
#pragma unroll
            for (int ks = 0; ks < 16; ++ks) {
                const bf16x8 af = *(const LAS bf16x8*)(hid + q * 528 + (16 * ks + 8 * hi) * 2);
                const bf16x8 b0 = *(const GAS bf16x8*)(w2t + (size_t)q * 256 + 16 * ks + 8 * hi), b1 = *(const GAS bf16x8*)(w2t + (size_t)(32 + q) * 256 + 16 * ks + 8 * hi);
                a0 = __builtin_amdgcn_mfma_f32_32x32x16_bf16(af, b0, a0, 0, 0, 0);
                a1 = __builtin_amdgcn_mfma_f32_32x32x16_bf16(af, b1, a1, 0, 0, 0);
            }
            bf16* outp = (bf16*)(ws + (kv ? WS_VCMP : WS_KCMP)) + (size_t)(b * 2 + g) * 128 * 64;
#pragma unroll
            for (int r = 0; r < 16; ++r) {
                const int cl = 32 * cb + crow(r, hi);
                float x1 = a0[r], x2 = a1[r];
                if (kv == 0) {
                    const int cr = cl < 127 ? cl : 126;
                    const float* rp = rope + ((size_t)b * T + 31 + 16 * cr) * 64;
                    const float cs = rp[q], sn = rp[32 + q];
                    const float o1 = x1 * cs - x2 * sn, o2 = x2 * cs + x1 * sn; x1 = o1; x2 = o2;
                }
                if (cl >= 127) { x1 = 0.f; x2 = 0.f; }
                outp[(size_t)cl * 64 + q] = (bf16)f2bf(x1); outp[(size_t)cl * 64 + 32 + q] = (bf16)f2bf(x2);
            }
        }
    }
    __syncthreads();
}

namespace att {
constexpr float ATT_THR = 6.0f;
constexpr int KP = 144;
constexpr int KTB = 64 * KP, VTB = 8192;
constexpr int L_K = 0;
constexpr int L_V = 4 * KTB;
constexpr int L_KC = 0;
constexpr int L_VC = 128 * KP;
constexpr int L_IMP = L_VC + 16384;
constexpr int L_OT = 4 * KTB + 4 * VTB;
constexpr int L_SEL = L_OT + 65536;
static_assert(L_IMP + 4 * 64 * 33 * 4 <= L_OT && L_SEL + 256 <= SCRATCH_BYTES, "attention LDS map");

__device__ __forceinline__ float max3f(float a, float b, float c) { float r; asm("v_max3_f32 %0, %1, %2, %3" : "=v"(r) : "v"(a), "v"(b), "v"(c)); return r; }
__device__ __forceinline__ float max2f(float a, float b) { float r; asm("v_max_f32_e32 %0, %1, %2" : "=v"(r) : "v"(a), "v"(b)); return r; }
typedef short v4i16_t __attribute__((ext_vector_type(4)));
__device__ __forceinline__ u32x2 vtr(const LAS unsigned char* p) { return __builtin_bit_cast(u32x2, __builtin_amdgcn_ds_read_tr16_b64_v4i16((LAS v4i16_t*)p)); }
__device__ __forceinline__ float xhalf_max(float v) { auto rr = __builtin_amdgcn_permlane32_swap(__float_as_uint(v), __float_as_uint(v), false, false); return fmaxf(__uint_as_float(rr[0]), __uint_as_float(rr[1])); }
__device__ __forceinline__ float xhalf_sum(float v) { auto rr = __builtin_amdgcn_permlane32_swap(__float_as_uint(v), __float_as_uint(v), false, false); return __uint_as_float(rr[0]) + __uint_as_float(rr[1]); }
template <bool SEL>
__device__ __forceinline__ void att_tile(LAS unsigned char* Kl, LAS unsigned char* Vl, int j, int qt, int jlo, int t, int W, unsigned selbits, const bf16x8 (&qf)[4],
                                         f32x16& o0, f32x16& o1, f32x16& negm, float& m_run, float& l_run, int q, int hi) {
        bf16x8 ka[4], kb2[4]; u32x2 va[4][2], vb[4][2];
#pragma unroll
        for (int s = 0; s < 4; ++s) { ka[s] = *(const LAS bf16x8*)(Kl + q * KP + (16 * s + 8 * hi) * 2); kb2[s] = *(const LAS bf16x8*)(Kl + (32 + q) * KP + (16 * s + 8 * hi) * 2); }
        {
            const LAS unsigned char* vp = Vl + ((q >> 4) & 1) * 32 + (q & 3) * 8 + (4 * hi + ((q & 15) >> 2)) * 64;
#pragma unroll
            for (int ks = 0; ks < 4; ++ks) {
                va[ks][0] = vtr(vp + ks * 1024); va[ks][1] = vtr(vp + ks * 1024 + 512);
                vb[ks][0] = vtr(vp + 4096 + ks * 1024); vb[ks][1] = vtr(vp + 4096 + ks * 1024 + 512);
            }
        }
        __builtin_amdgcn_sched_barrier(0);
        f32x16 s0 = __builtin_amdgcn_mfma_f32_32x32x16_bf16(ka[0], qf[0], negm, 0, 0, 0);
        f32x16 s1 = __builtin_amdgcn_mfma_f32_32x32x16_bf16(kb2[0], qf[0], negm, 0, 0, 0);
#pragma unroll
        for (int s = 1; s < 4; ++s) {
            s0 = __builtin_amdgcn_mfma_f32_32x32x16_bf16(ka[s], qf[s], s0, 0, 0, 0);
            s1 = __builtin_amdgcn_mfma_f32_32x32x16_bf16(kb2[s], qf[s], s1, 0, 0, 0);
        }
        const bool lane_ok = SEL ? (((selbits >> j) & 1u) != 0u) : true;
        if (j == qt || j == jlo) {
            const int d0 = t - 64 * j - 4 * hi;
#pragma unroll
            for (int r = 0; r < 16; ++r) {
                s0[r] = ((unsigned)(d0 - ((r & 3) + 8 * (r >> 2))) < (unsigned)W) ? s0[r] : -INFINITY;
                s1[r] = ((unsigned)(d0 - (32 + (r & 3) + 8 * (r >> 2))) < (unsigned)W) ? s1[r] : -INFINITY;
            }
        }
        float mx = fmaxf(s0[0], s1[0]), mx2 = fmaxf(s0[1], s1[1]);
#pragma unroll
        for (int r = 2; r < 16; r += 2) { mx = max3f(mx, s0[r], s1[r]); mx2 = max3f(mx2, s0[r + 1], s1[r + 1]); }
        mx = max2f(mx, mx2);
        mx = lane_ok ? mx : -INFINITY;
        mx = xhalf_max(mx);
        typedef float f32x2_ __attribute__((ext_vector_type(2)));
        f32x2_ ps2 = {0.f, 0.f};
#pragma unroll
        for (int r = 0; r < 16; ++r) { s0[r] = __builtin_amdgcn_exp2f(s0[r]); s1[r] = __builtin_amdgcn_exp2f(s1[r]); ps2 += (f32x2_){s0[r], s1[r]}; }
        const float ps = ps2.x + ps2.y;
        const unsigned okm = lane_ok ? 0xffffffffu : 0u;
        l_run += lane_ok ? ps : 0.f;
#pragma unroll
        for (int ks = 0; ks < 4; ++ks) {
            const int kb = ks >> 1, sp = ks & 1;
            bf16x8 pf = kb ? pack8(s1[8 * sp + 0], s1[8 * sp + 1], s1[8 * sp + 2], s1[8 * sp + 3], s1[8 * sp + 4], s1[8 * sp + 5], s1[8 * sp + 6], s1[8 * sp + 7])
                           : pack8(s0[8 * sp + 0], s0[8 * sp + 1], s0[8 * sp + 2], s0[8 * sp + 3], s0[8 * sp + 4], s0[8 * sp + 5], s0[8 * sp + 6], s0[8 * sp + 7]);
            if (SEL) { v4u pw = __builtin_bit_cast(v4u, pf); pw.x &= okm; pw.y &= okm; pw.z &= okm; pw.w &= okm; pf = __builtin_bit_cast(bf16x8, pw); }
            {
                v4u w; w.x = va[ks][0].x; w.y = va[ks][0].y; w.z = va[ks][1].x; w.w = va[ks][1].y;
                o0 = __builtin_amdgcn_mfma_f32_32x32x16_bf16(__builtin_bit_cast(bf16x8, w), pf, o0, 0, 0, 0);
            }
            {
                v4u w; w.x = vb[ks][0].x; w.y = vb[ks][0].y; w.z = vb[ks][1].x; w.w = vb[ks][1].y;
                o1 = __builtin_amdgcn_mfma_f32_32x32x16_bf16(__builtin_bit_cast(bf16x8, w), pf, o1, 0, 0, 0);
            }
        }
        if (__builtin_amdgcn_ballot_w64(mx > ATT_THR) != 0ull) {
            const float gmx = fmaxf(mx, 0.f);
            const float alpha = __builtin_amdgcn_exp2f(-gmx);
            l_run *= alpha; m_run += gmx;
#pragma unroll
            for (int r = 0; r < 16; ++r) { o0[r] *= alpha; o1[r] *= alpha; negm[r] -= gmx; }
        }
}
template <bool SEL>
__device__ __forceinline__ void stream(LAS unsigned char* lds, const bf16* Hb, int kcol, int vcol, int j0, int j1, int qt, int t, int W, unsigned selbits,
                                       const bf16x8 (&qf)[4], f32x16& o0, f32x16& o1, float& m_run, float& l_run, int tid, int lane, int wave) {
    const int q = lane & 31, hi = lane >> 5;
    const int krow = tid >> 3, kch = tid & 7, vrow = krow, vch = kch;
    const int vdst = (kch >> 2) * 4096 + (krow >> 3) * 512 + (krow & 7) * 64 + (kch & 3) * 16;
    const int jlo = qt - (W >> 6);
    f32x16 negm;
#pragma unroll
    for (int r = 0; r < 16; ++r) negm[r] = -m_run;
    __syncthreads();
    const bf16* kp0 = Hb + (size_t)(64 * j0 + krow) * HP + kcol + kch * 8;
    const bf16* vp0 = Hb + (size_t)(64 * j0 + vrow) * HP + vcol + vch * 8;
    v4u kA = *(const GAS v4u*)kp0, vA = *(const GAS v4u*)vp0, kB = kA, vB = vA;
    if (j0 + 1 <= j1) { kB = *(const GAS v4u*)(kp0 + (size_t)64 * HP); vB = *(const GAS v4u*)(vp0 + (size_t)64 * HP); }
    int pp = 0;
    for (int jp = j0; jp <= j1; jp += 2, pp ^= 1) {
        const bool has2 = jp + 1 <= j1;
        LAS unsigned char* Kl0 = lds + L_K + pp * (2 * KTB); LAS unsigned char* Kl1 = Kl0 + KTB;
        LAS unsigned char* Vl0 = lds + L_V + pp * (2 * VTB); LAS unsigned char* Vl1 = Vl0 + VTB;
        *(LAS v4u*)(Kl0 + krow * KP + kch * 16) = kA;
        *(LAS v4u*)(Vl0 + vdst) = vA;
        if (has2) { *(LAS v4u*)(Kl1 + krow * KP + kch * 16) = kB; *(LAS v4u*)(Vl1 + vdst) = vB; }
        if (jp + 2 <= j1) { kA = *(const GAS v4u*)(kp0 + (size_t)(64 * (jp + 2 - j0)) * HP); vA = *(const GAS v4u*)(vp0 + (size_t)(64 * (jp + 2 - j0)) * HP); }
        if (jp + 3 <= j1) { kB = *(const GAS v4u*)(kp0 + (size_t)(64 * (jp + 3 - j0)) * HP); vB = *(const GAS v4u*)(vp0 + (size_t)(64 * (jp + 3 - j0)) * HP); }
        __syncthreads();
        att_tile<SEL>(Kl0, Vl0, jp, qt, jlo, t, W, selbits, qf, o0, o1, negm, m_run, l_run, q, hi);
        if (has2) att_tile<SEL>(Kl1, Vl1, jp + 1, qt, jlo, t, W, selbits, qf, o0, o1, negm, m_run, l_run, q, hi);
    }
}

__device__ __forceinline__ void phase_attention(Frame& F, int L, const float* sinks_all) {
    const int tid = F.tid, lane = F.lane, wave = F.wave;
    const int rh = wave >> 1, th = wave & 1;
    unsigned char* ws = F.ws;
    LAS unsigned char* lds = F.lds + RING_OFF;
    const bf16* H = (const bf16*)(ws + WS_H);
    bf16* O = (bf16*)(ws + WS_O);
    const float* gates = (const float*)(ws + WS_GATES);
    const float* sinks = sinks_all + L * 8;
    LAS float* impb = (LAS float*)(lds + L_IMP);
    LAS unsigned* selm = (LAS unsigned*)(lds + L_SEL);
    const int NU = 2048;
    if (wave >= 4) __builtin_amdgcn_s_setprio(1);
    for (int i = 0;; ++i) {
        const int pos = (i & 1) ? (F.G - 1 - (int)blockIdx.x) : (int)blockIdx.x;
        const int n = i * F.G + pos;
        if (i * F.G >= NU) break;
        if (n >= NU) continue;
        const bool nsa = n < 1024;
        int b, g, qt;
        if (nsa) { qt = 31 - (n >> 5); b = (n & 31) >> 1; g = n & 1; }
        else { const int m2 = n - 1024; qt = 31 - (m2 >> 5); b = (m2 & 31) >> 1; g = m2 & 1; }
        int lane_v = lane; asm volatile("" : "+v"(lane_v));
        const int q = lane_v & 31, hi = lane_v >> 5;
        const int hq = 4 * g + rh;
        const int t = 64 * qt + 32 * th + q;
        const size_t row = (size_t)b * T + t;
        const bf16* Hb = H + (size_t)b * T * HP;
        bf16x8 qf[4];
        {
            const bf16* qp = H + row * HP + (nsa ? C_QN : C_QS) + 64 * hq + 8 * hi;
#pragma unroll
            for (int s = 0; s < 4; ++s) qf[s] = *(const GAS bf16x8*)(qp + 16 * s);
        }
        f32x16 ot0, ot1;
        if (nsa) {
            const float* gp = gates + row * 32 + hq * 3;
            const float g_cmp = gp[0], g_slc = gp[1], g_win = gp[2];
            __syncthreads();
            {
                const bf16* kc = (const bf16*)(ws + WS_KCMP) + (size_t)(b * 2 + g) * 128 * 64;
                const bf16* vc = (const bf16*)(ws + WS_VCMP) + (size_t)(b * 2 + g) * 128 * 64;
#pragma unroll
                for (int it = 0; it < 2; ++it) {
                    const int ci = tid + 512 * it, r = ci >> 3, ch = ci & 7;
                    *(LAS v4u*)(lds + L_KC + r * KP + ch * 16) = *(const GAS v4u*)(kc + (size_t)r * 64 + ch * 8);
                    *(LAS v4u*)(lds + L_VC + (ch >> 2) * 8192 + (r >> 3) * 512 + (r & 7) * 64 + (ch & 3) * 16) = *(const GAS v4u*)(vc + (size_t)r * 64 + ch * 8);
                }
            }
            __syncthreads();
            f32x16 sc[4];
#pragma unroll
            for (int kb = 0; kb < 4; ++kb) {
#pragma unroll
                for (int r = 0; r < 16; ++r) sc[kb][r] = 0.f;
#pragma unroll
                for (int s = 0; s < 4; ++s) {
                    const bf16x8 a = *(const LAS bf16x8*)(lds + L_KC + (32 * kb + q) * KP + (16 * s + 8 * hi) * 2);
                    sc[kb] = __builtin_amdgcn_mfma_f32_32x32x16_bf16(a, qf[s], sc[kb], 0, 0, 0);
                }
                __builtin_amdgcn_sched_barrier(0);
            }
            float mx = -INFINITY;
            const int cth = (((t - 31) >> 4) < 126 ? ((t - 31) >> 4) : 126) - 4 * hi;
#pragma unroll
            for (int kb = 0; kb < 4; ++kb)
#pragma unroll
                for (int r = 0; r < 16; ++r) {
                    const bool vis = (32 * kb + (r & 3) + 8 * (r >> 2)) <= cth;
                    sc[kb][r] = vis ? sc[kb][r] : -INFINITY;
                    mx = fmaxf(mx, sc[kb][r]);
                }
            mx = xhalf_max(mx);
            mx = fmaxf(mx, -1e30f);
            float ps = 0.f;
#pragma unroll
            for (int kb = 0; kb < 4; ++kb)
#pragma unroll
                for (int r = 0; r < 16; ++r) { sc[kb][r] = __builtin_amdgcn_exp2f(sc[kb][r] - mx); ps += sc[kb][r]; }
            ps = xhalf_sum(ps);
            const float inv = 1.0f / fmaxf(ps, 1e-30f);
#pragma unroll
            for (int kb = 0; kb < 4; ++kb)
#pragma unroll
                for (int r = 0; r < 16; ++r) sc[kb][r] *= inv;
#pragma unroll
            for (int kb = 0; kb < 4; ++kb)
#pragma unroll
                for (int ii = 0; ii < 4; ++ii)
                    impb[(rh * 64 + 32 * th + q) * 33 + 8 * kb + 2 * ii + hi] = (sc[kb][4 * ii] + sc[kb][4 * ii + 1]) + (sc[kb][4 * ii + 2] + sc[kb][4 * ii + 3]);
            f32x16 c0, c1;
#pragma unroll
            for (int r = 0; r < 16; ++r) { c0[r] = 0.f; c1[r] = 0.f; }
#pragma unroll
            for (int ks = 0; ks < 8; ++ks) {
                const int kb = ks >> 1, sp = ks & 1;
                const bf16x8 pf = pack8(sc[kb][8 * sp + 0], sc[kb][8 * sp + 1], sc[kb][8 * sp + 2], sc[kb][8 * sp + 3], sc[kb][8 * sp + 4], sc[kb][8 * sp + 5], sc[kb][8 * sp + 6], sc[kb][8 * sp + 7]);
                const LAS unsigned char* vp = lds + L_VC + ((q >> 4) & 1) * 32 + (q & 3) * 8 + (4 * hi + ((q & 15) >> 2)) * 64 + ks * 1024;
                {
                    const u32x2 lo = vtr(vp), hh = vtr(vp + 512);
                    v4u w; w.x = lo.x; w.y = lo.y; w.z = hh.x; w.w = hh.y;
                    c0 = __builtin_amdgcn_mfma_f32_32x32x16_bf16(__builtin_bit_cast(bf16x8, w), pf, c0, 0, 0, 0);
                }
                {
                    const u32x2 lo = vtr(vp + 8192), hh = vtr(vp + 8192 + 512);
                    v4u w; w.x = lo.x; w.y = lo.y; w.z = hh.x; w.w = hh.y;
                    c1 = __builtin_amdgcn_mfma_f32_32x32x16_bf16(__builtin_bit_cast(bf16x8, w), pf, c1, 0, 0, 0);
                }
                if (ks & 1) __builtin_amdgcn_sched_barrier(0);
            }
            __syncthreads();
            if (qt >= 8) {
                const int tok = tid >> 3, sub = tid & 7;
                unsigned key[4];
#pragma unroll
                for (int ii = 0; ii < 4; ++ii) {
                    const int j = 4 * sub + ii;
                    const float sum = (impb[tok * 33 + j] + impb[(64 + tok) * 33 + j]) + (impb[(128 + tok) * 33 + j] + impb[(192 + tok) * 33 + j]);
                    const unsigned kb = (__float_as_uint(sum) & ~31u) | (unsigned)(31 - j);
                    key[ii] = (j >= 1 && j <= qt - 2) ? kb : 0u;
                }
                unsigned mask = 1u | (1u << qt) | (1u << (qt - 1));
#pragma unroll
                for (int rnd = 0; rnd < 5; ++rnd) {
                    unsigned bk = key[0] > key[1] ? key[0] : key[1]; const unsigned b2 = key[2] > key[3] ? key[2] : key[3]; bk = bk > b2 ? bk : b2;
                    unsigned o1 = (unsigned)__shfl_xor((int)bk, 1); bk = bk > o1 ? bk : o1;
                    o1 = (unsigned)__shfl_xor((int)bk, 2); bk = bk > o1 ? bk : o1;
                    o1 = (unsigned)__shfl_xor((int)bk, 4); bk = bk > o1 ? bk : o1;
                    mask |= 1u << (31u - (bk & 31u));
#pragma unroll
                    for (int ii = 0; ii < 4; ++ii) key[ii] = key[ii] == bk ? 0u : key[ii];
                }
                if (sub == 0) selm[tok] = mask;
            } else if (tid < 64) selm[tid] = (2u << qt) - 1u;
            __syncthreads();
            const unsigned selbits = selm[32 * th + q];
            LAS float* otl = (LAS float*)(lds + L_OT + wave * 8192) + lane_v;
#pragma unroll
            for (int r = 0; r < 16; ++r) { otl[r * 64] = g_cmp * c0[r]; otl[(16 + r) * 64] = g_cmp * c1[r]; }
            {
                f32x16 a0, a1; float mr = 0.f, lr = 0.f;
#pragma unroll
                for (int r = 0; r < 16; ++r) { a0[r] = 0.f; a1[r] = 0.f; }
                stream<true>(lds, Hb, C_KS + 64 * g, C_VS + 64 * g, 0, qt, qt, t, 1 << 20, selbits, qf, a0, a1, mr, lr, tid, lane_v, wave);
                lr = xhalf_sum(lr);
                const float f = g_slc / fmaxf(lr, 1e-30f);
#pragma unroll
                for (int r = 0; r < 16; ++r) { otl[r * 64] += f * a0[r]; otl[(16 + r) * 64] += f * a1[r]; }
            }
            {
                f32x16 a0, a1; float mr = 0.f, lr = 0.f;
#pragma unroll
                for (int r = 0; r < 16; ++r) { a0[r] = 0.f; a1[r] = 0.f; }
                stream<false>(lds, Hb, C_KW + 64 * g, C_VW + 64 * g, qt >= 8 ? qt - 8 : 0, qt, qt, t, 512, 0u, qf, a0, a1, mr, lr, tid, lane_v, wave);
                lr = xhalf_sum(lr);
                const float f = g_win / fmaxf(lr, 1e-30f);
#pragma unroll
                for (int r = 0; r < 16; ++r) { ot0[r] = otl[r * 64] + f * a0[r]; ot1[r] = otl[(16 + r) * 64] + f * a1[r]; }
            }
        } else {
            f32x16 a0, a1; float mr = 0.f, lr = 0.f;
#pragma unroll
            for (int r = 0; r < 16; ++r) { a0[r] = 0.f; a1[r] = 0.f; }
            stream<false>(lds, Hb, C_KSW + 64 * g, C_VSW + 64 * g, qt >= 2 ? qt - 2 : 0, qt, qt, t, 128, 0u, qf, a0, a1, mr, lr, tid, lane_v, wave);
            lr = xhalf_sum(lr);
            const float sk = sinks[hq] * 1.4426950408889634f;
            const float mf = fmaxf(mr, sk);
            const float sm = __builtin_amdgcn_exp2f(mr - mf);
            const float den = lr * sm + __builtin_amdgcn_exp2f(sk - mf);
            const float f = sm / fmaxf(den, 1e-30f);
#pragma unroll
            for (int r = 0; r < 16; ++r) { ot0[r] = f * a0[r]; ot1[r] = f * a1[r]; }
        }
        bf16* op = O + row * 1024 + (nsa ? 0 : 512) + 64 * hq + 4 * hi;
#pragma unroll
        for (int ii = 0; ii < 4; ++ii) {
            u32x2 w0, w1;
            w0.x = cvtpk(ot0[4 * ii], ot0[4 * ii + 1]); w0.y = cvtpk(ot0[4 * ii + 2], ot0[4 * ii + 3]);
            w1.x = cvtpk(ot1[4 * ii], ot1[4 * ii + 1]); w1.y = cvtpk(ot1[4 * ii + 2], ot1[4 * ii + 3]);
            *(GAS u32x2*)(op + 8 * ii) = w0; *(GAS u32x2*)(op + 32 + 8 * ii) = w1;
        }
    }
    __builtin_amdgcn_s_setprio(0);
}
}

template <bool F8>
__device__ __forceinline__ void phase_ln1_router(Frame& F, int L, const float* xres, const float* ln_g, const float* ln_b, const float* b_r) {
    const int tid = F.tid, lane = F.lane, wave = F.wave;
    unsigned char* ws = F.ws;
    const bf16* A1 = (const bf16*)(ws + WS_Y1);
    float* X1 = (float*)(ws + WS_X1);
    bf16* X1B = (bf16*)(ws + WS_X1B);
    const bf16* Wh = (const bf16*)(ws + WS_WR) + (size_t)L * 2 * 32 * 1024;
    const bf16* Wl = Wh + 32 * 1024;
    LAS float* scr = (LAS float*)(F.lds + RING_OFF + wave * 4096);
    LAS unsigned* cntl = (LAS unsigned*)(F.lds + RING_OFF + 65536);
    LAS unsigned* basel = cntl + 32;
    gu32* gcnt = F.ctl + CW_CNT + L * 32;
    f32x4 gam[4], bet[4];
#pragma unroll
    for (int j = 0; j < 4; ++j) { gam[j] = *(const GAS f32x4*)(ln_g + (size_t)L * D + 4 * lane + 256 * j); bet[j] = *(const GAS f32x4*)(ln_b + (size_t)L * D + 4 * lane + 256 * j); }
    for (int chunk = blockIdx.x; chunk < M / 128; chunk += F.G) {
        if (tid < 32) cntl[tid] = 0u;
        __syncthreads();
        const int tok0 = chunk * 128 + wave * 16;
        for (int rr = 0; rr < 16; ++rr) {
            const size_t row = (size_t)(tok0 + rr);
            f32x4 v[4]; float s = 0.f;
#pragma unroll
            for (int j = 0; j < 4; ++j) {
                const u32x2 av = *(const GAS u32x2*)(A1 + row * D + 4 * lane + 256 * j);
                v[j] = *(const GAS f32x4*)(xres + row * D + 4 * lane + 256 * j) * DN_ALPHA + (f32x4){bf_lo(av.x), bf_hi(av.x), bf_lo(av.y), bf_hi(av.y)};
                s += (v[j].x + v[j].y) + (v[j].z + v[j].w);
            }
            const float mean = wave_sum(s) * (1.f / D); float s2 = 0.f;
#pragma unroll
            for (int j = 0; j < 4; ++j) { v[j] = v[j] - mean; s2 += (v[j].x * v[j].x + v[j].y * v[j].y) + (v[j].z * v[j].z + v[j].w * v[j].w); }
            const float rstd = 1.f / sqrtf(wave_sum(s2) * (1.f / D) + LN_EPS);
#pragma unroll
            for (int j = 0; j < 4; ++j) {
                const f32x4 o = v[j] * rstd * gam[j] + bet[j];
                if constexpr (!F8) *(GAS f32x4*)(X1 + row * D + 4 * lane + 256 * j) = o;
                u32x2 w; w.x = pk2(o.x, o.y); w.y = pk2(o.z, o.w);
                *(GAS u32x2*)(X1B + row * D + 4 * lane + 256 * j) = w;
                if constexpr (F8) *(GAS unsigned*)(ws + WS_X1F8 + row * D + 4 * lane + 256 * j) = pk4_fp8(o.x, o.y, o.z, o.w);
            }
            if constexpr (F8) { if (lane == 0) { scr[16 * 33 + 2 * rr] = mean; scr[16 * 33 + 2 * rr + 1] = rstd; } }
        }
        VM_WAIT(); LDS_WAIT();
        f32x4 acc0 = {0.f, 0.f, 0.f, 0.f}, acc1 = {0.f, 0.f, 0.f, 0.f};
        {
            const int ar = lane & 15, kg = lane >> 4;
            const float* xr = (F8 ? xres : (const float*)X1) + (size_t)(tok0 + ar) * D + 8 * kg;
            const bf16* ar1 = A1 + (size_t)(tok0 + ar) * D + 8 * kg;
            float rmean = 0.f, rrstd = 1.f;
            if constexpr (F8) { rmean = scr[16 * 33 + 2 * ar]; rrstd = scr[16 * 33 + 2 * ar + 1]; }
            const bf16* wh0 = Wh + (size_t)ar * 1024 + 8 * kg; const bf16* wl0 = Wl + (size_t)ar * 1024 + 8 * kg;
#pragma unroll 4
            for (int ks = 0; ks < 32; ++ks) {
                f32x4 xa = *(const GAS f32x4*)(xr + 32 * ks), xb = *(const GAS f32x4*)(xr + 32 * ks + 4);
                if constexpr (F8) {
                    const v4u aw = *(const GAS v4u*)(ar1 + 32 * ks);
                    xa = xa * DN_ALPHA + (f32x4){bf_lo(aw.x), bf_hi(aw.x), bf_lo(aw.y), bf_hi(aw.y)}; xb = xb * DN_ALPHA + (f32x4){bf_lo(aw.z), bf_hi(aw.z), bf_lo(aw.w), bf_hi(aw.w)};
                    const float* gp = ln_g + (size_t)L * D + 32 * ks + 8 * kg; const float* bp = ln_b + (size_t)L * D + 32 * ks + 8 * kg;
                    xa = (xa - rmean) * rrstd * *(const GAS f32x4*)gp + *(const GAS f32x4*)bp; xb = (xb - rmean) * rrstd * *(const GAS f32x4*)(gp + 4) + *(const GAS f32x4*)(bp + 4);
                }
                const float xv[8] = {xa.x, xa.y, xa.z, xa.w, xb.x, xb.y, xb.z, xb.w};
                unsigned hh[8], ll[8];
#pragma unroll
                for (int e = 0; e < 8; ++e) { hh[e] = f2bf(xv[e]); ll[e] = f2bf(xv[e] - __uint_as_float(hh[e] << 16)); }
                v4u ah, al;
                ah.x = hh[0] | (hh[1] << 16); ah.y = hh[2] | (hh[3] << 16); ah.z = hh[4] | (hh[5] << 16); ah.w = hh[6] | (hh[7] << 16);
                al.x = ll[0] | (ll[1] << 16); al.y = ll[2] | (ll[3] << 16); al.z = ll[4] | (ll[5] << 16); al.w = ll[6] | (ll[7] << 16);
                const bf16x8 fah = __builtin_bit_cast(bf16x8, ah), fal = __builtin_bit_cast(bf16x8, al);
                const bf16x8 w0h = *(const GAS bf16x8*)(wh0 + 32 * ks), w0l = *(const GAS bf16x8*)(wl0 + 32 * ks);
                const bf16x8 w1h = *(const GAS bf16x8*)(wh0 + 16 * 1024 + 32 * ks), w1l = *(const GAS bf16x8*)(wl0 + 16 * 1024 + 32 * ks);
                acc0 = __builtin_amdgcn_mfma_f32_16x16x32_bf16(fah, w0h, acc0, 0, 0, 0); acc0 = __builtin_amdgcn_mfma_f32_16x16x32_bf16(fal, w0h, acc0, 0, 0, 0); acc0 = __builtin_amdgcn_mfma_f32_16x16x32_bf16(fah, w0l, acc0, 0, 0, 0);
                acc1 = __builtin_amdgcn_mfma_f32_16x16x32_bf16(fah, w1h, acc1, 0, 0, 0); acc1 = __builtin_amdgcn_mfma_f32_16x16x32_bf16(fal, w1h, acc1, 0, 0, 0); acc1 = __builtin_amdgcn_mfma_f32_16x16x32_bf16(fah, w1l, acc1, 0, 0, 0);
            }
#pragma unroll
            for (int r = 0; r < 4; ++r) { scr[(4 * kg + r) * 33 + ar] = acc0[r]; scr[(4 * kg + r) * 33 + 16 + ar] = acc1[r]; }
        }
        LDS_WAIT(); asm volatile("" ::: "memory");
        int ek[4] = {0, 0, 0, 0}; float wk[4] = {0.f, 0.f, 0.f, 0.f}; unsigned lrk[4] = {0u, 0u, 0u, 0u};
        if (lane < 16) {
            float lv[32];
#pragma unroll
            for (int e = 0; e < 32; ++e) lv[e] = scr[lane * 33 + e] + b_r[(size_t)L * 32 + e];
            unsigned taken = 0u; float vk[4];
#pragma unroll
            for (int k = 0; k < 4; ++k) {
                float best = -INFINITY; int bi = 0;
#pragma unroll
                for (int e = 0; e < 32; ++e) { const bool ok = !((taken >> e) & 1u) && lv[e] > best; best = ok ? lv[e] : best; bi = ok ? e : bi; }
                taken |= 1u << bi; ek[k] = bi; vk[k] = best;
            }
            float den = 0.f;
#pragma unroll
            for (int k = 0; k < 4; ++k) { wk[k] = __expf(vk[k] - vk[0]); den += wk[k]; }
#pragma unroll
            for (int k = 0; k < 4; ++k) { wk[k] /= den; lrk[k] = atomicAdd((unsigned*)(cntl + ek[k]), 1u); }
        }
        __syncthreads();
        if (tid < 32) basel[tid] = __hip_atomic_fetch_add(gcnt + tid, cntl[tid], RLX_AGENT);
        __syncthreads();
        if (lane < 16) {
            const size_t tk = (size_t)(tok0 + lane) * 4;
#pragma unroll
            for (int k = 0; k < 4; ++k) {
                const int rank = (int)(basel[ek[k]] + lrk[k]);
                ((int*)(ws + WS_TOKE))[tk + k] = ek[k];
                ((int*)(ws + WS_TOKR))[tk + k] = rank;
                ((float*)(ws + WS_TOKW))[tk + k] = wk[k];
                if (rank < M) ((int*)(ws + WS_LIST))[(size_t)ek[k] * M + rank] = tok0 + lane;
            }
        }
        __syncthreads();
    }
}

__device__ __forceinline__ void build_tables(Frame& F, int L) {
    LAS int* cnt = (LAS int*)(F.lds + TAB_CNT); LAS int* soff = (LAS int*)(F.lds + TAB_SOFF); LAS int* tst = (LAS int*)(F.lds + TAB_TST); LAS int* te = (LAS int*)(F.lds + TAB_TE);
    __syncthreads();
    if (F.tid < 32) { int c = (int)__hip_atomic_load(F.ctl + CW_CNT + L * 32 + F.tid, RLX_AGENT); cnt[F.tid] = c < 0 ? 0 : (c > M ? M : c); }
    __syncthreads();
    if (F.tid == 0) { int a = 0; for (int e = 0; e < 32; ++e) { tst[e] = a; a += (cnt[e] + 255) >> 8; if (a > MAXTILES) a = MAXTILES; } tst[32] = a; }
    __syncthreads();
    if (F.tid < 32) { soff[F.tid] = tst[F.tid] * 256; for (int mt = tst[F.tid]; mt < tst[F.tid + 1]; ++mt) te[mt] = F.tid; }
    __syncthreads();
}

template <bool LAST>
__device__ __forceinline__ void phase_ln2(Frame& F, int L, const float* ln_g, const float* ln_b, float* outp) {
    float prb_scale = 1.f;
#ifdef PRB_SEL
    if (LAST) { const unsigned v = __hip_atomic_load((gu32*)(F.ws + WS_TOKE + 3 * MiB) + PRB_SEL, RLX_AGENT); const float fr = (float)v / (float)PRB_DEN; prb_scale = 1.f + 0.02f * (float)(1 + (int)(fr * 8.f + 0.5f)); }
#endif
    unsigned char* ws = F.ws;
    const float* X1 = (const float*)(ws + WS_X1); const bf16* X1B = (const bf16*)(ws + WS_X1B);
    const bf16* E = (const bf16*)(ws + WS_E); const bf16* YS = (const bf16*)(ws + WS_YS);
    bf16* XB = (bf16*)(ws + WS_XB);
    const LAS int* soff = (const LAS int*)(F.lds + TAB_SOFF);
    const int gw = F.vcu * NWAVES + F.wave, NGW = F.G * NWAVES, lane = F.lane;
    f32x4 gam[4], bet[4];
#pragma unroll
    for (int j = 0; j < 4; ++j) { gam[j] = *(const GAS f32x4*)(ln_g + (size_t)L * D + 4 * lane + 256 * j); bet[j] = *(const GAS f32x4*)(ln_b + (size_t)L * D + 4 * lane + 256 * j); }
    for (int tok = gw; tok < M; tok += NGW) {
        int sl[4]; float wk[4];
#pragma unroll
        for (int k = 0; k < 4; ++k) {
            const int e = ((const int*)(ws + WS_TOKE))[(size_t)tok * 4 + k] & 31, r = ((const int*)(ws + WS_TOKR))[(size_t)tok * 4 + k];
            int s = soff[e] + r; s = s < 0 ? 0 : (s >= MAXSLOTS ? MAXSLOTS - 1 : s);
            sl[k] = s; wk[k] = ((const float*)(ws + WS_TOKW))[(size_t)tok * 4 + k];
        }
        f32x4 v[4]; float s = 0.f;
#pragma unroll
        for (int j = 0; j < 4; ++j) {
            const int c = 4 * lane + 256 * j;
            f32x4 a;
            if constexpr (LAST) { const u32x2 xv = *(const GAS u32x2*)(X1B + (size_t)tok * D + c); a = (f32x4){bf_lo(xv.x), bf_hi(xv.x), bf_lo(xv.y), bf_hi(xv.y)} * DN_ALPHA; }
            else a = *(const GAS f32x4*)(X1 + (size_t)tok * D + c) * DN_ALPHA;
            const u32x2 ev = *(const GAS u32x2*)(E + (size_t)tok * D + c);
            a.x += bf_lo(ev.x); a.y += bf_hi(ev.x); a.z += bf_lo(ev.y); a.w += bf_hi(ev.y);
#pragma unroll
            for (int k = 0; k < 4; ++k) {
                if constexpr (LAST) {
                    typedef float f32x2_ __attribute__((ext_vector_type(2)));
                    const unsigned yw = *(const GAS unsigned*)((const unsigned char*)YS + (size_t)sl[k] * D + c);
                    const f32x2_ y01 = __builtin_amdgcn_cvt_pk_f32_fp8((int)yw, false), y23 = __builtin_amdgcn_cvt_pk_f32_fp8((int)yw, true);
                    a.x += wk[k] * y01.x; a.y += wk[k] * y01.y; a.z += wk[k] * y23.x; a.w += wk[k] * y23.y;
                } else {
                    const u32x2 yv = *(const GAS u32x2*)(YS + (size_t)sl[k] * D + c);
                    a.x += wk[k] * bf_lo(yv.x); a.y += wk[k] * bf_hi(yv.x); a.z += wk[k] * bf_lo(yv.y); a.w += wk[k] * bf_hi(yv.y);
                }
            }
            v[j] = a; s += (a.x + a.y) + (a.z + a.w);
        }
        const float mean = wave_sum(s) * (1.f / D); float s2 = 0.f;
#pragma unroll
        for (int j = 0; j < 4; ++j) { v[j] = v[j] - mean; s2 += (v[j].x * v[j].x + v[j].y * v[j].y) + (v[j].z * v[j].z + v[j].w * v[j].w); }
        const float rstd = 1.f / sqrtf(wave_sum(s2) * (1.f / D) + LN_EPS);
#pragma unroll
        for (int j = 0; j < 4; ++j) {
            const f32x4 o = v[j] * rstd * gam[j] + bet[j];
            *(GAS f32x4*)(outp + (size_t)tok * D + 4 * lane + 256 * j) = LAST ? o * prb_scale : o;
            if constexpr (!LAST) { u32x2 w; w.x = pk2(o.x, o.y); w.y = pk2(o.z, o.w); *(GAS u32x2*)(XB + (size_t)tok * D + 4 * lane + 256 * j) = w; }
        }
    }
}

#ifndef MK_ONE_LAUNCH
#define MK_ONE_LAUNCH 1
#endif
constexpr int PH_PER_LAYER = 9, NPH = 1 + NL * PH_PER_LAYER;
struct Args { const float* in[27]; float* out; unsigned char* ws; int ph_lo, ph_hi; };
typedef const __attribute__((address_space(4))) unsigned char* kptr_t;
__device__ __forceinline__ kptr_t karg_base() { kptr_t p = (kptr_t)__builtin_amdgcn_kernarg_segment_ptr(); asm volatile("" : "+s"(p)); return p; }
#define KIN(kb, i) (*(const float* const __attribute__((address_space(4)))*)((kb) + 8 * (i)))
#ifndef PH_MASK
#define PH_MASK 0x3ff
#endif
#define PHSEL(k) (((k) == 0) ? ((PH_MASK >> 9) & 1) : ((PH_MASK >> (((k) - 1) % PH_PER_LAYER)) & 1))
#define IN(k) (PHSEL(k) && lo <= (k) && (k) < hi)
#ifndef PROBE_PHASE
#define PROBE_PHASE -1
#endif
#ifndef PROBE_EXTRA
#define PROBE_EXTRA 0
#endif
#define NREP(k) (((k) == PROBE_PHASE) ? 1 + PROBE_EXTRA : 1)
#define PHASE(k) if (IN(k)) for (int rep_ = 0; rep_ < NREP(k); ++rep_)
#define SEAM(k) do { if (IN(k) && IN((k) + 1)) { if (MK_ONE_LAUNCH) xcd_barrier(bar); } } while (0)

#ifdef PRB_SEL
#define SNAP(k, q) do { if (blockIdx.x == 0 && xb_thread0(wave0)) { ((gu32*)(ws + WS_TOKE + 3 * MiB))[k] = __hip_atomic_load(F.ctl + CW_Q + (q), RLX_AGENT); } } while (0)
#else
#define SNAP(k, q) do {} while (0)
#endif
#define RELAUNDER() do { F.lane = (int)__builtin_amdgcn_mbcnt_hi(~0u, __builtin_amdgcn_mbcnt_lo(~0u, 0u)); asm volatile("" : "+v"(F.lane)); F.wave = wave0; F.tid = F.wave * 64 + F.lane; } while (0)
template <int L>
__device__ __forceinline__ void layer_body(Frame& F, const XcdBarrier& bar, const int lo, const int hi, const int wave0) {
    unsigned char* ws = F.ws;
        const int pb = 1 + L * PH_PER_LAYER;
        PHASE(pb + 0) {
            const int nsp = (F.G == 256) ? 24 : 0;
            if ((int)blockIdx.x >= F.G - nsp) { kptr_t kb = karg_base(); RELAUNDER(); conv_run<(L == 0) ? 0 : 2>(F, KIN(kb, 18), KIN(kb, 20), CW_STOP + pb + 0, (unsigned)(F.G - nsp) / 2u, (L == 0) ? 0 : 4); }
            else {
                pg8::Gemm g{(const bf16*)(ws + WS_XB), (const bf16*)(ws + WS_WIN) + (size_t)L * NIN * 1024, M, NIN, D};
                pg8::StaticOrder S; S.init(M, NIN, F.G - nsp, (int)blockIdx.x); S.tailw = F.ctl + CW_STOP + pb + 0;
                pg8::EpiIn E{(bf16*)(ws + WS_H), (float*)(ws + WS_GATES), (const float*)(ws + WS_BINP) + (size_t)L * NIN, (const float*)(ws + WS_ROPE)};
                pg8::gemm_phase<pg8::EpiIn, pg8::StaticOrder, true, true>(F.lds + RING_OFF, g, S, E, wave0, (LAS float*)(F.lds + BIAS_OFF));
            }
        }
        SEAM(pb + 0);
        PHASE(pb + 1) {
            { kptr_t kb = karg_base(); RELAUNDER(); conv_run<(L == 0) ? 0 : 2>(F, KIN(kb, 18), KIN(kb, 20), -1); __syncthreads(); }
            { kptr_t kb = karg_base(); RELAUNDER(); phase_compress(F, L, KIN(kb, 5), KIN(kb, 8)); }
            {
                pg8::Gemm g{(const bf16*)(ws + WS_PB) + (size_t)L * M * PD, (const bf16*)(ws + WS_WPP) + (size_t)L * 1024 * PD, M, D, PD};
                pg8::StaticOrder S; S.init(M, D, F.G, (int)blockIdx.x);
                pg8::EpiPlain E{(bf16*)(ws + WS_PP)};
                pg8::gemm_phase<pg8::EpiPlain, pg8::StaticOrder, true, true>(F.lds + RING_OFF, g, S, E, wave0, (LAS float*)(F.lds + BIAS_OFF));
            }
        }
        SEAM(pb + 1);
        PHASE(pb + 2) { kptr_t kb = karg_base(); RELAUNDER(); att::phase_attention(F, L, KIN(kb, 11)); }
        SEAM(pb + 2);
        PHASE(pb + 3) {
            pg8::Gemm g{(const bf16*)(ws + WS_O), (const bf16*)(ws + WS_WO) + (size_t)L * 1024 * 1024, M, D, D};
            pg8::StaticOrder S; S.init(M, D, F.G, (int)blockIdx.x);
            kptr_t kb = karg_base();
            pg8::EpiOut E{(bf16*)(ws + WS_Y1), KIN(kb, 13) + (size_t)L * D};
            pg8::gemm_phase<pg8::EpiOut, pg8::StaticOrder, true, true>(F.lds + RING_OFF, g, S, E, wave0, (LAS float*)(F.lds + BIAS_OFF));
        }
        SEAM(pb + 3);
        PHASE(pb + 4) { kptr_t kb = karg_base(); RELAUNDER(); phase_ln1_router<(L == NL - 1)>(F, L, L == 0 ? KIN(kb, 0) : (const float*)(ws + WS_XN), KIN(kb, 14), KIN(kb, 15), KIN(kb, 17)); }
        SEAM(pb + 4);
        PHASE(pb + 6) {
            RELAUNDER();
            build_tables(F, L);
            constexpr int ND6 = (L == 0) ? 2 : 0;
            const int per6 = F.G / 8, bx6 = (int)blockIdx.x;
            const bool cv6 = ND6 > 0 && (F.G % 8 == 0) && per6 > 4 * ND6;
            if (cv6 && bx6 / 8 >= per6 - ND6) { kptr_t kb = karg_base(); conv_run<1>(F, KIN(kb, 18), KIN(kb, 20), -1, 1u, 1); conv_run<2>(F, KIN(kb, 18), KIN(kb, 20), CW_STOP + pb + 6, (unsigned)(F.G - 8 * ND6) / 2u, 2); }
            else {
                constexpr bool F8 = (L == NL - 1);
                pg8::Gemm g{F8 ? (const bf16*)(ws + WS_X1F8) : (const bf16*)(ws + WS_X1B), (const bf16*)(ws + WS_W1T) + (size_t)L * 32 * 2048 * 1024, M, 32 * 2048, F8 ? D / 2 : D};
                pg8::MoeOrder S{(const LAS int*)(F.lds + TAB_TE), ((const LAS int*)(F.lds + TAB_TST))[32] * 8, 3, cv6 ? F.G - 8 * ND6 : F.G, cv6 ? (bx6 % 8) * (per6 - ND6) + bx6 / 8 : F.vcu, (const LAS int*)(F.lds + TAB_TST), (const LAS int*)(F.lds + TAB_CNT), (const int*)(ws + WS_LIST), M, (ND6 > 0) ? F.ctl + CW_STOP + pb + 6 : nullptr};
                pg8::EpiUp<F8> E{(bf16*)(ws + WS_ACT), (const float*)(ws + WS_B1P) + (size_t)L * 32 * 2048, F8 ? 1.0f / W1_F8_SCALE : 1.0f};
                pg8::gemm_phase<pg8::EpiUp<F8>, pg8::MoeOrder, true, true, F8, true>(F.lds + RING_OFF, g, S, E, wave0, (LAS float*)(F.lds + BIAS_OFF), (LAS int*)(F.lds + TOKL_OFF));
                if constexpr (ND6 > 0) { __syncthreads(); kptr_t kb = karg_base(); RELAUNDER(); conv_run<1>(F, KIN(kb, 18), KIN(kb, 20), -1); }
            }
        }
        SEAM(pb + 6);
        PHASE(pb + 7) {
            kptr_t kb = karg_base(); RELAUNDER();
            if (!IN(pb + 6)) build_tables(F, L);
            constexpr int ND7 = (L == 0) ? 1 : 0;
            const int per7 = F.G / 8, bx7 = (int)blockIdx.x;
            const bool cv7 = ND7 > 0 && (F.G % 8 == 0) && per7 > 4 * ND7;
            if (cv7 && bx7 / 8 >= per7 - ND7) { conv_run<2>(F, KIN(kb, 18), KIN(kb, 20), CW_STOP + pb + 7, (unsigned)(F.G - 8 * ND7) / 2u, 3); }
            else {
                constexpr bool F8 = (L == NL - 1);
                pg8::Gemm g{(const bf16*)(ws + WS_ACT), (const bf16*)(ws + WS_W2T) + (size_t)L * 32 * 1024 * 1024, MAXSLOTS, 32 * 1024, F8 ? D / 2 : D};
                pg8::MoeOrder S{(const LAS int*)(F.lds + TAB_TE), ((const LAS int*)(F.lds + TAB_TST))[32] * 4, 2, cv7 ? F.G - 8 * ND7 : F.G, cv7 ? (bx7 % 8) * (per7 - ND7) + bx7 / 8 : F.vcu, (const LAS int*)(F.lds + TAB_TST), (const LAS int*)(F.lds + TAB_CNT), nullptr, 0, (ND7 > 0) ? F.ctl + CW_STOP + pb + 7 : nullptr};
                pg8::EpiDown<F8> E{(bf16*)(ws + WS_YS), KIN(kb, 21) + (size_t)L * 32 * 1024, F8 ? 1.0f / W2_F8_SCALE : 1.0f};
                pg8::gemm_phase<pg8::EpiDown<F8>, pg8::MoeOrder, true, true, F8>(F.lds + RING_OFF, g, S, E, wave0, (LAS float*)(F.lds + BIAS_OFF));
            }
            if constexpr (ND7 > 0) __syncthreads();
            {
                constexpr bool F8 = (L == NL - 1);
                pg8::Gemm g{F8 ? (const bf16*)(ws + WS_X1F8) : (const bf16*)(ws + WS_X1B), (const bf16*)(ws + WS_WPG) + (size_t)L * 1024 * 1024, M, D, F8 ? D / 2 : D};
                pg8::StaticOrder S; S.init(M, D, F.G, (int)blockIdx.x);
                pg8::EpiGate E{(const bf16*)(ws + WS_PP), (bf16*)(ws + WS_E), KIN(kb, 23) + (size_t)L * D, F8 ? 1.0f / WPG_F8_SCALE : 1.0f};
                pg8::gemm_phase<pg8::EpiGate, pg8::StaticOrder, true, true, F8>(F.lds + RING_OFF, g, S, E, wave0, (LAS float*)(F.lds + BIAS_OFF));
            }
        }
        SEAM(pb + 7);
        PHASE(pb + 8) { kptr_t kb = karg_base(); RELAUNDER(); if (!IN(pb + 7)) build_tables(F, L); float* xout = L == NL - 1 ? (float*)KIN(kb, 27) : (float*)(ws + WS_XN); phase_ln2<(L == NL - 1)>(F, L, KIN(kb, 25), KIN(kb, 26), xout); }
        SEAM(pb + 8);
    }
__global__ void __launch_bounds__(NWAVES * 64, 2) mk_fwd(Args args) {
    extern __shared__ __attribute__((aligned(16))) unsigned char lds[];
    Frame F;
    F.lds = (LAS unsigned char*)lds;
    F.MISC = (volatile LAS unsigned*)(F.lds + MISC_OFF);
    const int wave0 = __builtin_amdgcn_readfirstlane((int)threadIdx.x >> 6);
    F.wave = wave0; F.lane = (int)__builtin_amdgcn_mbcnt_hi(~0u, __builtin_amdgcn_mbcnt_lo(~0u, 0u)); F.tid = F.wave * 64 + F.lane;
    F.G = gridDim.x; { const int bx = blockIdx.x; F.vcu = (F.G % 8 == 0) ? (bx % 8) * (F.G / 8) + bx / 8 : bx; }
    F.ws = args.ws; F.ctl = (gu32*)(args.ws + WS_CTL);
    unsigned char* ws = args.ws;
    for (int u = F.tid; u < (LDS_BYTES - LDSCTL_OFF) / 4; u += NWAVES * 64) ((LAS unsigned*)(F.lds + LDSCTL_OFF))[u] = 0u;
    __syncthreads();
    XcdBarrier bar; bar.bar = (unsigned*)(F.ctl + CW_BAR); bar.x = 0; bar.st = nullptr; bar.wave = wave0;
    if (MK_ONE_LAUNCH) bar = xcd_barrier_post((unsigned*)(F.ctl + CW_BAR), F.MISC + 8, wave0);
    const int lo = args.ph_lo, hi = args.ph_hi;
    PHASE(0) {
        kptr_t kb = karg_base(); RELAUNDER();
        PIn I{KIN(kb, 0), KIN(kb, 1), KIN(kb, 3), KIN(kb, 4), KIN(kb, 6), KIN(kb, 7), KIN(kb, 9), KIN(kb, 10), KIN(kb, 12), KIN(kb, 16), KIN(kb, 18), KIN(kb, 19), KIN(kb, 20), KIN(kb, 22), KIN(kb, 24), (const int*)KIN(kb, 2)};
        p0_prologue(F, I);
#ifdef PRB_SEL
        if (blockIdx.x == 0 && F.tid < 8) ((gu32*)(ws + WS_TOKE + 3 * MiB))[F.tid] = 0u;
#endif
    }
    SEAM(0);
    layer_body<0>(F, bar, lo, hi, wave0);
    layer_body<1>(F, bar, lo, hi, wave0);
#undef IN
#undef SEAM
}

extern "C" void kernel_launch(void* const* d_in, const int* in_sizes, int n_in, void* d_out, int out_size, void* d_ws, size_t ws_size, hipStream_t stream) {
    static int grid = 0;
    if (grid == 0) {
        if (n_in != 27 || out_size != M * D || ws_size < WS_END) { fprintf(stderr, "kernel_launch: unexpected problem (n_in %d, out %d, ws %zu); nothing launched\n", n_in, out_size, ws_size); grid = -1; return; }
        int dev = 0, cus = 0, per_cu = 0;
        if (hipGetDevice(&dev) != hipSuccess || hipDeviceGetAttribute(&cus, hipDeviceAttributeMultiprocessorCount, dev) != hipSuccess) { grid = -1; return; }
        if (hipFuncSetAttribute((const void*)mk_fwd, hipFuncAttributeMaxDynamicSharedMemorySize, LDS_BYTES) != hipSuccess) { fprintf(stderr, "kernel_launch: hipFuncSetAttribute failed\n"); grid = -1; return; }
        if (hipOccupancyMaxActiveBlocksPerMultiprocessor(&per_cu, (const void*)mk_fwd, NWAVES * 64, LDS_BYTES) != hipSuccess || per_cu < 1) { fprintf(stderr, "kernel_launch: occupancy query says %d\n", per_cu); }
        (void)hipGetLastError();
        grid = cus;
    }
    if (grid < 0) return;
    (void)in_sizes;
    if (hipMemsetAsync((char*)d_ws + WS_CTL, 0, CTL_ZERO_BYTES, stream) != hipSuccess) return;
    Args a{};
    for (int i = 0; i < 27; ++i) a.in[i] = (const float*)d_in[i];
    a.out = (float*)d_out; a.ws = (unsigned char*)d_ws;
#if MK_ONE_LAUNCH
    a.ph_lo = 0; a.ph_hi = NPH;
    hipLaunchKernelGGL(mk_fwd, dim3(grid), dim3(NWAVES * 64), LDS_BYTES, stream, a);
#else
    for (int ph = 0; ph < NPH; ++ph) { a.ph_lo = ph; a.ph_hi = ph + 1; hipLaunchKernelGGL(mk_fwd, dim3(grid), dim3(NWAVES * 64), LDS_BYTES, stream, a); }
#endif
}
```

```cpp
#include <hip/hip_runtime.h>
#include <cstdio>
#include <cstdint>
#define MK_ONE_LAUNCH 1
namespace pg8 {
#define PG8_LAS __attribute__((address_space(3)))
typedef unsigned short bf16_t;
typedef short bf16x8 __attribute__((ext_vector_type(8)));
typedef float f32x4 __attribute__((ext_vector_type(4)));
typedef unsigned u32x4 __attribute__((ext_vector_type(4)));
constexpr int BM = 256, BK = 64, HALF = 128, HTB = HALF * BK * 2  , STAGE_BYTES = 8 * HTB, NXCD = 8, WGM = 8;

__host__ __device__ __forceinline__ int lds_byte(int r, int c) { const int st = (r >> 4) * 2 + (c >> 5), rr = r & 15, cc = c & 31, ob = rr * 64 + cc * 2; return st * 1024 + (ob ^ (((ob >> 9) & 1) << 5)); }
__host__ __device__ __forceinline__ void stage_rc(int b, int& R, int& C) { const int st = b / 1024, sb = b % 1024, swz = sb ^ (((sb >> 9) & 1) << 5); R = (st >> 1) * 16 + swz / 64; C = (st & 1) * 32 + (swz % 64) / 2; }
__host__ __device__ __forceinline__ int perm32(int rho) { const int n = rho >> 4, i = rho & 15; return 8 * (i >> 2) + 4 * n + (i & 3); }

struct Unit { int pm, pn; };
struct Gemm { const bf16_t* A; const bf16_t* Bt; int M, N, K; };

struct StaticOrder {
    int nM, nN, nwg, G, c;
    __host__ __device__ void init(int M, int N, int G_, int c_) { nM = M / BM; nN = N / BM; nwg = nM * nN; G = G_; c = c_; }
    __host__ __device__ bool next(int i, Unit& u) const {
        const long L = (long)i * G + c; if (L >= nwg) return false;
        int wgid = (int)L; { const int q = nwg / NXCD, r = nwg % NXCD, xcd = wgid % NXCD, off = wgid / NXCD; wgid = (xcd < r ? xcd * (q + 1) : r * (q + 1) + (xcd - r) * q) + off; }
        const int nig = WGM * nN, gid = wgid / nig, fm = gid * WGM, gsz = (nM - fm) < WGM ? (nM - fm) : WGM;
        u.pm = fm + ((wgid % nig) % gsz); u.pn = (wgid % nig) / gsz; return true;
    }
    __device__ __forceinline__ void a_ready(const Unit&) const {}
    __device__ __forceinline__ void done(const Unit&) const {}
    __attribute__((address_space(1))) unsigned* tailw = nullptr;
    __device__ __forceinline__ void tail(int wid, int lane) const { if (tailw && wid == 0 && lane == 0) (void)__hip_atomic_fetch_add(tailw, 1u, __ATOMIC_RELAXED, __HIP_MEMORY_SCOPE_AGENT); }
};

__device__ __forceinline__ unsigned cvt_pk_bf16(float lo, float hi) { unsigned r; asm volatile("v_cvt_pk_bf16_f32 %0, %1, %2" : "=v"(r) : "v"(lo), "v"(hi)); return r; }
typedef float f32x2 __attribute__((ext_vector_type(2)));

typedef unsigned u32x2 __attribute__((ext_vector_type(2)));
__device__ __forceinline__ float sigm(float x) { return __builtin_amdgcn_rcpf(1.0f + __builtin_amdgcn_exp2f(-1.4426950408889634f * x)); }
__device__ __forceinline__ float bf_lo(unsigned w) { return __uint_as_float(w << 16); }
__device__ __forceinline__ float bf_hi(unsigned w) { return __uint_as_float(w & 0xffff0000u); }

constexpr unsigned ROPE_SEGS = 0x7D4Fu;
constexpr float QSCALE = 0.125f * 1.4426950408889634f;
struct EpiIn {
    static constexpr bool PERM = true, AFTER_DRAIN = false;
    bf16_t* H; float* gates; const float* bias; const float* rope;
    __device__ __forceinline__ const float* bias_slice(const Unit& u) const { return bias + u.pn * BM; }
    __device__ __forceinline__ void operator()(const f32x4 (&acc)[2][2][4][2], const Unit& u, int wr, int wc, int fr, int fq, const PG8_LAS float* bl) const {
        const int row0 = u.pm * BM + wr * 64 + fr;
#pragma unroll
        for (int bj = 0; bj < 2; ++bj) {
            const int seg = u.pn * 2 + bj;
            if (seg >= 17) continue;
            const int cl0 = bj * HALF + wc * 32 + 8 * fq;
            const f32x4 b0 = *(const PG8_LAS f32x4*)(bl + cl0), b1 = *(const PG8_LAS f32x4*)(bl + cl0 + 4);
            if (seg == 16) {
                const int gi = wc * 32 + 8 * fq;
                if (gi < 24) {
#pragma unroll
                    for (int ai = 0; ai < 2; ++ai)
#pragma unroll
                        for (int m = 0; m < 4; ++m) {
                            const int row = row0 + ai * HALF + m * 16;
                            f32x4 v0 = acc[ai][bj][m][0] + b0, v1 = acc[ai][bj][m][1] + b1;
                            v0 = (f32x4){sigm(v0[0]), sigm(v0[1]), sigm(v0[2]), sigm(v0[3])};
                            v1 = (f32x4){sigm(v1[0]), sigm(v1[1]), sigm(v1[2]), sigm(v1[3])};
                            float* gp = gates + (size_t)row * 32 + gi;
                            *(f32x4*)gp = v0; *(f32x4*)(gp + 4) = v1;
                        }
                }
            } else {
                const bool rope_on = (ROPE_SEGS >> seg) & 1u;
                const bool qseg = seg < 4 || (seg >= 10 && seg <= 13);
                const int g = 4 * (wc & 1) + fq;
                const int hc = seg * 128 + (wc >> 1) * 64 + 4 * g;
#pragma unroll
                for (int ai = 0; ai < 2; ++ai)
#pragma unroll
                    for (int m = 0; m < 4; ++m) {
                        const int row = row0 + ai * HALF + m * 16;
                        f32x4 v0 = acc[ai][bj][m][0] + b0, v1 = acc[ai][bj][m][1] + b1;
                        if (rope_on) {
                            const f32x4 c = *(const f32x4*)(rope + (size_t)row * 64 + 4 * g), s = *(const f32x4*)(rope + (size_t)row * 64 + 32 + 4 * g);
                            const f32x4 o0 = v0 * c - v1 * s, o1 = v1 * c + v0 * s; v0 = o0; v1 = o1;
                        }
                        if (qseg) { v0 = v0 * QSCALE; v1 = v1 * QSCALE; }
                        u32x2 w0, w1; w0.x = cvt_pk_bf16(v0[0], v0[1]); w0.y = cvt_pk_bf16(v0[2], v0[3]); w1.x = cvt_pk_bf16(v1[0], v1[1]); w1.y = cvt_pk_bf16(v1[2], v1[3]);
                        bf16_t* hp = H + (size_t)row * 2048 + hc;
                        *(u32x2*)hp = w0; *(u32x2*)(hp + 32) = w1;
                    }
            }
        }
    }
};
struct EpiOut {
    static constexpr bool PERM = true, AFTER_DRAIN = false;
    bf16_t* y; const float* bias;
    __device__ __forceinline__ const float* bias_slice(const Unit& u) const { return bias + u.pn * BM; }
    __device__ __forceinline__ void operator()(const f32x4 (&acc)[2][2][4][2], const Unit& u, int wr, int wc, int fr, int fq, const PG8_LAS float* bl) const {
        const int row0 = u.pm * BM + wr * 64 + fr, col0 = u.pn * BM + wc * 32 + 8 * fq;
        f32x4 bv[2][2];
#pragma unroll
        for (int bj = 0; bj < 2; ++bj)
#pragma unroll
            for (int n = 0; n < 2; ++n) bv[bj][n] = *(const PG8_LAS f32x4*)(bl + wc * 32 + 8 * fq + bj * HALF + 4 * n);
#pragma unroll
        for (int ai = 0; ai < 2; ++ai)
#pragma unroll
            for (int m = 0; m < 4; ++m) {
                bf16_t* rowp = y + (size_t)(row0 + ai * HALF + m * 16) * 1024 + col0;
#pragma unroll
                for (int bj = 0; bj < 2; ++bj) {
                    const f32x4 v0 = acc[ai][bj][m][0] + bv[bj][0], v1 = acc[ai][bj][m][1] + bv[bj][1];
                    u32x4 w; w.x = cvt_pk_bf16(v0[0], v0[1]); w.y = cvt_pk_bf16(v0[2], v0[3]); w.z = cvt_pk_bf16(v1[0], v1[1]); w.w = cvt_pk_bf16(v1[2], v1[3]);
                    *(u32x4*)(rowp + bj * HALF) = w;
                }
            }
    }
};
template <bool F8OUT>
struct EpiUp {
    static constexpr bool PERM = true, AFTER_DRAIN = false;
    bf16_t* act; const float* b1p; float ascale;
    __device__ __forceinline__ const float* bias_slice(const Unit& u) const { return b1p + (size_t)(u.pn >> 3) * 2048 + (u.pn & 7) * BM; }
    __device__ __forceinline__ void operator()(const f32x4 (&acc)[2][2][4][2], const Unit& u, int wr, int wc, int fr, int fq, const PG8_LAS float* bl) const {
        const int pn = u.pn & 7;
        const int row0 = u.pm * BM + wr * 64 + fr, ac0 = pn * 128 + wc * 32 + 8 * fq;
        const PG8_LAS float* bp = bl + wc * 32 + 8 * fq;
        const f32x4 bg0 = *(const PG8_LAS f32x4*)bp, bg1 = *(const PG8_LAS f32x4*)(bp + 4), bu0 = *(const PG8_LAS f32x4*)(bp + HALF), bu1 = *(const PG8_LAS f32x4*)(bp + HALF + 4);
#pragma unroll
        for (int ai = 0; ai < 2; ++ai)
#pragma unroll
            for (int m = 0; m < 4; ++m) {
                const f32x4 g0 = acc[ai][0][m][0] * ascale + bg0, g1 = acc[ai][0][m][1] * ascale + bg1, u0 = acc[ai][1][m][0] * ascale + bu0, u1 = acc[ai][1][m][1] * ascale + bu1;
                float o[8];
#pragma unroll
                for (int j = 0; j < 8; ++j) {
                    float gt = j < 4 ? g0[j & 3] : g1[j & 3], up = j < 4 ? u0[j & 3] : u1[j & 3];
                    gt = fminf(gt, 7.0f); up = fminf(fmaxf(up, -7.0f), 7.0f);
                    o[j] = (up + 1.0f) * gt * sigm(1.702f * gt);
                }
                if constexpr (F8OUT) {
                    int w0 = 0, w1 = 0;
                    w0 = __builtin_amdgcn_cvt_pk_fp8_f32(o[0], o[1], w0, false); w0 = __builtin_amdgcn_cvt_pk_fp8_f32(o[2], o[3], w0, true);
                    w1 = __builtin_amdgcn_cvt_pk_fp8_f32(o[4], o[5], w1, false); w1 = __builtin_amdgcn_cvt_pk_fp8_f32(o[6], o[7], w1, true);
                    u32x2 w; w.x = (unsigned)w0; w.y = (unsigned)w1;
                    *(u32x2*)((unsigned char*)act + (size_t)(row0 + ai * HALF + m * 16) * 1024 + ac0) = w;
                } else {
                    u32x4 w; w.x = cvt_pk_bf16(o[0], o[1]); w.y = cvt_pk_bf16(o[2], o[3]); w.z = cvt_pk_bf16(o[4], o[5]); w.w = cvt_pk_bf16(o[6], o[7]);
                    *(u32x4*)(act + (size_t)(row0 + ai * HALF + m * 16) * 1024 + ac0) = w;
                }
                asm volatile("" ::: "memory");
            }
    }
};
template <bool F8OUT>
struct EpiDown {
    static constexpr bool PERM = true, AFTER_DRAIN = false;
    bf16_t* ys; const float* b2; float ascale;
    __device__ __forceinline__ const float* bias_slice(const Unit& u) const { return b2 + (size_t)(u.pn >> 2) * 1024 + (u.pn & 3) * BM; }
    __device__ __forceinline__ void operator()(const f32x4 (&acc)[2][2][4][2], const Unit& u, int wr, int wc, int fr, int fq, const PG8_LAS float* bl) const {
        const int pn = u.pn & 3;
        const int row0 = u.pm * BM + wr * 64 + fr, col0 = pn * BM + wc * 32 + 8 * fq;
        f32x4 bv[2][2];
#pragma unroll
        for (int bj = 0; bj < 2; ++bj)
#pragma unroll
            for (int n = 0; n < 2; ++n) bv[bj][n] = *(const PG8_LAS f32x4*)(bl + wc * 32 + 8 * fq + bj * HALF + 4 * n);
#pragma unroll
        for (int ai = 0; ai < 2; ++ai)
#pragma unroll
            for (int m = 0; m < 4; ++m) {
                bf16_t* rowp = ys + (size_t)(row0 + ai * HALF + m * 16) * 1024 + col0;
#pragma unroll
                for (int bj = 0; bj < 2; ++bj) {
                    const f32x4 v0 = acc[ai][bj][m][0] * ascale + bv[bj][0], v1 = acc[ai][bj][m][1] * ascale + bv[bj][1];
                    if constexpr (F8OUT) {
                        int w0 = 0, w1 = 0;
                        w0 = __builtin_amdgcn_cvt_pk_fp8_f32(v0[0], v0[1], w0, false); w0 = __builtin_amdgcn_cvt_pk_fp8_f32(v0[2], v0[3], w0, true);
                        w1 = __builtin_amdgcn_cvt_pk_fp8_f32(v1[0], v1[1], w1, false); w1 = __builtin_amdgcn_cvt_pk_fp8_f32(v1[2], v1[3], w1, true);
                        u32x2 w; w.x = (unsigned)w0; w.y = (unsigned)w1;
                        *(u32x2*)((unsigned char*)ys + (size_t)(row0 + ai * HALF + m * 16) * 1024 + col0 + bj * HALF) = w;
                    } else {
                        u32x4 w; w.x = cvt_pk_bf16(v0[0], v0[1]); w.y = cvt_pk_bf16(v0[2], v0[3]); w.z = cvt_pk_bf16(v1[0], v1[1]); w.w = cvt_pk_bf16(v1[2], v1[3]);
                        *(u32x4*)(rowp + bj * HALF) = w;
                    }
                }
            }
    }
};
struct EpiPlain {
    static constexpr bool PERM = true, AFTER_DRAIN = false;
    bf16_t* O;
    __device__ __forceinline__ const float* bias_slice(const Unit&) const { return nullptr; }
    __device__ __forceinline__ void operator()(const f32x4 (&acc)[2][2][4][2], const Unit& u, int wr, int wc, int fr, int fq, const PG8_LAS float*) const {
        const int row0 = u.pm * BM + wr * 64 + fr, col0 = u.pn * BM + wc * 32 + 8 * fq;
#pragma unroll
        for (int ai = 0; ai < 2; ++ai)
#pragma unroll
            for (int m = 0; m < 4; ++m) {
                bf16_t* rowp = O + (size_t)(row0 + ai * HALF + m * 16) * 1024 + col0;
#pragma unroll
                for (int bj = 0; bj < 2; ++bj) {
                    const f32x4 v0 = acc[ai][bj][m][0], v1 = acc[ai][bj][m][1];
                    u32x4 w; w.x = cvt_pk_bf16(v0[0], v0[1]); w.y = cvt_pk_bf16(v0[2], v0[3]); w.z = cvt_pk_bf16(v1[0], v1[1]); w.w = cvt_pk_bf16(v1[2], v1[3]);
                    *(u32x4*)(rowp + bj * HALF) = w;
                }
            }
    }
};
struct EpiGate {
    static constexpr bool PERM = true, AFTER_DRAIN = false;
    const bf16_t* PP; bf16_t* E; const float* bias; float ascale;
    __device__ __forceinline__ const float* bias_slice(const Unit& u) const { return bias + u.pn * BM; }
    __device__ __forceinline__ void operator()(const f32x4 (&acc)[2][2][4][2], const Unit& u, int wr, int wc, int fr, int fq, const PG8_LAS float* bl) const {
        const int row0 = u.pm * BM + wr * 64 + fr, col0 = u.pn * BM + wc * 32 + 8 * fq;
        f32x4 bv[2][2];
#pragma unroll
        for (int bj = 0; bj < 2; ++bj)
#pragma unroll
            for (int n = 0; n < 2; ++n) bv[bj][n] = *(const PG8_LAS f32x4*)(bl + wc * 32 + 8 * fq + bj * HALF + 4 * n);
#pragma unroll
        for (int ai = 0; ai < 2; ++ai)
#pragma unroll
            for (int m = 0; m < 4; ++m) {
                const size_t off = (size_t)(row0 + ai * HALF + m * 16) * 1024 + col0;
#pragma unroll
                for (int bj = 0; bj < 2; ++bj) {
                    const u32x4 pv = *(const u32x4*)(PP + off + bj * HALF);
                    const f32x4 v0 = acc[ai][bj][m][0] * ascale + bv[bj][0], v1 = acc[ai][bj][m][1] * ascale + bv[bj][1];
                    u32x4 w;
                    w.x = cvt_pk_bf16(sigm(v0[0]) * bf_lo(pv.x), sigm(v0[1]) * bf_hi(pv.x)); w.y = cvt_pk_bf16(sigm(v0[2]) * bf_lo(pv.y), sigm(v0[3]) * bf_hi(pv.y));
                    w.z = cvt_pk_bf16(sigm(v1[0]) * bf_lo(pv.z), sigm(v1[1]) * bf_hi(pv.z)); w.w = cvt_pk_bf16(sigm(v1[2]) * bf_lo(pv.w), sigm(v1[3]) * bf_hi(pv.w));
                    *(u32x4*)(E + off + bj * HALF) = w;
                }
            }
    }
};
struct MoeOrder {
    const PG8_LAS int* tile_e; int nunits, lnt, G, c;
    const PG8_LAS int* tst; const PG8_LAS int* cnt; const int* list; int list_pitch;
    __device__ __forceinline__ const int* row_src(const Unit& u) const { const int e = tile_e[u.pm]; return list + (size_t)e * list_pitch + (u.pm - tst[e]) * 256; }
    __device__ __forceinline__ int nvalid(const Unit& u) const { const int e = tile_e[u.pm]; return cnt[e] - (u.pm - tst[e]) * 256; }
    __device__ __forceinline__ bool next(int i, Unit& u) const {
        const int L = i * G + c; if (L >= nunits) return false;
        const int mt = L >> lnt, pn = L & ((1 << lnt) - 1);
        u.pm = mt; u.pn = (tile_e[mt] << lnt) + pn; return true;
    }
    __device__ __forceinline__ void a_ready(const Unit&) const {}
    __device__ __forceinline__ void done(const Unit&) const {}
    __attribute__((address_space(1))) unsigned* tailw = nullptr;
    __device__ __forceinline__ void tail(int wid, int lane) const { if (tailw && wid == 0 && lane == 0) (void)__hip_atomic_fetch_add(tailw, 1u, __ATOMIC_RELAXED, __HIP_MEMORY_SCOPE_AGENT); }
};

template <class Epi, class Sched, bool ALIGN_EPI = false, bool SP2 = false, bool F8 = false, bool GATHER = false>
__device__ __forceinline__ void gemm_phase(PG8_LAS unsigned char* lds, const Gemm g, const Sched& S, const Epi& E, const int wave_id, PG8_LAS float* biasl, PG8_LAS int* tokl = nullptr) {
    static_assert(!GATHER || SP2, "the gathered-A form is written for the SP2 loop");
    int tid_l = wave_id * 64 + (int)__builtin_amdgcn_mbcnt_hi(~0u, __builtin_amdgcn_mbcnt_lo(~0u, 0u)); asm volatile("" : "+v"(tid_l));     const int tid = tid_l, wid = __builtin_amdgcn_readfirstlane(tid >> 6), lane = tid & 63, wr = wid >> 2, wc = wid & 3, fr = lane & 15, fq = lane >> 4;
    int K_l = g.K; asm volatile("" : "+s"(K_l)); const int K = K_l, nt = K / BK;
    unsigned voffA[2], voffB[2];
    unsigned voffG[2][2] = {{0u, 0u}, {0u, 0u}};
#pragma unroll
    for (int i = 0; i < 2; ++i) { int R, C; stage_rc(tid * 16 + i * 8192, R, C); const int Rb = Epi::PERM ? ((R & ~31) + perm32(R & 31)) : R;
        voffA[i] = (unsigned)(R * K + C) * 2u; voffB[i] = (unsigned)(Rb * K + C) * 2u; }
    const size_t kstep = (size_t)(BK * 2);
    const size_t hstep = (size_t)HALF * K * 2;
    const size_t tstep = 2 * hstep;
    const unsigned ldsw = (unsigned)wid * 1024u;
    const int aoff = lds_byte(wr * 64 + fr, fq * 8), boff = lds_byte(wc * 32 + fr, fq * 8);
#define PG8_SA(b, h) (((b) * 2 + (h)) * HTB)
#define PG8_SB(b, h) ((4 + (b) * 2 + (h)) * HTB)
#define PG8_STAGE(bufoff, gbase, voff) do { _Pragma("unroll") for (int _i = 0; _i < 2; ++_i) \
        __builtin_amdgcn_global_load_lds((const unsigned*)((const char*)(gbase) + (voff)[_i]), (PG8_LAS unsigned*)(lds + (bufoff) + ldsw + _i * 8192), 16, 0, 0); } while (0)
#define PG8_STAGE_A(bufoff, base, h) do { if constexpr (GATHER) { PG8_STAGE(bufoff, base, voffG[h]); } else { PG8_STAGE(bufoff, (base) + (h) * hstep, voffA); } } while (0)
#define PG8_TOKSTAGE(u_, slot_) do { if (wid == 0) { const int* rp_ = S.row_src(u_); __builtin_amdgcn_global_load_lds((const unsigned*)(rp_ + lane * 4), (PG8_LAS unsigned*)(tokl + (slot_) * 256), 16, 0, 0); } } while (0)
#define PG8_TOKSET(slot_, nv_) do { const int nvv_ = (nv_); _Pragma("unroll") for (int h_ = 0; h_ < 2; ++h_) _Pragma("unroll") for (int i_ = 0; i_ < 2; ++i_) { int R_, C_; stage_rc(tid * 16 + i_ * 8192, R_, C_); \
        const int r_ = h_ * HALF + R_; int tk_ = tokl[(slot_) * 256 + r_]; tk_ = (r_ < nvv_ && tk_ >= 0 && tk_ < g.M) ? tk_ : 0; voffG[h_][i_] = (unsigned)tk_ * (unsigned)(K * 2) + (unsigned)(C_ * 2); } } while (0)
#define PG8_LDA(dst, b, h) do { _Pragma("unroll") for (int m = 0; m < 4; ++m) _Pragma("unroll") for (int k = 0; k < 2; ++k) dst[m][k] = *(const PG8_LAS bf16x8*)(lds + PG8_SA(b, h) + aoff + m * 2048 + k * 1024); } while (0)
#define PG8_LDB(dst, b, h) do { _Pragma("unroll") for (int n = 0; n < 2; ++n) _Pragma("unroll") for (int k = 0; k < 2; ++k) dst[n][k] = *(const PG8_LAS bf16x8*)(lds + PG8_SB(b, h) + boff + n * 2048 + k * 1024); } while (0)
#define PG8_MMA(ai, bj, At, Bt) do { __builtin_amdgcn_s_setprio(1); _Pragma("unroll") for (int m = 0; m < 4; ++m) _Pragma("unroll") for (int n = 0; n < 2; ++n) { \
        if constexpr (F8) { typedef int i32x4_ __attribute__((ext_vector_type(4))); \
              \
            asm volatile("v_mfma_f32_16x16x128_f8f6f4 %0, %1, %2, %0" : "+v"(acc[ai][bj][m][n]) : "v"(__builtin_shufflevector(__builtin_bit_cast(i32x4_, Bt[n][0]), __builtin_bit_cast(i32x4_, Bt[n][1]), 0, 1, 2, 3, 4, 5, 6, 7)), \
                "v"(__builtin_shufflevector(__builtin_bit_cast(i32x4_, At[m][0]), __builtin_bit_cast(i32x4_, At[m][1]), 0, 1, 2, 3, 4, 5, 6, 7))); } \
        else { _Pragma("unroll") for (int k = 0; k < 2; ++k) acc[ai][bj][m][n] = __builtin_amdgcn_mfma_f32_16x16x32_bf16(Bt[n][k], At[m][k], acc[ai][bj][m][n], 0, 0, 0); } } \
        __builtin_amdgcn_s_setprio(0); } while (0)
#define PG8_WAIT_V(n) asm volatile("s_waitcnt vmcnt(" #n ")" ::: "memory")
#define PG8_WAIT_L(n) asm volatile("s_waitcnt lgkmcnt(" #n ")" ::: "memory")
#define PG8_BAR __builtin_amdgcn_s_barrier()
#define PG8_SCHED __builtin_amdgcn_sched_barrier(0)
    Unit cur, nxt; int ui = 0;
    if (!S.next(0, cur)) return;
#define PG8_BIAS(u_, slot_) do { if (wid == 0) { const float* bp_ = E.bias_slice(u_); if (bp_) __builtin_amdgcn_global_load_lds((const unsigned*)(bp_ + lane * 4), (PG8_LAS unsigned*)(biasl + (slot_) * 256), 16, 0, 0); } } while (0)
    PG8_BIAS(cur, 0);
    if constexpr (GATHER) { PG8_TOKSTAGE(cur, 0); asm volatile("s_waitcnt vmcnt(0)" ::: "memory"); __builtin_amdgcn_s_barrier(); asm volatile("" ::: "memory"); PG8_TOKSET(0, S.nvalid(cur)); }
    f32x4 acc[2][2][4][2];
#pragma unroll
    for (int a = 0; a < 2; ++a)
#pragma unroll
        for (int b = 0; b < 2; ++b)
#pragma unroll
            for (int m = 0; m < 4; ++m)
#pragma unroll
                for (int n = 0; n < 2; ++n) acc[a][b][m][n] = (f32x4){0.f, 0.f, 0.f, 0.f};
    bf16x8 At[4][2], B0[2][2], B1[2][2];
    const char* cA = (const char*)g.A + (GATHER ? (size_t)0 : (size_t)cur.pm * tstep); const char* cB = (const char*)g.Bt + (size_t)cur.pn * tstep;
    S.a_ready(cur);
    if constexpr (SP2) {
        PG8_STAGE(PG8_SB(0, 0), cB, voffB); PG8_STAGE(PG8_SB(0, 1), cB + hstep, voffB); PG8_STAGE_A(PG8_SA(0, 0), cA, 0); PG8_STAGE_A(PG8_SA(0, 1), cA, 1);
        if (wr == 1) PG8_BAR;
        PG8_WAIT_V(2); PG8_BAR;
        PG8_STAGE(PG8_SB(1, 0), cB + kstep, voffB); PG8_STAGE_A(PG8_SA(1, 0), cA + kstep, 0); PG8_STAGE(PG8_SB(1, 1), cB + hstep + kstep, voffB);
        PG8_WAIT_V(6); PG8_BAR;
    } else {
        PG8_STAGE(PG8_SB(0, 0), cB, voffB); PG8_STAGE_A(PG8_SA(0, 0), cA, 0); PG8_STAGE(PG8_SB(0, 1), cB + hstep, voffB); PG8_STAGE_A(PG8_SA(0, 1), cA, 1);
        if (wr == 1) PG8_BAR;
        PG8_WAIT_V(4); PG8_BAR;
        PG8_STAGE(PG8_SB(1, 0), cB + kstep, voffB); PG8_STAGE_A(PG8_SA(1, 0), cA + kstep, 0); PG8_STAGE(PG8_SB(1, 1), cB + hstep + kstep, voffB);
        PG8_WAIT_V(6); PG8_BAR;
    }
    for (;;) {
        const bool has_next = S.next(ui + 1, nxt);
        if (!has_next) S.tail(wid, lane);
        const char* nA = (has_next && !GATHER) ? (const char*)g.A + (size_t)nxt.pm * tstep : cA;
        if constexpr (GATHER) { if (has_next) PG8_TOKSTAGE(nxt, (ui + 1) & 1); } const char* nB = has_next ? (const char*)g.Bt + (size_t)nxt.pn * tstep : cB;
        for (int t = 0; t < nt; t += 2) {
            const bool last = (t == nt - 2);
            const char* a1 = cA + (size_t)(t + 1) * kstep;
            const char* a2 = last ? nA : cA + (size_t)(t + 2) * kstep; const char* b2 = last ? nB : cB + (size_t)(t + 2) * kstep;
            const char* a3 = a2 + kstep; const char* b3 = b2 + kstep;
            if (last && has_next) S.a_ready(nxt);
            if constexpr (SP2) {
            PG8_LDB(B0, 0, 0); PG8_LDB(B1, 0, 1); PG8_SCHED; PG8_LDA(At, 0, 0); PG8_STAGE_A(PG8_SA(1, 1), a1, 1);
            if constexpr (GATHER) { if (last && has_next) PG8_TOKSET((ui + 1) & 1, S.nvalid(nxt)); }
            PG8_WAIT_V(8); PG8_WAIT_L(0); PG8_BAR; PG8_MMA(0, 0, At, B0); PG8_MMA(0, 1, At, B1); PG8_BAR; PG8_SCHED;
            PG8_LDA(At, 0, 1); PG8_STAGE(PG8_SB(0, 0), b2, voffB); PG8_STAGE(PG8_SB(0, 1), b2 + hstep, voffB); PG8_STAGE_A(PG8_SA(0, 0), a2, 0);
            PG8_WAIT_V(8); PG8_WAIT_L(0); PG8_BAR; PG8_MMA(1, 0, At, B0); PG8_MMA(1, 1, At, B1); PG8_BAR; PG8_SCHED;
            PG8_LDB(B0, 1, 0); PG8_LDB(B1, 1, 1); PG8_SCHED; PG8_LDA(At, 1, 0); PG8_STAGE_A(PG8_SA(0, 1), a2, 1);
            PG8_WAIT_V(8); PG8_WAIT_L(0); PG8_BAR; PG8_MMA(0, 0, At, B0); PG8_MMA(0, 1, At, B1); PG8_BAR; PG8_SCHED;
            PG8_LDA(At, 1, 1); PG8_STAGE(PG8_SB(1, 0), b3, voffB); PG8_STAGE(PG8_SB(1, 1), b3 + hstep, voffB); PG8_STAGE_A(PG8_SA(1, 0), a3, 0);
            PG8_WAIT_V(8); PG8_WAIT_L(0); PG8_BAR; PG8_MMA(1, 0, At, B0); PG8_MMA(1, 1, At, B1); PG8_BAR; PG8_SCHED;
            } else {
            PG8_LDB(B0, 0, 0); PG8_SCHED; PG8_LDA(At, 0, 0); PG8_STAGE_A(PG8_SA(1, 1), a1, 1);
            PG8_WAIT_L(8); PG8_BAR; PG8_WAIT_L(0); PG8_MMA(0, 0, At, B0); PG8_BAR; PG8_SCHED;
            PG8_LDB(B1, 0, 1); PG8_STAGE(PG8_SB(0, 0), b2, voffB);
            PG8_BAR; PG8_WAIT_L(0); PG8_MMA(0, 1, At, B1); PG8_BAR;
            PG8_LDA(At, 0, 1); PG8_STAGE_A(PG8_SA(0, 0), a2, 0);
            PG8_BAR; PG8_WAIT_L(0); PG8_MMA(1, 0, At, B0); PG8_BAR; PG8_SCHED;
            PG8_STAGE(PG8_SB(0, 1), b2 + hstep, voffB);
            PG8_WAIT_V(6); PG8_BAR; PG8_MMA(1, 1, At, B1); PG8_BAR;
            PG8_LDB(B0, 1, 0); PG8_SCHED; PG8_LDA(At, 1, 0); PG8_STAGE_A(PG8_SA(0, 1), a2, 1);
            PG8_WAIT_L(8); PG8_BAR; PG8_WAIT_L(0); PG8_MMA(0, 0, At, B0); PG8_BAR; PG8_SCHED;
            PG8_LDB(B1, 1, 1); PG8_STAGE(PG8_SB(1, 0), b3, voffB);
            PG8_BAR; PG8_WAIT_L(0); PG8_MMA(0, 1, At, B1); PG8_BAR;
            PG8_LDA(At, 1, 1); PG8_STAGE_A(PG8_SA(1, 0), a3, 0);
            PG8_BAR; PG8_WAIT_L(0); PG8_MMA(1, 0, At, B0); PG8_BAR; PG8_SCHED;
            PG8_STAGE(PG8_SB(1, 1), b3 + hstep, voffB);
            PG8_WAIT_V(6); PG8_BAR; PG8_MMA(1, 1, At, B1); PG8_BAR;
            }
        }
        if constexpr (F8) { asm volatile("s_nop 7\n\ts_nop 7\n\ts_nop 7\n\ts_nop 7" ::: "memory"); }
        if constexpr (ALIGN_EPI) { if (wr == 0) PG8_BAR; }
        if constexpr (!Epi::AFTER_DRAIN) { E(acc, cur, wr, wc, fr, fq, biasl + (ui & 1) * 256); S.done(cur); }
        if (!has_next) break;
#pragma unroll
        for (int a = 0; a < 2; ++a)
#pragma unroll
            for (int b = 0; b < 2; ++b)
#pragma unroll
                for (int m = 0; m < 4; ++m)
#pragma unroll
                    for (int n = 0; n < 2; ++n) acc[a][b][m][n] = (f32x4){0.f, 0.f, 0.f, 0.f};
        cur = nxt; cA = nA; cB = nB; ++ui;
        PG8_BIAS(cur, ui & 1);
        if constexpr (ALIGN_EPI) { if (wr == 1) PG8_BAR; }
    }
    PG8_WAIT_V(0);
    if constexpr (!ALIGN_EPI) { if (wr == 0) PG8_BAR; }
    PG8_BAR;
    if constexpr (Epi::AFTER_DRAIN) { E.fused(acc, cur, wr, wc, fr, fq, lds, wid, lane); S.done(cur); }
#undef PG8_SA
#undef PG8_SB
#undef PG8_STAGE
#undef PG8_LDA
#undef PG8_LDB
#undef PG8_MMA
#undef PG8_WAIT_V
#undef PG8_WAIT_L
#undef PG8_BAR
#undef PG8_SCHED
#undef PG8_BIAS
#undef PG8_STAGE_A
#undef PG8_TOKSTAGE
#undef PG8_TOKSET
}
}

constexpr int NWAVES = 8;
constexpr int NB = 16, T = 2048, D = 1024, M = NB * T, NL = 2;
constexpr int HP = 2048;
constexpr int NIN = 2304;
constexpr int PD = 256;
constexpr int NE = 32, TOPK = 4;
constexpr int MAXTILES = (M * TOPK) / 256 + NE;
constexpr int MAXSLOTS = MAXTILES * 256;
constexpr float LN_EPS = 1e-5f;
constexpr float DN_ALPHA = 1.4142135623730951f;
constexpr float SC_LOG2E = 0.125f * 1.4426950408889634f;
constexpr int C_QN = 0, C_KC = 512, C_VC = 640, C_KS = 768, C_VS = 896, C_KW = 1024, C_VW = 1152, C_QS = 1280, C_KSW = 1792, C_VSW = 1920;

constexpr size_t MiB = 1u << 20;
constexpr size_t WS_CTL = 0, CTL_ZERO_BYTES = 32768;
constexpr size_t WS_WIN = 2 * MiB;
constexpr size_t WS_WO = 12 * MiB;
constexpr size_t WS_WPG = 16 * MiB;
constexpr size_t WS_WPP = 20 * MiB;
constexpr size_t WS_WC1 = 22 * MiB;
constexpr size_t WS_WC2 = 26 * MiB;
constexpr size_t WS_WR = 27 * MiB;
constexpr size_t WS_BINP = 28 * MiB;
constexpr size_t WS_B1P = 28 * MiB + 65536;
constexpr size_t WS_ROPE = 30 * MiB;
constexpr size_t WS_GATES = 38 * MiB;
constexpr size_t WS_KCMP = 42 * MiB;
constexpr size_t WS_VCMP = 42 * MiB + 512 * 1024;
constexpr size_t WS_TOKE = 43 * MiB;
constexpr size_t WS_TOKR = 43 * MiB + 512 * 1024;
constexpr size_t WS_TOKW = 44 * MiB;
constexpr size_t WS_SLOT = 44 * MiB + 512 * 1024;
constexpr size_t WS_W1T = 48 * MiB;
constexpr size_t WS_W2T = 304 * MiB;
constexpr size_t WS_XB = 432 * MiB;
constexpr size_t WS_PB = 496 * MiB;
constexpr size_t WS_R1 = 528 * MiB;
constexpr size_t WS_H = WS_R1, WS_O = WS_R1 + 128 * MiB, WS_YS = WS_R1;
constexpr size_t WS_LIST = WS_R1;

constexpr size_t WS_R2 = 808 * MiB;
constexpr size_t WS_Y1 = WS_R2, WS_ACT = WS_R2;
constexpr size_t WS_X1 = 1080 * MiB;
constexpr size_t WS_X1B = 1208 * MiB;
constexpr size_t WS_PP = 1272 * MiB;
constexpr size_t WS_E = 1336 * MiB;
constexpr size_t WS_XN = 1400 * MiB;
constexpr size_t WS_X1F8 = WS_XB;
constexpr size_t WS_END = 1528 * MiB;
static_assert((size_t)MAXSLOTS * 2048 <= 272 * MiB, "slot buffers");
constexpr int CW_TMO = 0, CW_CODE = 1;
constexpr int CW_CNT = 1024;
constexpr int CW_BAR = 4096;

constexpr int RING_OFF = 0, RING_BYTES = 131072;
constexpr int SCRATCH_BYTES = 139264;
constexpr int LDSCTL_OFF = SCRATCH_BYTES, MISC_OFF = LDSCTL_OFF + 320;
constexpr int TAB_OFF = MISC_OFF + 128;
constexpr int TAB_CNT = TAB_OFF, TAB_SOFF = TAB_OFF + 128, TAB_TST = TAB_OFF + 256, TAB_TE = TAB_OFF + 512;
constexpr int BIAS_OFF = 143360;
constexpr int TOKL_OFF = BIAS_OFF + 2048;
constexpr int LDS_BYTES = 147456;
static_assert(TAB_TE + MAXTILES * 4 <= BIAS_OFF && TOKL_OFF + 2048 <= LDS_BYTES, "LDS map");

static_assert((CW_BAR + 3456) * 4 <= (int)CTL_ZERO_BYTES && (CW_CNT + NL * 32) * 4 <= (int)CTL_ZERO_BYTES, "control words inside the memset region");
#define GAS __attribute__((address_space(1)))
#define LAS __attribute__((address_space(3)))
typedef unsigned short bf16;
typedef unsigned v4u __attribute__((ext_vector_type(4)));
typedef float f32x4 __attribute__((ext_vector_type(4)));
typedef short bf16x8 __attribute__((ext_vector_type(8)));
typedef GAS unsigned gu32;
typedef GAS unsigned long long gu64;
#define RLX_AGENT __ATOMIC_RELAXED, __HIP_MEMORY_SCOPE_AGENT
#define LDS_WAIT() asm volatile("s_waitcnt lgkmcnt(0)" ::: "memory")
#define VM_WAIT() asm volatile("s_waitcnt vmcnt(0)" ::: "memory")
__device__ __forceinline__ unsigned long long rt() { return __builtin_amdgcn_s_memrealtime(); }
__device__ __forceinline__ unsigned f2bf(float f) { unsigned u = __builtin_bit_cast(unsigned, f); return (u + 0x7fffu + ((u >> 16) & 1u)) >> 16; }
__device__ __forceinline__ unsigned pk2(float lo, float hi) { return f2bf(lo) | (f2bf(hi) << 16); }
#define XB_TMO      128
#define XB_XCNT(j)  (256  + 64 * (j))
#define XB_XSUB(j)  (1280 + 64 * (j))
#define XB_XGEN(j)  (2304 + 64 * (j))
#define XB_TOP      3328
#define XB_TOPGEN   3392
#define XCD_BAR_WORDS 3456
#define XB_SPIN_CAP (1u << 22)

__device__ __forceinline__ unsigned xb_ld(unsigned* p)              { return __hip_atomic_load(p, __ATOMIC_RELAXED, __HIP_MEMORY_SCOPE_AGENT); }
__device__ __forceinline__ unsigned xb_add(unsigned* p, unsigned v) { return __hip_atomic_fetch_add(p, v, __ATOMIC_RELAXED, __HIP_MEMORY_SCOPE_AGENT); }
__device__ __forceinline__ unsigned xb_xcc_id() { return (unsigned)__builtin_amdgcn_s_getreg((3 << 11) | 20) & 0xFu; }
#define XB_SPIN(cond, bar) do { unsigned _sp = 0; while (cond) { __builtin_amdgcn_s_sleep(1); \
    if ((++_sp & 255u) == 0u) { if (xb_ld(&(bar)[XB_TMO])) break; if (_sp > XB_SPIN_CAP) { atomicAdd(&(bar)[XB_TMO], 1u); break; } } } } while (0)

struct XcdBarrier {
    unsigned* bar; unsigned x; int wave;
    volatile LAS unsigned* st;
};

__device__ __forceinline__ bool xb_thread0(int wave) { return wave == 0 && __builtin_amdgcn_mbcnt_hi(~0u, __builtin_amdgcn_mbcnt_lo(~0u, 0u)) == 0u; }
__device__ __forceinline__ XcdBarrier xcd_barrier_post(unsigned* bar, volatile LAS unsigned* st, int wave) {
    XcdBarrier b; b.bar = bar; b.x = xb_xcc_id(); b.st = st; b.wave = wave;
    if (xb_thread0(wave)) (void)xb_add(&bar[XB_XCNT(b.x)], 1u);
    return b;
}
__device__ __forceinline__ void xcd_barrier_complete(unsigned* bar, unsigned x, unsigned& nloc, unsigned& nx) {
    const unsigned G = gridDim.x * gridDim.y * gridDim.z;
    unsigned sum, cnt, mine, sp = 0u;
    for (;;) {
        sum = 0u; cnt = 0u; mine = 0u;
#pragma unroll
        for (unsigned j = 0; j < 16; ++j) { const unsigned c = xb_ld(&bar[XB_XCNT(j)]); sum += c; cnt += (c > 0u) ? 1u : 0u; mine = (j == x) ? c : mine; }
        if (sum == G) break;
        __builtin_amdgcn_s_sleep(1);
        if ((++sp & 255u) == 0u) { if (xb_ld(&bar[XB_TMO])) break; if (sp > XB_SPIN_CAP) { atomicAdd(&bar[XB_TMO], 1u); break; } }
    }
    nloc = mine > 0u ? mine : 1u; nx = cnt > 0u ? cnt : 1u;
}

__device__ __forceinline__ void xcd_barrier(const XcdBarrier& b) {
    asm volatile("s_waitcnt vmcnt(0)" ::: "memory");
    __syncthreads();
    if (xb_thread0(b.wave)) {
        unsigned* bar = b.bar;
        __builtin_amdgcn_s_waitcnt(0);
        unsigned nloc = b.st[0], nx = b.st[1];
        if (nloc == 0u) { xcd_barrier_complete(bar, b.x, nloc, nx); b.st[0] = nloc; b.st[1] = nx; }
        const unsigned old = xb_add(&bar[XB_XSUB(b.x)], 1u);
        const unsigned gen = old / nloc;
        if (old + 1u == (gen + 1u) * nloc) {
            __builtin_amdgcn_fence(__ATOMIC_RELEASE, "agent");
            asm volatile("s_waitcnt vmcnt(0)" ::: "memory");
            const unsigned og = xb_add(&bar[XB_TOP], 1u);
            const unsigned tg = og / nx;
            if (og + 1u == (tg + 1u) * nx) xb_add(&bar[XB_TOPGEN], 1u);
            else XB_SPIN(xb_ld(&bar[XB_TOPGEN]) == tg, bar);
            __builtin_amdgcn_fence(__ATOMIC_ACQUIRE, "agent");
            xb_add(&bar[XB_XGEN(b.x)], 1u);
            asm volatile("s_waitcnt vmcnt(0)" ::: "memory");
        } else {
            XB_SPIN(xb_ld(&bar[XB_XGEN(b.x)]) == gen, bar);
            __builtin_amdgcn_fence(__ATOMIC_ACQUIRE, "agent");
            asm volatile("s_waitcnt vmcnt(0)" ::: "memory");
        }
    }
    __syncthreads();
}

typedef float f32x16 __attribute__((ext_vector_type(16)));
typedef unsigned u32x2 __attribute__((ext_vector_type(2)));
struct Frame {
    LAS unsigned char* lds;
    volatile LAS unsigned* MISC;
    gu32* ctl;
    unsigned char* ws;
    int tid, lane, wave;
    int vcu, G;
};
__device__ __forceinline__ float wave_sum(float v) {
#pragma unroll
    for (int o = 1; o < 64; o <<= 1) v += __shfl_xor(v, o);
    return v;
}
__device__ __forceinline__ float sigm(float x) { return __builtin_amdgcn_rcpf(1.0f + __builtin_amdgcn_exp2f(-1.4426950408889634f * x)); }
__device__ __forceinline__ float bf_lo(unsigned w) { return __uint_as_float(w << 16); }
__device__ __forceinline__ float bf_hi(unsigned w) { return __uint_as_float(w & 0xffff0000u); }
__device__ __forceinline__ unsigned cvtpk(float lo, float hi) { typedef float f2 __attribute__((ext_vector_type(2))); typedef __bf16 b2 __attribute__((ext_vector_type(2))); f2 v = {lo, hi}; b2 b = __builtin_convertvector(v, b2); return __builtin_bit_cast(unsigned, b); }
__device__ __forceinline__ bf16x8 pack8(float a0, float a1, float a2, float a3, float a4, float a5, float a6, float a7) {
    v4u w; w.x = cvtpk(a0, a1); w.y = cvtpk(a2, a3); w.z = cvtpk(a4, a5); w.w = cvtpk(a6, a7); return __builtin_bit_cast(bf16x8, w);
}
__device__ __forceinline__ int crow(int r, int hi) { return (r & 3) + 8 * (r >> 2) + 4 * hi; }

struct MapId { __device__ __forceinline__ int operator()(int n) const { return n; } };
struct MapW1 { __device__ __forceinline__ int operator()(int n) const { return ((n >> 7) & 1) * 1024 + (n >> 8) * 128 + (n & 127); } };
struct MapWin {
    __device__ __forceinline__ int operator()(int n) const {
        if (n >= 2048) { const int i = n - 2048; return i < 24 ? 1280 + i : -1; }
        const int seg = n >> 7, q = n & 127, hd = q >> 6, pos = q & 63, g = pos >> 3, j = pos & 7;
        const int dlog = j < 4 ? 4 * g + j : 32 + 4 * g + (j - 4);
        const int hc = seg * 128 + hd * 64 + dlog;
        return hc < 1280 ? hc : hc + 24;
    }
};
template <class Map>
__device__ __forceinline__ void transpose_item(const float* W, int K, int Nsrc, bf16* WT, LAS float* scr, int kb, int nb, int lane, Map map) {
    const int k0 = 64 * kb, n0 = 32 * nb;
    const int src = map(n0 + (lane & 31));
    float wv[32];
#pragma unroll
    for (int i = 0; i < 32; ++i) { const int kk = 2 * i + (lane >> 5); wv[i] = src >= 0 ? W[(size_t)(k0 + kk) * Nsrc + src] : 0.f; }
#pragma unroll
    for (int i = 0; i < 32; ++i) { const int kk = 2 * i + (lane >> 5); scr[kk * 33 + (lane & 31)] = wv[i]; }
    LDS_WAIT(); asm volatile("" ::: "memory");
    const int c = lane & 7;
#pragma unroll
    for (int j = 0; j < 4; ++j) { const int n = (lane >> 3) + 8 * j; const LAS float* s = scr + (8 * c) * 33 + n;
        v4u o; o.x = pk2(s[0 * 33], s[1 * 33]); o.y = pk2(s[2 * 33], s[3 * 33]); o.z = pk2(s[4 * 33], s[5 * 33]); o.w = pk2(s[6 * 33], s[7 * 33]);
        *(GAS v4u*)(WT + (size_t)(n0 + n) * K + k0 + 8 * c) = o; }
    LDS_WAIT(); asm volatile("" ::: "memory");
}
__device__ __forceinline__ unsigned pk4_fp8(float a, float b, float c, float d) { int w = 0; w = __builtin_amdgcn_cvt_pk_fp8_f32(a, b, w, false); w = __builtin_amdgcn_cvt_pk_fp8_f32(c, d, w, true); return (unsigned)w; }
template <class Map>
__device__ __forceinline__ void transpose_item_f8(const float* W, int K, int Nsrc, unsigned char* WT, LAS float* scr, int kb, int nb, int lane, Map map, float wscale) {
    const int k0 = 64 * kb, n0 = 32 * nb;
    const int src = map(n0 + (lane & 31));
    float wv[32];
#pragma unroll
    for (int i = 0; i < 32; ++i) { const int kk = 2 * i + (lane >> 5); wv[i] = src >= 0 ? W[(size_t)(k0 + kk) * Nsrc + src] * wscale : 0.f; }
#pragma unroll
    for (int i = 0; i < 32; ++i) { const int kk = 2 * i + (lane >> 5); scr[kk * 33 + (lane & 31)] = wv[i]; }
    LDS_WAIT(); asm volatile("" ::: "memory");
    const int c = lane & 7;
#pragma unroll
    for (int j = 0; j < 4; ++j) { const int n = (lane >> 3) + 8 * j; const LAS float* s = scr + (8 * c) * 33 + n;
        u32x2 o; o.x = pk4_fp8(s[0 * 33], s[1 * 33], s[2 * 33], s[3 * 33]); o.y = pk4_fp8(s[4 * 33], s[5 * 33], s[6 * 33], s[7 * 33]);
        *(GAS u32x2*)(WT + (size_t)(n0 + n) * K + k0 + 8 * c) = o; }
    LDS_WAIT(); asm volatile("" ::: "memory");
}
constexpr float W1_F8_SCALE = 64.0f, W2_F8_SCALE = 128.0f, WPG_F8_SCALE = 64.0f;
struct PIn { const float *x, *p, *w_in, *b_in, *w_ck1, *w_ck2, *w_cv1, *w_cv2, *w_o, *w_r, *w_e1, *b_e1, *w_e2, *w_pg, *w_pp; const int* pos; };
__device__ __forceinline__ void p0_prologue(Frame& F, const PIn& I) {
    LAS float* scr = (LAS float*)(F.lds + RING_OFF + F.wave * 16384);
    const int gw = F.vcu * NWAVES + F.wave, NGW = F.G * NWAVES, lane = F.lane;
    unsigned char* ws = F.ws;
    constexpr int I_IN = 16 * 72, I_O = 16 * 32, I_PG = 16 * 32, I_PP = 4 * 32, I_C1 = 32 * 8, I_C2 = 4 * 2;
    constexpr int I_LAYER = I_IN + I_O + I_PG + I_PP + 2 * I_C1 + 2 * I_C2;
    for (int it = gw; it < NL * I_LAYER; it += NGW) {
        const int L = it / I_LAYER; int r = it % I_LAYER;
        if (r < I_IN) { transpose_item(I.w_in + (size_t)L * 1024 * 2072, 1024, 2072, (bf16*)(ws + WS_WIN) + (size_t)L * NIN * 1024, scr, r / 72, r % 72, lane, MapWin()); continue; } r -= I_IN;
        if (r < I_O) { transpose_item(I.w_o + (size_t)L * 1024 * 1024, 1024, 1024, (bf16*)(ws + WS_WO) + (size_t)L * 1024 * 1024, scr, r / 32, r % 32, lane, MapId()); continue; } r -= I_O;
        if (r < I_PG) {
            if (L == NL - 1) transpose_item_f8(I.w_pg + (size_t)L * 1024 * 1024, 1024, 1024, ws + WS_WPG + (size_t)L * 1024 * 1024 * 2, scr, r / 32, r % 32, lane, MapId(), WPG_F8_SCALE);
            else transpose_item(I.w_pg + (size_t)L * 1024 * 1024, 1024, 1024, (bf16*)(ws + WS_WPG) + (size_t)L * 1024 * 1024, scr, r / 32, r % 32, lane, MapId());
            continue; } r -= I_PG;
        if (r < I_PP) { transpose_item(I.w_pp + (size_t)L * 256 * 1024, 256, 1024, (bf16*)(ws + WS_WPP) + (size_t)L * 1024 * 256, scr, r / 32, r % 32, lane, MapId()); continue; } r -= I_PP;
        if (r < I_C1) { transpose_item(I.w_ck1 + (size_t)L * 2048 * 256, 2048, 256, (bf16*)(ws + WS_WC1) + (size_t)(L * 2 + 0) * 256 * 2048, scr, r / 8, r % 8, lane, MapId()); continue; } r -= I_C1;
        if (r < I_C1) { transpose_item(I.w_cv1 + (size_t)L * 2048 * 256, 2048, 256, (bf16*)(ws + WS_WC1) + (size_t)(L * 2 + 1) * 256 * 2048, scr, r / 8, r % 8, lane, MapId()); continue; } r -= I_C1;
        if (r < I_C2) { transpose_item(I.w_ck2 + (size_t)L * 256 * 64, 256, 64, (bf16*)(ws + WS_WC2) + (size_t)(L * 2 + 0) * 64 * 256, scr, r / 2, r % 2, lane, MapId()); continue; } r -= I_C2;
        { transpose_item(I.w_cv2 + (size_t)L * 256 * 64, 256, 64, (bf16*)(ws + WS_WC2) + (size_t)(L * 2 + 1) * 64 * 256, scr, r / 2, r % 2, lane, MapId()); }
    }
    const size_t gt = (size_t)F.vcu * (NWAVES * 64) + F.tid, NGT = (size_t)F.G * NWAVES * 64;
    for (size_t i = gt; i < (size_t)NL * 32 * 1024; i += NGT) {
        const int L = (int)(i / (32 * 1024)), e = (int)((i / 1024) % 32), k = (int)(i % 1024);
        const float w = I.w_r[((size_t)L * 1024 + k) * 32 + e];
        const unsigned h = f2bf(w); const float wl = w - __uint_as_float(h << 16);
        bf16* d = (bf16*)(ws + WS_WR) + (size_t)L * 2 * 32 * 1024 + (size_t)e * 1024 + k;
        d[0] = (bf16)h; d[32 * 1024] = (bf16)f2bf(wl);
    }
    for (size_t i = gt; i < (size_t)NL * NIN; i += NGT) { const int L = (int)(i / NIN), n = (int)(i % NIN); const int s = MapWin()(n); ((float*)(ws + WS_BINP))[i] = s >= 0 ? I.b_in[(size_t)L * 2072 + s] : 0.f; }
    for (size_t i = gt; i < (size_t)NL * 32 * 2048; i += NGT) { const int le = (int)(i / 2048), n = (int)(i % 2048); ((float*)(ws + WS_B1P))[i] = I.b_e1[(size_t)le * 2048 + MapW1()(n)]; }
    for (size_t i = gt; i < (size_t)M * D / 8; i += NGT) {
        const f32x4 a = *(const GAS f32x4*)(I.x + i * 8), b = *(const GAS f32x4*)(I.x + i * 8 + 4);
        v4u o; o.x = pk2(a.x, a.y); o.y = pk2(a.z, a.w); o.z = pk2(b.x, b.y); o.w = pk2(b.z, b.w);
        *(GAS v4u*)((bf16*)(ws + WS_XB) + i * 8) = o;
    }
    for (size_t i = gt; i < (size_t)NL * M * PD / 8; i += NGT) {
        const f32x4 a = *(const GAS f32x4*)(I.p + i * 8), b = *(const GAS f32x4*)(I.p + i * 8 + 4);
        v4u o; o.x = pk2(a.x, a.y); o.y = pk2(a.z, a.w); o.z = pk2(b.x, b.y); o.w = pk2(b.z, b.w);
        *(GAS v4u*)((bf16*)(ws + WS_PB) + i * 8) = o;
    }
    for (size_t i = gt; i < (size_t)M * 32; i += NGT) {
        const int row = (int)(i >> 5), d = (int)(i & 31);
        const float inv = 1.0f / powf(10000.0f, (float)(2 * d) / 64.0f);
        const float ang = (float)I.pos[row] * inv;
        float* rp = (float*)(ws + WS_ROPE) + (size_t)row * 64;
        rp[d] = cosf(ang); rp[32 + d] = sinf(ang);
    }
}

static_assert(NL == 2, "the conversion queues are laid out for two layers");
constexpr int I_E1 = 32 * 16 * 32, I_E2 = 32 * 16 * 16;
constexpr int QCH = 2;
constexpr int CW_Q = 2048, CW_STOP = 2080;
constexpr int CV_PITCH = 65, CV_WAVE_BYTES = 17408;
static_assert(8 * CV_WAVE_BYTES <= SCRATCH_BYTES && 64 * CV_PITCH * 4 <= CV_WAVE_BYTES, "conversion tiles");
struct CvItem { const float* W; unsigned char* WT; int Nsrc, K, kb, nb, w1; float scale; };
template <int Q>
__device__ __forceinline__ CvItem cv_item(unsigned char* ws, const float* w_e1, const float* w_e2, int item) {
    CvItem d;
    constexpr int L = (Q == 2) ? NL - 1 : 0;
    const bool is1 = (Q == 0) || (Q == 2 && item < I_E1);
    const int r = (Q == 2 && !is1) ? item - I_E1 : item;
    if (is1) { const int e = r / 512, q = r % 512; d.W = w_e1 + ((size_t)L * 32 + e) * 1024 * 2048; d.Nsrc = 2048; d.kb = q / 32; d.nb = q % 32; d.w1 = 1; d.scale = W1_F8_SCALE;
        d.WT = (Q == 2) ? ws + WS_W1T + (size_t)L * 32 * 2048 * 1024 * 2 + (size_t)e * 2048 * 1024 : ws + WS_W1T + (size_t)e * 2048 * 1024 * 2; }
    else { const int e = r / 256, q = r % 256; d.W = w_e2 + ((size_t)L * 32 + e) * 1024 * 1024; d.Nsrc = 1024; d.kb = q / 16; d.nb = q % 16; d.w1 = 0; d.scale = W2_F8_SCALE;
        d.WT = (Q == 2) ? ws + WS_W2T + (size_t)L * 32 * 1024 * 1024 * 2 + (size_t)e * 1024 * 1024 : ws + WS_W2T + (size_t)e * 1024 * 1024 * 2; }
    d.K = 1024;
    return d;
}
__device__ __forceinline__ void cv_load(f32x4 (&r)[16], const CvItem& d, int lane) {
    const int kl = lane >> 4, c = lane & 15, n = 64 * d.nb + 4 * c;
    const int src = d.w1 ? MapW1()(n) : n;
    const float* p = d.W + (size_t)(64 * d.kb + kl) * d.Nsrc + src;
#pragma unroll
    for (int i = 0; i < 16; ++i) r[i] = __builtin_nontemporal_load((const GAS f32x4*)(p + (size_t)(4 * i) * d.Nsrc));
}
template <bool F8>
__device__ __forceinline__ void cv_store(const f32x4 (&r)[16], const CvItem& d, LAS float* scr, int lane) {
    const int kl = lane >> 4, c = lane & 15;
#pragma unroll
    for (int i = 0; i < 16; ++i) { LAS float* t = scr + (4 * i + kl) * CV_PITCH + 4 * c; t[0] = r[i].x; t[1] = r[i].y; t[2] = r[i].z; t[3] = r[i].w; }
    LDS_WAIT(); asm volatile("" ::: "memory");
    const int c8 = lane & 7, nl = lane >> 3;
#pragma unroll
    for (int jj = 0; jj < 8; ++jj) { const int n = nl + 8 * jj; const LAS float* s = scr + (8 * c8) * CV_PITCH + n;
        const float a0 = s[0 * CV_PITCH], a1 = s[1 * CV_PITCH], a2 = s[2 * CV_PITCH], a3 = s[3 * CV_PITCH], a4 = s[4 * CV_PITCH], a5 = s[5 * CV_PITCH], a6 = s[6 * CV_PITCH], a7 = s[7 * CV_PITCH];
        const size_t o = (size_t)(64 * d.nb + n) * d.K + 64 * d.kb + 8 * c8;
        if constexpr (F8) { const float w = d.scale; u32x2 v; v.x = pk4_fp8(a0 * w, a1 * w, a2 * w, a3 * w); v.y = pk4_fp8(a4 * w, a5 * w, a6 * w, a7 * w); __builtin_nontemporal_store(v, (GAS u32x2*)(d.WT + o)); }
        else { v4u v; v.x = pk2(a0, a1); v.y = pk2(a2, a3); v.z = pk2(a4, a5); v.w = pk2(a6, a7); __builtin_nontemporal_store(v, (GAS v4u*)((bf16*)d.WT + o)); } }
    LDS_WAIT(); asm volatile("" ::: "memory");
}
template <int Q>
__device__ __forceinline__ void conv_run(Frame& F, const float* w_e1, const float* w_e2, int stop_word, unsigned stop_thr = 1u, int stat = -1) {
    static_assert(QCH == 2, "one loop trip = one chunk = items A, B");
    constexpr int NCH = (Q == 0 ? I_E1 : Q == 1 ? I_E2 : I_E1 + I_E2) / QCH;
    constexpr bool F8 = (Q == 2);
    LAS float* scr = (LAS float*)(F.lds + RING_OFF + F.wave * CV_WAVE_BYTES);
    gu32* head = F.ctl + CW_Q + Q;
    const int lane = F.lane;
    if (__builtin_amdgcn_readfirstlane(__hip_atomic_load(head, RLX_AGENT)) >= (unsigned)NCH) return;
    if (stop_word >= 0 && __builtin_amdgcn_readfirstlane(__hip_atomic_load(F.ctl + stop_word, RLX_AGENT)) >= stop_thr) return;
    const __amdgpu_buffer_rsrc_t rs = __builtin_amdgcn_make_buffer_rsrc((unsigned*)head, 0, 4, 0x00020000);
    const int own = lane == 0 ? 0 : 0x40000000;
    unsigned c = (unsigned)__builtin_amdgcn_readfirstlane(__builtin_amdgcn_raw_ptr_buffer_atomic_add_i32(1, rs, own, 0, 0));
    if (c >= (unsigned)NCH) return;
    int pend = __builtin_amdgcn_raw_ptr_buffer_atomic_add_i32(1, rs, own, 0, 0);
    unsigned stp = 0u; bool last = false;
    if (stop_word >= 0) stp = __hip_atomic_load(F.ctl + stop_word, RLX_AGENT);
#ifdef PRB_SEL
    unsigned ndone = 0u;
#endif
    f32x4 ra[16], rb[16];
    CvItem da = cv_item<Q>(F.ws, w_e1, w_e2, (int)c * QCH), db;
    cv_load(ra, da, lane);
    for (;;) {
        db = cv_item<Q>(F.ws, w_e1, w_e2, (int)c * QCH + 1); cv_load(rb, db, lane);
        cv_store<F8>(ra, da, scr, lane);
        const unsigned cn = (unsigned)__builtin_amdgcn_readfirstlane(pend);
        const bool stopped = stop_word >= 0 && (unsigned)__builtin_amdgcn_readfirstlane(stp) >= stop_thr;
        const bool more = !last && cn < (unsigned)NCH;
        if (more) {
            pend = __builtin_amdgcn_raw_ptr_buffer_atomic_add_i32(1, rs, stopped ? 0x40000000 : own, 0, 0);
            last = stopped;
            if (stop_word >= 0) stp = __hip_atomic_load(F.ctl + stop_word, RLX_AGENT);
            da = cv_item<Q>(F.ws, w_e1, w_e2, (int)cn * QCH); cv_load(ra, da, lane);
        }
        cv_store<F8>(rb, db, scr, lane);
#ifdef PRB_SEL
        ++ndone;
#endif
        if (!more) break;
        c = cn;
    }
#ifdef PRB_SEL
    if (stat >= 0 && lane == 0) (void)__hip_atomic_fetch_add((gu32*)(F.ws + WS_TOKE + 3 * MiB) + stat, ndone, RLX_AGENT);
#endif
}

__device__ __forceinline__ float gelu_tanh(float x) {
    const float u = 0.7978845608028654f * (x + 0.044715f * x * x * x);
    const float e = __builtin_amdgcn_exp2f(2.0f * 1.4426950408889634f * u);
    const float t = 1.0f - 2.0f * __builtin_amdgcn_rcpf(e + 1.0f);
    return 0.5f * x * (1.0f + t);
}
__device__ __forceinline__ void phase_compress(Frame& F, int L, const float* ck_pe, const float* cv_pe) {
    const int lane = F.lane, wave = F.wave, tid = F.tid;
    unsigned char* ws = F.ws;
    const bf16* H = (const bf16*)(ws + WS_H);
    const float* rope = (const float*)(ws + WS_ROPE);
    LAS unsigned char* hid = F.lds + RING_OFF;
    LAS float* pel = (LAS float*)(F.lds + RING_OFF + 16896);
    LAS unsigned char* atok = F.lds + RING_OFF + 16896 + 8192;
    constexpr int AP = 144, AIS = 33 * AP;
    for (int unit = blockIdx.x; unit < 256; unit += F.G) {
        int lane_v = lane; asm volatile("" : "+v"(lane_v));
        const int q = lane_v & 31, hi = lane_v >> 5;
        const int b = unit >> 4, g = (unit >> 3) & 1, kv = (unit >> 2) & 1, cb = unit & 3;
        const bf16* w1t = (const bf16*)(ws + WS_WC1) + (size_t)(L * 2 + kv) * 256 * 2048;
        const bf16* w2t = (const bf16*)(ws + WS_WC2) + (size_t)(L * 2 + kv) * 64 * 256;
        const float* pe = (kv ? cv_pe : ck_pe) + (size_t)L * 32 * 64;
        const int scol = (kv ? C_VC : C_KC) + g * 64;
        const int tok0 = 512 * cb;
        __syncthreads();
        for (int ci = tid; ci < 528 * 8; ci += NWAVES * 64) {
            const int tk = ci >> 3, ch = ci & 7; int tg = tok0 + tk; tg = tg < T ? tg : T - 1;
            *(LAS v4u*)(atok + (tk & 15) * AIS + (tk >> 4) * AP + ch * 16) = *(const GAS v4u*)(H + ((size_t)b * T + tg) * HP + scol + ch * 8);
        }
        for (int ci = tid; ci < 32 * 64 / 4; ci += NWAVES * 64) *(LAS f32x4*)(pel + ci * 4) = *(const GAS f32x4*)(pe + ci * 4);
        __syncthreads();
        const bf16* brow = w1t + (size_t)(32 * wave + q) * 2048 + 8 * hi;
        f32x16 acc; for (int r = 0; r < 16; ++r) acc[r] = 0.f;
        bf16x8 bcur[8], bnxt[8];
#pragma unroll
        for (int u = 0; u < 8; ++u) bcur[u] = *(const GAS bf16x8*)(brow + u * 16);
        for (int i2 = 0; i2 < 16; ++i2) {
            if (i2 < 15) {
#pragma unroll
                for (int u = 0; u < 8; ++u) bnxt[u] = *(const GAS bf16x8*)(brow + (i2 + 1) * 128 + u * 16);
            }
#pragma unroll
            for (int u = 0; u < 8; ++u) {
                const int i = 2 * i2 + (u >> 2), s4 = u & 3;
                const v4u av = *(const LAS v4u*)(atok + (i & 15) * AIS + (q + (i >> 4)) * AP + (16 * s4 + 8 * hi) * 2);
                const f32x4 p0 = *(const LAS f32x4*)(pel + i * 64 + 16 * s4 + 8 * hi), p1 = *(const LAS f32x4*)(pel + i * 64 + 16 * s4 + 8 * hi + 4);
                const bf16x8 af = pack8(bf_lo(av.x) + p0.x, bf_hi(av.x) + p0.y, bf_lo(av.y) + p0.z, bf_hi(av.y) + p0.w, bf_lo(av.z) + p1.x, bf_hi(av.z) + p1.y, bf_lo(av.w) + p1.z, bf_hi(av.w) + p1.w);
                acc = __builtin_amdgcn_mfma_f32_32x32x16_bf16(af, bcur[u], acc, 0, 0, 0);
            }
#pragma unroll
            for (int u = 0; u < 8; ++u) bcur[u] = bnxt[u];
        }
#pragma unroll
        for (int r = 0; r < 16; ++r) *(LAS bf16*)(hid + crow(r, hi) * 528 + (32 * wave + q) * 2) = (bf16)f2bf(gelu_tanh(acc[r]));
        __syncthreads();
        if (wave == 0) {
            f32x16 a0, a1; for (int r = 0; r < 16; ++r) { a0[r] = 0.f; a1[r] = 0.f; }
#pragma unroll
            for (int ks = 0; ks < 16; ++ks) {
                const bf16x8 af = *(const LAS bf16x8*)(hid + q * 528 + (16 * ks + 8 * hi) * 2);
                const bf16x8 b0 = *(const GAS bf16x8*)(w2t + (size_t)q * 256 + 16 * ks + 8 * hi), b1 = *(const GAS bf16x8*)(w2t + (size_t)(32 + q) * 256 + 16 * ks + 8 * hi);
                a0 = __builtin_amdgcn_mfma_f32_32x32x16_bf16(af, b0, a0, 0, 0, 0);
                a1 = __builtin_amdgcn_mfma_f32_32x32x16_bf16(af, b1, a1, 0, 0, 0);
            }
            bf16* outp = (bf16*)(ws + (kv ? WS_VCMP : WS_KCMP)) + (size_t)(b * 2 + g) * 128 * 64;
#pragma unroll
            for (int r = 0; r < 16; ++r) {
                const int cl = 32 * cb + crow(r, hi);
                float x1 = a0[r], x2 = a1[r];
                if (kv == 0) {
                    const int cr = cl < 127 ? cl : 126;
                    const float* rp = rope + ((size_t)b * T + 31 + 16 * cr) * 64;
                    const float cs = rp[q], sn = rp[32 + q];
                    const float o1 = x1 * cs - x2 * sn, o2 = x2 * cs + x1 * sn; x1 = o1; x2 = o2;
                }
                if (cl >= 127) { x1 = 0.f; x2 = 0.f; }
                outp[(size_t)cl * 64 + q] = (bf16)f2bf(x1); outp[(size_t)cl * 64 + 32 + q] = (bf16)f2bf(x2);
            }
        }
    }
    __syncthreads();
}

namespace att {
constexpr float ATT_THR = 6.0f;
constexpr int KP = 144;
constexpr int KTB = 64 * KP, VTB = 8192;
constexpr int L_K = 0;
constexpr int L_V = 4 * KTB;
constexpr int L_KC = 0;
constexpr int L_VC = 128 * KP;
constexpr int L_IMP = L_VC + 16384;
constexpr int L_OT = 4 * KTB + 4 * VTB;
constexpr int L_SEL = L_OT + 65536;
static_assert(L_IMP + 4 * 64 * 33 * 4 <= L_OT && L_SEL + 256 <= SCRATCH_BYTES, "attention LDS map");

__device__ __forceinline__ float max3f(float a, float b, float c) { float r; asm("v_max3_f32 %0, %1, %2, %3" : "=v"(r) : "v"(a), "v"(b), "v"(c)); return r; }
__device__ __forceinline__ float max2f(float a, float b) { float r; asm("v_max_f32_e32 %0, %1, %2" : "=v"(r) : "v"(a), "v"(b)); return r; }
typedef short v4i16_t __attribute__((ext_vector_type(4)));
__device__ __forceinline__ u32x2 vtr(const LAS unsigned char* p) { return __builtin_bit_cast(u32x2, __builtin_amdgcn_ds_read_tr16_b64_v4i16((LAS v4i16_t*)p)); }
__device__ __forceinline__ float xhalf_max(float v) { auto rr = __builtin_amdgcn_permlane32_swap(__float_as_uint(v), __float_as_uint(v), false, false); return fmaxf(__uint_as_float(rr[0]), __uint_as_float(rr[1])); }
__device__ __forceinline__ float xhalf_sum(float v) { auto rr = __builtin_amdgcn_permlane32_swap(__float_as_uint(v), __float_as_uint(v), false, false); return __uint_as_float(rr[0]) + __uint_as_float(rr[1]); }
template <bool SEL>
__device__ __forceinline__ void att_tile(LAS unsigned char* Kl, LAS unsigned char* Vl, int j, int qt, int jlo, int t, int W, unsigned selbits, const bf16x8 (&qf)[4],
                                         f32x16& o0, f32x16& o1, f32x16& negm, float& m_run, float& l_run, int q, int hi) {
        bf16x8 ka[4], kb2[4]; u32x2 va[4][2], vb[4][2];
#pragma unroll
        for (int s = 0; s < 4; ++s) { ka[s] = *(const LAS bf16x8*)(Kl + q * KP + (16 * s + 8 * hi) * 2); kb2[s] = *(const LAS bf16x8*)(Kl + (32 + q) * KP + (16 * s + 8 * hi) * 2); }
        {
            const LAS unsigned char* vp = Vl + ((q >> 4) & 1) * 32 + (q & 3) * 8 + (4 * hi + ((q & 15) >> 2)) * 64;
#pragma unroll
            for (int ks = 0; ks < 4; ++ks) {
                va[ks][0] = vtr(vp + ks * 1024); va[ks][1] = vtr(vp + ks * 1024 + 512);
                vb[ks][0] = vtr(vp + 4096 + ks * 1024); vb[ks][1] = vtr(vp + 4096 + ks * 1024 + 512);
            }
        }
        __builtin_amdgcn_sched_barrier(0);
        f32x16 s0 = __builtin_amdgcn_mfma_f32_32x32x16_bf16(ka[0], qf[0], negm, 0, 0, 0);
        f32x16 s1 = __builtin_amdgcn_mfma_f32_32x32x16_bf16(kb2[0], qf[0], negm, 0, 0, 0);
#pragma unroll
        for (int s = 1; s < 4; ++s) {
            s0 = __builtin_amdgcn_mfma_f32_32x32x16_bf16(ka[s], qf[s], s0, 0, 0, 0);
            s1 = __builtin_amdgcn_mfma_f32_32x32x16_bf16(kb2[s], qf[s], s1, 0, 0, 0);
        }
        const bool lane_ok = SEL ? (((selbits >> j) & 1u) != 0u) : true;
        if (j == qt || j == jlo) {
            const int d0 = t - 64 * j - 4 * hi;
#pragma unroll
            for (int r = 0; r < 16; ++r) {
                s0[r] = ((unsigned)(d0 - ((r & 3) + 8 * (r >> 2))) < (unsigned)W) ? s0[r] : -INFINITY;
                s1[r] = ((unsigned)(d0 - (32 + (r & 3) + 8 * (r >> 2))) < (unsigned)W) ? s1[r] : -INFINITY;
            }
        }
        float mx = fmaxf(s0[0], s1[0]), mx2 = fmaxf(s0[1], s1[1]);
#pragma unroll
        for (int r = 2; r < 16; r += 2) { mx = max3f(mx, s0[r], s1[r]); mx2 = max3f(mx2, s0[r + 1], s1[r + 1]); }
        mx = max2f(mx, mx2);
        mx = lane_ok ? mx : -INFINITY;
        mx = xhalf_max(mx);
        typedef float f32x2_ __attribute__((ext_vector_type(2)));
        f32x2_ ps2 = {0.f, 0.f};
#pragma unroll
        for (int r = 0; r < 16; ++r) { s0[r] = __builtin_amdgcn_exp2f(s0[r]); s1[r] = __builtin_amdgcn_exp2f(s1[r]); ps2 += (f32x2_){s0[r], s1[r]}; }
        const float ps = ps2.x + ps2.y;
        const unsigned okm = lane_ok ? 0xffffffffu : 0u;
        l_run += lane_ok ? ps : 0.f;
#pragma unroll
        for (int ks = 0; ks < 4; ++ks) {
            const int kb = ks >> 1, sp = ks & 1;
            bf16x8 pf = kb ? pack8(s1[8 * sp + 0], s1[8 * sp + 1], s1[8 * sp + 2], s1[8 * sp + 3], s1[8 * sp + 4], s1[8 * sp + 5], s1[8 * sp + 6], s1[8 * sp + 7])
                           : pack8(s0[8 * sp + 0], s0[8 * sp + 1], s0[8 * sp + 2], s0[8 * sp + 3], s0[8 * sp + 4], s0[8 * sp + 5], s0[8 * sp + 6], s0[8 * sp + 7]);
            if (SEL) { v4u pw = __builtin_bit_cast(v4u, pf); pw.x &= okm; pw.y &= okm; pw.z &= okm; pw.w &= okm; pf = __builtin_bit_cast(bf16x8, pw); }
            {
                v4u w; w.x = va[ks][0].x; w.y = va[ks][0].y; w.z = va[ks][1].x; w.w = va[ks][1].y;
                o0 = __builtin_amdgcn_mfma_f32_32x32x16_bf16(__builtin_bit_cast(bf16x8, w), pf, o0, 0, 0, 0);
            }
            {
                v4u w; w.x = vb[ks][0].x; w.y = vb[ks][0].y; w.z = vb[ks][1].x; w.w = vb[ks][1].y;
                o1 = __builtin_amdgcn_mfma_f32_32x32x16_bf16(__builtin_bit_cast(bf16x8, w), pf, o1, 0, 0, 0);
            }
        }
        if (__builtin_amdgcn_ballot_w64(mx > ATT_THR) != 0ull) {
            const float gmx = fmaxf(mx, 0.f);
            const float alpha = __builtin_amdgcn_exp2f(-gmx);
            l_run *= alpha; m_run += gmx;
#pragma unroll
            for (int r = 0; r < 16; ++r) { o0[r] *= alpha; o1[r] *= alpha; negm[r] -= gmx; }
        }
}
template <bool SEL>
__device__ __forceinline__ void stream(LAS unsigned char* lds, const bf16* Hb, int kcol, int vcol, int j0, int j1, int qt, int t, int W, unsigned selbits,
                                       const bf16x8 (&qf)[4], f32x16& o0, f32x16& o1, float& m_run, float& l_run, int tid, int lane, int wave) {
    const int q = lane & 31, hi = lane >> 5;
    const int krow = tid >> 3, kch = tid & 7, vrow = krow, vch = kch;
    const int vdst = (kch >> 2) * 4096 + (krow >> 3) * 512 + (krow & 7) * 64 + (kch & 3) * 16;
    const int jlo = qt - (W >> 6);
    f32x16 negm;
#pragma unroll
    for (int r = 0; r < 16; ++r) negm[r] = -m_run;
    __syncthreads();
    const bf16* kp0 = Hb + (size_t)(64 * j0 + krow) * HP + kcol + kch * 8;
    const bf16* vp0 = Hb + (size_t)(64 * j0 + vrow) * HP + vcol + vch * 8;
    v4u kA = *(const GAS v4u*)kp0, vA = *(const GAS v4u*)vp0, kB = kA, vB = vA;
    if (j0 + 1 <= j1) { kB = *(const GAS v4u*)(kp0 + (size_t)64 * HP); vB = *(const GAS v4u*)(vp0 + (size_t)64 * HP); }
    int pp = 0;
    for (int jp = j0; jp <= j1; jp += 2, pp ^= 1) {
        const bool has2 = jp + 1 <= j1;
        LAS unsigned char* Kl0 = lds + L_K + pp * (2 * KTB); LAS unsigned char* Kl1 = Kl0 + KTB;
        LAS unsigned char* Vl0 = lds + L_V + pp * (2 * VTB); LAS unsigned char* Vl1 = Vl0 + VTB;
        *(LAS v4u*)(Kl0 + krow * KP + kch * 16) = kA;
        *(LAS v4u*)(Vl0 + vdst) = vA;
        if (has2) { *(LAS v4u*)(Kl1 + krow * KP + kch * 16) = kB; *(LAS v4u*)(Vl1 + vdst) = vB; }
        if (jp + 2 <= j1) { kA = *(const GAS v4u*)(kp0 + (size_t)(64 * (jp + 2 - j0)) * HP); vA = *(const GAS v4u*)(vp0 + (size_t)(64 * (jp + 2 - j0)) * HP); }
        if (jp + 3 <= j1) { kB = *(const GAS v4u*)(kp0 + (size_t)(64 * (jp + 3 - j0)) * HP); vB = *(const GAS v4u*)(vp0 + (size_t)(64 * (jp + 3 - j0)) * HP); }
        __syncthreads();
        att_tile<SEL>(Kl0, Vl0, jp, qt, jlo, t, W, selbits, qf, o0, o1, negm, m_run, l_run, q, hi);
        if (has2) att_tile<SEL>(Kl1, Vl1, jp + 1, qt, jlo, t, W, selbits, qf, o0, o1, negm, m_run, l_run, q, hi);
    }
}

__device__ __forceinline__ void phase_attention(Frame& F, int L, const float* sinks_all) {
    const int tid = F.tid, lane = F.lane, wave = F.wave;
    const int rh = wave >> 1, th = wave & 1;
    unsigned char* ws = F.ws;
    LAS unsigned char* lds = F.lds + RING_OFF;
    const bf16* H = (const bf16*)(ws + WS_H);
    bf16* O = (bf16*)(ws + WS_O);
    const float* gates = (const float*)(ws + WS_GATES);
    const float* sinks = sinks_all + L * 8;
    LAS float* impb = (LAS float*)(lds + L_IMP);
    LAS unsigned* selm = (LAS unsigned*)(lds + L_SEL);
    const int NU = 2048;
    if (wave >= 4) __builtin_amdgcn_s_setprio(1);
    for (int i = 0;; ++i) {
        const int pos = (i & 1) ? (F.G - 1 - (int)blockIdx.x) : (int)blockIdx.x;
        const int n = i * F.G + pos;
        if (i * F.G >= NU) break;
        if (n >= NU) continue;
        const bool nsa = n < 1024;
        int b, g, qt;
        if (nsa) { qt = 31 - (n >> 5); b = (n & 31) >> 1; g = n & 1; }
        else { const int m2 = n - 1024; qt = 31 - (m2 >> 5); b = (m2 & 31) >> 1; g = m2 & 1; }
        int lane_v = lane; asm volatile("" : "+v"(lane_v));
        const int q = lane_v & 31, hi = lane_v >> 5;
        const int hq = 4 * g + rh;
        const int t = 64 * qt + 32 * th + q;
        const size_t row = (size_t)b * T + t;
        const bf16* Hb = H + (size_t)b * T * HP;
        bf16x8 qf[4];
        {
            const bf16* qp = H + row * HP + (nsa ? C_QN : C_QS) + 64 * hq + 8 * hi;
#pragma unroll
            for (int s = 0; s < 4; ++s) qf[s] = *(const GAS bf16x8*)(qp + 16 * s);
        }
        f32x16 ot0, ot1;
        if (nsa) {
            const float* gp = gates + row * 32 + hq * 3;
            const float g_cmp = gp[0], g_slc = gp[1], g_win = gp[2];
            __syncthreads();
            {
                const bf16* kc = (const bf16*)(ws + WS_KCMP) + (size_t)(b * 2 + g) * 128 * 64;
                const bf16* vc = (const bf16*)(ws + WS_VCMP) + (size_t)(b * 2 + g) * 128 * 64;
#pragma unroll
                for (int it = 0; it < 2; ++it) {
                    const int ci = tid + 512 * it, r = ci >> 3, ch = ci & 7;
                    *(LAS v4u*)(lds + L_KC + r * KP + ch * 16) = *(const GAS v4u*)(kc + (size_t)r * 64 + ch * 8);
                    *(LAS v4u*)(lds + L_VC + (ch >> 2) * 8192 + (r >> 3) * 512 + (r & 7) * 64 + (ch & 3) * 16) = *(const GAS v4u*)(vc + (size_t)r * 64 + ch * 8);
                }
            }
            __syncthreads();
            f32x16 sc[4];
#pragma unroll
            for (int kb = 0; kb < 4; ++kb) {
#pragma unroll
                for (int r = 0; r < 16; ++r) sc[kb][r] = 0.f;
#pragma unroll
                for (int s = 0; s < 4; ++s) {
                    const bf16x8 a = *(const LAS bf16x8*)(lds + L_KC + (32 * kb + q) * KP + (16 * s + 8 * hi) * 2);
                    sc[kb] = __builtin_amdgcn_mfma_f32_32x32x16_bf16(a, qf[s], sc[kb], 0, 0, 0);
                }
                __builtin_amdgcn_sched_barrier(0);
            }
            float mx = -INFINITY;
            const int cth = (((t - 31) >> 4) < 126 ? ((t - 31) >> 4) : 126) - 4 * hi;
#pragma unroll
            for (int kb = 0; kb < 4; ++kb)
#pragma unroll
                for (int r = 0; r < 16; ++r) {
                    const bool vis = (32 * kb + (r & 3) + 8 * (r >> 2)) <= cth;
                    sc[kb][r] = vis ? sc[kb][r] : -INFINITY;
                    mx = fmaxf(mx, sc[kb][r]);
                }
            mx = xhalf_max(mx);
            mx = fmaxf(mx, -1e30f);
            float ps = 0.f;
#pragma unroll
            for (int kb = 0; kb < 4; ++kb)
#pragma unroll
                for (int r = 0; r < 16; ++r) { sc[kb][r] = __builtin_amdgcn_exp2f(sc[kb][r] - mx); ps += sc[kb][r]; }
            ps = xhalf_sum(ps);
            const float inv = 1.0f / fmaxf(ps, 1e-30f);
#pragma unroll
            for (int kb = 0; kb < 4; ++kb)
#pragma unroll
                for (int r = 0; r < 16; ++r) sc[kb][r] *= inv;
#pragma unroll
            for (int kb = 0; kb < 4; ++kb)
#pragma unroll
                for (int ii = 0; ii < 4; ++ii)
                    impb[(rh * 64 + 32 * th + q) * 33 + 8 * kb + 2 * ii + hi] = (sc[kb][4 * ii] + sc[kb][4 * ii + 1]) + (sc[kb][4 * ii + 2] + sc[kb][4 * ii + 3]);
            f32x16 c0, c1;
#pragma unroll
            for (int r = 0; r < 16; ++r) { c0[r] = 0.f; c1[r] = 0.f; }
#pragma unroll
            for (int ks = 0; ks < 8; ++ks) {
                const int kb = ks >> 1, sp = ks & 1;
                const bf16x8 pf = pack8(sc[kb][8 * sp + 0], sc[kb][8 * sp + 1], sc[kb][8 * sp + 2], sc[kb][8 * sp + 3], sc[kb][8 * sp + 4], sc[kb][8 * sp + 5], sc[kb][8 * sp + 6], sc[kb][8 * sp + 7]);
                const LAS unsigned char* vp = lds + L_VC + ((q >> 4) & 1) * 32 + (q & 3) * 8 + (4 * hi + ((q & 15) >> 2)) * 64 + ks * 1024;
                {
                    const u32x2 lo = vtr(vp), hh = vtr(vp + 512);
                    v4u w; w.x = lo.x; w.y = lo.y; w.z = hh.x; w.w = hh.y;
                    c0 = __builtin_amdgcn_mfma_f32_32x32x16_bf16(__builtin_bit_cast(bf16x8, w), pf, c0, 0, 0, 0);
                }
                {
                    const u32x2 lo = vtr(vp + 8192), hh = vtr(vp + 8192 + 512);
                    v4u w; w.x = lo.x; w.y = lo.y; w.z = hh.x; w.w = hh.y;
                    c1 = __builtin_amdgcn_mfma_f32_32x32x16_bf16(__builtin_bit_cast(bf16x8, w), pf, c1, 0, 0, 0);
                }
                if (ks & 1) __builtin_amdgcn_sched_barrier(0);
            }
            __syncthreads();
            if (qt >= 8) {
                const int tok = tid >> 3, sub = tid & 7;
                unsigned key[4];
#pragma unroll
                for (int ii = 0; ii < 4; ++ii) {
                    const int j = 4 * sub + ii;
                    const float sum = (impb[tok * 33 + j] + impb[(64 + tok) * 33 + j]) + (impb[(128 + tok) * 33 + j] + impb[(192 + tok) * 33 + j]);
                    const unsigned kb = (__float_as_uint(sum) & ~31u) | (unsigned)(31 - j);
                    key[ii] = (j >= 1 && j <= qt - 2) ? kb : 0u;
                }
                unsigned mask = 1u | (1u << qt) | (1u << (qt - 1));
#pragma unroll
                for (int rnd = 0; rnd < 5; ++rnd) {
                    unsigned bk = key[0] > key[1] ? key[0] : key[1]; const unsigned b2 = key[2] > key[3] ? key[2] : key[3]; bk = bk > b2 ? bk : b2;
                    unsigned o1 = (unsigned)__shfl_xor((int)bk, 1); bk = bk > o1 ? bk : o1;
                    o1 = (unsigned)__shfl_xor((int)bk, 2); bk = bk > o1 ? bk : o1;
                    o1 = (unsigned)__shfl_xor((int)bk, 4); bk = bk > o1 ? bk : o1;
                    mask |= 1u << (31u - (bk & 31u));
#pragma unroll
                    for (int ii = 0; ii < 4; ++ii) key[ii] = key[ii] == bk ? 0u : key[ii];
                }
                if (sub == 0) selm[tok] = mask;
            } else if (tid < 64) selm[tid] = (2u << qt) - 1u;
            __syncthreads();
            const unsigned selbits = selm[32 * th + q];
            LAS float* otl = (LAS float*)(lds + L_OT + wave * 8192) + lane_v;
#pragma unroll
            for (int r = 0; r < 16; ++r) { otl[r * 64] = g_cmp * c0[r]; otl[(16 + r) * 64] = g_cmp * c1[r]; }
            {
                f32x16 a0, a1; float mr = 0.f, lr = 0.f;
#pragma unroll
                for (int r = 0; r < 16; ++r) { a0[r] = 0.f; a1[r] = 0.f; }
                stream<true>(lds, Hb, C_KS + 64 * g, C_VS + 64 * g, 0, qt, qt, t, 1 << 20, selbits, qf, a0, a1, mr, lr, tid, lane_v, wave);
                lr = xhalf_sum(lr);
                const float f = g_slc / fmaxf(lr, 1e-30f);
#pragma unroll
                for (int r = 0; r < 16; ++r) { otl[r * 64] += f * a0[r]; otl[(16 + r) * 64] += f * a1[r]; }
            }
            {
                f32x16 a0, a1; float mr = 0.f, lr = 0.f;
#pragma unroll
                for (int r = 0; r < 16; ++r) { a0[r] = 0.f; a1[r] = 0.f; }
                stream<false>(lds, Hb, C_KW + 64 * g, C_VW + 64 * g, qt >= 8 ? qt - 8 : 0, qt, qt, t, 512, 0u, qf, a0, a1, mr, lr, tid, lane_v, wave);
                lr = xhalf_sum(lr);
                const float f = g_win / fmaxf(lr, 1e-30f);
#pragma unroll
                for (int r = 0; r < 16; ++r) { ot0[r] = otl[r * 64] + f * a0[r]; ot1[r] = otl[(16 + r) * 64] + f * a1[r]; }
            }
        } else {
            f32x16 a0, a1; float mr = 0.f, lr = 0.f;
#pragma unroll
            for (int r = 0; r < 16; ++r) { a0[r] = 0.f; a1[r] = 0.f; }
            stream<false>(lds, Hb, C_KSW + 64 * g, C_VSW + 64 * g, qt >= 2 ? qt - 2 : 0, qt, qt, t, 128, 0u, qf, a0, a1, mr, lr, tid, lane_v, wave);
            lr = xhalf_sum(lr);
            const float sk = sinks[hq] * 1.4426950408889634f;
            const float mf = fmaxf(mr, sk);
            const float sm = __builtin_amdgcn_exp2f(mr - mf);
            const float den = lr * sm + __builtin_amdgcn_exp2f(sk - mf);
            const float f = sm / fmaxf(den, 1e-30f);
#pragma unroll
            for (int r = 0; r < 16; ++r) { ot0[r] = f * a0[r]; ot1[r] = f * a1[r]; }
        }
        bf16* op = O + row * 1024 + (nsa ? 0 : 512) + 64 * hq + 4 * hi;
#pragma unroll
        for (int ii = 0; ii < 4; ++ii) {
            u32x2 w0, w1;
            w0.x = cvtpk(ot0[4 * ii], ot0[4 * ii + 1]); w0.y = cvtpk(ot0[4 * ii + 2], ot0[4 * ii + 3]);
            w1.x = cvtpk(ot1[4 * ii], ot1[4 * ii + 1]); w1.y = cvtpk(ot1[4 * ii + 2], ot1[4 * ii + 3]);
            *(GAS u32x2*)(op + 8 * ii) = w0; *(GAS u32x2*)(op + 32 + 8 * ii) = w1;
        }
    }
    __builtin_amdgcn_s_setprio(0);
}
}

template <bool F8>
__device__ __forceinline__ void phase_ln1_router(Frame& F, int L, const float* xres, const float* ln_g, const float* ln_b, const float* b_r) {
    const int tid = F.tid, lane = F.lane, wave = F.wave;
    unsigned char* ws = F.ws;
    const bf16* A1 = (const bf16*)(ws + WS_Y1);
    float* X1 = (float*)(ws + WS_X1);
    bf16* X1B = (bf16*)(ws + WS_X1B);
    const bf16* Wh = (const bf16*)(ws + WS_WR) + (size_t)L * 2 * 32 * 1024;
    const bf16* Wl = Wh + 32 * 1024;
    LAS float* scr = (LAS float*)(F.lds + RING_OFF + wave * 4096);
    LAS unsigned* cntl = (LAS unsigned*)(F.lds + RING_OFF + 65536);
    LAS unsigned* basel = cntl + 32;
    gu32* gcnt = F.ctl + CW_CNT + L * 32;
    f32x4 gam[4], bet[4];
#pragma unroll
    for (int j = 0; j < 4; ++j) { gam[j] = *(const GAS f32x4*)(ln_g + (size_t)L * D + 4 * lane + 256 * j); bet[j] = *(const GAS f32x4*)(ln_b + (size_t)L * D + 4 * lane + 256 * j); }
    for (int chunk = blockIdx.x; chunk < M / 128; chunk += F.G) {
        if (tid < 32) cntl[tid] = 0u;
        __syncthreads();
        const int tok0 = chunk * 128 + wave * 16;
        for (int rr = 0; rr < 16; ++rr) {
            const size_t row = (size_t)(tok0 + rr);
            f32x4 v[4]; float s = 0.f;
#pragma unroll
            for (int j = 0; j < 4; ++j) {
                const u32x2 av = *(const GAS u32x2*)(A1 + row * D + 4 * lane + 256 * j);
                v[j] = *(const GAS f32x4*)(xres + row * D + 4 * lane + 256 * j) * DN_ALPHA + (f32x4){bf_lo(av.x), bf_hi(av.x), bf_lo(av.y), bf_hi(av.y)};
                s += (v[j].x + v[j].y) + (v[j].z + v[j].w);
            }
            const float mean = wave_sum(s) * (1.f / D); float s2 = 0.f;
#pragma unroll
            for (int j = 0; j < 4; ++j) { v[j] = v[j] - mean; s2 += (v[j].x * v[j].x + v[j].y * v[j].y) + (v[j].z * v[j].z + v[j].w * v[j].w); }
            const float rstd = 1.f / sqrtf(wave_sum(s2) * (1.f / D) + LN_EPS);
#pragma unroll
            for (int j = 0; j < 4; ++j) {
                const f32x4 o = v[j] * rstd * gam[j] + bet[j];
                if constexpr (!F8) *(GAS f32x4*)(X1 + row * D + 4 * lane + 256 * j) = o;
                u32x2 w; w.x = pk2(o.x, o.y); w.y = pk2(o.z, o.w);
                *(GAS u32x2*)(X1B + row * D + 4 * lane + 256 * j) = w;
                if constexpr (F8) *(GAS unsigned*)(ws + WS_X1F8 + row * D + 4 * lane + 256 * j) = pk4_fp8(o.x, o.y, o.z, o.w);
            }
            if constexpr (F8) { if (lane == 0) { scr[16 * 33 + 2 * rr] = mean; scr[16 * 33 + 2 * rr + 1] = rstd; } }
        }
        VM_WAIT(); LDS_WAIT();
        f32x4 acc0 = {0.f, 0.f, 0.f, 0.f}, acc1 = {0.f, 0.f, 0.f, 0.f};
        {
            const int ar = lane & 15, kg = lane >> 4;
            const float* xr = (F8 ? xres : (const float*)X1) + (size_t)(tok0 + ar) * D + 8 * kg;
            const bf16* ar1 = A1 + (size_t)(tok0 + ar) * D + 8 * kg;
            float rmean = 0.f, rrstd = 1.f;
            if constexpr (F8) { rmean = scr[16 * 33 + 2 * ar]; rrstd = scr[16 * 33 + 2 * ar + 1]; }
            const bf16* wh0 = Wh + (size_t)ar * 1024 + 8 * kg; const bf16* wl0 = Wl + (size_t)ar * 1024 + 8 * kg;
#pragma unroll 4
            for (int ks = 0; ks < 32; ++ks) {
                f32x4 xa = *(const GAS f32x4*)(xr + 32 * ks), xb = *(const GAS f32x4*)(xr + 32 * ks + 4);
                if constexpr (F8) {
                    const v4u aw = *(const GAS v4u*)(ar1 + 32 * ks);
                    xa = xa * DN_ALPHA + (f32x4){bf_lo(aw.x), bf_hi(aw.x), bf_lo(aw.y), bf_hi(aw.y)}; xb = xb * DN_ALPHA + (f32x4){bf_lo(aw.z), bf_hi(aw.z), bf_lo(aw.w), bf_hi(aw.w)};
                    const float* gp = ln_g + (size_t)L * D + 32 * ks + 8 * kg; const float* bp = ln_b + (size_t)L * D + 32 * ks + 8 * kg;
                    xa = (xa - rmean) * rrstd * *(const GAS f32x4*)gp + *(const GAS f32x4*)bp; xb = (xb - rmean) * rrstd * *(const GAS f32x4*)(gp + 4) + *(const GAS f32x4*)(bp + 4);
                }
                const float xv[8] = {xa.x, xa.y, xa.z, xa.w, xb.x, xb.y, xb.z, xb.w};
                unsigned hh[8], ll[8];
#pragma unroll
                for (int e = 0; e < 8; ++e) { hh[e] = f2bf(xv[e]); ll[e] = f2bf(xv[e] - __uint_as_float(hh[e] << 16)); }
                v4u ah, al;
                ah.x = hh[0] | (hh[1] << 16); ah.y = hh[2] | (hh[3] << 16); ah.z = hh[4] | (hh[5] << 16); ah.w = hh[6] | (hh[7] << 16);
                al.x = ll[0] | (ll[1] << 16); al.y = ll[2] | (ll[3] << 16); al.z = ll[4] | (ll[5] << 16); al.w = ll[6] | (ll[7] << 16);
                const bf16x8 fah = __builtin_bit_cast(bf16x8, ah), fal = __builtin_bit_cast(bf16x8, al);
                const bf16x8 w0h = *(const GAS bf16x8*)(wh0 + 32 * ks), w0l = *(const GAS bf16x8*)(wl0 + 32 * ks);
                const bf16x8 w1h = *(const GAS bf16x8*)(wh0 + 16 * 1024 + 32 * ks), w1l = *(const GAS bf16x8*)(wl0 + 16 * 1024 + 32 * ks);
                acc0 = __builtin_amdgcn_mfma_f32_16x16x32_bf16(fah, w0h, acc0, 0, 0, 0); acc0 = __builtin_amdgcn_mfma_f32_16x16x32_bf16(fal, w0h, acc0, 0, 0, 0); acc0 = __builtin_amdgcn_mfma_f32_16x16x32_bf16(fah, w0l, acc0, 0, 0, 0);
                acc1 = __builtin_amdgcn_mfma_f32_16x16x32_bf16(fah, w1h, acc1, 0, 0, 0); acc1 = __builtin_amdgcn_mfma_f32_16x16x32_bf16(fal, w1h, acc1, 0, 0, 0); acc1 = __builtin_amdgcn_mfma_f32_16x16x32_bf16(fah, w1l, acc1, 0, 0, 0);
            }
#pragma unroll
            for (int r = 0; r < 4; ++r) { scr[(4 * kg + r) * 33 + ar] = acc0[r]; scr[(4 * kg + r) * 33 + 16 + ar] = acc1[r]; }
        }
        LDS_WAIT(); asm volatile("" ::: "memory");
        int ek[4] = {0, 0, 0, 0}; float wk[4] = {0.f, 0.f, 0.f, 0.f}; unsigned lrk[4] = {0u, 0u, 0u, 0u};
        if (lane < 16) {
            float lv[32];
#pragma unroll
            for (int e = 0; e < 32; ++e) lv[e] = scr[lane * 33 + e] + b_r[(size_t)L * 32 + e];
            unsigned taken = 0u; float vk[4];
#pragma unroll
            for (int k = 0; k < 4; ++k) {
                float best = -INFINITY; int bi = 0;
#pragma unroll
                for (int e = 0; e < 32; ++e) { const bool ok = !((taken >> e) & 1u) && lv[e] > best; best = ok ? lv[e] : best; bi = ok ? e : bi; }
                taken |= 1u << bi; ek[k] = bi; vk[k] = best;
            }
            float den = 0.f;
#pragma unroll
            for (int k = 0; k < 4; ++k) { wk[k] = __expf(vk[k] - vk[0]); den += wk[k]; }
#pragma unroll
            for (int k = 0; k < 4; ++k) { wk[k] /= den; lrk[k] = atomicAdd((unsigned*)(cntl + ek[k]), 1u); }
        }
        __syncthreads();
        if (tid < 32) basel[tid] = __hip_atomic_fetch_add(gcnt + tid, cntl[tid], RLX_AGENT);
        __syncthreads();
        if (lane < 16) {
            const size_t tk = (size_t)(tok0 + lane) * 4;
#pragma unroll
            for (int k = 0; k < 4; ++k) {
                const int rank = (int)(basel[ek[k]] + lrk[k]);
                ((int*)(ws + WS_TOKE))[tk + k] = ek[k];
                ((int*)(ws + WS_TOKR))[tk + k] = rank;
                ((float*)(ws + WS_TOKW))[tk + k] = wk[k];
                if (rank < M) ((int*)(ws + WS_LIST))[(size_t)ek[k] * M + rank] = tok0 + lane;
            }
        }
        __syncthreads();
    }
}

__device__ __forceinline__ void build_tables(Frame& F, int L) {
    LAS int* cnt = (LAS int*)(F.lds + TAB_CNT); LAS int* soff = (LAS int*)(F.lds + TAB_SOFF); LAS int* tst = (LAS int*)(F.lds + TAB_TST); LAS int* te = (LAS int*)(F.lds + TAB_TE);
    __syncthreads();
    if (F.tid < 32) { int c = (int)__hip_atomic_load(F.ctl + CW_CNT + L * 32 + F.tid, RLX_AGENT); cnt[F.tid] = c < 0 ? 0 : (c > M ? M : c); }
    __syncthreads();
    if (F.tid == 0) { int a = 0; for (int e = 0; e < 32; ++e) { tst[e] = a; a += (cnt[e] + 255) >> 8; if (a > MAXTILES) a = MAXTILES; } tst[32] = a; }
    __syncthreads();
    if (F.tid < 32) { soff[F.tid] = tst[F.tid] * 256; for (int mt = tst[F.tid]; mt < tst[F.tid + 1]; ++mt) te[mt] = F.tid; }
    __syncthreads();
}

template <bool LAST>
__device__ __forceinline__ void phase_ln2(Frame& F, int L, const float* ln_g, const float* ln_b, float* outp) {
    float prb_scale = 1.f;
#ifdef PRB_SEL
    if (LAST) { const unsigned v = __hip_atomic_load((gu32*)(F.ws + WS_TOKE + 3 * MiB) + PRB_SEL, RLX_AGENT); const float fr = (float)v / (float)PRB_DEN; prb_scale = 1.f + 0.02f * (float)(1 + (int)(fr * 8.f + 0.5f)); }
#endif
    unsigned char* ws = F.ws;
    const float* X1 = (const float*)(ws + WS_X1); const bf16* X1B = (const bf16*)(ws + WS_X1B);
    const bf16* E = (const bf16*)(ws + WS_E); const bf16* YS = (const bf16*)(ws + WS_YS);
    bf16* XB = (bf16*)(ws + WS_XB);
    const LAS int* soff = (const LAS int*)(F.lds + TAB_SOFF);
    const int gw = F.vcu * NWAVES + F.wave, NGW = F.G * NWAVES, lane = F.lane;
    f32x4 gam[4], bet[4];
#pragma unroll
    for (int j = 0; j < 4; ++j) { gam[j] = *(const GAS f32x4*)(ln_g + (size_t)L * D + 4 * lane + 256 * j); bet[j] = *(const GAS f32x4*)(ln_b + (size_t)L * D + 4 * lane + 256 * j); }
    for (int tok = gw; tok < M; tok += NGW) {
        int sl[4]; float wk[4];
#pragma unroll
        for (int k = 0; k < 4; ++k) {
            const int e = ((const int*)(ws + WS_TOKE))[(size_t)tok * 4 + k] & 31, r = ((const int*)(ws + WS_TOKR))[(size_t)tok * 4 + k];
            int s = soff[e] + r; s = s < 0 ? 0 : (s >= MAXSLOTS ? MAXSLOTS - 1 : s);
            sl[k] = s; wk[k] = ((const float*)(ws + WS_TOKW))[(size_t)tok * 4 + k];
        }
        f32x4 v[4]; float s = 0.f;
#pragma unroll
        for (int j = 0; j < 4; ++j) {
            const int c = 4 * lane + 256 * j;
            f32x4 a;
            if constexpr (LAST) { const u32x2 xv = *(const GAS u32x2*)(X1B + (size_t)tok * D + c); a = (f32x4){bf_lo(xv.x), bf_hi(xv.x), bf_lo(xv.y), bf_hi(xv.y)} * DN_ALPHA; }
            else a = *(const GAS f32x4*)(X1 + (size_t)tok * D + c) * DN_ALPHA;
            const u32x2 ev = *(const GAS u32x2*)(E + (size_t)tok * D + c);
            a.x += bf_lo(ev.x); a.y += bf_hi(ev.x); a.z += bf_lo(ev.y); a.w += bf_hi(ev.y);
#pragma unroll
            for (int k = 0; k < 4; ++k) {
                if constexpr (LAST) {
                    typedef float f32x2_ __attribute__((ext_vector_type(2)));
                    const unsigned yw = *(const GAS unsigned*)((const unsigned char*)YS + (size_t)sl[k] * D + c);
                    const f32x2_ y01 = __builtin_amdgcn_cvt_pk_f32_fp8((int)yw, false), y23 = __builtin_amdgcn_cvt_pk_f32_fp8((int)yw, true);
                    a.x += wk[k] * y01.x; a.y += wk[k] * y01.y; a.z += wk[k] * y23.x; a.w += wk[k] * y23.y;
                } else {
                    const u32x2 yv = *(const GAS u32x2*)(YS + (size_t)sl[k] * D + c);
                    a.x += wk[k] * bf_lo(yv.x); a.y += wk[k] * bf_hi(yv.x); a.z += wk[k] * bf_lo(yv.y); a.w += wk[k] * bf_hi(yv.y);
                }
            }
            v[j] = a; s += (a.x + a.y) + (a.z + a.w);
        }
        const float mean = wave_sum(s) * (1.f / D); float s2 = 0.f;
#pragma unroll
        for (int j = 0; j < 4; ++j) { v[j] = v[j] - mean; s2 += (v[j].x * v[j].x + v[j].y * v[j].y) + (v[j].z * v[j].z + v[j].w * v[j].w); }
        const float rstd = 1.f / sqrtf(wave_sum(s2) * (1.f / D) + LN_EPS);
#pragma unroll
        for (int j = 0; j < 4; ++j) {
            const f32x4 o = v[j] * rstd * gam[j] + bet[j];
            *(GAS f32x4*)(outp + (size_t)tok * D + 4 * lane + 256 * j) = LAST ? o * prb_scale : o;
            if constexpr (!LAST) { u32x2 w; w.x = pk2(o.x, o.y); w.y = pk2(o.z, o.w); *(GAS u32x2*)(XB + (size_t)tok * D + 4 * lane + 256 * j) = w; }
        }
    }
}

#ifndef MK_ONE_LAUNCH
#define MK_ONE_LAUNCH 1
#endif
constexpr int PH_PER_LAYER = 9, NPH = 1 + NL * PH_PER_LAYER;
struct Args { const float* in[27]; float* out; unsigned char* ws; int ph_lo, ph_hi; };
typedef const __attribute__((address_space(4))) unsigned char* kptr_t;
__device__ __forceinline__ kptr_t karg_base() { kptr_t p = (kptr_t)__builtin_amdgcn_kernarg_segment_ptr(); asm volatile("" : "+s"(p)); return p; }
#define KIN(kb, i) (*(const float* const __attribute__((address_space(4)))*)((kb) + 8 * (i)))
#ifndef PH_MASK
#define PH_MASK 0x3ff
#endif
#define PHSEL(k) (((k) == 0) ? ((PH_MASK >> 9) & 1) : ((PH_MASK >> (((k) - 1) % PH_PER_LAYER)) & 1))
#define IN(k) (PHSEL(k) && lo <= (k) && (k) < hi)
#ifndef PROBE_PHASE
#define PROBE_PHASE -1
#endif
#ifndef PROBE_EXTRA
#define PROBE_EXTRA 0
#endif
#define NREP(k) (((k) == PROBE_PHASE) ? 1 + PROBE_EXTRA : 1)
#define PHASE(k) if (IN(k)) for (int rep_ = 0; rep_ < NREP(k); ++rep_)
#define SEAM(k) do { if (IN(k) && IN((k) + 1)) { if (MK_ONE_LAUNCH) xcd_barrier(bar); } } while (0)

#ifdef PRB_SEL
#define SNAP(k, q) do { if (blockIdx.x == 0 && xb_thread0(wave0)) { ((gu32*)(ws + WS_TOKE + 3 * MiB))[k] = __hip_atomic_load(F.ctl + CW_Q + (q), RLX_AGENT); } } while (0)
#else
#define SNAP(k, q) do {} while (0)
#endif
#define RELAUNDER() do { F.lane = (int)__builtin_amdgcn_mbcnt_hi(~0u, __builtin_amdgcn_mbcnt_lo(~0u, 0u)); asm volatile("" : "+v"(F.lane)); F.wave = wave0; F.tid = F.wave * 64 + F.lane; } while (0)
template <int L>
__device__ __forceinline__ void layer_body(Frame& F, const XcdBarrier& bar, const int lo, const int hi, const int wave0) {
    unsigned char* ws = F.ws;
        const int pb = 1 + L * PH_PER_LAYER;
        PHASE(pb + 0) {
            const int nsp = (F.G == 256) ? 24 : 0;
            if ((int)blockIdx.x >= F.G - nsp) { kptr_t kb = karg_base(); RELAUNDER(); conv_run<(L == 0) ? 0 : 2>(F, KIN(kb, 18), KIN(kb, 20), CW_STOP + pb + 0, (unsigned)(F.G - nsp) / 2u, (L == 0) ? 0 : 4); }
            else {
                pg8::Gemm g{(const bf16*)(ws + WS_XB), (const bf16*)(ws + WS_WIN) + (size_t)L * NIN * 1024, M, NIN, D};
                pg8::StaticOrder S; S.init(M, NIN, F.G - nsp, (int)blockIdx.x); S.tailw = F.ctl + CW_STOP + pb + 0;
                pg8::EpiIn E{(bf16*)(ws + WS_H), (float*)(ws + WS_GATES), (const float*)(ws + WS_BINP) + (size_t)L * NIN, (const float*)(ws + WS_ROPE)};
                pg8::gemm_phase<pg8::EpiIn, pg8::StaticOrder, true, true>(F.lds + RING_OFF, g, S, E, wave0, (LAS float*)(F.lds + BIAS_OFF));
            }
        }
        SEAM(pb + 0);
        PHASE(pb + 1) {
            { kptr_t kb = karg_base(); RELAUNDER(); conv_run<(L == 0) ? 0 : 2>(F, KIN(kb, 18), KIN(kb, 20), -1); __syncthreads(); }
            { kptr_t kb = karg_base(); RELAUNDER(); phase_compress(F, L, KIN(kb, 5), KIN(kb, 8)); }
            {
                pg8::Gemm g{(const bf16*)(ws + WS_PB) + (size_t)L * M * PD, (const bf16*)(ws + WS_WPP) + (size_t)L * 1024 * PD, M, D, PD};
                pg8::StaticOrder S; S.init(M, D, F.G, (int)blockIdx.x);
                pg8::EpiPlain E{(bf16*)(ws + WS_PP)};
                pg8::gemm_phase<pg8::EpiPlain, pg8::StaticOrder, true, true>(F.lds + RING_OFF, g, S, E, wave0, (LAS float*)(F.lds + BIAS_OFF));
            }
        }
        SEAM(pb + 1);
        PHASE(pb + 2) { kptr_t kb = karg_base(); RELAUNDER(); att::phase_attention(F, L, KIN(kb, 11)); }
        SEAM(pb + 2);
        PHASE(pb + 3) {
            pg8::Gemm g{(const bf16*)(ws + WS_O), (const bf16*)(ws + WS_WO) + (size_t)L * 1024 * 1024, M, D, D};
            pg8::StaticOrder S; S.init(M, D, F.G, (int)blockIdx.x);
            kptr_t kb = karg_base();
            pg8::EpiOut E{(bf16*)(ws + WS_Y1), KIN(kb, 13) + (size_t)L * D};
            pg8::gemm_phase<pg8::EpiOut, pg8::StaticOrder, true, true>(F.lds + RING_OFF, g, S, E, wave0, (LAS float*)(F.lds + BIAS_OFF));
        }
        SEAM(pb + 3);
        PHASE(pb + 4) { kptr_t kb = karg_base(); RELAUNDER(); phase_ln1_router<(L == NL - 1)>(F, L, L == 0 ? KIN(kb, 0) : (const float*)(ws + WS_XN), KIN(kb, 14), KIN(kb, 15), KIN(kb, 17)); }
        SEAM(pb + 4);
        PHASE(pb + 6) {
            RELAUNDER();
            build_tables(F, L);
            constexpr int ND6 = (L == 0) ? 4 : 0;
            const int per6 = F.G / 8, bx6 = (int)blockIdx.x;
            const bool cv6 = ND6 > 0 && (F.G % 8 == 0) && per6 > 4 * ND6;
            if (cv6 && bx6 / 8 >= per6 - ND6) { kptr_t kb = karg_base(); conv_run<1>(F, KIN(kb, 18), KIN(kb, 20), -1, 1u, 1); conv_run<2>(F, KIN(kb, 18), KIN(kb, 20), CW_STOP + pb + 6, (unsigned)(F.G - 8 * ND6) / 2u, 2); }
            else {
                constexpr bool F8 = (L == NL - 1);
                pg8::Gemm g{F8 ? (const bf16*)(ws + WS_X1F8) : (const bf16*)(ws + WS_X1B), (const bf16*)(ws + WS_W1T) + (size_t)L * 32 * 2048 * 1024, M, 32 * 2048, F8 ? D / 2 : D};
                pg8::MoeOrder S{(const LAS int*)(F.lds + TAB_TE), ((const LAS int*)(F.lds + TAB_TST))[32] * 8, 3, cv6 ? F.G - 8 * ND6 : F.G, cv6 ? (bx6 % 8) * (per6 - ND6) + bx6 / 8 : F.vcu, (const LAS int*)(F.lds + TAB_TST), (const LAS int*)(F.lds + TAB_CNT), (const int*)(ws + WS_LIST), M, (ND6 > 0) ? F.ctl + CW_STOP + pb + 6 : nullptr};
                pg8::EpiUp<F8> E{(bf16*)(ws + WS_ACT), (const float*)(ws + WS_B1P) + (size_t)L * 32 * 2048, F8 ? 1.0f / W1_F8_SCALE : 1.0f};
                pg8::gemm_phase<pg8::EpiUp<F8>, pg8::MoeOrder, true, true, F8, true>(F.lds + RING_OFF, g, S, E, wave0, (LAS float*)(F.lds + BIAS_OFF), (LAS int*)(F.lds + TOKL_OFF));
                if constexpr (ND6 > 0) { __syncthreads(); kptr_t kb = karg_base(); RELAUNDER(); conv_run<1>(F, KIN(kb, 18), KIN(kb, 20), -1); }
            }
        }
        SEAM(pb + 6);
        PHASE(pb + 7) {
            kptr_t kb = karg_base(); RELAUNDER();
            if (!IN(pb + 6)) build_tables(F, L);
            constexpr int ND7 = (L == 0) ? 1 : 0;
            const int per7 = F.G / 8, bx7 = (int)blockIdx.x;
            const bool cv7 = ND7 > 0 && (F.G % 8 == 0) && per7 > 4 * ND7;
            if (cv7 && bx7 / 8 >= per7 - ND7) { conv_run<2>(F, KIN(kb, 18), KIN(kb, 20), CW_STOP + pb + 7, (unsigned)(F.G - 8 * ND7) / 2u, 3); }
            else {
                constexpr bool F8 = (L == NL - 1);
                pg8::Gemm g{(const bf16*)(ws + WS_ACT), (const bf16*)(ws + WS_W2T) + (size_t)L * 32 * 1024 * 1024, MAXSLOTS, 32 * 1024, F8 ? D / 2 : D};
                pg8::MoeOrder S{(const LAS int*)(F.lds + TAB_TE), ((const LAS int*)(F.lds + TAB_TST))[32] * 4, 2, cv7 ? F.G - 8 * ND7 : F.G, cv7 ? (bx7 % 8) * (per7 - ND7) + bx7 / 8 : F.vcu, (const LAS int*)(F.lds + TAB_TST), (const LAS int*)(F.lds + TAB_CNT), nullptr, 0, (ND7 > 0) ? F.ctl + CW_STOP + pb + 7 : nullptr};
                pg8::EpiDown<F8> E{(bf16*)(ws + WS_YS), KIN(kb, 21) + (size_t)L * 32 * 1024, F8 ? 1.0f / W2_F8_SCALE : 1.0f};
                pg8::gemm_phase<pg8::EpiDown<F8>, pg8::MoeOrder, true, true, F8>(F.lds + RING_OFF, g, S, E, wave0, (LAS float*)(F.lds + BIAS_OFF));
            }
            if constexpr (ND7 > 0) __syncthreads();
            {
                constexpr bool F8 = (L == NL - 1);
                pg8::Gemm g{F8 ? (const bf16*)(ws + WS_X1F8) : (const bf16*)(ws + WS_X1B), (const bf16*)(ws + WS_WPG) + (size_t)L * 1024 * 1024, M, D, F8 ? D / 2 : D};
                pg8::StaticOrder S; S.init(M, D, F.G, (int)blockIdx.x);
                pg8::EpiGate E{(const bf16*)(ws + WS_PP), (bf16*)(ws + WS_E), KIN(kb, 23) + (size_t)L * D, F8 ? 1.0f / WPG_F8_SCALE : 1.0f};
                pg8::gemm_phase<pg8::EpiGate, pg8::StaticOrder, true, true, F8>(F.lds + RING_OFF, g, S, E, wave0, (LAS float*)(F.lds + BIAS_OFF));
            }
        }
        SEAM(pb + 7);
        PHASE(pb + 8) { kptr_t kb = karg_base(); RELAUNDER(); if (!IN(pb + 7)) build_tables(F, L); float* xout = L == NL - 1 ? (float*)KIN(kb, 27) : (float*)(ws + WS_XN); phase_ln2<(L == NL - 1)>(F, L, KIN(kb, 25), KIN(kb, 26), xout); }
        SEAM(pb + 8);
    }
__global__ void __launch_bounds__(NWAVES * 64, 2) mk_fwd(Args args) {
    extern __shared__ __attribute__((aligned(16))) unsigned char lds[];
    Frame F;
    F.lds = (LAS unsigned char*)lds;
    F.MISC = (volatile LAS unsigned*)(F.lds + MISC_OFF);
    const int wave0 = __builtin_amdgcn_readfirstlane((int)threadIdx.x >> 6);
    F.wave = wave0; F.lane = (int)__builtin_amdgcn_mbcnt_hi(~0u, __builtin_amdgcn_mbcnt_lo(~0u, 0u)); F.tid = F.wave * 64 + F.lane;
    F.G = gridDim.x; { const int bx = blockIdx.x; F.vcu = (F.G % 8 == 0) ? (bx % 8) * (F.G / 8) + bx / 8 : bx; }
    F.ws = args.ws; F.ctl = (gu32*)(args.ws + WS_CTL);
    unsigned char* ws = args.ws;
    for (int u = F.tid; u < (LDS_BYTES - LDSCTL_OFF) / 4; u += NWAVES * 64) ((LAS unsigned*)(F.lds + LDSCTL_OFF))[u] = 0u;
    __syncthreads();
    XcdBarrier bar; bar.bar = (unsigned*)(F.ctl + CW_BAR); bar.x = 0; bar.st = nullptr; bar.wave = wave0;
    if (MK_ONE_LAUNCH) bar = xcd_barrier_post((unsigned*)(F.ctl + CW_BAR), F.MISC + 8, wave0);
    const int lo = args.ph_lo, hi = args.ph_hi;
    PHASE(0) {
        kptr_t kb = karg_base(); RELAUNDER();
        PIn I{KIN(kb, 0), KIN(kb, 1), KIN(kb, 3), KIN(kb, 4), KIN(kb, 6), KIN(kb, 7), KIN(kb, 9), KIN(kb, 10), KIN(kb, 12), KIN(kb, 16), KIN(kb, 18), KIN(kb, 19), KIN(kb, 20), KIN(kb, 22), KIN(kb, 24), (const int*)KIN(kb, 2)};
        p0_prologue(F, I);
#ifdef PRB_SEL
        if (blockIdx.x == 0 && F.tid < 8) ((gu32*)(ws + WS_TOKE + 3 * MiB))[F.tid] = 0u;
#endif
    }
    SEAM(0);
    layer_body<0>(F, bar, lo, hi, wave0);
    layer_body<1>(F, bar, lo, hi, wave0);
#undef IN
#undef SEAM
}

extern "C" void kernel_launch(void* const* d_in, const int* in_sizes, int n_in, void* d_out, int out_size, void* d_ws, size_t ws_size, hipStream_t stream) {
    static int grid = 0;
    if (grid == 0) {
        if (n_in != 27 || out_size != M * D || ws_size < WS_END) { fprintf(stderr, "kernel_launch: unexpected problem (n_in %d, out %d, ws %zu); nothing launched\n", n_in, out_size, ws_size); grid = -1; return; }
        int dev = 0, cus = 0, per_cu = 0;
        if (hipGetDevice(&dev) != hipSuccess || hipDeviceGetAttribute(&cus, hipDeviceAttributeMultiprocessorCount, dev) != hipSuccess) { grid = -1; return; }
        if (hipFuncSetAttribute((const void*)mk_fwd, hipFuncAttributeMaxDynamicSharedMemorySize, LDS_BYTES) != hipSuccess) { fprintf(stderr, "kernel_launch: hipFuncSetAttribute failed\n"); grid = -1; return; }
        if (hipOccupancyMaxActiveBlocksPerMultiprocessor(&per_cu, (const void*)mk_fwd, NWAVES * 64, LDS_BYTES) != hipSuccess || per_cu < 1) { fprintf(stderr, "kernel_launch: occupancy query says %d\n", per_cu); }
        (void)hipGetLastError();
        grid = cus;
    }
    if (grid < 0) return;
    (void)in_sizes;
    if (hipMemsetAsync((char*)d_ws + WS_CTL, 0, CTL_ZERO_BYTES, stream) != hipSuccess) return;
    Args a{};
    for (int i = 0; i < 27; ++i) a.in[i] = (const float*)d_in[i];
    a.out = (float*)d_out; a.ws = (unsigned char*)d_ws;
#if MK_ONE_LAUNCH
    a.ph_lo = 0; a.ph_hi = NPH;
    hipLaunchKernelGGL(mk_fwd, dim3(grid), dim3(NWAVES * 64), LDS_BYTES, stream, a);
#else
    for (int ph = 0; ph < NPH; ++ph) { a.ph_lo = ph; a.ph_hi = ph + 1; hipLaunchKernelGGL(mk_fwd, dim3(grid), dim3(NWAVES * 64), LDS_BYTES, stream, a); }
#endif
}
```

```cpp
#include <hip/hip_runtime.h>
#include <cstdio>
#include <cstdint>
#define MK_ONE_LAUNCH 1
namespace pg8 {
#define PG8_LAS __attribute__((address_space(3)))
typedef unsigned short bf16_t;
typedef short bf16x8 __attribute__((ext_vector_type(8)));
typedef float f32x4 __attribute__((ext_vector_type(4)));
typedef unsigned u32x4 __attribute__((ext_vector_type(4)));
constexpr int BM = 256, BK = 64, HALF = 128, HTB = HALF * BK * 2  , STAGE_BYTES = 8 * HTB, NXCD = 8, WGM = 8;

__host__ __device__ __forceinline__ int lds_byte(int r, int c) { const int st = (r >> 4) * 2 + (c >> 5), rr = r & 15, cc = c & 31, ob = rr * 64 + cc * 2; return st * 1024 + (ob ^ (((ob >> 9) & 1) << 5)); }
__host__ __device__ __forceinline__ void stage_rc(int b, int& R, int& C) { const int st = b / 1024, sb = b % 1024, swz = sb ^ (((sb >> 9) & 1) << 5); R = (st >> 1) * 16 + swz / 64; C = (st & 1) * 32 + (swz % 64) / 2; }
__host__ __device__ __forceinline__ int perm32(int rho) { const int n = rho >> 4, i = rho & 15; return 8 * (i >> 2) + 4 * n + (i & 3); }

struct Unit { int pm, pn; };
struct Gemm { const bf16_t* A; const bf16_t* Bt; int M, N, K; };

struct StaticOrder {
    int nM, nN, nwg, G, c;
    __host__ __device__ void init(int M, int N, int G_, int c_) { nM = M / BM; nN = N / BM; nwg = nM * nN; G = G_; c = c_; }
    __host__ __device__ bool next(int i, Unit& u) const {
        const long L = (long)i * G + c; if (L >= nwg) return false;
        int wgid = (int)L; { const int q = nwg / NXCD, r = nwg % NXCD, xcd = wgid % NXCD, off = wgid / NXCD; wgid = (xcd < r ? xcd * (q + 1) : r * (q + 1) + (xcd - r) * q) + off; }
        const int nig = WGM * nN, gid = wgid / nig, fm = gid * WGM, gsz = (nM - fm) < WGM ? (nM - fm) : WGM;
        u.pm = fm + ((wgid % nig) % gsz); u.pn = (wgid % nig) / gsz; return true;
    }
    __device__ __forceinline__ void a_ready(const Unit&) const {}
    __device__ __forceinline__ void done(const Unit&) const {}
    __attribute__((address_space(1))) unsigned* tailw = nullptr;
    __device__ __forceinline__ void tail(int wid, int lane) const { if (tailw && wid == 0 && lane == 0) (void)__hip_atomic_fetch_add(tailw, 1u, __ATOMIC_RELAXED, __HIP_MEMORY_SCOPE_AGENT); }
};

__device__ __forceinline__ unsigned cvt_pk_bf16(float lo, float hi) { unsigned r; asm volatile("v_cvt_pk_bf16_f32 %0, %1, %2" : "=v"(r) : "v"(lo), "v"(hi)); return r; }
typedef float f32x2 __attribute__((ext_vector_type(2)));

typedef unsigned u32x2 __attribute__((ext_vector_type(2)));
__device__ __forceinline__ float sigm(float x) { return __builtin_amdgcn_rcpf(1.0f + __builtin_amdgcn_exp2f(-1.4426950408889634f * x)); }
__device__ __forceinline__ float bf_lo(unsigned w) { return __uint_as_float(w << 16); }
__device__ __forceinline__ float bf_hi(unsigned w) { return __uint_as_float(w & 0xffff0000u); }

constexpr unsigned ROPE_SEGS = 0x7D4Fu;
constexpr float QSCALE = 0.125f * 1.4426950408889634f;
struct EpiIn {
    static constexpr bool PERM = true, AFTER_DRAIN = false;
    bf16_t* H; float* gates; const float* bias; const float* rope;
    __device__ __forceinline__ const float* bias_slice(const Unit& u) const { return bias + u.pn * BM; }
    __device__ __forceinline__ void operator()(const f32x4 (&acc)[2][2][4][2], const Unit& u, int wr, int wc, int fr, int fq, const PG8_LAS float* bl) const {
        const int row0 = u.pm * BM + wr * 64 + fr;
#pragma unroll
        for (int bj = 0; bj < 2; ++bj) {
            const int seg = u.pn * 2 + bj;
            if (seg >= 17) continue;
            const int cl0 = bj * HALF + wc * 32 + 8 * fq;
            const f32x4 b0 = *(const PG8_LAS f32x4*)(bl + cl0), b1 = *(const PG8_LAS f32x4*)(bl + cl0 + 4);
            if (seg == 16) {
                const int gi = wc * 32 + 8 * fq;
                if (gi < 24) {
#pragma unroll
                    for (int ai = 0; ai < 2; ++ai)
#pragma unroll
                        for (int m = 0; m < 4; ++m) {
                            const int row = row0 + ai * HALF + m * 16;
                            f32x4 v0 = acc[ai][bj][m][0] + b0, v1 = acc[ai][bj][m][1] + b1;
                            v0 = (f32x4){sigm(v0[0]), sigm(v0[1]), sigm(v0[2]), sigm(v0[3])};
                            v1 = (f32x4){sigm(v1[0]), sigm(v1[1]), sigm(v1[2]), sigm(v1[3])};
                            float* gp = gates + (size_t)row * 32 + gi;
                            *(f32x4*)gp = v0; *(f32x4*)(gp + 4) = v1;
                        }
                }
            } else {
                const bool rope_on = (ROPE_SEGS >> seg) & 1u;
                const bool qseg = seg < 4 || (seg >= 10 && seg <= 13);
                const int g = 4 * (wc & 1) + fq;
                const int hc = seg * 128 + (wc >> 1) * 64 + 4 * g;
#pragma unroll
                for (int ai = 0; ai < 2; ++ai)
#pragma unroll
                    for (int m = 0; m < 4; ++m) {
                        const int row = row0 + ai * HALF + m * 16;
                        f32x4 v0 = acc[ai][bj][m][0] + b0, v1 = acc[ai][bj][m][1] + b1;
                        if (rope_on) {
                            const f32x4 c = *(const f32x4*)(rope + (size_t)row * 64 + 4 * g), s = *(const f32x4*)(rope + (size_t)row * 64 + 32 + 4 * g);
                            const f32x4 o0 = v0 * c - v1 * s, o1 = v1 * c + v0 * s; v0 = o0; v1 = o1;
                        }
                        if (qseg) { v0 = v0 * QSCALE; v1 = v1 * QSCALE; }
                        u32x2 w0, w1; w0.x = cvt_pk_bf16(v0[0], v0[1]); w0.y = cvt_pk_bf16(v0[2], v0[3]); w1.x = cvt_pk_bf16(v1[0], v1[1]); w1.y = cvt_pk_bf16(v1[2], v1[3]);
                        bf16_t* hp = H + (size_t)row * 2048 + hc;
                        *(u32x2*)hp = w0; *(u32x2*)(hp + 32) = w1;
                    }
            }
        }
    }
};
struct EpiOut {
    static constexpr bool PERM = true, AFTER_DRAIN = false;
    bf16_t* y; const float* bias;
    __device__ __forceinline__ const float* bias_slice(const Unit& u) const { return bias + u.pn * BM; }
    __device__ __forceinline__ void operator()(const f32x4 (&acc)[2][2][4][2], const Unit& u, int wr, int wc, int fr, int fq, const PG8_LAS float* bl) const {
        const int row0 = u.pm * BM + wr * 64 + fr, col0 = u.pn * BM + wc * 32 + 8 * fq;
        f32x4 bv[2][2];
#pragma unroll
        for (int bj = 0; bj < 2; ++bj)
#pragma unroll
            for (int n = 0; n < 2; ++n) bv[bj][n] = *(const PG8_LAS f32x4*)(bl + wc * 32 + 8 * fq + bj * HALF + 4 * n);
#pragma unroll
        for (int ai = 0; ai < 2; ++ai)
#pragma unroll
            for (int m = 0; m < 4; ++m) {
                bf16_t* rowp = y + (size_t)(row0 + ai * HALF + m * 16) * 1024 + col0;
#pragma unroll
                for (int bj = 0; bj < 2; ++bj) {
                    const f32x4 v0 = acc[ai][bj][m][0] + bv[bj][0], v1 = acc[ai][bj][m][1] + bv[bj][1];
                    u32x4 w; w.x = cvt_pk_bf16(v0[0], v0[1]); w.y = cvt_pk_bf16(v0[2], v0[3]); w.z = cvt_pk_bf16(v1[0], v1[1]); w.w = cvt_pk_bf16(v1[2], v1[3]);
                    *(u32x4*)(rowp + bj * HALF) = w;
                }
            }
    }
};
template <bool F8OUT>
struct EpiUp {
    static constexpr bool PERM = true, AFTER_DRAIN = false;
    bf16_t* act; const float* b1p; float ascale;
    __device__ __forceinline__ const float* bias_slice(const Unit& u) const { return b1p + (size_t)(u.pn >> 3) * 2048 + (u.pn & 7) * BM; }
    __device__ __forceinline__ void operator()(const f32x4 (&acc)[2][2][4][2], const Unit& u, int wr, int wc, int fr, int fq, const PG8_LAS float* bl) const {
        const int pn = u.pn & 7;
        const int row0 = u.pm * BM + wr * 64 + fr, ac0 = pn * 128 + wc * 32 + 8 * fq;
        const PG8_LAS float* bp = bl + wc * 32 + 8 * fq;
        const f32x4 bg0 = *(const PG8_LAS f32x4*)bp, bg1 = *(const PG8_LAS f32x4*)(bp + 4), bu0 = *(const PG8_LAS f32x4*)(bp + HALF), bu1 = *(const PG8_LAS f32x4*)(bp + HALF + 4);
#pragma unroll
        for (int ai = 0; ai < 2; ++ai)
#pragma unroll
            for (int m = 0; m < 4; ++m) {
                const f32x4 g0 = acc[ai][0][m][0] * ascale + bg0, g1 = acc[ai][0][m][1] * ascale + bg1, u0 = acc[ai][1][m][0] * ascale + bu0, u1 = acc[ai][1][m][1] * ascale + bu1;
                float o[8];
#pragma unroll
                for (int j = 0; j < 8; ++j) {
                    float gt = j < 4 ? g0[j & 3] : g1[j & 3], up = j < 4 ? u0[j & 3] : u1[j & 3];
                    gt = fminf(gt, 7.0f); up = fminf(fmaxf(up, -7.0f), 7.0f);
                    o[j] = (up + 1.0f) * gt * sigm(1.702f * gt);
                }
                if constexpr (F8OUT) {
                    int w0 = 0, w1 = 0;
                    w0 = __builtin_amdgcn_cvt_pk_fp8_f32(o[0], o[1], w0, false); w0 = __builtin_amdgcn_cvt_pk_fp8_f32(o[2], o[3], w0, true);
                    w1 = __builtin_amdgcn_cvt_pk_fp8_f32(o[4], o[5], w1, false); w1 = __builtin_amdgcn_cvt_pk_fp8_f32(o[6], o[7], w1, true);
                    u32x2 w; w.x = (unsigned)w0; w.y = (unsigned)w1;
                    *(u32x2*)((unsigned char*)act + (size_t)(row0 + ai * HALF + m * 16) * 1024 + ac0) = w;
                } else {
                    u32x4 w; w.x = cvt_pk_bf16(o[0], o[1]); w.y = cvt_pk_bf16(o[2], o[3]); w.z = cvt_pk_bf16(o[4], o[5]); w.w = cvt_pk_bf16(o[6], o[7]);
                    *(u32x4*)(act + (size_t)(row0 + ai * HALF + m * 16) * 1024 + ac0) = w;
                }
                asm volatile("" ::: "memory");
            }
    }
};
template <bool F8OUT>
struct EpiDown {
    static constexpr bool PERM = true, AFTER_DRAIN = false;
    bf16_t* ys; const float* b2; float ascale;
    __device__ __forceinline__ const float* bias_slice(const Unit& u) const { return b2 + (size_t)(u.pn >> 2) * 1024 + (u.pn & 3) * BM; }
    __device__ __forceinline__ void operator()(const f32x4 (&acc)[2][2][4][2], const Unit& u, int wr, int wc, int fr, int fq, const PG8_LAS float* bl) const {
        const int pn = u.pn & 3;
        const int row0 = u.pm * BM + wr * 64 + fr, col0 = pn * BM + wc * 32 + 8 * fq;
        f32x4 bv[2][2];
#pragma unroll
        for (int bj = 0; bj < 2; ++bj)
#pragma unroll
            for (int n = 0; n < 2; ++n) bv[bj][n] = *(const PG8_LAS f32x4*)(bl + wc * 32 + 8 * fq + bj * HALF + 4 * n);
#pragma unroll
        for (int ai = 0; ai < 2; ++ai)
#pragma unroll
            for (int m = 0; m < 4; ++m) {
                bf16_t* rowp = ys + (size_t)(row0 + ai * HALF + m * 16) * 1024 + col0;
#pragma unroll
                for (int bj = 0; bj < 2; ++bj) {
                    const f32x4 v0 = acc[ai][bj][m][0] * ascale + bv[bj][0], v1 = acc[ai][bj][m][1] * ascale + bv[bj][1];
                    if constexpr (F8OUT) {
                        int w0 = 0, w1 = 0;
                        w0 = __builtin_amdgcn_cvt_pk_fp8_f32(v0[0], v0[1], w0, false); w0 = __builtin_amdgcn_cvt_pk_fp8_f32(v0[2], v0[3], w0, true);
                        w1 = __builtin_amdgcn_cvt_pk_fp8_f32(v1[0], v1[1], w1, false); w1 = __builtin_amdgcn_cvt_pk_fp8_f32(v1[2], v1[3], w1, true);
                        u32x2 w; w.x = (unsigned)w0; w.y = (unsigned)w1;
                        *(u32x2*)((unsigned char*)ys + (size_t)(row0 + ai * HALF + m * 16) * 1024 + col0 + bj * HALF) = w;
                    } else {
                        u32x4 w; w.x = cvt_pk_bf16(v0[0], v0[1]); w.y = cvt_pk_bf16(v0[2], v0[3]); w.z = cvt_pk_bf16(v1[0], v1[1]); w.w = cvt_pk_bf16(v1[2], v1[3]);
                        *(u32x4*)(rowp + bj * HALF) = w;
                    }
                }
            }
    }
};
struct EpiPlain {
    static constexpr bool PERM = true, AFTER_DRAIN = false;
    bf16_t* O;
    __device__ __forceinline__ const float* bias_slice(const Unit&) const { return nullptr; }
    __device__ __forceinline__ void operator()(const f32x4 (&acc)[2][2][4][2], const Unit& u, int wr, int wc, int fr, int fq, const PG8_LAS float*) const {
        const int row0 = u.pm * BM + wr * 64 + fr, col0 = u.pn * BM + wc * 32 + 8 * fq;
#pragma unroll
        for (int ai = 0; ai < 2; ++ai)
#pragma unroll
            for (int m = 0; m < 4; ++m) {
                bf16_t* rowp = O + (size_t)(row0 + ai * HALF + m * 16) * 1024 + col0;
#pragma unroll
                for (int bj = 0; bj < 2; ++bj) {
                    const f32x4 v0 = acc[ai][bj][m][0], v1 = acc[ai][bj][m][1];
                    u32x4 w; w.x = cvt_pk_bf16(v0[0], v0[1]); w.y = cvt_pk_bf16(v0[2], v0[3]); w.z = cvt_pk_bf16(v1[0], v1[1]); w.w = cvt_pk_bf16(v1[2], v1[3]);
                    *(u32x4*)(rowp + bj * HALF) = w;
                }
            }
    }
};
struct EpiGate {
    static constexpr bool PERM = true, AFTER_DRAIN = false;
    const bf16_t* PP; bf16_t* E; const float* bias; float ascale;
    __device__ __forceinline__ const float* bias_slice(const Unit& u) const { return bias + u.pn * BM; }
    __device__ __forceinline__ void operator()(const f32x4 (&acc)[2][2][4][2], const Unit& u, int wr, int wc, int fr, int fq, const PG8_LAS float* bl) const {
        const int row0 = u.pm * BM + wr * 64 + fr, col0 = u.pn * BM + wc * 32 + 8 * fq;
        f32x4 bv[2][2];
#pragma unroll
        for (int bj = 0; bj < 2; ++bj)
#pragma unroll
            for (int n = 0; n < 2; ++n) bv[bj][n] = *(const PG8_LAS f32x4*)(bl + wc * 32 + 8 * fq + bj * HALF + 4 * n);
#pragma unroll
        for (int ai = 0; ai < 2; ++ai)
#pragma unroll
            for (int m = 0; m < 4; ++m) {
                const size_t off = (size_t)(row0 + ai * HALF + m * 16) * 1024 + col0;
#pragma unroll
                for (int bj = 0; bj < 2; ++bj) {
                    const u32x4 pv = *(const u32x4*)(PP + off + bj * HALF);
                    const f32x4 v0 = acc[ai][bj][m][0] * ascale + bv[bj][0], v1 = acc[ai][bj][m][1] * ascale + bv[bj][1];
                    u32x4 w;
                    w.x = cvt_pk_bf16(sigm(v0[0]) * bf_lo(pv.x), sigm(v0[1]) * bf_hi(pv.x)); w.y = cvt_pk_bf16(sigm(v0[2]) * bf_lo(pv.y), sigm(v0[3]) * bf_hi(pv.y));
                    w.z = cvt_pk_bf16(sigm(v1[0]) * bf_lo(pv.z), sigm(v1[1]) * bf_hi(pv.z)); w.w = cvt_pk_bf16(sigm(v1[2]) * bf_lo(pv.w), sigm(v1[3]) * bf_hi(pv.w));
                    *(u32x4*)(E + off + bj * HALF) = w;
                }
            }
    }
};
struct MoeOrder {
    const PG8_LAS int* tile_e; int nunits, lnt, G, c;
    const PG8_LAS int* tst; const PG8_LAS int* cnt; const int* list; int list_pitch;
    __device__ __forceinline__ const int* row_src(const Unit& u) const { const int e = tile_e[u.pm]; return list + (size_t)e * list_pitch + (u.pm - tst[e]) * 256; }
    __device__ __forceinline__ int nvalid(const Unit& u) const { const int e = tile_e[u.pm]; return cnt[e] - (u.pm - tst[e]) * 256; }
    __device__ __forceinline__ bool next(int i, Unit& u) const {
        const int L = i * G + c; if (L >= nunits) return false;
        const int mt = L >> lnt, pn = L & ((1 << lnt) - 1);
        u.pm = mt; u.pn = (tile_e[mt] << lnt) + pn; return true;
    }
    __device__ __forceinline__ void a_ready(const Unit&) const {}
    __device__ __forceinline__ void done(const Unit&) const {}
    __attribute__((address_space(1))) unsigned* tailw = nullptr;
    __device__ __forceinline__ void tail(int wid, int lane) const { if (tailw && wid == 0 && lane == 0) (void)__hip_atomic_fetch_add(tailw, 1u, __ATOMIC_RELAXED, __HIP_MEMORY_SCOPE_AGENT); }
};

template <class Epi, class Sched, bool ALIGN_EPI = false, bool SP2 = false, bool F8 = false, bool GATHER = false>
__device__ __forceinline__ void gemm_phase(PG8_LAS unsigned char* lds, const Gemm g, const Sched& S, const Epi& E, const int wave_id, PG8_LAS float* biasl, PG8_LAS int* tokl = nullptr) {
    static_assert(!GATHER || SP2, "the gathered-A form is written for the SP2 loop");
    int tid_l = wave_id * 64 + (int)__builtin_amdgcn_mbcnt_hi(~0u, __builtin_amdgcn_mbcnt_lo(~0u, 0u)); asm volatile("" : "+v"(tid_l));     const int tid = tid_l, wid = __builtin_amdgcn_readfirstlane(tid >> 6), lane = tid & 63, wr = wid >> 2, wc = wid & 3, fr = lane & 15, fq = lane >> 4;
    int K_l = g.K; asm volatile("" : "+s"(K_l)); const int K = K_l, nt = K / BK;
    unsigned voffA[2], voffB[2];
    unsigned voffG[2][2] = {{0u, 0u}, {0u, 0u}};
#pragma unroll
    for (int i = 0; i < 2; ++i) { int R, C; stage_rc(tid * 16 + i * 8192, R, C); const int Rb = Epi::PERM ? ((R & ~31) + perm32(R & 31)) : R;
        voffA[i] = (unsigned)(R * K + C) * 2u; voffB[i] = (unsigned)(Rb * K + C) * 2u; }
    const size_t kstep = (size_t)(BK * 2);
    const size_t hstep = (size_t)HALF * K * 2;
    const size_t tstep = 2 * hstep;
    const unsigned ldsw = (unsigned)wid * 1024u;
    const int aoff = lds_byte(wr * 64 + fr, fq * 8), boff = lds_byte(wc * 32 + fr, fq * 8);
#define PG8_SA(b, h) (((b) * 2 + (h)) * HTB)
#define PG8_SB(b, h) ((4 + (b) * 2 + (h)) * HTB)
#define PG8_STAGE(bufoff, gbase, voff) do { _Pragma("unroll") for (int _i = 0; _i < 2; ++_i) \
        __builtin_amdgcn_global_load_lds((const unsigned*)((const char*)(gbase) + (voff)[_i]), (PG8_LAS unsigned*)(lds + (bufoff) + ldsw + _i * 8192), 16, 0, 0); } while (0)
#define PG8_STAGE_A(bufoff, base, h) do { if constexpr (GATHER) { PG8_STAGE(bufoff, base, voffG[h]); } else { PG8_STAGE(bufoff, (base) + (h) * hstep, voffA); } } while (0)
#define PG8_TOKSTAGE(u_, slot_) do { if (wid == 0) { const int* rp_ = S.row_src(u_); __builtin_amdgcn_global_load_lds((const unsigned*)(rp_ + lane * 4), (PG8_LAS unsigned*)(tokl + (slot_) * 256), 16, 0, 0); } } while (0)
#define PG8_TOKSET(slot_, nv_) do { const int nvv_ = (nv_); _Pragma("unroll") for (int h_ = 0; h_ < 2; ++h_) _Pragma("unroll") for (int i_ = 0; i_ < 2; ++i_) { int R_, C_; stage_rc(tid * 16 + i_ * 8192, R_, C_); \
        const int r_ = h_ * HALF + R_; int tk_ = tokl[(slot_) * 256 + r_]; tk_ = (r_ < nvv_ && tk_ >= 0 && tk_ < g.M) ? tk_ : 0; voffG[h_][i_] = (unsigned)tk_ * (unsigned)(K * 2) + (unsigned)(C_ * 2); } } while (0)
#define PG8_LDA(dst, b, h) do { _Pragma("unroll") for (int m = 0; m < 4; ++m) _Pragma("unroll") for (int k = 0; k < 2; ++k) dst[m][k] = *(const PG8_LAS bf16x8*)(lds + PG8_SA(b, h) + aoff + m * 2048 + k * 1024); } while (0)
#define PG8_LDB(dst, b, h) do { _Pragma("unroll") for (int n = 0; n < 2; ++n) _Pragma("unroll") for (int k = 0; k < 2; ++k) dst[n][k] = *(const PG8_LAS bf16x8*)(lds + PG8_SB(b, h) + boff + n * 2048 + k * 1024); } while (0)
#define PG8_MMA(ai, bj, At, Bt) do { __builtin_amdgcn_s_setprio(1); _Pragma("unroll") for (int m = 0; m < 4; ++m) _Pragma("unroll") for (int n = 0; n < 2; ++n) { \
        if constexpr (F8) { typedef int i32x4_ __attribute__((ext_vector_type(4))); \
              \
            asm volatile("v_mfma_f32_16x16x128_f8f6f4 %0, %1, %2, %0" : "+v"(acc[ai][bj][m][n]) : "v"(__builtin_shufflevector(__builtin_bit_cast(i32x4_, Bt[n][0]), __builtin_bit_cast(i32x4_, Bt[n][1]), 0, 1, 2, 3, 4, 5, 6, 7)), \
                "v"(__builtin_shufflevector(__builtin_bit_cast(i32x4_, At[m][0]), __builtin_bit_cast(i32x4_, At[m][1]), 0, 1, 2, 3, 4, 5, 6, 7))); } \
        else { _Pragma("unroll") for (int k = 0; k < 2; ++k) acc[ai][bj][m][n] = __builtin_amdgcn_mfma_f32_16x16x32_bf16(Bt[n][k], At[m][k], acc[ai][bj][m][n], 0, 0, 0); } } \
        __builtin_amdgcn_s_setprio(0); } while (0)
#define PG8_WAIT_V(n) asm volatile("s_waitcnt vmcnt(" #n ")" ::: "memory")
#define PG8_WAIT_L(n) asm volatile("s_waitcnt lgkmcnt(" #n ")" ::: "memory")
#define PG8_BAR __builtin_amdgcn_s_barrier()
#define PG8_SCHED __builtin_amdgcn_sched_barrier(0)
    Unit cur, nxt; int ui = 0;
    if (!S.next(0, cur)) return;
#define PG8_BIAS(u_, slot_) do { if (wid == 0) { const float* bp_ = E.bias_slice(u_); if (bp_) __builtin_amdgcn_global_load_lds((const unsigned*)(bp_ + lane * 4), (PG8_LAS unsigned*)(biasl + (slot_) * 256), 16, 0, 0); } } while (0)
    PG8_BIAS(cur, 0);
    if constexpr (GATHER) { PG8_TOKSTAGE(cur, 0); asm volatile("s_waitcnt vmcnt(0)" ::: "memory"); __builtin_amdgcn_s_barrier(); asm volatile("" ::: "memory"); PG8_TOKSET(0, S.nvalid(cur)); }
    f32x4 acc[2][2][4][2];
#pragma unroll
    for (int a = 0; a < 2; ++a)
#pragma unroll
        for (int b = 0; b < 2; ++b)
#pragma unroll
            for (int m = 0; m < 4; ++m)
#pragma unroll
                for (int n = 0; n < 2; ++n) acc[a][b][m][n] = (f32x4){0.f, 0.f, 0.f, 0.f};
    bf16x8 At[4][2], B0[2][2], B1[2][2];
    const char* cA = (const char*)g.A + (GATHER ? (size_t)0 : (size_t)cur.pm * tstep); const char* cB = (const char*)g.Bt + (size_t)cur.pn * tstep;
    S.a_ready(cur);
    if constexpr (SP2) {
        PG8_STAGE(PG8_SB(0, 0), cB, voffB); PG8_STAGE(PG8_SB(0, 1), cB + hstep, voffB); PG8_STAGE_A(PG8_SA(0, 0), cA, 0); PG8_STAGE_A(PG8_SA(0, 1), cA, 1);
        if (wr == 1) PG8_BAR;
        PG8_WAIT_V(2); PG8_BAR;
        PG8_STAGE(PG8_SB(1, 0), cB + kstep, voffB); PG8_STAGE_A(PG8_SA(1, 0), cA + kstep, 0); PG8_STAGE(PG8_SB(1, 1), cB + hstep + kstep, voffB);
        PG8_WAIT_V(6); PG8_BAR;
    } else {
        PG8_STAGE(PG8_SB(0, 0), cB, voffB); PG8_STAGE_A(PG8_SA(0, 0), cA, 0); PG8_STAGE(PG8_SB(0, 1), cB + hstep, voffB); PG8_STAGE_A(PG8_SA(0, 1), cA, 1);
        if (wr == 1) PG8_BAR;
        PG8_WAIT_V(4); PG8_BAR;
        PG8_STAGE(PG8_SB(1, 0), cB + kstep, voffB); PG8_STAGE_A(PG8_SA(1, 0), cA + kstep, 0); PG8_STAGE(PG8_SB(1, 1), cB + hstep + kstep, voffB);
        PG8_WAIT_V(6); PG8_BAR;
    }
    for (;;) {
        const bool has_next = S.next(ui + 1, nxt);
        if (!has_next) S.tail(wid, lane);
        const char* nA = (has_next && !GATHER) ? (const char*)g.A + (size_t)nxt.pm * tstep : cA;
        if constexpr (GATHER) { if (has_next) PG8_TOKSTAGE(nxt, (ui + 1) & 1); } const char* nB = has_next ? (const char*)g.Bt + (size_t)nxt.pn * tstep : cB;
        for (int t = 0; t < nt; t += 2) {
            const bool last = (t == nt - 2);
            const char* a1 = cA + (size_t)(t + 1) * kstep;
            const char* a2 = last ? nA : cA + (size_t)(t + 2) * kstep; const char* b2 = last ? nB : cB + (size_t)(t + 2) * kstep;
            const char* a3 = a2 + kstep; const char* b3 = b2 + kstep;
            if (last && has_next) S.a_ready(nxt);
            if constexpr (SP2) {
            PG8_LDB(B0, 0, 0); PG8_LDB(B1, 0, 1); PG8_SCHED; PG8_LDA(At, 0, 0); PG8_STAGE_A(PG8_SA(1, 1), a1, 1);
            if constexpr (GATHER) { if (last && has_next) PG8_TOKSET((ui + 1) & 1, S.nvalid(nxt)); }
            PG8_WAIT_V(8); PG8_WAIT_L(0); PG8_BAR; PG8_MMA(0, 0, At, B0); PG8_MMA(0, 1, At, B1); PG8_BAR; PG8_SCHED;
            PG8_LDA(At, 0, 1); PG8_STAGE(PG8_SB(0, 0), b2, voffB); PG8_STAGE(PG8_SB(0, 1), b2 + hstep, voffB); PG8_STAGE_A(PG8_SA(0, 0), a2, 0);
            PG8_WAIT_V(8); PG8_WAIT_L(0); PG8_BAR; PG8_MMA(1, 0, At, B0); PG8_MMA(1, 1, At, B1); PG8_BAR; PG8_SCHED;
            PG8_LDB(B0, 1, 0); PG8_LDB(B1, 1, 1); PG8_SCHED; PG8_LDA(At, 1, 0); PG8_STAGE_A(PG8_SA(0, 1), a2, 1);
            PG8_WAIT_V(8); PG8_WAIT_L(0); PG8_BAR; PG8_MMA(0, 0, At, B0); PG8_MMA(0, 1, At, B1); PG8_BAR; PG8_SCHED;
            PG8_LDA(At, 1, 1); PG8_STAGE(PG8_SB(1, 0), b3, voffB); PG8_STAGE(PG8_SB(1, 1), b3 + hstep, voffB); PG8_STAGE_A(PG8_SA(1, 0), a3, 0);
            PG8_WAIT_V(8); PG8_WAIT_L(0); PG8_BAR; PG8_MMA(1, 0, At, B0); PG8_MMA(1, 1, At, B1); PG8_BAR; PG8_SCHED;
            } else {
            PG8_LDB(B0, 0, 0); PG8_SCHED; PG8_LDA(At, 0, 0); PG8_STAGE_A(PG8_SA(1, 1), a1, 1);
            PG8_WAIT_L(8); PG8_BAR; PG8_WAIT_L(0); PG8_MMA(0, 0, At, B0); PG8_BAR; PG8_SCHED;
            PG8_LDB(B1, 0, 1); PG8_STAGE(PG8_SB(0, 0), b2, voffB);
            PG8_BAR; PG8_WAIT_L(0); PG8_MMA(0, 1, At, B1); PG8_BAR;
            PG8_LDA(At, 0, 1); PG8_STAGE_A(PG8_SA(0, 0), a2, 0);
            PG8_BAR; PG8_WAIT_L(0); PG8_MMA(1, 0, At, B0); PG8_BAR; PG8_SCHED;
            PG8_STAGE(PG8_SB(0, 1), b2 + hstep, voffB);
            PG8_WAIT_V(6); PG8_BAR; PG8_MMA(1, 1, At, B1); PG8_BAR;
            PG8_LDB(B0, 1, 0); PG8_SCHED; PG8_LDA(At, 1, 0); PG8_STAGE_A(PG8_SA(0, 1), a2, 1);
            PG8_WAIT_L(8); PG8_BAR; PG8_WAIT_L(0); PG8_MMA(0, 0, At, B0); PG8_BAR; PG8_SCHED;
            PG8_LDB(B1, 1, 1); PG8_STAGE(PG8_SB(1, 0), b3, voffB);
            PG8_BAR; PG8_WAIT_L(0); PG8_MMA(0, 1, At, B1); PG8_BAR;
            PG8_LDA(At, 1, 1); PG8_STAGE_A(PG8_SA(1, 0), a3, 0);
            PG8_BAR; PG8_WAIT_L(0); PG8_MMA(1, 0, At, B0); PG8_BAR; PG8_SCHED;
            PG8_STAGE(PG8_SB(1, 1), b3 + hstep, voffB);
            PG8_WAIT_V(6); PG8_BAR; PG8_MMA(1, 1, At, B1); PG8_BAR;
            }
        }
        if constexpr (F8) { asm volatile("s_nop 7\n\ts_nop 7\n\ts_nop 7\n\ts_nop 7" ::: "memory"); }
        if constexpr (ALIGN_EPI) { if (wr == 0) PG8_BAR; }
        if constexpr (!Epi::AFTER_DRAIN) { E(acc, cur, wr, wc, fr, fq, biasl + (ui & 1) * 256); S.done(cur); }
        if (!has_next) break;
#pragma unroll
        for (int a = 0; a < 2; ++a)
#pragma unroll
            for (int b = 0; b < 2; ++b)
#pragma unroll
                for (int m = 0; m < 4; ++m)
#pragma unroll
                    for (int n = 0; n < 2; ++n) acc[a][b][m][n] = (f32x4){0.f, 0.f, 0.f, 0.f};
        cur = nxt; cA = nA; cB = nB; ++ui;
        PG8_BIAS(cur, ui & 1);
        if constexpr (ALIGN_EPI) { if (wr == 1) PG8_BAR; }
    }
    PG8_WAIT_V(0);
    if constexpr (!ALIGN_EPI) { if (wr == 0) PG8_BAR; }
    PG8_BAR;
    if constexpr (Epi::AFTER_DRAIN) { E.fused(acc, cur, wr, wc, fr, fq, lds, wid, lane); S.done(cur); }
#undef PG8_SA
#undef PG8_SB
#undef PG8_STAGE
#undef PG8_LDA
#undef PG8_LDB
#undef PG8_MMA
#undef PG8_WAIT_V
#undef PG8_WAIT_L
#undef PG8_BAR
#undef PG8_SCHED
#undef PG8_BIAS
#undef PG8_STAGE_A
#undef PG8_TOKSTAGE
#undef PG8_TOKSET
}
}

constexpr int NWAVES = 8;
constexpr int NB = 16, T = 2048, D = 1024, M = NB * T, NL = 2;
constexpr int HP = 2048;
constexpr int NIN = 2304;
constexpr int PD = 256;
constexpr int NE = 32, TOPK = 4;
constexpr int MAXTILES = (M * TOPK) / 256 + NE;
constexpr int MAXSLOTS = MAXTILES * 256;
constexpr float LN_EPS = 1e-5f;
constexpr float DN_ALPHA = 1.4142135623730951f;
constexpr float SC_LOG2E = 0.125f * 1.4426950408889634f;
constexpr int C_QN = 0, C_KC = 512, C_VC = 640, C_KS = 768, C_VS = 896, C_KW = 1024, C_VW = 1152, C_QS = 1280, C_KSW = 1792, C_VSW = 1920;

constexpr size_t MiB = 1u << 20;
constexpr size_t WS_CTL = 0, CTL_ZERO_BYTES = 32768;
constexpr size_t WS_WIN = 2 * MiB;
constexpr size_t WS_WO = 12 * MiB;
constexpr size_t WS_WPG = 16 * MiB;
constexpr size_t WS_WPP = 20 * MiB;
constexpr size_t WS_WC1 = 22 * MiB;
constexpr size_t WS_WC2 = 26 * MiB;
constexpr size_t WS_WR = 27 * MiB;
constexpr size_t WS_BINP = 28 * MiB;
constexpr size_t WS_B1P = 28 * MiB + 65536;
constexpr size_t WS_ROPE = 30 * MiB;
constexpr size_t WS_GATES = 38 * MiB;
constexpr size_t WS_KCMP = 42 * MiB;
constexpr size_t WS_VCMP = 42 * MiB + 512 * 1024;
constexpr size_t WS_TOKE = 43 * MiB;
constexpr size_t WS_TOKR = 43 * MiB + 512 * 1024;
constexpr size_t WS_TOKW = 44 * MiB;
constexpr size_t WS_SLOT = 44 * MiB + 512 * 1024;
constexpr size_t WS_W1T = 48 * MiB;
constexpr size_t WS_W2T = 304 * MiB;
constexpr size_t WS_XB = 432 * MiB;
constexpr size_t WS_PB = 496 * MiB;
constexpr size_t WS_R1 = 528 * MiB;
constexpr size_t WS_H = WS_R1, WS_O = WS_R1 + 128 * MiB, WS_YS = WS_R1;
constexpr size_t WS_LIST = WS_R1;

constexpr size_t WS_R2 = 808 * MiB;
constexpr size_t WS_Y1 = WS_R2, WS_ACT = WS_R2;
constexpr size_t WS_X1 = 1080 * MiB;
constexpr size_t WS_X1B = 1208 * MiB;
constexpr size_t WS_PP = 1272 * MiB;
constexpr size_t WS_E = 1336 * MiB;
constexpr size_t WS_XN = 1400 * MiB;
constexpr size_t WS_X1L = WS_X1;
constexpr size_t WS_XNL = WS_XN;
constexpr size_t WS_X1F8 = WS_X1 + 64 * MiB;
constexpr size_t WS_END = 1528 * MiB;
static_assert((size_t)MAXSLOTS * 2048 <= 272 * MiB, "slot buffers");
constexpr int CW_TMO = 0, CW_CODE = 1;
constexpr int CW_CNT = 1024;
constexpr int CW_BAR = 4096;

constexpr int RING_OFF = 0, RING_BYTES = 131072;
constexpr int SCRATCH_BYTES = 139264;
constexpr int LDSCTL_OFF = SCRATCH_BYTES, MISC_OFF = LDSCTL_OFF + 320;
constexpr int TAB_OFF = MISC_OFF + 128;
constexpr int TAB_CNT = TAB_OFF, TAB_SOFF = TAB_OFF + 128, TAB_TST = TAB_OFF + 256, TAB_TE = TAB_OFF + 512;
constexpr int BIAS_OFF = 143360;
constexpr int TOKL_OFF = BIAS_OFF + 2048;
constexpr int LDS_BYTES = 147456;
static_assert(TAB_TE + MAXTILES * 4 <= BIAS_OFF && TOKL_OFF + 2048 <= LDS_BYTES, "LDS map");

static_assert((CW_BAR + 3456) * 4 <= (int)CTL_ZERO_BYTES && (CW_CNT + NL * 32) * 4 <= (int)CTL_ZERO_BYTES, "control words inside the memset region");
#define GAS __attribute__((address_space(1)))
#define LAS __attribute__((address_space(3)))
typedef unsigned short bf16;
typedef unsigned v4u __attribute__((ext_vector_type(4)));
typedef float f32x4 __attribute__((ext_vector_type(4)));
typedef short bf16x8 __attribute__((ext_vector_type(8)));
typedef GAS unsigned gu32;
typedef GAS unsigned long long gu64;
#define RLX_AGENT __ATOMIC_RELAXED, __HIP_MEMORY_SCOPE_AGENT
#define LDS_WAIT() asm volatile("s_waitcnt lgkmcnt(0)" ::: "memory")
#define VM_WAIT() asm volatile("s_waitcnt vmcnt(0)" ::: "memory")
__device__ __forceinline__ unsigned long long rt() { return __builtin_amdgcn_s_memrealtime(); }
__device__ __forceinline__ unsigned f2bf(float f) { unsigned u = __builtin_bit_cast(unsigned, f); return (u + 0x7fffu + ((u >> 16) & 1u)) >> 16; }
__device__ __forceinline__ unsigned pk2(float lo, float hi) { return f2bf(lo) | (f2bf(hi) << 16); }
#define XB_TMO      128
#define XB_XCNT(j)  (256  + 64 * (j))
#define XB_XSUB(j)  (1280 + 64 * (j))
#define XB_XGEN(j)  (2304 + 64 * (j))
#define XB_TOP      3328
#define XB_TOPGEN   3392
#define XCD_BAR_WORDS 3456
#define XB_SPIN_CAP (1u << 22)

__device__ __forceinline__ unsigned xb_ld(unsigned* p)              { return __hip_atomic_load(p, __ATOMIC_RELAXED, __HIP_MEMORY_SCOPE_AGENT); }
__device__ __forceinline__ unsigned xb_add(unsigned* p, unsigned v) { return __hip_atomic_fetch_add(p, v, __ATOMIC_RELAXED, __HIP_MEMORY_SCOPE_AGENT); }
__device__ __forceinline__ unsigned xb_xcc_id() { return (unsigned)__builtin_amdgcn_s_getreg((3 << 11) | 20) & 0xFu; }
#define XB_SPIN(cond, bar) do { unsigned _sp = 0; while (cond) { __builtin_amdgcn_s_sleep(1); \
    if ((++_sp & 255u) == 0u) { if (xb_ld(&(bar)[XB_TMO])) break; if (_sp > XB_SPIN_CAP) { atomicAdd(&(bar)[XB_TMO], 1u); break; } } } } while (0)

struct XcdBarrier {
    unsigned* bar; unsigned x; int wave;
    volatile LAS unsigned* st;
};

__device__ __forceinline__ bool xb_thread0(int wave) { return wave == 0 && __builtin_amdgcn_mbcnt_hi(~0u, __builtin_amdgcn_mbcnt_lo(~0u, 0u)) == 0u; }
__device__ __forceinline__ XcdBarrier xcd_barrier_post(unsigned* bar, volatile LAS unsigned* st, int wave) {
    XcdBarrier b; b.bar = bar; b.x = xb_xcc_id(); b.st = st; b.wave = wave;
    if (xb_thread0(wave)) (void)xb_add(&bar[XB_XCNT(b.x)], 1u);
    return b;
}
__device__ __forceinline__ void xcd_barrier_complete(unsigned* bar, unsigned x, unsigned& nloc, unsigned& nx) {
    const unsigned G = gridDim.x * gridDim.y * gridDim.z;
    unsigned sum, cnt, mine, sp = 0u;
    for (;;) {
        sum = 0u; cnt = 0u; mine = 0u;
#pragma unroll
        for (unsigned j = 0; j < 16; ++j) { const unsigned c = xb_ld(&bar[XB_XCNT(j)]); sum += c; cnt += (c > 0u) ? 1u : 0u; mine = (j == x) ? c : mine; }
        if (sum == G) break;
        __builtin_amdgcn_s_sleep(1);
        if ((++sp & 255u) == 0u) { if (xb_ld(&bar[XB_TMO])) break; if (sp > XB_SPIN_CAP) { atomicAdd(&bar[XB_TMO], 1u); break; } }
    }
    nloc = mine > 0u ? mine : 1u; nx = cnt > 0u ? cnt : 1u;
}

__device__ __forceinline__ void xcd_barrier(const XcdBarrier& b) {
    asm volatile("s_waitcnt vmcnt(0)" ::: "memory");
    __syncthreads();
    if (xb_thread0(b.wave)) {
        unsigned* bar = b.bar;
        __builtin_amdgcn_s_waitcnt(0);
        unsigned nloc = b.st[0], nx = b.st[1];
        if (nloc == 0u) { xcd_barrier_complete(bar, b.x, nloc, nx); b.st[0] = nloc; b.st[1] = nx; }
        const unsigned old = xb_add(&bar[XB_XSUB(b.x)], 1u);
        const unsigned gen = old / nloc;
        if (old + 1u == (gen + 1u) * nloc) {
            __builtin_amdgcn_fence(__ATOMIC_RELEASE, "agent");
            asm volatile("s_waitcnt vmcnt(0)" ::: "memory");
            const unsigned og = xb_add(&bar[XB_TOP], 1u);
            const unsigned tg = og / nx;
            if (og + 1u == (tg + 1u) * nx) xb_add(&bar[XB_TOPGEN], 1u);
            else XB_SPIN(xb_ld(&bar[XB_TOPGEN]) == tg, bar);
            __builtin_amdgcn_fence(__ATOMIC_ACQUIRE, "agent");
            xb_add(&bar[XB_XGEN(b.x)], 1u);
            asm volatile("s_waitcnt vmcnt(0)" ::: "memory");
        } else {
            XB_SPIN(xb_ld(&bar[XB_XGEN(b.x)]) == gen, bar);
            __builtin_amdgcn_fence(__ATOMIC_ACQUIRE, "agent");
            asm volatile("s_waitcnt vmcnt(0)" ::: "memory");
        }
    }
    __syncthreads();
}

typedef float f32x16 __attribute__((ext_vector_type(16)));
typedef unsigned u32x2 __attribute__((ext_vector_type(2)));
struct Frame {
    LAS unsigned char* lds;
    volatile LAS unsigned* MISC;
    gu32* ctl;
    unsigned char* ws;
    int tid, lane, wave;
    int vcu, G;
};
__device__ __forceinline__ float wave_sum(float v) {
#pragma unroll
    for (int o = 1; o < 64; o <<= 1) v += __shfl_xor(v, o);
    return v;
}
__device__ __forceinline__ float sigm(float x) { return __builtin_amdgcn_rcpf(1.0f + __builtin_amdgcn_exp2f(-1.4426950408889634f * x)); }
__device__ __forceinline__ float bf_lo(unsigned w) { return __uint_as_float(w << 16); }
__device__ __forceinline__ float bf_hi(unsigned w) { return __uint_as_float(w & 0xffff0000u); }
__device__ __forceinline__ unsigned cvtpk(float lo, float hi) { typedef float f2 __attribute__((ext_vector_type(2))); typedef __bf16 b2 __attribute__((ext_vector_type(2))); f2 v = {lo, hi}; b2 b = __builtin_convertvector(v, b2); return __builtin_bit_cast(unsigned, b); }
__device__ __forceinline__ bf16x8 pack8(float a0, float a1, float a2, float a3, float a4, float a5, float a6, float a7) {
    v4u w; w.x = cvtpk(a0, a1); w.y = cvtpk(a2, a3); w.z = cvtpk(a4, a5); w.w = cvtpk(a6, a7); return __builtin_bit_cast(bf16x8, w);
}
__device__ __forceinline__ unsigned rs_byte(float x, unsigned h) {
    const unsigned E = (h >> 7) & 0xffu;
    const float q = rintf((x - __uint_as_float(h << 16)) * __uint_as_float((269u - E) << 23)) + 128.f;
    return E < 16u ? 128u : (unsigned)fminf(fmaxf(q, 0.f), 255.f);
}
__device__ __forceinline__ void rs_enc(const f32x4 o, u32x2& w, unsigned& b) {
    const unsigned h0 = f2bf(o.x), h1 = f2bf(o.y), h2 = f2bf(o.z), h3 = f2bf(o.w);
    w.x = h0 | (h1 << 16); w.y = h2 | (h3 << 16);
    b = rs_byte(o.x, h0) | (rs_byte(o.y, h1) << 8) | (rs_byte(o.z, h2) << 16) | (rs_byte(o.w, h3) << 24);
}
__device__ __forceinline__ float rs_dec1(unsigned h, unsigned u) {
    const unsigned E = (h >> 7) & 0xffu;
    return __uint_as_float(h << 16) + ((float)u - 128.f) * __uint_as_float((E < 16u ? 0u : E - 15u) << 23);
}
__device__ __forceinline__ f32x4 rs_dec(const u32x2 w, unsigned b) {
    return (f32x4){rs_dec1(w.x & 0xffffu, b & 0xffu), rs_dec1(w.x >> 16, (b >> 8) & 0xffu), rs_dec1(w.y & 0xffffu, (b >> 16) & 0xffu), rs_dec1(w.y >> 16, b >> 24)};
}
__device__ __forceinline__ int crow(int r, int hi) { return (r & 3) + 8 * (r >> 2) + 4 * hi; }

struct MapId { __device__ __forceinline__ int operator()(int n) const { return n; } };
struct MapW1 { __device__ __forceinline__ int operator()(int n) const { return ((n >> 7) & 1) * 1024 + (n >> 8) * 128 + (n & 127); } };
struct MapWin {
    __device__ __forceinline__ int operator()(int n) const {
        if (n >= 2048) { const int i = n - 2048; return i < 24 ? 1280 + i : -1; }
        const int seg = n >> 7, q = n & 127, hd = q >> 6, pos = q & 63, g = pos >> 3, j = pos & 7;
        const int dlog = j < 4 ? 4 * g + j : 32 + 4 * g + (j - 4);
        const int hc = seg * 128 + hd * 64 + dlog;
        return hc < 1280 ? hc : hc + 24;
    }
};
template <class Map>
__device__ __forceinline__ void transpose_item(const float* W, int K, int Nsrc, bf16* WT, LAS float* scr, int kb, int nb, int lane, Map map) {
    const int k0 = 64 * kb, n0 = 32 * nb;
    const int src = map(n0 + (lane & 31));
    float wv[32];
#pragma unroll
    for (int i = 0; i < 32; ++i) { const int kk = 2 * i + (lane >> 5); wv[i] = src >= 0 ? W[(size_t)(k0 + kk) * Nsrc + src] : 0.f; }
#pragma unroll
    for (int i = 0; i < 32; ++i) { const int kk = 2 * i + (lane >> 5); scr[kk * 33 + (lane & 31)] = wv[i]; }
    LDS_WAIT(); asm volatile("" ::: "memory");
    const int c = lane & 7;
#pragma unroll
    for (int j = 0; j < 4; ++j) { const int n = (lane >> 3) + 8 * j; const LAS float* s = scr + (8 * c) * 33 + n;
        v4u o; o.x = pk2(s[0 * 33], s[1 * 33]); o.y = pk2(s[2 * 33], s[3 * 33]); o.z = pk2(s[4 * 33], s[5 * 33]); o.w = pk2(s[6 * 33], s[7 * 33]);
        *(GAS v4u*)(WT + (size_t)(n0 + n) * K + k0 + 8 * c) = o; }
    LDS_WAIT(); asm volatile("" ::: "memory");
}
__device__ __forceinline__ unsigned pk4_fp8(float a, float b, float c, float d) { int w = 0; w = __builtin_amdgcn_cvt_pk_fp8_f32(a, b, w, false); w = __builtin_amdgcn_cvt_pk_fp8_f32(c, d, w, true); return (unsigned)w; }
template <class Map>
__device__ __forceinline__ void transpose_item_f8(const float* W, int K, int Nsrc, unsigned char* WT, LAS float* scr, int kb, int nb, int lane, Map map, float wscale) {
    const int k0 = 64 * kb, n0 = 32 * nb;
    const int src = map(n0 + (lane & 31));
    float wv[32];
#pragma unroll
    for (int i = 0; i < 32; ++i) { const int kk = 2 * i + (lane >> 5); wv[i] = src >= 0 ? W[(size_t)(k0 + kk) * Nsrc + src] * wscale : 0.f; }
#pragma unroll
    for (int i = 0; i < 32; ++i) { const int kk = 2 * i + (lane >> 5); scr[kk * 33 + (lane & 31)] = wv[i]; }
    LDS_WAIT(); asm volatile("" ::: "memory");
    const int c = lane & 7;
#pragma unroll
    for (int j = 0; j < 4; ++j) { const int n = (lane >> 3) + 8 * j; const LAS float* s = scr + (8 * c) * 33 + n;
        u32x2 o; o.x = pk4_fp8(s[0 * 33], s[1 * 33], s[2 * 33], s[3 * 33]); o.y = pk4_fp8(s[4 * 33], s[5 * 33], s[6 * 33], s[7 * 33]);
        *(GAS u32x2*)(WT + (size_t)(n0 + n) * K + k0 + 8 * c) = o; }
    LDS_WAIT(); asm volatile("" ::: "memory");
}
constexpr float W1_F8_SCALE = 64.0f, W2_F8_SCALE = 128.0f, WPG_F8_SCALE = 64.0f;
struct PIn { const float *x, *p, *w_in, *b_in, *w_ck1, *w_ck2, *w_cv1, *w_cv2, *w_o, *w_r, *w_e1, *b_e1, *w_e2, *w_pg, *w_pp; const int* pos; };
__device__ __forceinline__ void p0_prologue(Frame& F, const PIn& I) {
    LAS float* scr = (LAS float*)(F.lds + RING_OFF + F.wave * 16384);
    const int gw = F.vcu * NWAVES + F.wave, NGW = F.G * NWAVES, lane = F.lane;
    unsigned char* ws = F.ws;
    constexpr int I_IN = 16 * 72, I_O = 16 * 32, I_PG = 16 * 32, I_PP = 4 * 32, I_C1 = 32 * 8, I_C2 = 4 * 2;
    constexpr int I_LAYER = I_IN + I_O + I_PG + I_PP + 2 * I_C1 + 2 * I_C2;
    for (int it = gw; it < NL * I_LAYER; it += NGW) {
        const int L = it / I_LAYER; int r = it % I_LAYER;
        if (r < I_IN) { transpose_item(I.w_in + (size_t)L * 1024 * 2072, 1024, 2072, (bf16*)(ws + WS_WIN) + (size_t)L * NIN * 1024, scr, r / 72, r % 72, lane, MapWin()); continue; } r -= I_IN;
        if (r < I_O) { transpose_item(I.w_o + (size_t)L * 1024 * 1024, 1024, 1024, (bf16*)(ws + WS_WO) + (size_t)L * 1024 * 1024, scr, r / 32, r % 32, lane, MapId()); continue; } r -= I_O;
        if (r < I_PG) {
            if (L == NL - 1) transpose_item_f8(I.w_pg + (size_t)L * 1024 * 1024, 1024, 1024, ws + WS_WPG + (size_t)L * 1024 * 1024 * 2, scr, r / 32, r % 32, lane, MapId(), WPG_F8_SCALE);
            else transpose_item(I.w_pg + (size_t)L * 1024 * 1024, 1024, 1024, (bf16*)(ws + WS_WPG) + (size_t)L * 1024 * 1024, scr, r / 32, r % 32, lane, MapId());
            continue; } r -= I_PG;
        if (r < I_PP) { transpose_item(I.w_pp + (size_t)L * 256 * 1024, 256, 1024, (bf16*)(ws + WS_WPP) + (size_t)L * 1024 * 256, scr, r / 32, r % 32, lane, MapId()); continue; } r -= I_PP;
        if (r < I_C1) { transpose_item(I.w_ck1 + (size_t)L * 2048 * 256, 2048, 256, (bf16*)(ws + WS_WC1) + (size_t)(L * 2 + 0) * 256 * 2048, scr, r / 8, r % 8, lane, MapId()); continue; } r -= I_C1;
        if (r < I_C1) { transpose_item(I.w_cv1 + (size_t)L * 2048 * 256, 2048, 256, (bf16*)(ws + WS_WC1) + (size_t)(L * 2 + 1) * 256 * 2048, scr, r / 8, r % 8, lane, MapId()); continue; } r -= I_C1;
        if (r < I_C2) { transpose_item(I.w_ck2 + (size_t)L * 256 * 64, 256, 64, (bf16*)(ws + WS_WC2) + (size_t)(L * 2 + 0) * 64 * 256, scr, r / 2, r % 2, lane, MapId()); continue; } r -= I_C2;
        { transpose_item(I.w_cv2 + (size_t)L * 256 * 64, 256, 64, (bf16*)(ws + WS_WC2) + (size_t)(L * 2 + 1) * 64 * 256, scr, r / 2, r % 2, lane, MapId()); }
    }
    const size_t gt = (size_t)F.vcu * (NWAVES * 64) + F.tid, NGT = (size_t)F.G * NWAVES * 64;
    for (size_t i = gt; i < (size_t)NL * 32 * 1024; i += NGT) {
        const int L = (int)(i / (32 * 1024)), e = (int)((i / 1024) % 32), k = (int)(i % 1024);
        const float w = I.w_r[((size_t)L * 1024 + k) * 32 + e];
        const unsigned h = f2bf(w); const float wl = w - __uint_as_float(h << 16);
        bf16* d = (bf16*)(ws + WS_WR) + (size_t)L * 2 * 32 * 1024 + (size_t)e * 1024 + k;
        d[0] = (bf16)h; d[32 * 1024] = (bf16)f2bf(wl);
    }
    for (size_t i = gt; i < (size_t)NL * NIN; i += NGT) { const int L = (int)(i / NIN), n = (int)(i % NIN); const int s = MapWin()(n); ((float*)(ws + WS_BINP))[i] = s >= 0 ? I.b_in[(size_t)L * 2072 + s] : 0.f; }
    for (size_t i = gt; i < (size_t)NL * 32 * 2048; i += NGT) { const int le = (int)(i / 2048), n = (int)(i % 2048); ((float*)(ws + WS_B1P))[i] = I.b_e1[(size_t)le * 2048 + MapW1()(n)]; }
    for (size_t i = gt; i < (size_t)M * D / 8; i += NGT) {
        const f32x4 a = *(const GAS f32x4*)(I.x + i * 8), b = *(const GAS f32x4*)(I.x + i * 8 + 4);
        v4u o; o.x = pk2(a.x, a.y); o.y = pk2(a.z, a.w); o.z = pk2(b.x, b.y); o.w = pk2(b.z, b.w);
        *(GAS v4u*)((bf16*)(ws + WS_XB) + i * 8) = o;
    }
    for (size_t i = gt; i < (size_t)NL * M * PD / 8; i += NGT) {
        const f32x4 a = *(const GAS f32x4*)(I.p + i * 8), b = *(const GAS f32x4*)(I.p + i * 8 + 4);
        v4u o; o.x = pk2(a.x, a.y); o.y = pk2(a.z, a.w); o.z = pk2(b.x, b.y); o.w = pk2(b.z, b.w);
        *(GAS v4u*)((bf16*)(ws + WS_PB) + i * 8) = o;
    }
    for (size_t i = gt; i < (size_t)M * 32; i += NGT) {
        const int row = (int)(i >> 5), d = (int)(i & 31);
        const float inv = 1.0f / powf(10000.0f, (float)(2 * d) / 64.0f);
        const float ang = (float)I.pos[row] * inv;
        float* rp = (float*)(ws + WS_ROPE) + (size_t)row * 64;
        rp[d] = cosf(ang); rp[32 + d] = sinf(ang);
    }
}

static_assert(NL == 2, "the conversion queues are laid out for two layers");
constexpr int I_E1 = 32 * 16 * 32, I_E2 = 32 * 16 * 16;
constexpr int QCH = 2;
constexpr int CW_Q = 2048, CW_STOP = 2080;
constexpr int CV_PITCH = 65, CV_WAVE_BYTES = 17408;
static_assert(8 * CV_WAVE_BYTES <= SCRATCH_BYTES && 64 * CV_PITCH * 4 <= CV_WAVE_BYTES, "conversion tiles");
struct CvItem { const float* W; unsigned char* WT; int Nsrc, K, kb, nb, w1; float scale; };
template <int Q>
__device__ __forceinline__ CvItem cv_item(unsigned char* ws, const float* w_e1, const float* w_e2, int item) {
    CvItem d;
    constexpr int L = (Q == 2) ? NL - 1 : 0;
    const bool is1 = (Q == 0) || (Q == 2 && item < I_E1);
    const int r = (Q == 2 && !is1) ? item - I_E1 : item;
    if (is1) { const int e = r / 512, q = r % 512; d.W = w_e1 + ((size_t)L * 32 + e) * 1024 * 2048; d.Nsrc = 2048; d.kb = q / 32; d.nb = q % 32; d.w1 = 1; d.scale = W1_F8_SCALE;
        d.WT = (Q == 2) ? ws + WS_W1T + (size_t)L * 32 * 2048 * 1024 * 2 + (size_t)e * 2048 * 1024 : ws + WS_W1T + (size_t)e * 2048 * 1024 * 2; }
    else { const int e = r / 256, q = r % 256; d.W = w_e2 + ((size_t)L * 32 + e) * 1024 * 1024; d.Nsrc = 1024; d.kb = q / 16; d.nb = q % 16; d.w1 = 0; d.scale = W2_F8_SCALE;
        d.WT = (Q == 2) ? ws + WS_W2T + (size_t)L * 32 * 1024 * 1024 * 2 + (size_t)e * 1024 * 1024 : ws + WS_W2T + (size_t)e * 1024 * 1024 * 2; }
    d.K = 1024;
    return d;
}
__device__ __forceinline__ void cv_load(f32x4 (&r)[16], const CvItem& d, int lane) {
    const int kl = lane >> 4, c = lane & 15, n = 64 * d.nb + 4 * c;
    const int src = d.w1 ? MapW1()(n) : n;
    const float* p = d.W + (size_t)(64 * d.kb + kl) * d.Nsrc + src;
#pragma unroll
    for (int i = 0; i < 16; ++i) r[i] = __builtin_nontemporal_load((const GAS f32x4*)(p + (size_t)(4 * i) * d.Nsrc));
}
template <bool F8>
__device__ __forceinline__ void cv_store(const f32x4 (&r)[16], const CvItem& d, LAS float* scr, int lane) {
    const int kl = lane >> 4, c = lane & 15;
#pragma unroll
    for (int i = 0; i < 16; ++i) { LAS float* t = scr + (4 * i + kl) * CV_PITCH + 4 * c; t[0] = r[i].x; t[1] = r[i].y; t[2] = r[i].z; t[3] = r[i].w; }
    LDS_WAIT(); asm volatile("" ::: "memory");
    const int c8 = lane & 7, nl = lane >> 3;
#pragma unroll
    for (int jj = 0; jj < 8; ++jj) { const int n = nl + 8 * jj; const LAS float* s = scr + (8 * c8) * CV_PITCH + n;
        const float a0 = s[0 * CV_PITCH], a1 = s[1 * CV_PITCH], a2 = s[2 * CV_PITCH], a3 = s[3 * CV_PITCH], a4 = s[4 * CV_PITCH], a5 = s[5 * CV_PITCH], a6 = s[6 * CV_PITCH], a7 = s[7 * CV_PITCH];
        const size_t o = (size_t)(64 * d.nb + n) * d.K + 64 * d.kb + 8 * c8;
        if constexpr (F8) { const float w = d.scale; u32x2 v; v.x = pk4_fp8(a0 * w, a1 * w, a2 * w, a3 * w); v.y = pk4_fp8(a4 * w, a5 * w, a6 * w, a7 * w); __builtin_nontemporal_store(v, (GAS u32x2*)(d.WT + o)); }
        else { v4u v; v.x = pk2(a0, a1); v.y = pk2(a2, a3); v.z = pk2(a4, a5); v.w = pk2(a6, a7); __builtin_nontemporal_store(v, (GAS v4u*)((bf16*)d.WT + o)); } }
    LDS_WAIT(); asm volatile("" ::: "memory");
}
template <int Q>
__device__ __forceinline__ void conv_run(Frame& F, const float* w_e1, const float* w_e2, int stop_word, unsigned stop_thr = 1u, int stat = -1) {
    static_assert(QCH == 2, "one loop trip = one chunk = items A, B");
    constexpr int NCH = (Q == 0 ? I_E1 : Q == 1 ? I_E2 : I_E1 + I_E2) / QCH;
    constexpr bool F8 = (Q == 2);
    LAS float* scr = (LAS float*)(F.lds + RING_OFF + F.wave * CV_WAVE_BYTES);
    gu32* head = F.ctl + CW_Q + Q;
    const int lane = F.lane;
    if (__builtin_amdgcn_readfirstlane(__hip_atomic_load(head, RLX_AGENT)) >= (unsigned)NCH) return;
    if (stop_word >= 0 && __builtin_amdgcn_readfirstlane(__hip_atomic_load(F.ctl + stop_word, RLX_AGENT)) >= stop_thr) return;
    const __amdgpu_buffer_rsrc_t rs = __builtin_amdgcn_make_buffer_rsrc((unsigned*)head, 0, 4, 0x00020000);
    const int own = lane == 0 ? 0 : 0x40000000;
    unsigned c = (unsigned)__builtin_amdgcn_readfirstlane(__builtin_amdgcn_raw_ptr_buffer_atomic_add_i32(1, rs, own, 0, 0));
    if (c >= (unsigned)NCH) return;
    int pend = __builtin_amdgcn_raw_ptr_buffer_atomic_add_i32(1, rs, own, 0, 0);
    unsigned stp = 0u; bool last = false;
    if (stop_word >= 0) stp = __hip_atomic_load(F.ctl + stop_word, RLX_AGENT);
#ifdef PRB_SEL
    unsigned ndone = 0u;
#endif
    f32x4 ra[16], rb[16];
    CvItem da = cv_item<Q>(F.ws, w_e1, w_e2, (int)c * QCH), db;
    cv_load(ra, da, lane);
    for (;;) {
        db = cv_item<Q>(F.ws, w_e1, w_e2, (int)c * QCH + 1); cv_load(rb, db, lane);
        cv_store<F8>(ra, da, scr, lane);
        const unsigned cn = (unsigned)__builtin_amdgcn_readfirstlane(pend);
        const bool stopped = stop_word >= 0 && (unsigned)__builtin_amdgcn_readfirstlane(stp) >= stop_thr;
        const bool more = !last && cn < (unsigned)NCH;
        if (more) {
            pend = __builtin_amdgcn_raw_ptr_buffer_atomic_add_i32(1, rs, stopped ? 0x40000000 : own, 0, 0);
            last = stopped;
            if (stop_word >= 0) stp = __hip_atomic_load(F.ctl + stop_word, RLX_AGENT);
            da = cv_item<Q>(F.ws, w_e1, w_e2, (int)cn * QCH); cv_load(ra, da, lane);
        }
        cv_store<F8>(rb, db, scr, lane);
#ifdef PRB_SEL
        ++ndone;
#endif
        if (!more) break;
        c = cn;
    }
#ifdef PRB_SEL
    if (stat >= 0 && lane == 0) (void)__hip_atomic_fetch_add((gu32*)(F.ws + WS_TOKE + 3 * MiB) + stat, ndone, RLX_AGENT);
#endif
}

__device__ __forceinline__ float gelu_tanh(float x) {
    const float u = 0.7978845608028654f * (x + 0.044715f * x * x * x);
    const float e = __builtin_amdgcn_exp2f(2.0f * 1.4426950408889634f * u);
    const float t = 1.0f - 2.0f * __builtin_amdgcn_rcpf(e + 1.0f);
    return 0.5f * x * (1.0f + t);
}
__device__ __forceinline__ void phase_compress(Frame& F, int L, const float* ck_pe, const float* cv_pe) {
    const int lane = F.lane, wave = F.wave, tid = F.tid;
    unsigned char* ws = F.ws;
    const bf16* H = (const bf16*)(ws + WS_H);
    const float* rope = (const float*)(ws + WS_ROPE);
    LAS unsigned char* hid = F.lds + RING_OFF;
    LAS float* pel = (LAS float*)(F.lds + RING_OFF + 16896);
    LAS unsigned char* atok = F.lds + RING_OFF + 16896 + 8192;
    constexpr int AP = 144, AIS = 33 * AP;
    for (int unit = blockIdx.x; unit < 256; unit += F.G) {
        int lane_v = lane; asm volatile("" : "+v"(lane_v));
        const int q = lane_v & 31, hi = lane_v >> 5;
        const int b = unit >> 4, g = (unit >> 3) & 1, kv = (unit >> 2) & 1, cb = unit & 3;
        const bf16* w1t = (const bf16*)(ws + WS_WC1) + (size_t)(L * 2 + kv) * 256 * 2048;
        const bf16* w2t = (const bf16*)(ws + WS_WC2) + (size_t)(L * 2 + kv) * 64 * 256;
        const float* pe = (kv ? cv_pe : ck_pe) + (size_t)L * 32 * 64;
        const int scol = (kv ? C_VC : C_KC) + g * 64;
        const int tok0 = 512 * cb;
        __syncthreads();
        for (int ci = tid; ci < 528 * 8; ci += NWAVES * 64) {
            const int tk = ci >> 3, ch = ci & 7; int tg = tok0 + tk; tg = tg < T ? tg : T - 1;
            *(LAS v4u*)(atok + (tk & 15) * AIS + (tk >> 4) * AP + ch * 16) = *(const GAS v4u*)(H + ((size_t)b * T + tg) * HP + scol + ch * 8);
        }
        for (int ci = tid; ci < 32 * 64 / 4; ci += NWAVES * 64) *(LAS f32x4*)(pel + ci * 4) = *(const GAS f32x4*)(pe + ci * 4);
        __syncthreads();
        const bf16* brow = w1t + (size_t)(32 * wave + q) * 2048 + 8 * hi;
        f32x16 acc; for (int r = 0; r < 16; ++r) acc[r] = 0.f;
        bf16x8 bcur[8], bnxt[8];
#pragma unroll
        for (int u = 0; u < 8; ++u) bcur[u] = *(const GAS bf16x8*)(brow + u * 16);
        for (int i2 = 0; i2 < 16; ++i2) {
            if (i2 < 15) {
#pragma unroll
                for (int u = 0; u < 8; ++u) bnxt[u] = *(const GAS bf16x8*)(brow + (i2 + 1) * 128 + u * 16);
            }
#pragma unroll
            for (int u = 0; u < 8; ++u) {
                const int i = 2 * i2 + (u >> 2), s4 = u & 3;
                const v4u av = *(const LAS v4u*)(atok + (i & 15) * AIS + (q + (i >> 4)) * AP + (16 * s4 + 8 * hi) * 2);
                const f32x4 p0 = *(const LAS f32x4*)(pel + i * 64 + 16 * s4 + 8 * hi), p1 = *(const LAS f32x4*)(pel + i * 64 + 16 * s4 + 8 * hi + 4);
                const bf16x8 af = pack8(bf_lo(av.x) + p0.x, bf_hi(av.x) + p0.y, bf_lo(av.y) + p0.z, bf_hi(av.y) + p0.w, bf_lo(av.z) + p1.x, bf_hi(av.z) + p1.y, bf_lo(av.w) + p1.z, bf_hi(av.w) + p1.w);
                acc = __builtin_amdgcn_mfma_f32_32x32x16_bf16(af, bcur[u], acc, 0, 0, 0);
            }
#pragma unroll
            for (int u = 0; u < 8; ++u) bcur[u] = bnxt[u];
        }
#pragma unroll
        for (int r = 0; r < 16; ++r) *(LAS bf16*)(hid + crow(r, hi) * 528 + (32 * wave + q) * 2) = (bf16)f2bf(gelu_tanh(acc[r]));
        __syncthreads();
        if (wave == 0) {
            f32x16 a0, a1; for (int r = 0; r < 16; ++r) { a0[r] = 0.f; a1[r] = 0.f; }
#pragma unroll
            for (int ks = 0; ks < 16; ++ks) {
                const bf16x8 af = *(const LAS bf16x8*)(hid + q * 528 + (16 * ks + 8 * hi) * 2);
                const bf16x8 b0 = *(const GAS bf16x8*)(w2t + (size_t)q * 256 + 16 * ks + 8 * hi), b1 = *(const GAS bf16x8*)(w2t + (size_t)(32 + q) * 256 + 16 * ks + 8 * hi);
                a0 = __builtin_amdgcn_mfma_f32_32x32x16_bf16(af, b0, a0, 0, 0, 0);
                a1 = __builtin_amdgcn_mfma_f32_32x32x16_bf16(af, b1, a1, 0, 0, 0);
            }
            bf16* outp = (bf16*)(ws + (kv ? WS_VCMP : WS_KCMP)) + (size_t)(b * 2 + g) * 128 * 64;
#pragma unroll
            for (int r = 0; r < 16; ++r) {
                const int cl = 32 * cb + crow(r, hi);
                float x1 = a0[r], x2 = a1[r];
                if (kv == 0) {
                    const int cr = cl < 127 ? cl : 126;
                    const float* rp = rope + ((size_t)b * T + 31 + 16 * cr) * 64;
                    const float cs = rp[q], sn = rp[32 + q];
                    const float o1 = x1 * cs - x2 * sn, o2 = x2 * cs + x1 * sn; x1 = o1; x2 = o2;
                }
                if (cl >= 127) { x1 = 0.f; x2 = 0.f; }
                outp[(size_t)cl * 64 + q] = (bf16)f2bf(x1); outp[(size_t)cl * 64 + 32 + q] = (bf16)f2bf(x2);
            }
        }
    }
    __syncthreads();
}

namespace att {
constexpr float ATT_THR = 6.0f;
constexpr int KP = 144;
constexpr int KTB = 64 * KP, VTB = 8192;
constexpr int L_K = 0;
constexpr int L_V = 4 * KTB;
constexpr int L_KC = 0;
constexpr int L_VC = 128 * KP;
constexpr int L_IMP = L_VC + 16384;
constexpr int L_OT = 4 * KTB + 4 * VTB;
constexpr int L_SEL = L_OT + 65536;
static_assert(L_IMP + 4 * 64 * 33 * 4 <= L_OT && L_SEL + 256 <= SCRATCH_BYTES, "attention LDS map");

__device__ __forceinline__ float max3f(float a, float b, float c) { float r; asm("v_max3_f32 %0, %1, %2, %3" : "=v"(r) : "v"(a), "v"(b), "v"(c)); return r; }
__device__ __forceinline__ float max2f(float a, float b) { float r; asm("v_max_f32_e32 %0, %1, %2" : "=v"(r) : "v"(a), "v"(b)); return r; }
typedef short v4i16_t __attribute__((ext_vector_type(4)));
__device__ __forceinline__ u32x2 vtr(const LAS unsigned char* p) { return __builtin_bit_cast(u32x2, __builtin_amdgcn_ds_read_tr16_b64_v4i16((LAS v4i16_t*)p)); }
__device__ __forceinline__ float xhalf_max(float v) { auto rr = __builtin_amdgcn_permlane32_swap(__float_as_uint(v), __float_as_uint(v), false, false); return fmaxf(__uint_as_float(rr[0]), __uint_as_float(rr[1])); }
__device__ __forceinline__ float xhalf_sum(float v) { auto rr = __builtin_amdgcn_permlane32_swap(__float_as_uint(v), __float_as_uint(v), false, false); return __uint_as_float(rr[0]) + __uint_as_float(rr[1]); }
template <bool SEL>
__device__ __forceinline__ void att_tile(LAS unsigned char* Kl, LAS unsigned char* Vl, int j, int qt, int jlo, int t, int W, unsigned selbits, const bf16x8 (&qf)[4],
                                         f32x16& o0, f32x16& o1, f32x16& negm, float& m_run, float& l_run, int q, int hi) {
        bf16x8 ka[4], kb2[4]; u32x2 va[4][2], vb[4][2];
#pragma unroll
        for (int s = 0; s < 4; ++s) { ka[s] = *(const LAS bf16x8*)(Kl + q * KP + (16 * s + 8 * hi) * 2); kb2[s] = *(const LAS bf16x8*)(Kl + (32 + q) * KP + (16 * s + 8 * hi) * 2); }
        {
            const LAS unsigned char* vp = Vl + ((q >> 4) & 1) * 32 + (q & 3) * 8 + (4 * hi + ((q & 15) >> 2)) * 64;
#pragma unroll
            for (int ks = 0; ks < 4; ++ks) {
                va[ks][0] = vtr(vp + ks * 1024); va[ks][1] = vtr(vp + ks * 1024 + 512);
                vb[ks][0] = vtr(vp + 4096 + ks * 1024); vb[ks][1] = vtr(vp + 4096 + ks * 1024 + 512);
            }
        }
        __builtin_amdgcn_sched_barrier(0);
        f32x16 s0 = __builtin_amdgcn_mfma_f32_32x32x16_bf16(ka[0], qf[0], negm, 0, 0, 0);
        f32x16 s1 = __builtin_amdgcn_mfma_f32_32x32x16_bf16(kb2[0], qf[0], negm, 0, 0, 0);
#pragma unroll
        for (int s = 1; s < 4; ++s) {
            s0 = __builtin_amdgcn_mfma_f32_32x32x16_bf16(ka[s], qf[s], s0, 0, 0, 0);
            s1 = __builtin_amdgcn_mfma_f32_32x32x16_bf16(kb2[s], qf[s], s1, 0, 0, 0);
        }
        const bool lane_ok = SEL ? (((selbits >> j) & 1u) != 0u) : true;
        if (j == qt || j == jlo) {
            const int d0 = t - 64 * j - 4 * hi;
#pragma unroll
            for (int r = 0; r < 16; ++r) {
                s0[r] = ((unsigned)(d0 - ((r & 3) + 8 * (r >> 2))) < (unsigned)W) ? s0[r] : -INFINITY;
                s1[r] = ((unsigned)(d0 - (32 + (r & 3) + 8 * (r >> 2))) < (unsigned)W) ? s1[r] : -INFINITY;
            }
        }
        float mx = fmaxf(s0[0], s1[0]), mx2 = fmaxf(s0[1], s1[1]);
#pragma unroll
        for (int r = 2; r < 16; r += 2) { mx = max3f(mx, s0[r], s1[r]); mx2 = max3f(mx2, s0[r + 1], s1[r + 1]); }
        mx = max2f(mx, mx2);
        mx = lane_ok ? mx : -INFINITY;
        mx = xhalf_max(mx);
        typedef float f32x2_ __attribute__((ext_vector_type(2)));
        f32x2_ ps2 = {0.f, 0.f};
#pragma unroll
        for (int r = 0; r < 16; ++r) { s0[r] = __builtin_amdgcn_exp2f(s0[r]); s1[r] = __builtin_amdgcn_exp2f(s1[r]); ps2 += (f32x2_){s0[r], s1[r]}; }
        const float ps = ps2.x + ps2.y;
        const unsigned okm = lane_ok ? 0xffffffffu : 0u;
        l_run += lane_ok ? ps : 0.f;
#pragma unroll
        for (int ks = 0; ks < 4; ++ks) {
            const int kb = ks >> 1, sp = ks & 1;
            bf16x8 pf = kb ? pack8(s1[8 * sp + 0], s1[8 * sp + 1], s1[8 * sp + 2], s1[8 * sp + 3], s1[8 * sp + 4], s1[8 * sp + 5], s1[8 * sp + 6], s1[8 * sp + 7])
                           : pack8(s0[8 * sp + 0], s0[8 * sp + 1], s0[8 * sp + 2], s0[8 * sp + 3], s0[8 * sp + 4], s0[8 * sp + 5], s0[8 * sp + 6], s0[8 * sp + 7]);
            if (SEL) { v4u pw = __builtin_bit_cast(v4u, pf); pw.x &= okm; pw.y &= okm; pw.z &= okm; pw.w &= okm; pf = __builtin_bit_cast(bf16x8, pw); }
            {
                v4u w; w.x = va[ks][0].x; w.y = va[ks][0].y; w.z = va[ks][1].x; w.w = va[ks][1].y;
                o0 = __builtin_amdgcn_mfma_f32_32x32x16_bf16(__builtin_bit_cast(bf16x8, w), pf, o0, 0, 0, 0);
            }
            {
                v4u w; w.x = vb[ks][0].x; w.y = vb[ks][0].y; w.z = vb[ks][1].x; w.w = vb[ks][1].y;
                o1 = __builtin_amdgcn_mfma_f32_32x32x16_bf16(__builtin_bit_cast(bf16x8, w), pf, o1, 0, 0, 0);
            }
        }
        if (__builtin_amdgcn_ballot_w64(mx > ATT_THR) != 0ull) {
            const float gmx = fmaxf(mx, 0.f);
            const float alpha = __builtin_amdgcn_exp2f(-gmx);
            l_run *= alpha; m_run += gmx;
#pragma unroll
            for (int r = 0; r < 16; ++r) { o0[r] *= alpha; o1[r] *= alpha; negm[r] -= gmx; }
        }
}
template <bool SEL>
__device__ __forceinline__ void stream(LAS unsigned char* lds, const bf16* Hb, int kcol, int vcol, int j0, int j1, int qt, int t, int W, unsigned selbits,
                                       const bf16x8 (&qf)[4], f32x16& o0, f32x16& o1, float& m_run, float& l_run, int tid, int lane, int wave) {
    const int q = lane & 31, hi = lane >> 5;
    const int krow = tid >> 3, kch = tid & 7, vrow = krow, vch = kch;
    const int vdst = (kch >> 2) * 4096 + (krow >> 3) * 512 + (krow & 7) * 64 + (kch & 3) * 16;
    const int jlo = qt - (W >> 6);
    f32x16 negm;
#pragma unroll
    for (int r = 0; r < 16; ++r) negm[r] = -m_run;
    __syncthreads();
    const bf16* kp0 = Hb + (size_t)(64 * j0 + krow) * HP + kcol + kch * 8;
    const bf16* vp0 = Hb + (size_t)(64 * j0 + vrow) * HP + vcol + vch * 8;
    v4u kA = *(const GAS v4u*)kp0, vA = *(const GAS v4u*)vp0, kB = kA, vB = vA;
    if (j0 + 1 <= j1) { kB = *(const GAS v4u*)(kp0 + (size_t)64 * HP); vB = *(const GAS v4u*)(vp0 + (size_t)64 * HP); }
    int pp = 0;
    for (int jp = j0; jp <= j1; jp += 2, pp ^= 1) {
        const bool has2 = jp + 1 <= j1;
        LAS unsigned char* Kl0 = lds + L_K + pp * (2 * KTB); LAS unsigned char* Kl1 = Kl0 + KTB;
        LAS unsigned char* Vl0 = lds + L_V + pp * (2 * VTB); LAS unsigned char* Vl1 = Vl0 + VTB;
        *(LAS v4u*)(Kl0 + krow * KP + kch * 16) = kA;
        *(LAS v4u*)(Vl0 + vdst) = vA;
        if (has2) { *(LAS v4u*)(Kl1 + krow * KP + kch * 16) = kB; *(LAS v4u*)(Vl1 + vdst) = vB; }
        if (jp + 2 <= j1) { kA = *(const GAS v4u*)(kp0 + (size_t)(64 * (jp + 2 - j0)) * HP); vA = *(const GAS v4u*)(vp0 + (size_t)(64 * (jp + 2 - j0)) * HP); }
        if (jp + 3 <= j1) { kB = *(const GAS v4u*)(kp0 + (size_t)(64 * (jp + 3 - j0)) * HP); vB = *(const GAS v4u*)(vp0 + (size_t)(64 * (jp + 3 - j0)) * HP); }
        __syncthreads();
        att_tile<SEL>(Kl0, Vl0, jp, qt, jlo, t, W, selbits, qf, o0, o1, negm, m_run, l_run, q, hi);
        if (has2) att_tile<SEL>(Kl1, Vl1, jp + 1, qt, jlo, t, W, selbits, qf, o0, o1, negm, m_run, l_run, q, hi);
    }
}

__device__ __forceinline__ void phase_attention(Frame& F, int L, const float* sinks_all) {
    const int tid = F.tid, lane = F.lane, wave = F.wave;
    const int rh = wave >> 1, th = wave & 1;
    unsigned char* ws = F.ws;
    LAS unsigned char* lds = F.lds + RING_OFF;
    const bf16* H = (const bf16*)(ws + WS_H);
    bf16* O = (bf16*)(ws + WS_O);
    const float* gates = (const float*)(ws + WS_GATES);
    const float* sinks = sinks_all + L * 8;
    LAS float* impb = (LAS float*)(lds + L_IMP);
    LAS unsigned* selm = (LAS unsigned*)(lds + L_SEL);
    const int NU = 2048;
    if (wave >= 4) __builtin_amdgcn_s_setprio(1);
    for (int i = 0;; ++i) {
        const int pos = (i & 1) ? (F.G - 1 - (int)blockIdx.x) : (int)blockIdx.x;
        const int n = i * F.G + pos;
        if (i * F.G >= NU) break;
        if (n >= NU) continue;
        const bool nsa = n < 1024;
        int b, g, qt;
        if (nsa) { qt = 31 - (n >> 5); b = (n & 31) >> 1; g = n & 1; }
        else { const int m2 = n - 1024; qt = 31 - (m2 >> 5); b = (m2 & 31) >> 1; g = m2 & 1; }
        int lane_v = lane; asm volatile("" : "+v"(lane_v));
        const int q = lane_v & 31, hi = lane_v >> 5;
        const int hq = 4 * g + rh;
        const int t = 64 * qt + 32 * th + q;
        const size_t row = (size_t)b * T + t;
        const bf16* Hb = H + (size_t)b * T * HP;
        bf16x8 qf[4];
        {
            const bf16* qp = H + row * HP + (nsa ? C_QN : C_QS) + 64 * hq + 8 * hi;
#pragma unroll
            for (int s = 0; s < 4; ++s) qf[s] = *(const GAS bf16x8*)(qp + 16 * s);
        }
        f32x16 ot0, ot1;
        if (nsa) {
            const float* gp = gates + row * 32 + hq * 3;
            const float g_cmp = gp[0], g_slc = gp[1], g_win = gp[2];
            __syncthreads();
            {
                const bf16* kc = (const bf16*)(ws + WS_KCMP) + (size_t)(b * 2 + g) * 128 * 64;
                const bf16* vc = (const bf16*)(ws + WS_VCMP) + (size_t)(b * 2 + g) * 128 * 64;
#pragma unroll
                for (int it = 0; it < 2; ++it) {
                    const int ci = tid + 512 * it, r = ci >> 3, ch = ci & 7;
                    *(LAS v4u*)(lds + L_KC + r * KP + ch * 16) = *(const GAS v4u*)(kc + (size_t)r * 64 + ch * 8);
                    *(LAS v4u*)(lds + L_VC + (ch >> 2) * 8192 + (r >> 3) * 512 + (r & 7) * 64 + (ch & 3) * 16) = *(const GAS v4u*)(vc + (size_t)r * 64 + ch * 8);
                }
            }
            __syncthreads();
            f32x16 sc[4];
#pragma unroll
            for (int kb = 0; kb < 4; ++kb) {
#pragma unroll
                for (int r = 0; r < 16; ++r) sc[kb][r] = 0.f;
#pragma unroll
                for (int s = 0; s < 4; ++s) {
                    const bf16x8 a = *(const LAS bf16x8*)(lds + L_KC + (32 * kb + q) * KP + (16 * s + 8 * hi) * 2);
                    sc[kb] = __builtin_amdgcn_mfma_f32_32x32x16_bf16(a, qf[s], sc[kb], 0, 0, 0);
                }
                __builtin_amdgcn_sched_barrier(0);
            }
            float mx = -INFINITY;
            const int cth = (((t - 31) >> 4) < 126 ? ((t - 31) >> 4) : 126) - 4 * hi;
#pragma unroll
            for (int kb = 0; kb < 4; ++kb)
#pragma unroll
                for (int r = 0; r < 16; ++r) {
                    const bool vis = (32 * kb + (r & 3) + 8 * (r >> 2)) <= cth;
                    sc[kb][r] = vis ? sc[kb][r] : -INFINITY;
                    mx = fmaxf(mx, sc[kb][r]);
                }
            mx = xhalf_max(mx);
            mx = fmaxf(mx, -1e30f);
            float ps = 0.f;
#pragma unroll
            for (int kb = 0; kb < 4; ++kb)
#pragma unroll
                for (int r = 0; r < 16; ++r) { sc[kb][r] = __builtin_amdgcn_exp2f(sc[kb][r] - mx); ps += sc[kb][r]; }
            ps = xhalf_sum(ps);
            const float inv = 1.0f / fmaxf(ps, 1e-30f);
#pragma unroll
            for (int kb = 0; kb < 4; ++kb)
#pragma unroll
                for (int r = 0; r < 16; ++r) sc[kb][r] *= inv;
#pragma unroll
            for (int kb = 0; kb < 4; ++kb)
#pragma unroll
                for (int ii = 0; ii < 4; ++ii)
                    impb[(rh * 64 + 32 * th + q) * 33 + 8 * kb + 2 * ii + hi] = (sc[kb][4 * ii] + sc[kb][4 * ii + 1]) + (sc[kb][4 * ii + 2] + sc[kb][4 * ii + 3]);
            f32x16 c0, c1;
#pragma unroll
            for (int r = 0; r < 16; ++r) { c0[r] = 0.f; c1[r] = 0.f; }
#pragma unroll
            for (int ks = 0; ks < 8; ++ks) {
                const int kb = ks >> 1, sp = ks & 1;
                const bf16x8 pf = pack8(sc[kb][8 * sp + 0], sc[kb][8 * sp + 1], sc[kb][8 * sp + 2], sc[kb][8 * sp + 3], sc[kb][8 * sp + 4], sc[kb][8 * sp + 5], sc[kb][8 * sp + 6], sc[kb][8 * sp + 7]);
                const LAS unsigned char* vp = lds + L_VC + ((q >> 4) & 1) * 32 + (q & 3) * 8 + (4 * hi + ((q & 15) >> 2)) * 64 + ks * 1024;
                {
                    const u32x2 lo = vtr(vp), hh = vtr(vp + 512);
                    v4u w; w.x = lo.x; w.y = lo.y; w.z = hh.x; w.w = hh.y;
                    c0 = __builtin_amdgcn_mfma_f32_32x32x16_bf16(__builtin_bit_cast(bf16x8, w), pf, c0, 0, 0, 0);
                }
                {
                    const u32x2 lo = vtr(vp + 8192), hh = vtr(vp + 8192 + 512);
                    v4u w; w.x = lo.x; w.y = lo.y; w.z = hh.x; w.w = hh.y;
                    c1 = __builtin_amdgcn_mfma_f32_32x32x16_bf16(__builtin_bit_cast(bf16x8, w), pf, c1, 0, 0, 0);
                }
                if (ks & 1) __builtin_amdgcn_sched_barrier(0);
            }
            __syncthreads();
            if (qt >= 8) {
                const int tok = tid >> 3, sub = tid & 7;
                unsigned key[4];
#pragma unroll
                for (int ii = 0; ii < 4; ++ii) {
                    const int j = 4 * sub + ii;
                    const float sum = (impb[tok * 33 + j] + impb[(64 + tok) * 33 + j]) + (impb[(128 + tok) * 33 + j] + impb[(192 + tok) * 33 + j]);
                    const unsigned kb = (__float_as_uint(sum) & ~31u) | (unsigned)(31 - j);
                    key[ii] = (j >= 1 && j <= qt - 2) ? kb : 0u;
                }
                unsigned mask = 1u | (1u << qt) | (1u << (qt - 1));
#pragma unroll
                for (int rnd = 0; rnd < 5; ++rnd) {
                    unsigned bk = key[0] > key[1] ? key[0] : key[1]; const unsigned b2 = key[2] > key[3] ? key[2] : key[3]; bk = bk > b2 ? bk : b2;
                    unsigned o1 = (unsigned)__shfl_xor((int)bk, 1); bk = bk > o1 ? bk : o1;
                    o1 = (unsigned)__shfl_xor((int)bk, 2); bk = bk > o1 ? bk : o1;
                    o1 = (unsigned)__shfl_xor((int)bk, 4); bk = bk > o1 ? bk : o1;
                    mask |= 1u << (31u - (bk & 31u));
#pragma unroll
                    for (int ii = 0; ii < 4; ++ii) key[ii] = key[ii] == bk ? 0u : key[ii];
                }
                if (sub == 0) selm[tok] = mask;
            } else if (tid < 64) selm[tid] = (2u << qt) - 1u;
            __syncthreads();
            const unsigned selbits = selm[32 * th + q];
            LAS float* otl = (LAS float*)(lds + L_OT + wave * 8192) + lane_v;
#pragma unroll
            for (int r = 0; r < 16; ++r) { otl[r * 64] = g_cmp * c0[r]; otl[(16 + r) * 64] = g_cmp * c1[r]; }
            {
                f32x16 a0, a1; float mr = 0.f, lr = 0.f;
#pragma unroll
                for (int r = 0; r < 16; ++r) { a0[r] = 0.f; a1[r] = 0.f; }
                stream<true>(lds, Hb, C_KS + 64 * g, C_VS + 64 * g, 0, qt, qt, t, 1 << 20, selbits, qf, a0, a1, mr, lr, tid, lane_v, wave);
                lr = xhalf_sum(lr);
                const float f = g_slc / fmaxf(lr, 1e-30f);
#pragma unroll
                for (int r = 0; r < 16; ++r) { otl[r * 64] += f * a0[r]; otl[(16 + r) * 64] += f * a1[r]; }
            }
            {
                f32x16 a0, a1; float mr = 0.f, lr = 0.f;
#pragma unroll
                for (int r = 0; r < 16; ++r) { a0[r] = 0.f; a1[r] = 0.f; }
                stream<false>(lds, Hb, C_KW + 64 * g, C_VW + 64 * g, qt >= 8 ? qt - 8 : 0, qt, qt, t, 512, 0u, qf, a0, a1, mr, lr, tid, lane_v, wave);
                lr = xhalf_sum(lr);
                const float f = g_win / fmaxf(lr, 1e-30f);
#pragma unroll
                for (int r = 0; r < 16; ++r) { ot0[r] = otl[r * 64] + f * a0[r]; ot1[r] = otl[(16 + r) * 64] + f * a1[r]; }
            }
        } else {
            f32x16 a0, a1; float mr = 0.f, lr = 0.f;
#pragma unroll
            for (int r = 0; r < 16; ++r) { a0[r] = 0.f; a1[r] = 0.f; }
            stream<false>(lds, Hb, C_KSW + 64 * g, C_VSW + 64 * g, qt >= 2 ? qt - 2 : 0, qt, qt, t, 128, 0u, qf, a0, a1, mr, lr, tid, lane_v, wave);
            lr = xhalf_sum(lr);
            const float sk = sinks[hq] * 1.4426950408889634f;
            const float mf = fmaxf(mr, sk);
            const float sm = __builtin_amdgcn_exp2f(mr - mf);
            const float den = lr * sm + __builtin_amdgcn_exp2f(sk - mf);
            const float f = sm / fmaxf(den, 1e-30f);
#pragma unroll
            for (int r = 0; r < 16; ++r) { ot0[r] = f * a0[r]; ot1[r] = f * a1[r]; }
        }
        bf16* op = O + row * 1024 + (nsa ? 0 : 512) + 64 * hq + 4 * hi;
#pragma unroll
        for (int ii = 0; ii < 4; ++ii) {
            u32x2 w0, w1;
            w0.x = cvtpk(ot0[4 * ii], ot0[4 * ii + 1]); w0.y = cvtpk(ot0[4 * ii + 2], ot0[4 * ii + 3]);
            w1.x = cvtpk(ot1[4 * ii], ot1[4 * ii + 1]); w1.y = cvtpk(ot1[4 * ii + 2], ot1[4 * ii + 3]);
            *(GAS u32x2*)(op + 8 * ii) = w0; *(GAS u32x2*)(op + 32 + 8 * ii) = w1;
        }
    }
    __builtin_amdgcn_s_setprio(0);
}
}

template <bool F8, bool XSPLIT>
__device__ __forceinline__ void phase_ln1_router(Frame& F, int L, const float* xres, const float* ln_g, const float* ln_b, const float* b_r) {
    const int tid = F.tid, lane = F.lane, wave = F.wave;
    unsigned char* ws = F.ws;
    const bf16* A1 = (const bf16*)(ws + WS_Y1);
    unsigned char* X1L = ws + WS_X1L;
    bf16* X1B = (bf16*)(ws + WS_X1B);
    const bf16* XRB = (const bf16*)(ws + WS_XB); const unsigned char* XRL = ws + WS_XNL;
    const bf16* Wh = (const bf16*)(ws + WS_WR) + (size_t)L * 2 * 32 * 1024;
    const bf16* Wl = Wh + 32 * 1024;
    LAS float* scr = (LAS float*)(F.lds + RING_OFF + wave * 4096);
    LAS unsigned* cntl = (LAS unsigned*)(F.lds + RING_OFF + 65536);
    LAS unsigned* basel = cntl + 32;
    gu32* gcnt = F.ctl + CW_CNT + L * 32;
    f32x4 gam[4], bet[4];
#pragma unroll
    for (int j = 0; j < 4; ++j) { gam[j] = *(const GAS f32x4*)(ln_g + (size_t)L * D + 4 * lane + 256 * j); bet[j] = *(const GAS f32x4*)(ln_b + (size_t)L * D + 4 * lane + 256 * j); }
    for (int chunk = blockIdx.x; chunk < M / 128; chunk += F.G) {
        if (tid < 32) cntl[tid] = 0u;
        __syncthreads();
        const int tok0 = chunk * 128 + wave * 16;
        for (int rr = 0; rr < 16; ++rr) {
            const size_t row = (size_t)(tok0 + rr);
            f32x4 v[4]; float s = 0.f;
#pragma unroll
            for (int j = 0; j < 4; ++j) {
                const u32x2 av = *(const GAS u32x2*)(A1 + row * D + 4 * lane + 256 * j);
                f32x4 xr4;
                if constexpr (XSPLIT) xr4 = rs_dec(*(const GAS u32x2*)(XRB + row * D + 4 * lane + 256 * j), *(const GAS unsigned*)(XRL + row * D + 4 * lane + 256 * j));
                else xr4 = *(const GAS f32x4*)(xres + row * D + 4 * lane + 256 * j);
                v[j] = xr4 * DN_ALPHA + (f32x4){bf_lo(av.x), bf_hi(av.x), bf_lo(av.y), bf_hi(av.y)};
                s += (v[j].x + v[j].y) + (v[j].z + v[j].w);
            }
            const float mean = wave_sum(s) * (1.f / D); float s2 = 0.f;
#pragma unroll
            for (int j = 0; j < 4; ++j) { v[j] = v[j] - mean; s2 += (v[j].x * v[j].x + v[j].y * v[j].y) + (v[j].z * v[j].z + v[j].w * v[j].w); }
            const float rstd = 1.f / sqrtf(wave_sum(s2) * (1.f / D) + LN_EPS);
#pragma unroll
            for (int j = 0; j < 4; ++j) {
                const f32x4 o = v[j] * rstd * gam[j] + bet[j];
                u32x2 w; unsigned xb8; rs_enc(o, w, xb8);
                *(GAS u32x2*)(X1B + row * D + 4 * lane + 256 * j) = w;
                if constexpr (!F8) *(GAS unsigned*)(X1L + row * D + 4 * lane + 256 * j) = xb8;
                if constexpr (F8) *(GAS unsigned*)(ws + WS_X1F8 + row * D + 4 * lane + 256 * j) = pk4_fp8(o.x, o.y, o.z, o.w);
            }
            if (lane == 0) { scr[16 * 33 + 2 * rr] = mean; scr[16 * 33 + 2 * rr + 1] = rstd; }
        }
        VM_WAIT(); LDS_WAIT();
        f32x4 acc0 = {0.f, 0.f, 0.f, 0.f}, acc1 = {0.f, 0.f, 0.f, 0.f};
        {
            const int ar = lane & 15, kg = lane >> 4;
            const size_t xo = (size_t)(tok0 + ar) * D + 8 * kg;
            const bf16* ar1 = A1 + xo;
            const float rmean = scr[16 * 33 + 2 * ar], rrstd = scr[16 * 33 + 2 * ar + 1];
            const bf16* wh0 = Wh + (size_t)ar * 1024 + 8 * kg; const bf16* wl0 = Wl + (size_t)ar * 1024 + 8 * kg;
#pragma unroll 4
            for (int ks = 0; ks < 32; ++ks) {
                f32x4 xa, xb;
                if constexpr (XSPLIT) { const v4u hw = *(const GAS v4u*)(XRB + xo + 32 * ks); const u32x2 lw = *(const GAS u32x2*)(XRL + xo + 32 * ks);
                    u32x2 h01; h01.x = hw.x; h01.y = hw.y; u32x2 h23; h23.x = hw.z; h23.y = hw.w; xa = rs_dec(h01, lw.x); xb = rs_dec(h23, lw.y); }
                else { xa = *(const GAS f32x4*)(xres + xo + 32 * ks); xb = *(const GAS f32x4*)(xres + xo + 32 * ks + 4); }
                {
                    const v4u aw = *(const GAS v4u*)(ar1 + 32 * ks);
                    xa = xa * DN_ALPHA + (f32x4){bf_lo(aw.x), bf_hi(aw.x), bf_lo(aw.y), bf_hi(aw.y)}; xb = xb * DN_ALPHA + (f32x4){bf_lo(aw.z), bf_hi(aw.z), bf_lo(aw.w), bf_hi(aw.w)};
                    const float* gp = ln_g + (size_t)L * D + 32 * ks + 8 * kg; const float* bp = ln_b + (size_t)L * D + 32 * ks + 8 * kg;
                    xa = (xa - rmean) * rrstd * *(const GAS f32x4*)gp + *(const GAS f32x4*)bp; xb = (xb - rmean) * rrstd * *(const GAS f32x4*)(gp + 4) + *(const GAS f32x4*)(bp + 4);
                }
                const float xv[8] = {xa.x, xa.y, xa.z, xa.w, xb.x, xb.y, xb.z, xb.w};
                unsigned hh[8], ll[8];
#pragma unroll
                for (int e = 0; e < 8; ++e) { hh[e] = f2bf(xv[e]); ll[e] = f2bf(xv[e] - __uint_as_float(hh[e] << 16)); }
                v4u ah, al;
                ah.x = hh[0] | (hh[1] << 16); ah.y = hh[2] | (hh[3] << 16); ah.z = hh[4] | (hh[5] << 16); ah.w = hh[6] | (hh[7] << 16);
                al.x = ll[0] | (ll[1] << 16); al.y = ll[2] | (ll[3] << 16); al.z = ll[4] | (ll[5] << 16); al.w = ll[6] | (ll[7] << 16);
                const bf16x8 fah = __builtin_bit_cast(bf16x8, ah), fal = __builtin_bit_cast(bf16x8, al);
                const bf16x8 w0h = *(const GAS bf16x8*)(wh0 + 32 * ks), w0l = *(const GAS bf16x8*)(wl0 + 32 * ks);
                const bf16x8 w1h = *(const GAS bf16x8*)(wh0 + 16 * 1024 + 32 * ks), w1l = *(const GAS bf16x8*)(wl0 + 16 * 1024 + 32 * ks);
                acc0 = __builtin_amdgcn_mfma_f32_16x16x32_bf16(fah, w0h, acc0, 0, 0, 0); acc0 = __builtin_amdgcn_mfma_f32_16x16x32_bf16(fal, w0h, acc0, 0, 0, 0); acc0 = __builtin_amdgcn_mfma_f32_16x16x32_bf16(fah, w0l, acc0, 0, 0, 0);
                acc1 = __builtin_amdgcn_mfma_f32_16x16x32_bf16(fah, w1h, acc1, 0, 0, 0); acc1 = __builtin_amdgcn_mfma_f32_16x16x32_bf16(fal, w1h, acc1, 0, 0, 0); acc1 = __builtin_amdgcn_mfma_f32_16x16x32_bf16(fah, w1l, acc1, 0, 0, 0);
            }
#pragma unroll
            for (int r = 0; r < 4; ++r) { scr[(4 * kg + r) * 33 + ar] = acc0[r]; scr[(4 * kg + r) * 33 + 16 + ar] = acc1[r]; }
        }
        LDS_WAIT(); asm volatile("" ::: "memory");
        int ek[4] = {0, 0, 0, 0}; float wk[4] = {0.f, 0.f, 0.f, 0.f}; unsigned lrk[4] = {0u, 0u, 0u, 0u};
        if (lane < 16) {
            float lv[32];
#pragma unroll
            for (int e = 0; e < 32; ++e) lv[e] = scr[lane * 33 + e] + b_r[(size_t)L * 32 + e];
            unsigned taken = 0u; float vk[4];
#pragma unroll
            for (int k = 0; k < 4; ++k) {
                float best = -INFINITY; int bi = 0;
#pragma unroll
                for (int e = 0; e < 32; ++e) { const bool ok = !((taken >> e) & 1u) && lv[e] > best; best = ok ? lv[e] : best; bi = ok ? e : bi; }
                taken |= 1u << bi; ek[k] = bi; vk[k] = best;
            }
            float den = 0.f;
#pragma unroll
            for (int k = 0; k < 4; ++k) { wk[k] = __expf(vk[k] - vk[0]); den += wk[k]; }
#pragma unroll
            for (int k = 0; k < 4; ++k) { wk[k] /= den; lrk[k] = atomicAdd((unsigned*)(cntl + ek[k]), 1u); }
        }
        __syncthreads();
        if (tid < 32) basel[tid] = __hip_atomic_fetch_add(gcnt + tid, cntl[tid], RLX_AGENT);
        __syncthreads();
        if (lane < 16) {
            const size_t tk = (size_t)(tok0 + lane) * 4;
#pragma unroll
            for (int k = 0; k < 4; ++k) {
                const int rank = (int)(basel[ek[k]] + lrk[k]);
                ((int*)(ws + WS_TOKE))[tk + k] = ek[k];
                ((int*)(ws + WS_TOKR))[tk + k] = rank;
                ((float*)(ws + WS_TOKW))[tk + k] = wk[k];
                if (rank < M) ((int*)(ws + WS_LIST))[(size_t)ek[k] * M + rank] = tok0 + lane;
            }
        }
        __syncthreads();
    }
}

__device__ __forceinline__ void build_tables(Frame& F, int L) {
    LAS int* cnt = (LAS int*)(F.lds + TAB_CNT); LAS int* soff = (LAS int*)(F.lds + TAB_SOFF); LAS int* tst = (LAS int*)(F.lds + TAB_TST); LAS int* te = (LAS int*)(F.lds + TAB_TE);
    __syncthreads();
    if (F.tid < 32) { int c = (int)__hip_atomic_load(F.ctl + CW_CNT + L * 32 + F.tid, RLX_AGENT); cnt[F.tid] = c < 0 ? 0 : (c > M ? M : c); }
    __syncthreads();
    if (F.tid == 0) { int a = 0; for (int e = 0; e < 32; ++e) { tst[e] = a; a += (cnt[e] + 255) >> 8; if (a > MAXTILES) a = MAXTILES; } tst[32] = a; }
    __syncthreads();
    if (F.tid < 32) { soff[F.tid] = tst[F.tid] * 256; for (int mt = tst[F.tid]; mt < tst[F.tid + 1]; ++mt) te[mt] = F.tid; }
    __syncthreads();
}

template <bool LAST>
__device__ __forceinline__ void phase_ln2(Frame& F, int L, const float* ln_g, const float* ln_b, float* outp) {
    float prb_scale = 1.f;
#ifdef PRB_SEL
    if (LAST) { const unsigned v = __hip_atomic_load((gu32*)(F.ws + WS_TOKE + 3 * MiB) + PRB_SEL, RLX_AGENT); const float fr = (float)v / (float)PRB_DEN; prb_scale = 1.f + 0.02f * (float)(1 + (int)(fr * 8.f + 0.5f)); }
#endif
    unsigned char* ws = F.ws;
    const unsigned char* X1L = ws + WS_X1L; const bf16* X1B = (const bf16*)(ws + WS_X1B);
    const bf16* E = (const bf16*)(ws + WS_E); const bf16* YS = (const bf16*)(ws + WS_YS);
    bf16* XB = (bf16*)(ws + WS_XB); unsigned char* XNL = ws + WS_XNL;
    const LAS int* soff = (const LAS int*)(F.lds + TAB_SOFF);
    const int gw = F.vcu * NWAVES + F.wave, NGW = F.G * NWAVES, lane = F.lane;
    f32x4 gam[4], bet[4];
#pragma unroll
    for (int j = 0; j < 4; ++j) { gam[j] = *(const GAS f32x4*)(ln_g + (size_t)L * D + 4 * lane + 256 * j); bet[j] = *(const GAS f32x4*)(ln_b + (size_t)L * D + 4 * lane + 256 * j); }
    for (int tok = gw; tok < M; tok += NGW) {
        int sl[4]; float wk[4];
#pragma unroll
        for (int k = 0; k < 4; ++k) {
            const int e = ((const int*)(ws + WS_TOKE))[(size_t)tok * 4 + k] & 31, r = ((const int*)(ws + WS_TOKR))[(size_t)tok * 4 + k];
            int s = soff[e] + r; s = s < 0 ? 0 : (s >= MAXSLOTS ? MAXSLOTS - 1 : s);
            sl[k] = s; wk[k] = ((const float*)(ws + WS_TOKW))[(size_t)tok * 4 + k];
        }
        f32x4 v[4]; float s = 0.f;
#pragma unroll
        for (int j = 0; j < 4; ++j) {
            const int c = 4 * lane + 256 * j;
            f32x4 a;
            if constexpr (LAST) { const u32x2 xv = *(const GAS u32x2*)(X1B + (size_t)tok * D + c); a = (f32x4){bf_lo(xv.x), bf_hi(xv.x), bf_lo(xv.y), bf_hi(xv.y)} * DN_ALPHA; }
            else a = rs_dec(*(const GAS u32x2*)(X1B + (size_t)tok * D + c), *(const GAS unsigned*)(X1L + (size_t)tok * D + c)) * DN_ALPHA;
            const u32x2 ev = *(const GAS u32x2*)(E + (size_t)tok * D + c);
            a.x += bf_lo(ev.x); a.y += bf_hi(ev.x); a.z += bf_lo(ev.y); a.w += bf_hi(ev.y);
#pragma unroll
            for (int k = 0; k < 4; ++k) {
                if constexpr (LAST) {
                    typedef float f32x2_ __attribute__((ext_vector_type(2)));
                    const unsigned yw = *(const GAS unsigned*)((const unsigned char*)YS + (size_t)sl[k] * D + c);
                    const f32x2_ y01 = __builtin_amdgcn_cvt_pk_f32_fp8((int)yw, false), y23 = __builtin_amdgcn_cvt_pk_f32_fp8((int)yw, true);
                    a.x += wk[k] * y01.x; a.y += wk[k] * y01.y; a.z += wk[k] * y23.x; a.w += wk[k] * y23.y;
                } else {
                    const u32x2 yv = *(const GAS u32x2*)(YS + (size_t)sl[k] * D + c);
                    a.x += wk[k] * bf_lo(yv.x); a.y += wk[k] * bf_hi(yv.x); a.z += wk[k] * bf_lo(yv.y); a.w += wk[k] * bf_hi(yv.y);
                }
            }
            v[j] = a; s += (a.x + a.y) + (a.z + a.w);
        }
        const float mean = wave_sum(s) * (1.f / D); float s2 = 0.f;
#pragma unroll
        for (int j = 0; j < 4; ++j) { v[j] = v[j] - mean; s2 += (v[j].x * v[j].x + v[j].y * v[j].y) + (v[j].z * v[j].z + v[j].w * v[j].w); }
        const float rstd = 1.f / sqrtf(wave_sum(s2) * (1.f / D) + LN_EPS);
#pragma unroll
        for (int j = 0; j < 4; ++j) {
            const f32x4 o = v[j] * rstd * gam[j] + bet[j];
            if constexpr (LAST) *(GAS f32x4*)(outp + (size_t)tok * D + 4 * lane + 256 * j) = o * prb_scale;
            else { u32x2 w; unsigned b8; rs_enc(o, w, b8); *(GAS u32x2*)(XB + (size_t)tok * D + 4 * lane + 256 * j) = w; *(GAS unsigned*)(XNL + (size_t)tok * D + 4 * lane + 256 * j) = b8; }
        }
    }
}

#ifndef MK_ONE_LAUNCH
#define MK_ONE_LAUNCH 1
#endif
constexpr int PH_PER_LAYER = 9, NPH = 1 + NL * PH_PER_LAYER;
struct Args { const float* in[27]; float* out; unsigned char* ws; int ph_lo, ph_hi; };
typedef const __attribute__((address_space(4))) unsigned char* kptr_t;
__device__ __forceinline__ kptr_t karg_base() { kptr_t p = (kptr_t)__builtin_amdgcn_kernarg_segment_ptr(); asm volatile("" : "+s"(p)); return p; }
#define KIN(kb, i) (*(const float* const __attribute__((address_space(4)))*)((kb) + 8 * (i)))
#ifndef PH_MASK
#define PH_MASK 0x3ff
#endif
#define PHSEL(k) (((k) == 0) ? ((PH_MASK >> 9) & 1) : ((PH_MASK >> (((k) - 1) % PH_PER_LAYER)) & 1))
#define IN(k) (PHSEL(k) && lo <= (k) && (k) < hi)
#ifndef PROBE_PHASE
#define PROBE_PHASE -1
#endif
#ifndef PROBE_EXTRA
#define PROBE_EXTRA 0
#endif
#define NREP(k) (((k) == PROBE_PHASE) ? 1 + PROBE_EXTRA : 1)
#define PHASE(k) if (IN(k)) for (int rep_ = 0; rep_ < NREP(k); ++rep_)
#define SEAM(k) do { if (IN(k) && IN((k) + 1)) { if (MK_ONE_LAUNCH) xcd_barrier(bar); } } while (0)

#ifdef PRB_SEL
#define SNAP(k, q) do { if (blockIdx.x == 0 && xb_thread0(wave0)) { ((gu32*)(ws + WS_TOKE + 3 * MiB))[k] = __hip_atomic_load(F.ctl + CW_Q + (q), RLX_AGENT); } } while (0)
#else
#define SNAP(k, q) do {} while (0)
#endif
#define RELAUNDER() do { F.lane = (int)__builtin_amdgcn_mbcnt_hi(~0u, __builtin_amdgcn_mbcnt_lo(~0u, 0u)); asm volatile("" : "+v"(F.lane)); F.wave = wave0; F.tid = F.wave * 64 + F.lane; } while (0)
template <int L>
__device__ __forceinline__ void layer_body(Frame& F, const XcdBarrier& bar, const int lo, const int hi, const int wave0) {
    unsigned char* ws = F.ws;
        const int pb = 1 + L * PH_PER_LAYER;
        PHASE(pb + 0) {
            const int nsp = (F.G == 256) ? 24 : 0;
            if ((int)blockIdx.x >= F.G - nsp) { kptr_t kb = karg_base(); RELAUNDER(); conv_run<(L == 0) ? 0 : 2>(F, KIN(kb, 18), KIN(kb, 20), CW_STOP + pb + 0, (unsigned)(F.G - nsp) / 2u, (L == 0) ? 0 : 4); }
            else {
                pg8::Gemm g{(const bf16*)(ws + WS_XB), (const bf16*)(ws + WS_WIN) + (size_t)L * NIN * 1024, M, NIN, D};
                pg8::StaticOrder S; S.init(M, NIN, F.G - nsp, (int)blockIdx.x); S.tailw = F.ctl + CW_STOP + pb + 0;
                pg8::EpiIn E{(bf16*)(ws + WS_H), (float*)(ws + WS_GATES), (const float*)(ws + WS_BINP) + (size_t)L * NIN, (const float*)(ws + WS_ROPE)};
                pg8::gemm_phase<pg8::EpiIn, pg8::StaticOrder, true, true>(F.lds + RING_OFF, g, S, E, wave0, (LAS float*)(F.lds + BIAS_OFF));
            }
        }
        SEAM(pb + 0);
        PHASE(pb + 1) {
            { kptr_t kb = karg_base(); RELAUNDER(); conv_run<(L == 0) ? 0 : 2>(F, KIN(kb, 18), KIN(kb, 20), -1); __syncthreads(); }
            { kptr_t kb = karg_base(); RELAUNDER(); phase_compress(F, L, KIN(kb, 5), KIN(kb, 8)); }
            {
                pg8::Gemm g{(const bf16*)(ws + WS_PB) + (size_t)L * M * PD, (const bf16*)(ws + WS_WPP) + (size_t)L * 1024 * PD, M, D, PD};
                pg8::StaticOrder S; S.init(M, D, F.G, (int)blockIdx.x);
                pg8::EpiPlain E{(bf16*)(ws + WS_PP)};
                pg8::gemm_phase<pg8::EpiPlain, pg8::StaticOrder, true, true>(F.lds + RING_OFF, g, S, E, wave0, (LAS float*)(F.lds + BIAS_OFF));
            }
        }
        SEAM(pb + 1);
        PHASE(pb + 2) { kptr_t kb = karg_base(); RELAUNDER(); att::phase_attention(F, L, KIN(kb, 11)); }
        SEAM(pb + 2);
        PHASE(pb + 3) {
            pg8::Gemm g{(const bf16*)(ws + WS_O), (const bf16*)(ws + WS_WO) + (size_t)L * 1024 * 1024, M, D, D};
            pg8::StaticOrder S; S.init(M, D, F.G, (int)blockIdx.x);
            kptr_t kb = karg_base();
            pg8::EpiOut E{(bf16*)(ws + WS_Y1), KIN(kb, 13) + (size_t)L * D};
            pg8::gemm_phase<pg8::EpiOut, pg8::StaticOrder, true, true>(F.lds + RING_OFF, g, S, E, wave0, (LAS float*)(F.lds + BIAS_OFF));
        }
        SEAM(pb + 3);
        PHASE(pb + 4) { kptr_t kb = karg_base(); RELAUNDER(); phase_ln1_router<(L == NL - 1), (L > 0)>(F, L, KIN(kb, 0), KIN(kb, 14), KIN(kb, 15), KIN(kb, 17)); }
        SEAM(pb + 4);
        PHASE(pb + 6) {
            RELAUNDER();
            build_tables(F, L);
            constexpr int ND6 = (L == 0) ? 4 : 0;
            const int per6 = F.G / 8, bx6 = (int)blockIdx.x;
            const bool cv6 = ND6 > 0 && (F.G % 8 == 0) && per6 > 4 * ND6;
            if (cv6 && bx6 / 8 >= per6 - ND6) { kptr_t kb = karg_base(); conv_run<1>(F, KIN(kb, 18), KIN(kb, 20), -1, 1u, 1); conv_run<2>(F, KIN(kb, 18), KIN(kb, 20), CW_STOP + pb + 6, (unsigned)(F.G - 8 * ND6) / 2u, 2); }
            else {
                constexpr bool F8 = (L == NL - 1);
                pg8::Gemm g{F8 ? (const bf16*)(ws + WS_X1F8) : (const bf16*)(ws + WS_X1B), (const bf16*)(ws + WS_W1T) + (size_t)L * 32 * 2048 * 1024, M, 32 * 2048, F8 ? D / 2 : D};
                pg8::MoeOrder S{(const LAS int*)(F.lds + TAB_TE), ((const LAS int*)(F.lds + TAB_TST))[32] * 8, 3, cv6 ? F.G - 8 * ND6 : F.G, cv6 ? (bx6 % 8) * (per6 - ND6) + bx6 / 8 : F.vcu, (const LAS int*)(F.lds + TAB_TST), (const LAS int*)(F.lds + TAB_CNT), (const int*)(ws + WS_LIST), M, (ND6 > 0) ? F.ctl + CW_STOP + pb + 6 : nullptr};
                pg8::EpiUp<F8> E{(bf16*)(ws + WS_ACT), (const float*)(ws + WS_B1P) + (size_t)L * 32 * 2048, F8 ? 1.0f / W1_F8_SCALE : 1.0f};
                pg8::gemm_phase<pg8::EpiUp<F8>, pg8::MoeOrder, true, true, F8, true>(F.lds + RING_OFF, g, S, E, wave0, (LAS float*)(F.lds + BIAS_OFF), (LAS int*)(F.lds + TOKL_OFF));
                if constexpr (ND6 > 0) { __syncthreads(); kptr_t kb = karg_base(); RELAUNDER(); conv_run<1>(F, KIN(kb, 18), KIN(kb, 20), -1); }
            }
        }
        SEAM(pb + 6);
        PHASE(pb + 7) {
            kptr_t kb = karg_base(); RELAUNDER();
            if (!IN(pb + 6)) build_tables(F, L);
            constexpr int ND7 = (L == 0) ? 1 : 0;
            const int per7 = F.G / 8, bx7 = (int)blockIdx.x;
            const bool cv7 = ND7 > 0 && (F.G % 8 == 0) && per7 > 4 * ND7;
            if (cv7 && bx7 / 8 >= per7 - ND7) { conv_run<2>(F, KIN(kb, 18), KIN(kb, 20), CW_STOP + pb + 7, (unsigned)(F.G - 8 * ND7) / 2u, 3); }
            else {
                constexpr bool F8 = (L == NL - 1);
                pg8::Gemm g{(const bf16*)(ws + WS_ACT), (const bf16*)(ws + WS_W2T) + (size_t)L * 32 * 1024 * 1024, MAXSLOTS, 32 * 1024, F8 ? D / 2 : D};
                pg8::MoeOrder S{(const LAS int*)(F.lds + TAB_TE), ((const LAS int*)(F.lds + TAB_TST))[32] * 4, 2, cv7 ? F.G - 8 * ND7 : F.G, cv7 ? (bx7 % 8) * (per7 - ND7) + bx7 / 8 : F.vcu, (const LAS int*)(F.lds + TAB_TST), (const LAS int*)(F.lds + TAB_CNT), nullptr, 0, (ND7 > 0) ? F.ctl + CW_STOP + pb + 7 : nullptr};
                pg8::EpiDown<F8> E{(bf16*)(ws + WS_YS), KIN(kb, 21) + (size_t)L * 32 * 1024, F8 ? 1.0f / W2_F8_SCALE : 1.0f};
                pg8::gemm_phase<pg8::EpiDown<F8>, pg8::MoeOrder, true, true, F8>(F.lds + RING_OFF, g, S, E, wave0, (LAS float*)(F.lds + BIAS_OFF));
            }
            if constexpr (ND7 > 0) __syncthreads();
            {
                constexpr bool F8 = (L == NL - 1);
                pg8::Gemm g{F8 ? (const bf16*)(ws + WS_X1F8) : (const bf16*)(ws + WS_X1B), (const bf16*)(ws + WS_WPG) + (size_t)L * 1024 * 1024, M, D, F8 ? D / 2 : D};
                pg8::StaticOrder S; S.init(M, D, F.G, (int)blockIdx.x);
                pg8::EpiGate E{(const bf16*)(ws + WS_PP), (bf16*)(ws + WS_E), KIN(kb, 23) + (size_t)L * D, F8 ? 1.0f / WPG_F8_SCALE : 1.0f};
                pg8::gemm_phase<pg8::EpiGate, pg8::StaticOrder, true, true, F8>(F.lds + RING_OFF, g, S, E, wave0, (LAS float*)(F.lds + BIAS_OFF));
            }
        }
        SEAM(pb + 7);
        PHASE(pb + 8) { kptr_t kb = karg_base(); RELAUNDER(); if (!IN(pb + 7)) build_tables(F, L); float* xout = L == NL - 1 ? (float*)KIN(kb, 27) : (float*)(ws + WS_XN); phase_ln2<(L == NL - 1)>(F, L, KIN(kb, 25), KIN(kb, 26), xout); }
        SEAM(pb + 8);
    }
__global__ void __launch_bounds__(NWAVES * 64, 2) mk_fwd(Args args) {
    extern __shared__ __attribute__((aligned(16))) unsigned char lds[];
    Frame F;
    F.lds = (LAS unsigned char*)lds;
    F.MISC = (volatile LAS unsigned*)(F.lds + MISC_OFF);
    const int wave0 = __builtin_amdgcn_readfirstlane((int)threadIdx.x >> 6);
    F.wave = wave0; F.lane = (int)__builtin_amdgcn_mbcnt_hi(~0u, __builtin_amdgcn_mbcnt_lo(~0u, 0u)); F.tid = F.wave * 64 + F.lane;
    F.G = gridDim.x; { const int bx = blockIdx.x; F.vcu = (F.G % 8 == 0) ? (bx % 8) * (F.G / 8) + bx / 8 : bx; }
    F.ws = args.ws; F.ctl = (gu32*)(args.ws + WS_CTL);
    unsigned char* ws = args.ws;
    for (int u = F.tid; u < (LDS_BYTES - LDSCTL_OFF) / 4; u += NWAVES * 64) ((LAS unsigned*)(F.lds + LDSCTL_OFF))[u] = 0u;
    __syncthreads();
    XcdBarrier bar; bar.bar = (unsigned*)(F.ctl + CW_BAR); bar.x = 0; bar.st = nullptr; bar.wave = wave0;
    if (MK_ONE_LAUNCH) bar = xcd_barrier_post((unsigned*)(F.ctl + CW_BAR), F.MISC + 8, wave0);
    const int lo = args.ph_lo, hi = args.ph_hi;
    PHASE(0) {
        kptr_t kb = karg_base(); RELAUNDER();
        PIn I{KIN(kb, 0), KIN(kb, 1), KIN(kb, 3), KIN(kb, 4), KIN(kb, 6), KIN(kb, 7), KIN(kb, 9), KIN(kb, 10), KIN(kb, 12), KIN(kb, 16), KIN(kb, 18), KIN(kb, 19), KIN(kb, 20), KIN(kb, 22), KIN(kb, 24), (const int*)KIN(kb, 2)};
        p0_prologue(F, I);
#ifdef PRB_SEL
        if (blockIdx.x == 0 && F.tid < 8) ((gu32*)(ws + WS_TOKE + 3 * MiB))[F.tid] = 0u;
#endif
    }
    SEAM(0);
    layer_body<0>(F, bar, lo, hi, wave0);
    layer_body<1>(F, bar, lo, hi, wave0);
#undef IN
#undef SEAM
}

extern "C" void kernel_launch(void* const* d_in, const int* in_sizes, int n_in, void* d_out, int out_size, void* d_ws, size_t ws_size, hipStream_t stream) {
    static int grid = 0;
    if (grid == 0) {
        if (n_in != 27 || out_size != M * D || ws_size < WS_END) { fprintf(stderr, "kernel_launch: unexpected problem (n_in %d, out %d, ws %zu); nothing launched\n", n_in, out_size, ws_size); grid = -1; return; }
        int dev = 0, cus = 0, per_cu = 0;
        if (hipGetDevice(&dev) != hipSuccess || hipDeviceGetAttribute(&cus, hipDeviceAttributeMultiprocessorCount, dev) != hipSuccess) { grid = -1; return; }
        if (hipFuncSetAttribute((const void*)mk_fwd, hipFuncAttributeMaxDynamicSharedMemorySize, LDS_BYTES) != hipSuccess) { fprintf(stderr, "kernel_launch: hipFuncSetAttribute failed\n"); grid = -1; return; }
        if (hipOccupancyMaxActiveBlocksPerMultiprocessor(&per_cu, (const void*)mk_fwd, NWAVES * 64, LDS_BYTES) != hipSuccess || per_cu < 1) { fprintf(stderr, "kernel_launch: occupancy query says %d\n", per_cu); }
        (void)hipGetLastError();
        grid = cus;
    }
    if (grid < 0) return;
    (void)in_sizes;
    if (hipMemsetAsync((char*)d_ws + WS_CTL, 0, CTL_ZERO_BYTES, stream) != hipSuccess) return;
    Args a{};
    for (int i = 0; i < 27; ++i) a.in[i] = (const float*)d_in[i];
    a.out = (float*)d_out; a.ws = (unsigned char*)d_ws;
#if MK_ONE_LAUNCH
    a.ph_lo = 0; a.ph_hi = NPH;
    hipLaunchKernelGGL(mk_fwd, dim3(grid), dim3(NWAVES * 64), LDS_BYTES, stream, a);
#else
    for (int ph = 0; ph < NPH; ++ph) { a.ph_lo = ph; a.ph_hi = ph + 1; hipLaunchKernelGGL(mk_fwd, dim3(grid), dim3(NWAVES * 64), LDS_BYTES, stream, a); }
#endif
}
```

```cpp
#include <hip/hip_runtime.h>
#include <cstdio>
#include <cstdint>
#define MK_ONE_LAUNCH 1
namespace pg8 {
#define PG8_LAS __attribute__((address_space(3)))
typedef unsigned short bf16_t;
typedef short bf16x8 __attribute__((ext_vector_type(8)));
typedef float f32x4 __attribute__((ext_vector_type(4)));
typedef unsigned u32x4 __attribute__((ext_vector_type(4)));
constexpr int BM = 256, BK = 64, HALF = 128, HTB = HALF * BK * 2  , STAGE_BYTES = 8 * HTB, NXCD = 8, WGM = 8;

__host__ __device__ __forceinline__ int lds_byte(int r, int c) { const int st = (r >> 4) * 2 + (c >> 5), rr = r & 15, cc = c & 31, ob = rr * 64 + cc * 2; return st * 1024 + (ob ^ (((ob >> 9) & 1) << 5)); }
__host__ __device__ __forceinline__ void stage_rc(int b, int& R, int& C) { const int st = b / 1024, sb = b % 1024, swz = sb ^ (((sb >> 9) & 1) << 5); R = (st >> 1) * 16 + swz / 64; C = (st & 1) * 32 + (swz % 64) / 2; }
__host__ __device__ __forceinline__ int perm32(int rho) { const int n = rho >> 4, i = rho & 15; return 8 * (i >> 2) + 4 * n + (i & 3); }

struct Unit { int pm, pn; };
struct Gemm { const bf16_t* A; const bf16_t* Bt; int M, N, K; };

struct StaticOrder {
    int nM, nN, nwg, G, c;
    __host__ __device__ void init(int M, int N, int G_, int c_) { nM = M / BM; nN = N / BM; nwg = nM * nN; G = G_; c = c_; }
    __host__ __device__ bool next(int i, Unit& u) const {
        const long L = (long)i * G + c; if (L >= nwg) return false;
        int wgid = (int)L; { const int q = nwg / NXCD, r = nwg % NXCD, xcd = wgid % NXCD, off = wgid / NXCD; wgid = (xcd < r ? xcd * (q + 1) : r * (q + 1) + (xcd - r) * q) + off; }
        const int nig = WGM * nN, gid = wgid / nig, fm = gid * WGM, gsz = (nM - fm) < WGM ? (nM - fm) : WGM;
        u.pm = fm + ((wgid % nig) % gsz); u.pn = (wgid % nig) / gsz; return true;
    }
    __device__ __forceinline__ void a_ready(const Unit&) const {}
    __device__ __forceinline__ void done(const Unit&) const {}
    __attribute__((address_space(1))) unsigned* tailw = nullptr;
    __device__ __forceinline__ void tail(int wid, int lane) const { if (tailw && wid == 0 && lane == 0) (void)__hip_atomic_fetch_add(tailw, 1u, __ATOMIC_RELAXED, __HIP_MEMORY_SCOPE_AGENT); }
};

__device__ __forceinline__ unsigned cvt_pk_bf16(float lo, float hi) { unsigned r; asm volatile("v_cvt_pk_bf16_f32 %0, %1, %2" : "=v"(r) : "v"(lo), "v"(hi)); return r; }
typedef float f32x2 __attribute__((ext_vector_type(2)));

typedef unsigned u32x2 __attribute__((ext_vector_type(2)));
__device__ __forceinline__ float sigm(float x) { return __builtin_amdgcn_rcpf(1.0f + __builtin_amdgcn_exp2f(-1.4426950408889634f * x)); }
__device__ __forceinline__ float bf_lo(unsigned w) { return __uint_as_float(w << 16); }
__device__ __forceinline__ float bf_hi(unsigned w) { return __uint_as_float(w & 0xffff0000u); }

constexpr unsigned ROPE_SEGS = 0x7D4Fu;
constexpr float QSCALE = 0.125f * 1.4426950408889634f;
struct EpiIn {
    static constexpr bool PERM = true, AFTER_DRAIN = false;
    bf16_t* H; float* gates; const float* bias; const float* rope;
    __device__ __forceinline__ const float* bias_slice(const Unit& u) const { return bias + u.pn * BM; }
    __device__ __forceinline__ void operator()(const f32x4 (&acc)[2][2][4][2], const Unit& u, int wr, int wc, int fr, int fq, const PG8_LAS float* bl) const {
        const int row0 = u.pm * BM + wr * 64 + fr;
#pragma unroll
        for (int bj = 0; bj < 2; ++bj) {
            const int seg = u.pn * 2 + bj;
            if (seg >= 17) continue;
            const int cl0 = bj * HALF + wc * 32 + 8 * fq;
            const f32x4 b0 = *(const PG8_LAS f32x4*)(bl + cl0), b1 = *(const PG8_LAS f32x4*)(bl + cl0 + 4);
            if (seg == 16) {
                const int gi = wc * 32 + 8 * fq;
                if (gi < 24) {
#pragma unroll
                    for (int ai = 0; ai < 2; ++ai)
#pragma unroll
                        for (int m = 0; m < 4; ++m) {
                            const int row = row0 + ai * HALF + m * 16;
                            f32x4 v0 = acc[ai][bj][m][0] + b0, v1 = acc[ai][bj][m][1] + b1;
                            v0 = (f32x4){sigm(v0[0]), sigm(v0[1]), sigm(v0[2]), sigm(v0[3])};
                            v1 = (f32x4){sigm(v1[0]), sigm(v1[1]), sigm(v1[2]), sigm(v1[3])};
                            float* gp = gates + (size_t)row * 32 + gi;
                            *(f32x4*)gp = v0; *(f32x4*)(gp + 4) = v1;
                        }
                }
            } else {
                const bool rope_on = (ROPE_SEGS >> seg) & 1u;
                const bool qseg = seg < 4 || (seg >= 10 && seg <= 13);
                const int g = 4 * (wc & 1) + fq;
                const int hc = seg * 128 + (wc >> 1) * 64 + 4 * g;
#pragma unroll
                for (int ai = 0; ai < 2; ++ai)
#pragma unroll
                    for (int m = 0; m < 4; ++m) {
                        const int row = row0 + ai * HALF + m * 16;
                        f32x4 v0 = acc[ai][bj][m][0] + b0, v1 = acc[ai][bj][m][1] + b1;
                        if (rope_on) {
                            const f32x4 c = *(const f32x4*)(rope + (size_t)row * 64 + 4 * g), s = *(const f32x4*)(rope + (size_t)row * 64 + 32 + 4 * g);
                            const f32x4 o0 = v0 * c - v1 * s, o1 = v1 * c + v0 * s; v0 = o0; v1 = o1;
                        }
                        if (qseg) { v0 = v0 * QSCALE; v1 = v1 * QSCALE; }
                        u32x2 w0, w1; w0.x = cvt_pk_bf16(v0[0], v0[1]); w0.y = cvt_pk_bf16(v0[2], v0[3]); w1.x = cvt_pk_bf16(v1[0], v1[1]); w1.y = cvt_pk_bf16(v1[2], v1[3]);
                        bf16_t* hp = H + (size_t)row * 2048 + hc;
                        *(u32x2*)hp = w0; *(u32x2*)(hp + 32) = w1;
                    }
            }
        }
    }
};
struct EpiOut {
    static constexpr bool PERM = true, AFTER_DRAIN = false;
    bf16_t* y; const float* bias;
    __device__ __forceinline__ const float* bias_slice(const Unit& u) const { return bias + u.pn * BM; }
    __device__ __forceinline__ void operator()(const f32x4 (&acc)[2][2][4][2], const Unit& u, int wr, int wc, int fr, int fq, const PG8_LAS float* bl) const {
        const int row0 = u.pm * BM + wr * 64 + fr, col0 = u.pn * BM + wc * 32 + 8 * fq;
        f32x4 bv[2][2];
#pragma unroll
        for (int bj = 0; bj < 2; ++bj)
#pragma unroll
            for (int n = 0; n < 2; ++n) bv[bj][n] = *(const PG8_LAS f32x4*)(bl + wc * 32 + 8 * fq + bj * HALF + 4 * n);
#pragma unroll
        for (int ai = 0; ai < 2; ++ai)
#pragma unroll
            for (int m = 0; m < 4; ++m) {
                bf16_t* rowp = y + (size_t)(row0 + ai * HALF + m * 16) * 1024 + col0;
#pragma unroll
                for (int bj = 0; bj < 2; ++bj) {
                    const f32x4 v0 = acc[ai][bj][m][0] + bv[bj][0], v1 = acc[ai][bj][m][1] + bv[bj][1];
                    u32x4 w; w.x = cvt_pk_bf16(v0[0], v0[1]); w.y = cvt_pk_bf16(v0[2], v0[3]); w.z = cvt_pk_bf16(v1[0], v1[1]); w.w = cvt_pk_bf16(v1[2], v1[3]);
                    *(u32x4*)(rowp + bj * HALF) = w;
                }
            }
    }
};
template <bool F8OUT>
struct EpiUp {
    static constexpr bool PERM = true, AFTER_DRAIN = false;
    bf16_t* act; const float* b1p; float ascale;
    __device__ __forceinline__ const float* bias_slice(const Unit& u) const { return b1p + (size_t)(u.pn >> 3) * 2048 + (u.pn & 7) * BM; }
    __device__ __forceinline__ void operator()(const f32x4 (&acc)[2][2][4][2], const Unit& u, int wr, int wc, int fr, int fq, const PG8_LAS float* bl) const {
        const int pn = u.pn & 7;
        const int row0 = u.pm * BM + wr * 64 + fr, ac0 = pn * 128 + wc * 32 + 8 * fq;
        const PG8_LAS float* bp = bl + wc * 32 + 8 * fq;
        const f32x4 bg0 = *(const PG8_LAS f32x4*)bp, bg1 = *(const PG8_LAS f32x4*)(bp + 4), bu0 = *(const PG8_LAS f32x4*)(bp + HALF), bu1 = *(const PG8_LAS f32x4*)(bp + HALF + 4);
#pragma unroll
        for (int ai = 0; ai < 2; ++ai)
#pragma unroll
            for (int m = 0; m < 4; ++m) {
                const f32x4 g0 = acc[ai][0][m][0] * ascale + bg0, g1 = acc[ai][0][m][1] * ascale + bg1, u0 = acc[ai][1][m][0] * ascale + bu0, u1 = acc[ai][1][m][1] * ascale + bu1;
                float o[8];
#pragma unroll
                for (int j = 0; j < 8; ++j) {
                    float gt = j < 4 ? g0[j & 3] : g1[j & 3], up = j < 4 ? u0[j & 3] : u1[j & 3];
                    gt = fminf(gt, 7.0f); up = fminf(fmaxf(up, -7.0f), 7.0f);
                    o[j] = (up + 1.0f) * gt * sigm(1.702f * gt);
                }
                if constexpr (F8OUT) {
                    int w0 = 0, w1 = 0;
                    w0 = __builtin_amdgcn_cvt_pk_fp8_f32(o[0], o[1], w0, false); w0 = __builtin_amdgcn_cvt_pk_fp8_f32(o[2], o[3], w0, true);
                    w1 = __builtin_amdgcn_cvt_pk_fp8_f32(o[4], o[5], w1, false); w1 = __builtin_amdgcn_cvt_pk_fp8_f32(o[6], o[7], w1, true);
                    u32x2 w; w.x = (unsigned)w0; w.y = (unsigned)w1;
                    *(u32x2*)((unsigned char*)act + (size_t)(row0 + ai * HALF + m * 16) * 1024 + ac0) = w;
                } else {
                    u32x4 w; w.x = cvt_pk_bf16(o[0], o[1]); w.y = cvt_pk_bf16(o[2], o[3]); w.z = cvt_pk_bf16(o[4], o[5]); w.w = cvt_pk_bf16(o[6], o[7]);
                    *(u32x4*)(act + (size_t)(row0 + ai * HALF + m * 16) * 1024 + ac0) = w;
                }
                asm volatile("" ::: "memory");
            }
    }
};
template <bool F8OUT>
struct EpiDown {
    static constexpr bool PERM = true, AFTER_DRAIN = false;
    bf16_t* ys; const float* b2; float ascale;
    __device__ __forceinline__ const float* bias_slice(const Unit& u) const { return b2 + (size_t)(u.pn >> 2) * 1024 + (u.pn & 3) * BM; }
    __device__ __forceinline__ void operator()(const f32x4 (&acc)[2][2][4][2], const Unit& u, int wr, int wc, int fr, int fq, const PG8_LAS float* bl) const {
        const int pn = u.pn & 3;
        const int row0 = u.pm * BM + wr * 64 + fr, col0 = pn * BM + wc * 32 + 8 * fq;
        f32x4 bv[2][2];
#pragma unroll
        for (int bj = 0; bj < 2; ++bj)
#pragma unroll
            for (int n = 0; n < 2; ++n) bv[bj][n] = *(const PG8_LAS f32x4*)(bl + wc * 32 + 8 * fq + bj * HALF + 4 * n);
#pragma unroll
        for (int ai = 0; ai < 2; ++ai)
#pragma unroll
            for (int m = 0; m < 4; ++m) {
                bf16_t* rowp = ys + (size_t)(row0 + ai * HALF + m * 16) * 1024 + col0;
#pragma unroll
                for (int bj = 0; bj < 2; ++bj) {
                    const f32x4 v0 = acc[ai][bj][m][0] * ascale + bv[bj][0], v1 = acc[ai][bj][m][1] * ascale + bv[bj][1];
                    if constexpr (F8OUT) {
                        int w0 = 0, w1 = 0;
                        w0 = __builtin_amdgcn_cvt_pk_fp8_f32(v0[0], v0[1], w0, false); w0 = __builtin_amdgcn_cvt_pk_fp8_f32(v0[2], v0[3], w0, true);
                        w1 = __builtin_amdgcn_cvt_pk_fp8_f32(v1[0], v1[1], w1, false); w1 = __builtin_amdgcn_cvt_pk_fp8_f32(v1[2], v1[3], w1, true);
                        u32x2 w; w.x = (unsigned)w0; w.y = (unsigned)w1;
                        *(u32x2*)((unsigned char*)ys + (size_t)(row0 + ai * HALF + m * 16) * 1024 + col0 + bj * HALF) = w;
                    } else {
                        u32x4 w; w.x = cvt_pk_bf16(v0[0], v0[1]); w.y = cvt_pk_bf16(v0[2], v0[3]); w.z = cvt_pk_bf16(v1[0], v1[1]); w.w = cvt_pk_bf16(v1[2], v1[3]);
                        *(u32x4*)(rowp + bj * HALF) = w;
                    }
                }
            }
    }
};
struct EpiPlain {
    static constexpr bool PERM = true, AFTER_DRAIN = false;
    bf16_t* O;
    __device__ __forceinline__ const float* bias_slice(const Unit&) const { return nullptr; }
    __device__ __forceinline__ void operator()(const f32x4 (&acc)[2][2][4][2], const Unit& u, int wr, int wc, int fr, int fq, const PG8_LAS float*) const {
        const int row0 = u.pm * BM + wr * 64 + fr, col0 = u.pn * BM + wc * 32 + 8 * fq;
#pragma unroll
        for (int ai = 0; ai < 2; ++ai)
#pragma unroll
            for (int m = 0; m < 4; ++m) {
                bf16_t* rowp = O + (size_t)(row0 + ai * HALF + m * 16) * 1024 + col0;
#pragma unroll
                for (int bj = 0; bj < 2; ++bj) {
                    const f32x4 v0 = acc[ai][bj][m][0], v1 = acc[ai][bj][m][1];
                    u32x4 w; w.x = cvt_pk_bf16(v0[0], v0[1]); w.y = cvt_pk_bf16(v0[2], v0[3]); w.z = cvt_pk_bf16(v1[0], v1[1]); w.w = cvt_pk_bf16(v1[2], v1[3]);
                    *(u32x4*)(rowp + bj * HALF) = w;
                }
            }
    }
};
struct EpiGate {
    static constexpr bool PERM = true, AFTER_DRAIN = false;
    const bf16_t* PP; bf16_t* E; const float* bias; float ascale;
    __device__ __forceinline__ const float* bias_slice(const Unit& u) const { return bias + u.pn * BM; }
    __device__ __forceinline__ void operator()(const f32x4 (&acc)[2][2][4][2], const Unit& u, int wr, int wc, int fr, int fq, const PG8_LAS float* bl) const {
        const int row0 = u.pm * BM + wr * 64 + fr, col0 = u.pn * BM + wc * 32 + 8 * fq;
        f32x4 bv[2][2];
#pragma unroll
        for (int bj = 0; bj < 2; ++bj)
#pragma unroll
            for (int n = 0; n < 2; ++n) bv[bj][n] = *(const PG8_LAS f32x4*)(bl + wc * 32 + 8 * fq + bj * HALF + 4 * n);
#pragma unroll
        for (int ai = 0; ai < 2; ++ai)
#pragma unroll
            for (int m = 0; m < 4; ++m) {
                const size_t off = (size_t)(row0 + ai * HALF + m * 16) * 1024 + col0;
#pragma unroll
                for (int bj = 0; bj < 2; ++bj) {
                    const u32x4 pv = *(const u32x4*)(PP + off + bj * HALF);
                    const f32x4 v0 = acc[ai][bj][m][0] * ascale + bv[bj][0], v1 = acc[ai][bj][m][1] * ascale + bv[bj][1];
                    u32x4 w;
                    w.x = cvt_pk_bf16(sigm(v0[0]) * bf_lo(pv.x), sigm(v0[1]) * bf_hi(pv.x)); w.y = cvt_pk_bf16(sigm(v0[2]) * bf_lo(pv.y), sigm(v0[3]) * bf_hi(pv.y));
                    w.z = cvt_pk_bf16(sigm(v1[0]) * bf_lo(pv.z), sigm(v1[1]) * bf_hi(pv.z)); w.w = cvt_pk_bf16(sigm(v1[2]) * bf_lo(pv.w), sigm(v1[3]) * bf_hi(pv.w));
                    *(u32x4*)(E + off + bj * HALF) = w;
                }
            }
    }
};
struct MoeOrder {
    const PG8_LAS int* tile_e; int nunits, lnt, G, c;
    const PG8_LAS int* tst; const PG8_LAS int* cnt; const int* list; int list_pitch;
    __device__ __forceinline__ const int* row_src(const Unit& u) const { const int e = tile_e[u.pm]; return list + (size_t)e * list_pitch + (u.pm - tst[e]) * 256; }
    __device__ __forceinline__ int nvalid(const Unit& u) const { const int e = tile_e[u.pm]; return cnt[e] - (u.pm - tst[e]) * 256; }
    __device__ __forceinline__ bool next(int i, Unit& u) const {
        const int L = i * G + c; if (L >= nunits) return false;
        const int mt = L >> lnt, pn = L & ((1 << lnt) - 1);
        u.pm = mt; u.pn = (tile_e[mt] << lnt) + pn; return true;
    }
    __device__ __forceinline__ void a_ready(const Unit&) const {}
    __device__ __forceinline__ void done(const Unit&) const {}
    __attribute__((address_space(1))) unsigned* tailw = nullptr;
    __device__ __forceinline__ void tail(int wid, int lane) const { if (tailw && wid == 0 && lane == 0) (void)__hip_atomic_fetch_add(tailw, 1u, __ATOMIC_RELAXED, __HIP_MEMORY_SCOPE_AGENT); }
};

template <class Epi, class Sched, bool ALIGN_EPI = false, bool SP2 = false, bool F8 = false, bool GATHER = false>
__device__ __forceinline__ void gemm_phase(PG8_LAS unsigned char* lds, const Gemm g, const Sched& S, const Epi& E, const int wave_id, PG8_LAS float* biasl, PG8_LAS int* tokl = nullptr) {
    static_assert(!GATHER || SP2, "the gathered-A form is written for the SP2 loop");
    int tid_l = wave_id * 64 + (int)__builtin_amdgcn_mbcnt_hi(~0u, __builtin_amdgcn_mbcnt_lo(~0u, 0u)); asm volatile("" : "+v"(tid_l));     const int tid = tid_l, wid = __builtin_amdgcn_readfirstlane(tid >> 6), lane = tid & 63, wr = wid >> 2, wc = wid & 3, fr = lane & 15, fq = lane >> 4;
    int K_l = g.K; asm volatile("" : "+s"(K_l)); const int K = K_l, nt = K / BK;
    unsigned voffA[2], voffB[2];
    unsigned voffG[2][2] = {{0u, 0u}, {0u, 0u}};
#pragma unroll
    for (int i = 0; i < 2; ++i) { int R, C; stage_rc(tid * 16 + i * 8192, R, C); const int Rb = Epi::PERM ? ((R & ~31) + perm32(R & 31)) : R;
        voffA[i] = (unsigned)(R * K + C) * 2u; voffB[i] = (unsigned)(Rb * K + C) * 2u; }
    const size_t kstep = (size_t)(BK * 2);
    const size_t hstep = (size_t)HALF * K * 2;
    const size_t tstep = 2 * hstep;
    const unsigned ldsw = (unsigned)wid * 1024u;
    const int aoff = lds_byte(wr * 64 + fr, fq * 8), boff = lds_byte(wc * 32 + fr, fq * 8);
#define PG8_SA(b, h) (((b) * 2 + (h)) * HTB)
#define PG8_SB(b, h) ((4 + (b) * 2 + (h)) * HTB)
#define PG8_STAGE(bufoff, gbase, voff) do { _Pragma("unroll") for (int _i = 0; _i < 2; ++_i) \
        __builtin_amdgcn_global_load_lds((const unsigned*)((const char*)(gbase) + (voff)[_i]), (PG8_LAS unsigned*)(lds + (bufoff) + ldsw + _i * 8192), 16, 0, 0); } while (0)
#define PG8_STAGE_A(bufoff, base, h) do { if constexpr (GATHER) { PG8_STAGE(bufoff, base, voffG[h]); } else { PG8_STAGE(bufoff, (base) + (h) * hstep, voffA); } } while (0)
#define PG8_TOKSTAGE(u_, slot_) do { if (wid == 0) { const int* rp_ = S.row_src(u_); __builtin_amdgcn_global_load_lds((const unsigned*)(rp_ + lane * 4), (PG8_LAS unsigned*)(tokl + (slot_) * 256), 16, 0, 0); } } while (0)
#define PG8_TOKSET(slot_, nv_) do { const int nvv_ = (nv_); _Pragma("unroll") for (int h_ = 0; h_ < 2; ++h_) _Pragma("unroll") for (int i_ = 0; i_ < 2; ++i_) { int R_, C_; stage_rc(tid * 16 + i_ * 8192, R_, C_); \
        const int r_ = h_ * HALF + R_; int tk_ = tokl[(slot_) * 256 + r_]; tk_ = (r_ < nvv_ && tk_ >= 0 && tk_ < g.M) ? tk_ : 0; voffG[h_][i_] = (unsigned)tk_ * (unsigned)(K * 2) + (unsigned)(C_ * 2); } } while (0)
#define PG8_LDA(dst, b, h) do { _Pragma("unroll") for (int m = 0; m < 4; ++m) _Pragma("unroll") for (int k = 0; k < 2; ++k) dst[m][k] = *(const PG8_LAS bf16x8*)(lds + PG8_SA(b, h) + aoff + m * 2048 + k * 1024); } while (0)
#define PG8_LDB(dst, b, h) do { _Pragma("unroll") for (int n = 0; n < 2; ++n) _Pragma("unroll") for (int k = 0; k < 2; ++k) dst[n][k] = *(const PG8_LAS bf16x8*)(lds + PG8_SB(b, h) + boff + n * 2048 + k * 1024); } while (0)
#define PG8_MMA(ai, bj, At, Bt) do { __builtin_amdgcn_s_setprio(1); _Pragma("unroll") for (int m = 0; m < 4; ++m) _Pragma("unroll") for (int n = 0; n < 2; ++n) { \
        if constexpr (F8) { typedef int i32x4_ __attribute__((ext_vector_type(4))); \
              \
            asm volatile("v_mfma_f32_16x16x128_f8f6f4 %0, %1, %2, %0" : "+v"(acc[ai][bj][m][n]) : "v"(__builtin_shufflevector(__builtin_bit_cast(i32x4_, Bt[n][0]), __builtin_bit_cast(i32x4_, Bt[n][1]), 0, 1, 2, 3, 4, 5, 6, 7)), \
                "v"(__builtin_shufflevector(__builtin_bit_cast(i32x4_, At[m][0]), __builtin_bit_cast(i32x4_, At[m][1]), 0, 1, 2, 3, 4, 5, 6, 7))); } \
        else { _Pragma("unroll") for (int k = 0; k < 2; ++k) acc[ai][bj][m][n] = __builtin_amdgcn_mfma_f32_16x16x32_bf16(Bt[n][k], At[m][k], acc[ai][bj][m][n], 0, 0, 0); } } \
        __builtin_amdgcn_s_setprio(0); } while (0)
#define PG8_WAIT_V(n) asm volatile("s_waitcnt vmcnt(" #n ")" ::: "memory")
#define PG8_WAIT_L(n) asm volatile("s_waitcnt lgkmcnt(" #n ")" ::: "memory")
#define PG8_BAR __builtin_amdgcn_s_barrier()
#define PG8_SCHED __builtin_amdgcn_sched_barrier(0)
    Unit cur, nxt; int ui = 0;
    if (!S.next(0, cur)) return;
#define PG8_BIAS(u_, slot_) do { if (wid == 0) { const float* bp_ = E.bias_slice(u_); if (bp_) __builtin_amdgcn_global_load_lds((const unsigned*)(bp_ + lane * 4), (PG8_LAS unsigned*)(biasl + (slot_) * 256), 16, 0, 0); } } while (0)
    PG8_BIAS(cur, 0);
    if constexpr (GATHER) { PG8_TOKSTAGE(cur, 0); asm volatile("s_waitcnt vmcnt(0)" ::: "memory"); __builtin_amdgcn_s_barrier(); asm volatile("" ::: "memory"); PG8_TOKSET(0, S.nvalid(cur)); }
    f32x4 acc[2][2][4][2];
#pragma unroll
    for (int a = 0; a < 2; ++a)
#pragma unroll
        for (int b = 0; b < 2; ++b)
#pragma unroll
            for (int m = 0; m < 4; ++m)
#pragma unroll
                for (int n = 0; n < 2; ++n) acc[a][b][m][n] = (f32x4){0.f, 0.f, 0.f, 0.f};
    bf16x8 At[4][2], B0[2][2], B1[2][2];
    const char* cA = (const char*)g.A + (GATHER ? (size_t)0 : (size_t)cur.pm * tstep); const char* cB = (const char*)g.Bt + (size_t)cur.pn * tstep;
    S.a_ready(cur);
    if constexpr (SP2) {
        PG8_STAGE(PG8_SB(0, 0), cB, voffB); PG8_STAGE(PG8_SB(0, 1), cB + hstep, voffB); PG8_STAGE_A(PG8_SA(0, 0), cA, 0); PG8_STAGE_A(PG8_SA(0, 1), cA, 1);
        if (wr == 1) PG8_BAR;
        PG8_WAIT_V(2); PG8_BAR;
        PG8_STAGE(PG8_SB(1, 0), cB + kstep, voffB); PG8_STAGE_A(PG8_SA(1, 0), cA + kstep, 0); PG8_STAGE(PG8_SB(1, 1), cB + hstep + kstep, voffB);
        PG8_WAIT_V(6); PG8_BAR;
    } else {
        PG8_STAGE(PG8_SB(0, 0), cB, voffB); PG8_STAGE_A(PG8_SA(0, 0), cA, 0); PG8_STAGE(PG8_SB(0, 1), cB + hstep, voffB); PG8_STAGE_A(PG8_SA(0, 1), cA, 1);
        if (wr == 1) PG8_BAR;
        PG8_WAIT_V(4); PG8_BAR;
        PG8_STAGE(PG8_SB(1, 0), cB + kstep, voffB); PG8_STAGE_A(PG8_SA(1, 0), cA + kstep, 0); PG8_STAGE(PG8_SB(1, 1), cB + hstep + kstep, voffB);
        PG8_WAIT_V(6); PG8_BAR;
    }
    for (;;) {
        const bool has_next = S.next(ui + 1, nxt);
        if (!has_next) S.tail(wid, lane);
        const char* nA = (has_next && !GATHER) ? (const char*)g.A + (size_t)nxt.pm * tstep : cA;
        if constexpr (GATHER) { if (has_next) PG8_TOKSTAGE(nxt, (ui + 1) & 1); } const char* nB = has_next ? (const char*)g.Bt + (size_t)nxt.pn * tstep : cB;
        for (int t = 0; t < nt; t += 2) {
            const bool last = (t == nt - 2);
            const char* a1 = cA + (size_t)(t + 1) * kstep;
            const char* a2 = last ? nA : cA + (size_t)(t + 2) * kstep; const char* b2 = last ? nB : cB + (size_t)(t + 2) * kstep;
            const char* a3 = a2 + kstep; const char* b3 = b2 + kstep;
            if (last && has_next) S.a_ready(nxt);
            if constexpr (SP2) {
            PG8_LDB(B0, 0, 0); PG8_LDB(B1, 0, 1); PG8_SCHED; PG8_LDA(At, 0, 0); PG8_STAGE_A(PG8_SA(1, 1), a1, 1);
            if constexpr (GATHER) { if (last && has_next) PG8_TOKSET((ui + 1) & 1, S.nvalid(nxt)); }
            PG8_WAIT_V(8); PG8_WAIT_L(0); PG8_BAR; PG8_MMA(0, 0, At, B0); PG8_MMA(0, 1, At, B1); PG8_BAR; PG8_SCHED;
            PG8_LDA(At, 0, 1); PG8_STAGE(PG8_SB(0, 0), b2, voffB); PG8_STAGE(PG8_SB(0, 1), b2 + hstep, voffB); PG8_STAGE_A(PG8_SA(0, 0), a2, 0);
            PG8_WAIT_V(8); PG8_WAIT_L(0); PG8_BAR; PG8_MMA(1, 0, At, B0); PG8_MMA(1, 1, At, B1); PG8_BAR; PG8_SCHED;
            PG8_LDB(B0, 1, 0); PG8_LDB(B1, 1, 1); PG8_SCHED; PG8_LDA(At, 1, 0); PG8_STAGE_A(PG8_SA(0, 1), a2, 1);
            PG8_WAIT_V(8); PG8_WAIT_L(0); PG8_BAR; PG8_MMA(0, 0, At, B0); PG8_MMA(0, 1, At, B1); PG8_BAR; PG8_SCHED;
            PG8_LDA(At, 1, 1); PG8_STAGE(PG8_SB(1, 0), b3, voffB); PG8_STAGE(PG8_SB(1, 1), b3 + hstep, voffB); PG8_STAGE_A(PG8_SA(1, 0), a3, 0);
            PG8_WAIT_V(8); PG8_WAIT_L(0); PG8_BAR; PG8_MMA(1, 0, At, B0); PG8_MMA(1, 1, At, B1); PG8_BAR; PG8_SCHED;
            } else {
            PG8_LDB(B0, 0, 0); PG8_SCHED; PG8_LDA(At, 0, 0); PG8_STAGE_A(PG8_SA(1, 1), a1, 1);
            PG8_WAIT_L(8); PG8_BAR; PG8_WAIT_L(0); PG8_MMA(0, 0, At, B0); PG8_BAR; PG8_SCHED;
            PG8_LDB(B1, 0, 1); PG8_STAGE(PG8_SB(0, 0), b2, voffB);
            PG8_BAR; PG8_WAIT_L(0); PG8_MMA(0, 1, At, B1); PG8_BAR;
            PG8_LDA(At, 0, 1); PG8_STAGE_A(PG8_SA(0, 0), a2, 0);
            PG8_BAR; PG8_WAIT_L(0); PG8_MMA(1, 0, At, B0); PG8_BAR; PG8_SCHED;
            PG8_STAGE(PG8_SB(0, 1), b2 + hstep, voffB);
            PG8_WAIT_V(6); PG8_BAR; PG8_MMA(1, 1, At, B1); PG8_BAR;
            PG8_LDB(B0, 1, 0); PG8_SCHED; PG8_LDA(At, 1, 0); PG8_STAGE_A(PG8_SA(0, 1), a2, 1);
            PG8_WAIT_L(8); PG8_BAR; PG8_WAIT_L(0); PG8_MMA(0, 0, At, B0); PG8_BAR; PG8_SCHED;
            PG8_LDB(B1, 1, 1); PG8_STAGE(PG8_SB(1, 0), b3, voffB);
            PG8_BAR; PG8_WAIT_L(0); PG8_MMA(0, 1, At, B1); PG8_BAR;
            PG8_LDA(At, 1, 1); PG8_STAGE_A(PG8_SA(1, 0), a3, 0);
            PG8_BAR; PG8_WAIT_L(0); PG8_MMA(1, 0, At, B0); PG8_BAR; PG8_SCHED;
            PG8_STAGE(PG8_SB(1, 1), b3 + hstep, voffB);
            PG8_WAIT_V(6); PG8_BAR; PG8_MMA(1, 1, At, B1); PG8_BAR;
            }
        }
        if constexpr (F8) { asm volatile("s_nop 7\n\ts_nop 7\n\ts_nop 7\n\ts_nop 7" ::: "memory"); }
        if constexpr (ALIGN_EPI) { if (wr == 0) PG8_BAR; }
        if constexpr (!Epi::AFTER_DRAIN) { E(acc, cur, wr, wc, fr, fq, biasl + (ui & 1) * 256); S.done(cur); }
        if (!has_next) break;
#pragma unroll
        for (int a = 0; a < 2; ++a)
#pragma unroll
            for (int b = 0; b < 2; ++b)
#pragma unroll
                for (int m = 0; m < 4; ++m)
#pragma unroll
                    for (int n = 0; n < 2; ++n) acc[a][b][m][n] = (f32x4){0.f, 0.f, 0.f, 0.f};
        cur = nxt; cA = nA; cB = nB; ++ui;
        PG8_BIAS(cur, ui & 1);
        if constexpr (ALIGN_EPI) { if (wr == 1) PG8_BAR; }
    }
    PG8_WAIT_V(0);
    if constexpr (!ALIGN_EPI) { if (wr == 0) PG8_BAR; }
    PG8_BAR;
    if constexpr (Epi::AFTER_DRAIN) { E.fused(acc, cur, wr, wc, fr, fq, lds, wid, lane); S.done(cur); }
#undef PG8_SA
#undef PG8_SB
#undef PG8_STAGE
#undef PG8_LDA
#undef PG8_LDB
#undef PG8_MMA
#undef PG8_WAIT_V
#undef PG8_WAIT_L
#undef PG8_BAR
#undef PG8_SCHED
#undef PG8_BIAS
#undef PG8_STAGE_A
#undef PG8_TOKSTAGE
#undef PG8_TOKSET
}
}

constexpr int NWAVES = 8;
constexpr int NB = 16, T = 2048, D = 1024, M = NB * T, NL = 2;
constexpr int HP = 2048;
constexpr int NIN = 2304;
constexpr int PD = 256;
constexpr int NE = 32, TOPK = 4;
constexpr int MAXTILES = (M * TOPK) / 256 + NE;
constexpr int MAXSLOTS = MAXTILES * 256;
constexpr float LN_EPS = 1e-5f;
constexpr float DN_ALPHA = 1.4142135623730951f;
constexpr float SC_LOG2E = 0.125f * 1.4426950408889634f;
constexpr int C_QN = 0, C_KC = 512, C_VC = 640, C_KS = 768, C_VS = 896, C_KW = 1024, C_VW = 1152, C_QS = 1280, C_KSW = 1792, C_VSW = 1920;

constexpr size_t MiB = 1u << 20;
constexpr size_t WS_CTL = 0, CTL_ZERO_BYTES = 32768;
constexpr size_t WS_WIN = 2 * MiB;
constexpr size_t WS_WO = 12 * MiB;
constexpr size_t WS_WPG = 16 * MiB;
constexpr size_t WS_WPP = 20 * MiB;
constexpr size_t WS_WC1 = 22 * MiB;
constexpr size_t WS_WC2 = 26 * MiB;
constexpr size_t WS_WR = 27 * MiB;
constexpr size_t WS_BINP = 28 * MiB;
constexpr size_t WS_B1P = 28 * MiB + 65536;
constexpr size_t WS_ROPE = 30 * MiB;
constexpr size_t WS_GATES = 38 * MiB;
constexpr size_t WS_KCMP = 42 * MiB;
constexpr size_t WS_VCMP = 42 * MiB + 512 * 1024;
constexpr size_t WS_TOKE = 43 * MiB;
constexpr size_t WS_TOKR = 43 * MiB + 512 * 1024;
constexpr size_t WS_TOKW = 44 * MiB;
constexpr size_t WS_SLOT = 44 * MiB + 512 * 1024;
constexpr size_t WS_W1T = 48 * MiB;
constexpr size_t WS_W2T = 304 * MiB;
constexpr size_t WS_XB = 432 * MiB;
constexpr size_t WS_PB = 496 * MiB;
constexpr size_t WS_R1 = 528 * MiB;
constexpr size_t WS_H = WS_R1, WS_O = WS_R1 + 128 * MiB, WS_YS = WS_R1;
constexpr size_t WS_LIST = WS_R1;

constexpr size_t WS_R2 = 808 * MiB;
constexpr size_t WS_Y1 = WS_R2, WS_ACT = WS_R2;
constexpr size_t WS_X1 = 1080 * MiB;
constexpr size_t WS_X1B = 1208 * MiB;
constexpr size_t WS_PP = 1272 * MiB;
constexpr size_t WS_E = 1336 * MiB;
constexpr size_t WS_XN = 1400 * MiB;
constexpr size_t WS_X1L = WS_X1;
constexpr size_t WS_XNL = WS_XN;
constexpr size_t WS_X1F8 = WS_X1 + 64 * MiB;
constexpr size_t WS_END = 1528 * MiB;
static_assert((size_t)MAXSLOTS * 2048 <= 272 * MiB, "slot buffers");
constexpr int CW_TMO = 0, CW_CODE = 1;
constexpr int CW_CNT = 1024;
constexpr int CW_BAR = 4096;

constexpr int RING_OFF = 0, RING_BYTES = 131072;
constexpr int SCRATCH_BYTES = 139264;
constexpr int LDSCTL_OFF = SCRATCH_BYTES, MISC_OFF = LDSCTL_OFF + 320;
constexpr int TAB_OFF = MISC_OFF + 128;
constexpr int TAB_CNT = TAB_OFF, TAB_SOFF = TAB_OFF + 128, TAB_TST = TAB_OFF + 256, TAB_TE = TAB_OFF + 512;
constexpr int BIAS_OFF = 143360;
constexpr int TOKL_OFF = BIAS_OFF + 2048;
constexpr int LDS_BYTES = 147456;
static_assert(TAB_TE + MAXTILES * 4 <= BIAS_OFF && TOKL_OFF + 2048 <= LDS_BYTES, "LDS map");

static_assert((CW_BAR + 3456) * 4 <= (int)CTL_ZERO_BYTES && (CW_CNT + NL * 32) * 4 <= (int)CTL_ZERO_BYTES, "control words inside the memset region");
#define GAS __attribute__((address_space(1)))
#define LAS __attribute__((address_space(3)))
typedef unsigned short bf16;
typedef unsigned v4u __attribute__((ext_vector_type(4)));
typedef float f32x4 __attribute__((ext_vector_type(4)));
typedef short bf16x8 __attribute__((ext_vector_type(8)));
typedef GAS unsigned gu32;
typedef GAS unsigned long long gu64;
#define RLX_AGENT __ATOMIC_RELAXED, __HIP_MEMORY_SCOPE_AGENT
#define LDS_WAIT() asm volatile("s_waitcnt lgkmcnt(0)" ::: "memory")
#define VM_WAIT() asm volatile("s_waitcnt vmcnt(0)" ::: "memory")
__device__ __forceinline__ unsigned long long rt() { return __builtin_amdgcn_s_memrealtime(); }
__device__ __forceinline__ unsigned f2bf(float f) { unsigned u = __builtin_bit_cast(unsigned, f); return (u + 0x7fffu + ((u >> 16) & 1u)) >> 16; }
__device__ __forceinline__ unsigned pk2(float lo, float hi) { return f2bf(lo) | (f2bf(hi) << 16); }
#define XB_TMO      128
#define XB_XCNT(j)  (256  + 64 * (j))
#define XB_XSUB(j)  (1280 + 64 * (j))
#define XB_XGEN(j)  (2304 + 64 * (j))
#define XB_TOP      3328
#define XB_TOPGEN   3392
#define XCD_BAR_WORDS 3456
#define XB_SPIN_CAP (1u << 22)

__device__ __forceinline__ unsigned xb_ld(unsigned* p)              { return __hip_atomic_load(p, __ATOMIC_RELAXED, __HIP_MEMORY_SCOPE_AGENT); }
__device__ __forceinline__ unsigned xb_add(unsigned* p, unsigned v) { return __hip_atomic_fetch_add(p, v, __ATOMIC_RELAXED, __HIP_MEMORY_SCOPE_AGENT); }
__device__ __forceinline__ unsigned xb_xcc_id() { return (unsigned)__builtin_amdgcn_s_getreg((3 << 11) | 20) & 0xFu; }
#define XB_SPIN(cond, bar) do { unsigned _sp = 0; while (cond) { __builtin_amdgcn_s_sleep(1); \
    if ((++_sp & 255u) == 0u) { if (xb_ld(&(bar)[XB_TMO])) break; if (_sp > XB_SPIN_CAP) { atomicAdd(&(bar)[XB_TMO], 1u); break; } } } } while (0)

struct XcdBarrier {
    unsigned* bar; unsigned x; int wave;
    volatile LAS unsigned* st;
};

__device__ __forceinline__ bool xb_thread0(int wave) { return wave == 0 && __builtin_amdgcn_mbcnt_hi(~0u, __builtin_amdgcn_mbcnt_lo(~0u, 0u)) == 0u; }
__device__ __forceinline__ XcdBarrier xcd_barrier_post(unsigned* bar, volatile LAS unsigned* st, int wave) {
    XcdBarrier b; b.bar = bar; b.x = xb_xcc_id(); b.st = st; b.wave = wave;
    if (xb_thread0(wave)) (void)xb_add(&bar[XB_XCNT(b.x)], 1u);
    return b;
}
__device__ __forceinline__ void xcd_barrier_complete(unsigned* bar, unsigned x, unsigned& nloc, unsigned& nx) {
    const unsigned G = gridDim.x * gridDim.y * gridDim.z;
    unsigned sum, cnt, mine, sp = 0u;
    for (;;) {
        sum = 0u; cnt = 0u; mine = 0u;
#pragma unroll
        for (unsigned j = 0; j < 16; ++j) { const unsigned c = xb_ld(&bar[XB_XCNT(j)]); sum += c; cnt += (c > 0u) ? 1u : 0u; mine = (j == x) ? c : mine; }
        if (sum == G) break;
        __builtin_amdgcn_s_sleep(1);
        if ((++sp & 255u) == 0u) { if (xb_ld(&bar[XB_TMO])) break; if (sp > XB_SPIN_CAP) { atomicAdd(&bar[XB_TMO], 1u); break; } }
    }
    nloc = mine > 0u ? mine : 1u; nx = cnt > 0u ? cnt : 1u;
}

__device__ __forceinline__ void xcd_barrier(const XcdBarrier& b) {
    asm volatile("s_waitcnt vmcnt(0)" ::: "memory");
    __syncthreads();
    if (xb_thread0(b.wave)) {
        unsigned* bar = b.bar;
        __builtin_amdgcn_s_waitcnt(0);
        unsigned nloc = b.st[0], nx = b.st[1];
        if (nloc == 0u) { xcd_barrier_complete(bar, b.x, nloc, nx); b.st[0] = nloc; b.st[1] = nx; }
        const unsigned old = xb_add(&bar[XB_XSUB(b.x)], 1u);
        const unsigned gen = old / nloc;
        if (old + 1u == (gen + 1u) * nloc) {
            __builtin_amdgcn_fence(__ATOMIC_RELEASE, "agent");
            asm volatile("s_waitcnt vmcnt(0)" ::: "memory");
            const unsigned og = xb_add(&bar[XB_TOP], 1u);
            const unsigned tg = og / nx;
            if (og + 1u == (tg + 1u) * nx) xb_add(&bar[XB_TOPGEN], 1u);
            else XB_SPIN(xb_ld(&bar[XB_TOPGEN]) == tg, bar);
            __builtin_amdgcn_fence(__ATOMIC_ACQUIRE, "agent");
            xb_add(&bar[XB_XGEN(b.x)], 1u);
            asm volatile("s_waitcnt vmcnt(0)" ::: "memory");
        } else {
            XB_SPIN(xb_ld(&bar[XB_XGEN(b.x)]) == gen, bar);
            __builtin_amdgcn_fence(__ATOMIC_ACQUIRE, "agent");
            asm volatile("s_waitcnt vmcnt(0)" ::: "memory");
        }
    }
    __syncthreads();
}

typedef float f32x16 __attribute__((ext_vector_type(16)));
typedef unsigned u32x2 __attribute__((ext_vector_type(2)));
struct Frame {
    LAS unsigned char* lds;
    volatile LAS unsigned* MISC;
    gu32* ctl;
    unsigned char* ws;
    int tid, lane, wave;
    int vcu, G;
};
__device__ __forceinline__ float wave_sum(float v) {
#pragma unroll
    for (int o = 1; o < 64; o <<= 1) v += __shfl_xor(v, o);
    return v;
}
__device__ __forceinline__ float sigm(float x) { return __builtin_amdgcn_rcpf(1.0f + __builtin_amdgcn_exp2f(-1.4426950408889634f * x)); }
__device__ __forceinline__ float bf_lo(unsigned w) { return __uint_as_float(w << 16); }
__device__ __forceinline__ float bf_hi(unsigned w) { return __uint_as_float(w & 0xffff0000u); }
__device__ __forceinline__ unsigned cvtpk(float lo, float hi) { typedef float f2 __attribute__((ext_vector_type(2))); typedef __bf16 b2 __attribute__((ext_vector_type(2))); f2 v = {lo, hi}; b2 b = __builtin_convertvector(v, b2); return __builtin_bit_cast(unsigned, b); }
__device__ __forceinline__ bf16x8 pack8(float a0, float a1, float a2, float a3, float a4, float a5, float a6, float a7) {
    v4u w; w.x = cvtpk(a0, a1); w.y = cvtpk(a2, a3); w.z = cvtpk(a4, a5); w.w = cvtpk(a6, a7); return __builtin_bit_cast(bf16x8, w);
}
__device__ __forceinline__ unsigned rs_byte(float x, unsigned h) {
    const unsigned E = (h >> 7) & 0xffu;
    const float q = rintf((x - __uint_as_float(h << 16)) * __uint_as_float((269u - E) << 23)) + 128.f;
    return E < 16u ? 128u : (unsigned)fminf(fmaxf(q, 0.f), 255.f);
}
__device__ __forceinline__ void rs_enc(const f32x4 o, u32x2& w, unsigned& b) {
    const unsigned h0 = f2bf(o.x), h1 = f2bf(o.y), h2 = f2bf(o.z), h3 = f2bf(o.w);
    w.x = h0 | (h1 << 16); w.y = h2 | (h3 << 16);
    b = rs_byte(o.x, h0) | (rs_byte(o.y, h1) << 8) | (rs_byte(o.z, h2) << 16) | (rs_byte(o.w, h3) << 24);
}
__device__ __forceinline__ float rs_dec1(unsigned h, unsigned u) {
    const unsigned E = (h >> 7) & 0xffu;
    return __uint_as_float(h << 16) + ((float)u - 128.f) * __uint_as_float((E < 16u ? 0u : E - 15u) << 23);
}
__device__ __forceinline__ f32x4 rs_dec(const u32x2 w, unsigned b) {
    return (f32x4){rs_dec1(w.x & 0xffffu, b & 0xffu), rs_dec1(w.x >> 16, (b >> 8) & 0xffu), rs_dec1(w.y & 0xffffu, (b >> 16) & 0xffu), rs_dec1(w.y >> 16, b >> 24)};
}
__device__ __forceinline__ int crow(int r, int hi) { return (r & 3) + 8 * (r >> 2) + 4 * hi; }

struct MapId { __device__ __forceinline__ int operator()(int n) const { return n; } };
struct MapW1 { __device__ __forceinline__ int operator()(int n) const { return ((n >> 7) & 1) * 1024 + (n >> 8) * 128 + (n & 127); } };
struct MapWin {
    __device__ __forceinline__ int operator()(int n) const {
        if (n >= 2048) { const int i = n - 2048; return i < 24 ? 1280 + i : -1; }
        const int seg = n >> 7, q = n & 127, hd = q >> 6, pos = q & 63, g = pos >> 3, j = pos & 7;
        const int dlog = j < 4 ? 4 * g + j : 32 + 4 * g + (j - 4);
        const int hc = seg * 128 + hd * 64 + dlog;
        return hc < 1280 ? hc : hc + 24;
    }
};
template <class Map>
__device__ __forceinline__ void transpose_item(const float* W, int K, int Nsrc, bf16* WT, LAS float* scr, int kb, int nb, int lane, Map map) {
    const int k0 = 64 * kb, n0 = 32 * nb;
    const int src = map(n0 + (lane & 31));
    float wv[32];
#pragma unroll
    for (int i = 0; i < 32; ++i) { const int kk = 2 * i + (lane >> 5); wv[i] = src >= 0 ? W[(size_t)(k0 + kk) * Nsrc + src] : 0.f; }
#pragma unroll
    for (int i = 0; i < 32; ++i) { const int kk = 2 * i + (lane >> 5); scr[kk * 33 + (lane & 31)] = wv[i]; }
    LDS_WAIT(); asm volatile("" ::: "memory");
    const int c = lane & 7;
#pragma unroll
    for (int j = 0; j < 4; ++j) { const int n = (lane >> 3) + 8 * j; const LAS float* s = scr + (8 * c) * 33 + n;
        v4u o; o.x = pk2(s[0 * 33], s[1 * 33]); o.y = pk2(s[2 * 33], s[3 * 33]); o.z = pk2(s[4 * 33], s[5 * 33]); o.w = pk2(s[6 * 33], s[7 * 33]);
        *(GAS v4u*)(WT + (size_t)(n0 + n) * K + k0 + 8 * c) = o; }
    LDS_WAIT(); asm volatile("" ::: "memory");
}
__device__ __forceinline__ unsigned pk4_fp8(float a, float b, float c, float d) { int w = 0; w = __builtin_amdgcn_cvt_pk_fp8_f32(a, b, w, false); w = __builtin_amdgcn_cvt_pk_fp8_f32(c, d, w, true); return (unsigned)w; }
template <class Map>
__device__ __forceinline__ void transpose_item_f8(const float* W, int K, int Nsrc, unsigned char* WT, LAS float* scr, int kb, int nb, int lane, Map map, float wscale) {
    const int k0 = 64 * kb, n0 = 32 * nb;
    const int src = map(n0 + (lane & 31));
    float wv[32];
#pragma unroll
    for (int i = 0; i < 32; ++i) { const int kk = 2 * i + (lane >> 5); wv[i] = src >= 0 ? W[(size_t)(k0 + kk) * Nsrc + src] * wscale : 0.f; }
#pragma unroll
    for (int i = 0; i < 32; ++i) { const int kk = 2 * i + (lane >> 5); scr[kk * 33 + (lane & 31)] = wv[i]; }
    LDS_WAIT(); asm volatile("" ::: "memory");
    const int c = lane & 7;
#pragma unroll
    for (int j = 0; j < 4; ++j) { const int n = (lane >> 3) + 8 * j; const LAS float* s = scr + (8 * c) * 33 + n;
        u32x2 o; o.x = pk4_fp8(s[0 * 33], s[1 * 33], s[2 * 33], s[3 * 33]); o.y = pk4_fp8(s[4 * 33], s[5 * 33], s[6 * 33], s[7 * 33]);
        *(GAS u32x2*)(WT + (size_t)(n0 + n) * K + k0 + 8 * c) = o; }
    LDS_WAIT(); asm volatile("" ::: "memory");
}
constexpr float W1_F8_SCALE = 64.0f, W2_F8_SCALE = 128.0f, WPG_F8_SCALE = 64.0f;
struct PIn { const float *x, *p, *w_in, *b_in, *w_ck1, *w_ck2, *w_cv1, *w_cv2, *w_o, *w_r, *w_e1, *b_e1, *w_e2, *w_pg, *w_pp; const int* pos; };
__device__ __forceinline__ void p0_prologue(Frame& F, const PIn& I) {
    LAS float* scr = (LAS float*)(F.lds + RING_OFF + F.wave * 16384);
    const int gw = F.vcu * NWAVES + F.wave, NGW = F.G * NWAVES, lane = F.lane;
    unsigned char* ws = F.ws;
    constexpr int I_IN = 16 * 72, I_O = 16 * 32, I_PG = 16 * 32, I_PP = 4 * 32, I_C1 = 32 * 8, I_C2 = 4 * 2;
    constexpr int I_LAYER = I_IN + I_O + I_PG + I_PP + 2 * I_C1 + 2 * I_C2;
    for (int it = gw; it < NL * I_LAYER; it += NGW) {
        const int L = it / I_LAYER; int r = it % I_LAYER;
        if (r < I_IN) { transpose_item(I.w_in + (size_t)L * 1024 * 2072, 1024, 2072, (bf16*)(ws + WS_WIN) + (size_t)L * NIN * 1024, scr, r / 72, r % 72, lane, MapWin()); continue; } r -= I_IN;
        if (r < I_O) { transpose_item(I.w_o + (size_t)L * 1024 * 1024, 1024, 1024, (bf16*)(ws + WS_WO) + (size_t)L * 1024 * 1024, scr, r / 32, r % 32, lane, MapId()); continue; } r -= I_O;
        if (r < I_PG) {
            if (L == NL - 1) transpose_item_f8(I.w_pg + (size_t)L * 1024 * 1024, 1024, 1024, ws + WS_WPG + (size_t)L * 1024 * 1024 * 2, scr, r / 32, r % 32, lane, MapId(), WPG_F8_SCALE);
            else transpose_item(I.w_pg + (size_t)L * 1024 * 1024, 1024, 1024, (bf16*)(ws + WS_WPG) + (size_t)L * 1024 * 1024, scr, r / 32, r % 32, lane, MapId());
            continue; } r -= I_PG;
        if (r < I_PP) { transpose_item(I.w_pp + (size_t)L * 256 * 1024, 256, 1024, (bf16*)(ws + WS_WPP) + (size_t)L * 1024 * 256, scr, r / 32, r % 32, lane, MapId()); continue; } r -= I_PP;
        if (r < I_C1) { transpose_item(I.w_ck1 + (size_t)L * 2048 * 256, 2048, 256, (bf16*)(ws + WS_WC1) + (size_t)(L * 2 + 0) * 256 * 2048, scr, r / 8, r % 8, lane, MapId()); continue; } r -= I_C1;
        if (r < I_C1) { transpose_item(I.w_cv1 + (size_t)L * 2048 * 256, 2048, 256, (bf16*)(ws + WS_WC1) + (size_t)(L * 2 + 1) * 256 * 2048, scr, r / 8, r % 8, lane, MapId()); continue; } r -= I_C1;
        if (r < I_C2) { transpose_item(I.w_ck2 + (size_t)L * 256 * 64, 256, 64, (bf16*)(ws + WS_WC2) + (size_t)(L * 2 + 0) * 64 * 256, scr, r / 2, r % 2, lane, MapId()); continue; } r -= I_C2;
        { transpose_item(I.w_cv2 + (size_t)L * 256 * 64, 256, 64, (bf16*)(ws + WS_WC2) + (size_t)(L * 2 + 1) * 64 * 256, scr, r / 2, r % 2, lane, MapId()); }
    }
    const size_t gt = (size_t)F.vcu * (NWAVES * 64) + F.tid, NGT = (size_t)F.G * NWAVES * 64;
    for (size_t i = gt; i < (size_t)NL * 32 * 1024; i += NGT) {
        const int L = (int)(i / (32 * 1024)), e = (int)((i / 1024) % 32), k = (int)(i % 1024);
        const float w = I.w_r[((size_t)L * 1024 + k) * 32 + e];
        const unsigned h = f2bf(w); const float wl = w - __uint_as_float(h << 16);
        bf16* d = (bf16*)(ws + WS_WR) + (size_t)L * 2 * 32 * 1024 + (size_t)e * 1024 + k;
        d[0] = (bf16)h; d[32 * 1024] = (bf16)f2bf(wl);
    }
    for (size_t i = gt; i < (size_t)NL * NIN; i += NGT) { const int L = (int)(i / NIN), n = (int)(i % NIN); const int s = MapWin()(n); ((float*)(ws + WS_BINP))[i] = s >= 0 ? I.b_in[(size_t)L * 2072 + s] : 0.f; }
    for (size_t i = gt; i < (size_t)NL * 32 * 2048; i += NGT) { const int le = (int)(i / 2048), n = (int)(i % 2048); ((float*)(ws + WS_B1P))[i] = I.b_e1[(size_t)le * 2048 + MapW1()(n)]; }
    for (size_t i = gt; i < (size_t)M * D / 8; i += NGT) {
        const f32x4 a = *(const GAS f32x4*)(I.x + i * 8), b = *(const GAS f32x4*)(I.x + i * 8 + 4);
        v4u o; o.x = pk2(a.x, a.y); o.y = pk2(a.z, a.w); o.z = pk2(b.x, b.y); o.w = pk2(b.z, b.w);
        *(GAS v4u*)((bf16*)(ws + WS_XB) + i * 8) = o;
    }
    for (size_t i = gt; i < (size_t)NL * M * PD / 8; i += NGT) {
        const f32x4 a = *(const GAS f32x4*)(I.p + i * 8), b = *(const GAS f32x4*)(I.p + i * 8 + 4);
        v4u o; o.x = pk2(a.x, a.y); o.y = pk2(a.z, a.w); o.z = pk2(b.x, b.y); o.w = pk2(b.z, b.w);
        *(GAS v4u*)((bf16*)(ws + WS_PB) + i * 8) = o;
    }
    for (size_t i = gt; i < (size_t)M * 32; i += NGT) {
        const int row = (int)(i >> 5), d = (int)(i & 31);
        const float inv = 1.0f / powf(10000.0f, (float)(2 * d) / 64.0f);
        const float ang = (float)I.pos[row] * inv;
        float* rp = (float*)(ws + WS_ROPE) + (size_t)row * 64;
        rp[d] = cosf(ang); rp[32 + d] = sinf(ang);
    }
}

static_assert(NL == 2, "the conversion queues are laid out for two layers");
constexpr int I_E1 = 32 * 16 * 32, I_E2 = 32 * 16 * 16;
constexpr int QCH = 2;
constexpr int CW_Q = 2048, CW_STOP = 2080;
constexpr int CV_PITCH = 65, CV_WAVE_BYTES = 17408;
static_assert(8 * CV_WAVE_BYTES <= SCRATCH_BYTES && 64 * CV_PITCH * 4 <= CV_WAVE_BYTES, "conversion tiles");
struct CvItem { const float* W; unsigned char* WT; int Nsrc, K, kb, nb, w1; float scale; };
template <int Q>
__device__ __forceinline__ CvItem cv_item(unsigned char* ws, const float* w_e1, const float* w_e2, int item) {
    CvItem d;
    constexpr int L = (Q == 2) ? NL - 1 : 0;
    const bool is1 = (Q == 0) || (Q == 2 && item < I_E1);
    const int r = (Q == 2 && !is1) ? item - I_E1 : item;
    if (is1) { const int e = r / 512, q = r % 512; d.W = w_e1 + ((size_t)L * 32 + e) * 1024 * 2048; d.Nsrc = 2048; d.kb = q / 32; d.nb = q % 32; d.w1 = 1; d.scale = W1_F8_SCALE;
        d.WT = (Q == 2) ? ws + WS_W1T + (size_t)L * 32 * 2048 * 1024 * 2 + (size_t)e * 2048 * 1024 : ws + WS_W1T + (size_t)e * 2048 * 1024 * 2; }
    else { const int e = r / 256, q = r % 256; d.W = w_e2 + ((size_t)L * 32 + e) * 1024 * 1024; d.Nsrc = 1024; d.kb = q / 16; d.nb = q % 16; d.w1 = 0; d.scale = W2_F8_SCALE;
        d.WT = (Q == 2) ? ws + WS_W2T + (size_t)L * 32 * 1024 * 1024 * 2 + (size_t)e * 1024 * 1024 : ws + WS_W2T + (size_t)e * 1024 * 1024 * 2; }
    d.K = 1024;
    return d;
}
__device__ __forceinline__ void cv_load(f32x4 (&r)[16], const CvItem& d, int lane) {
    const int kl = lane >> 4, c = lane & 15, n = 64 * d.nb + 4 * c;
    const int src = d.w1 ? MapW1()(n) : n;
    const float* p = d.W + (size_t)(64 * d.kb + kl) * d.Nsrc + src;
#pragma unroll
    for (int i = 0; i < 16; ++i) r[i] = __builtin_nontemporal_load((const GAS f32x4*)(p + (size_t)(4 * i) * d.Nsrc));
}
template <bool F8>
__device__ __forceinline__ void cv_store(const f32x4 (&r)[16], const CvItem& d, LAS float* scr, int lane) {
    const int kl = lane >> 4, c = lane & 15;
#pragma unroll
    for (int i = 0; i < 16; ++i) { LAS float* t = scr + (4 * i + kl) * CV_PITCH + 4 * c; t[0] = r[i].x; t[1] = r[i].y; t[2] = r[i].z; t[3] = r[i].w; }
    LDS_WAIT(); asm volatile("" ::: "memory");
    const int c8 = lane & 7, nl = lane >> 3;
#pragma unroll
    for (int jj = 0; jj < 8; ++jj) { const int n = nl + 8 * jj; const LAS float* s = scr + (8 * c8) * CV_PITCH + n;
        const float a0 = s[0 * CV_PITCH], a1 = s[1 * CV_PITCH], a2 = s[2 * CV_PITCH], a3 = s[3 * CV_PITCH], a4 = s[4 * CV_PITCH], a5 = s[5 * CV_PITCH], a6 = s[6 * CV_PITCH], a7 = s[7 * CV_PITCH];
        const size_t o = (size_t)(64 * d.nb + n) * d.K + 64 * d.kb + 8 * c8;
        if constexpr (F8) { const float w = d.scale; u32x2 v; v.x = pk4_fp8(a0 * w, a1 * w, a2 * w, a3 * w); v.y = pk4_fp8(a4 * w, a5 * w, a6 * w, a7 * w); __builtin_nontemporal_store(v, (GAS u32x2*)(d.WT + o)); }
        else { v4u v; v.x = pk2(a0, a1); v.y = pk2(a2, a3); v.z = pk2(a4, a5); v.w = pk2(a6, a7); __builtin_nontemporal_store(v, (GAS v4u*)((bf16*)d.WT + o)); } }
    LDS_WAIT(); asm volatile("" ::: "memory");
}
template <int Q>
__device__ __forceinline__ void conv_run(Frame& F, const float* w_e1, const float* w_e2, int stop_word, unsigned stop_thr = 1u, int stat = -1) {
    static_assert(QCH == 2, "one loop trip = one chunk = items A, B");
    constexpr int NCH = (Q == 0 ? I_E1 : Q == 1 ? I_E2 : I_E1 + I_E2) / QCH;
    constexpr bool F8 = (Q == 2);
    LAS float* scr = (LAS float*)(F.lds + RING_OFF + F.wave * CV_WAVE_BYTES);
    gu32* head = F.ctl + CW_Q + Q;
    const int lane = F.lane;
    if (__builtin_amdgcn_readfirstlane(__hip_atomic_load(head, RLX_AGENT)) >= (unsigned)NCH) return;
    if (stop_word >= 0 && __builtin_amdgcn_readfirstlane(__hip_atomic_load(F.ctl + stop_word, RLX_AGENT)) >= stop_thr) return;
    const __amdgpu_buffer_rsrc_t rs = __builtin_amdgcn_make_buffer_rsrc((unsigned*)head, 0, 4, 0x00020000);
    const int own = lane == 0 ? 0 : 0x40000000;
    unsigned c = (unsigned)__builtin_amdgcn_readfirstlane(__builtin_amdgcn_raw_ptr_buffer_atomic_add_i32(1, rs, own, 0, 0));
    if (c >= (unsigned)NCH) return;
    int pend = __builtin_amdgcn_raw_ptr_buffer_atomic_add_i32(1, rs, own, 0, 0);
    unsigned stp = 0u; bool last = false;
    if (stop_word >= 0) stp = __hip_atomic_load(F.ctl + stop_word, RLX_AGENT);
#ifdef PRB_SEL
    unsigned ndone = 0u;
#endif
    f32x4 ra[16], rb[16];
    CvItem da = cv_item<Q>(F.ws, w_e1, w_e2, (int)c * QCH), db;
    cv_load(ra, da, lane);
    for (;;) {
        db = cv_item<Q>(F.ws, w_e1, w_e2, (int)c * QCH + 1); cv_load(rb, db, lane);
        cv_store<F8>(ra, da, scr, lane);
        const unsigned cn = (unsigned)__builtin_amdgcn_readfirstlane(pend);
        const bool stopped = stop_word >= 0 && (unsigned)__builtin_amdgcn_readfirstlane(stp) >= stop_thr;
        const bool more = !last && cn < (unsigned)NCH;
        if (more) {
            pend = __builtin_amdgcn_raw_ptr_buffer_atomic_add_i32(1, rs, stopped ? 0x40000000 : own, 0, 0);
            last = stopped;
            if (stop_word >= 0) stp = __hip_atomic_load(F.ctl + stop_word, RLX_AGENT);
            da = cv_item<Q>(F.ws, w_e1, w_e2, (int)cn * QCH); cv_load(ra, da, lane);
        }
        cv_store<F8>(rb, db, scr, lane);
#ifdef PRB_SEL
        ++ndone;
#endif
        if (!more) break;
        c = cn;
    }
#ifdef PRB_SEL
    if (stat >= 0 && lane == 0) (void)__hip_atomic_fetch_add((gu32*)(F.ws + WS_TOKE + 3 * MiB) + stat, ndone, RLX_AGENT);
#endif
}

__device__ __forceinline__ float gelu_tanh(float x) {
    const float u = 0.7978845608028654f * (x + 0.044715f * x * x * x);
    const float e = __builtin_amdgcn_exp2f(2.0f * 1.4426950408889634f * u);
    const float t = 1.0f - 2.0f * __builtin_amdgcn_rcpf(e + 1.0f);
    return 0.5f * x * (1.0f + t);
}
__device__ __forceinline__ void phase_compress(Frame& F, int L, const float* ck_pe, const float* cv_pe) {
    const int lane = F.lane, wave = F.wave, tid = F.tid;
    unsigned char* ws = F.ws;
    const bf16* H = (const bf16*)(ws + WS_H);
    const float* rope = (const float*)(ws + WS_ROPE);
    LAS unsigned char* hid = F.lds + RING_OFF;
    LAS float* pel = (LAS float*)(F.lds + RING_OFF + 16896);
    LAS unsigned char* atok = F.lds + RING_OFF + 16896 + 8192;
    constexpr int AP = 144, AIS = 33 * AP;
    for (int unit = blockIdx.x; unit < 256; unit += F.G) {
        int lane_v = lane; asm volatile("" : "+v"(lane_v));
        const int q = lane_v & 31, hi = lane_v >> 5;
        const int b = unit >> 4, g = (unit >> 3) & 1, kv = (unit >> 2) & 1, cb = unit & 3;
        const bf16* w1t = (const bf16*)(ws + WS_WC1) + (size_t)(L * 2 + kv) * 256 * 2048;
        const bf16* w2t = (const bf16*)(ws + WS_WC2) + (size_t)(L * 2 + kv) * 64 * 256;
        const float* pe = (kv ? cv_pe : ck_pe) + (size_t)L * 32 * 64;
        const int scol = (kv ? C_VC : C_KC) + g * 64;
        const int tok0 = 512 * cb;
        __syncthreads();
        for (int ci = tid; ci < 528 * 8; ci += NWAVES * 64) {
            const int tk = ci >> 3, ch = ci & 7; int tg = tok0 + tk; tg = tg < T ? tg : T - 1;
            *(LAS v4u*)(atok + (tk & 15) * AIS + (tk >> 4) * AP + ch * 16) = *(const GAS v4u*)(H + ((size_t)b * T + tg) * HP + scol + ch * 8);
        }
        for (int ci = tid; ci < 32 * 64 / 4; ci += NWAVES * 64) *(LAS f32x4*)(pel + ci * 4) = *(const GAS f32x4*)(pe + ci * 4);
        __syncthreads();
        const bf16* brow = w1t + (size_t)(32 * wave + q) * 2048 + 8 * hi;
        f32x16 acc; for (int r = 0; r < 16; ++r) acc[r] = 0.f;
        bf16x8 bcur[8], bnxt[8];
#pragma unroll
        for (int u = 0; u < 8; ++u) bcur[u] = *(const GAS bf16x8*)(brow + u * 16);
        for (int i2 = 0; i2 < 16; ++i2) {
            if (i2 < 15) {
#pragma unroll
                for (int u = 0; u < 8; ++u) bnxt[u] = *(const GAS bf16x8*)(brow + (i2 + 1) * 128 + u * 16);
            }
#pragma unroll
            for (int u = 0; u < 8; ++u) {
                const int i = 2 * i2 + (u >> 2), s4 = u & 3;
                const v4u av = *(const LAS v4u*)(atok + (i & 15) * AIS + (q + (i >> 4)) * AP + (16 * s4 + 8 * hi) * 2);
                const f32x4 p0 = *(const LAS f32x4*)(pel + i * 64 + 16 * s4 + 8 * hi), p1 = *(const LAS f32x4*)(pel + i * 64 + 16 * s4 + 8 * hi + 4);
                const bf16x8 af = pack8(bf_lo(av.x) + p0.x, bf_hi(av.x) + p0.y, bf_lo(av.y) + p0.z, bf_hi(av.y) + p0.w, bf_lo(av.z) + p1.x, bf_hi(av.z) + p1.y, bf_lo(av.w) + p1.z, bf_hi(av.w) + p1.w);
                acc = __builtin_amdgcn_mfma_f32_32x32x16_bf16(af, bcur[u], acc, 0, 0, 0);
            }
#pragma unroll
            for (int u = 0; u < 8; ++u) bcur[u] = bnxt[u];
        }
#pragma unroll
        for (int r = 0; r < 16; ++r) *(LAS bf16*)(hid + crow(r, hi) * 528 + (32 * wave + q) * 2) = (bf16)f2bf(gelu_tanh(acc[r]));
        __syncthreads();
        if (wave == 0) {
            f32x16 a0, a1; for (int r = 0; r < 16; ++r) { a0[r] = 0.f; a1[r] = 0.f; }
#pragma unroll
            for (int ks = 0; ks < 16; ++ks) {
                const bf16x8 af = *(const LAS bf16x8*)(hid + q * 528 + (16 * ks + 8 * hi) * 2);
                const bf16x8 b0 = *(const GAS bf16x8*)(w2t + (size_t)q * 256 + 16 * ks + 8 * hi), b1 = *(const GAS bf16x8*)(w2t + (size_t)(32 + q) * 256 + 16 * ks + 8 * hi);
                a0 = __builtin_amdgcn_mfma_f32_32x32x16_bf16(af, b0, a0, 0, 0, 0);
                a1 = __builtin_amdgcn_mfma_f32_32x32x16_bf16(af, b1, a1, 0, 0, 0);
            }
            bf16* outp = (bf16*)(ws + (kv ? WS_VCMP : WS_KCMP)) + (size_t)(b * 2 + g) * 128 * 64;
#pragma unroll
            for (int r = 0; r < 16; ++r) {
                const int cl = 32 * cb + crow(r, hi);
                float x1 = a0[r], x2 = a1[r];
                if (kv == 0) {
                    const int cr = cl < 127 ? cl : 126;
                    const float* rp = rope + ((size_t)b * T + 31 + 16 * cr) * 64;
                    const float cs = rp[q], sn = rp[32 + q];
                    const float o1 = x1 * cs - x2 * sn, o2 = x2 * cs + x1 * sn; x1 = o1; x2 = o2;
                }
                if (cl >= 127) { x1 = 0.f; x2 = 0.f; }
                outp[(size_t)cl * 64 + q] = (bf16)f2bf(x1); outp[(size_t)cl * 64 + 32 + q] = (bf16)f2bf(x2);
            }
        }
    }
    __syncthreads();
}

namespace att {
constexpr float ATT_THR = 6.0f;
constexpr int KP = 144;
constexpr int KTB = 64 * KP, VTB = 8192;
constexpr int L_K = 0;
constexpr int L_V = 4 * KTB;
constexpr int L_KC = 0;
constexpr int L_VC = 128 * KP;
constexpr int L_IMP = L_VC + 16384;
constexpr int L_OT = 4 * KTB + 4 * VTB;
constexpr int L_SEL = L_OT + 65536;
static_assert(L_IMP + 4 * 64 * 33 * 4 <= L_OT && L_SEL + 256 <= SCRATCH_BYTES, "attention LDS map");

__device__ __forceinline__ float max3f(float a, float b, float c) { float r; asm("v_max3_f32 %0, %1, %2, %3" : "=v"(r) : "v"(a), "v"(b), "v"(c)); return r; }
__device__ __forceinline__ float max2f(float a, float b) { float r; asm("v_max_f32_e32 %0, %1, %2" : "=v"(r) : "v"(a), "v"(b)); return r; }
typedef short v4i16_t __attribute__((ext_vector_type(4)));
__device__ __forceinline__ u32x2 vtr(const LAS unsigned char* p) { return __builtin_bit_cast(u32x2, __builtin_amdgcn_ds_read_tr16_b64_v4i16((LAS v4i16_t*)p)); }
__device__ __forceinline__ float xhalf_max(float v) { auto rr = __builtin_amdgcn_permlane32_swap(__float_as_uint(v), __float_as_uint(v), false, false); return fmaxf(__uint_as_float(rr[0]), __uint_as_float(rr[1])); }
__device__ __forceinline__ float xhalf_sum(float v) { auto rr = __builtin_amdgcn_permlane32_swap(__float_as_uint(v), __float_as_uint(v), false, false); return __uint_as_float(rr[0]) + __uint_as_float(rr[1]); }
template <bool SEL>
__device__ __forceinline__ void att_tile(LAS unsigned char* Kl, LAS unsigned char* Vl, int j, int qt, int jlo, int t, int W, unsigned selbits, const bf16x8 (&qf)[4],
                                         f32x16& o0, f32x16& o1, f32x16& negm, float& m_run, float& l_run, int q, int hi) {
        bf16x8 ka[4], kb2[4]; u32x2 va[4][2], vb[4][2];
#pragma unroll
        for (int s = 0; s < 4; ++s) { ka[s] = *(const LAS bf16x8*)(Kl + q * KP + (16 * s + 8 * hi) * 2); kb2[s] = *(const LAS bf16x8*)(Kl + (32 + q) * KP + (16 * s + 8 * hi) * 2); }
        {
            const LAS unsigned char* vp = Vl + ((q >> 4) & 1) * 32 + (q & 3) * 8 + (4 * hi + ((q & 15) >> 2)) * 64;
#pragma unroll
            for (int ks = 0; ks < 4; ++ks) {
                va[ks][0] = vtr(vp + ks * 1024); va[ks][1] = vtr(vp + ks * 1024 + 512);
                vb[ks][0] = vtr(vp + 4096 + ks * 1024); vb[ks][1] = vtr(vp + 4096 + ks * 1024 + 512);
            }
        }
        __builtin_amdgcn_sched_barrier(0);
        f32x16 s0 = __builtin_amdgcn_mfma_f32_32x32x16_bf16(ka[0], qf[0], negm, 0, 0, 0);
        f32x16 s1 = __builtin_amdgcn_mfma_f32_32x32x16_bf16(kb2[0], qf[0], negm, 0, 0, 0);
#pragma unroll
        for (int s = 1; s < 4; ++s) {
            s0 = __builtin_amdgcn_mfma_f32_32x32x16_bf16(ka[s], qf[s], s0, 0, 0, 0);
            s1 = __builtin_amdgcn_mfma_f32_32x32x16_bf16(kb2[s], qf[s], s1, 0, 0, 0);
        }
        const bool lane_ok = SEL ? (((selbits >> j) & 1u) != 0u) : true;
        if (j == qt || j == jlo) {
            const int d0 = t - 64 * j - 4 * hi;
#pragma unroll
            for (int r = 0; r < 16; ++r) {
                s0[r] = ((unsigned)(d0 - ((r & 3) + 8 * (r >> 2))) < (unsigned)W) ? s0[r] : -INFINITY;
                s1[r] = ((unsigned)(d0 - (32 + (r & 3) + 8 * (r >> 2))) < (unsigned)W) ? s1[r] : -INFINITY;
            }
        }
        float mx = fmaxf(s0[0], s1[0]), mx2 = fmaxf(s0[1], s1[1]);
#pragma unroll
        for (int r = 2; r < 16; r += 2) { mx = max3f(mx, s0[r], s1[r]); mx2 = max3f(mx2, s0[r + 1], s1[r + 1]); }
        mx = max2f(mx, mx2);
        mx = lane_ok ? mx : -INFINITY;
        mx = xhalf_max(mx);
        typedef float f32x2_ __attribute__((ext_vector_type(2)));
        f32x2_ ps2 = {0.f, 0.f};
#pragma unroll
        for (int r = 0; r < 16; ++r) { s0[r] = __builtin_amdgcn_exp2f(s0[r]); s1[r] = __builtin_amdgcn_exp2f(s1[r]); ps2 += (f32x2_){s0[r], s1[r]}; }
        const float ps = ps2.x + ps2.y;
        const unsigned okm = lane_ok ? 0xffffffffu : 0u;
        l_run += lane_ok ? ps : 0.f;
#pragma unroll
        for (int ks = 0; ks < 4; ++ks) {
            const int kb = ks >> 1, sp = ks & 1;
            bf16x8 pf = kb ? pack8(s1[8 * sp + 0], s1[8 * sp + 1], s1[8 * sp + 2], s1[8 * sp + 3], s1[8 * sp + 4], s1[8 * sp + 5], s1[8 * sp + 6], s1[8 * sp + 7])
                           : pack8(s0[8 * sp + 0], s0[8 * sp + 1], s0[8 * sp + 2], s0[8 * sp + 3], s0[8 * sp + 4], s0[8 * sp + 5], s0[8 * sp + 6], s0[8 * sp + 7]);
            if (SEL) { v4u pw = __builtin_bit_cast(v4u, pf); pw.x &= okm; pw.y &= okm; pw.z &= okm; pw.w &= okm; pf = __builtin_bit_cast(bf16x8, pw); }
            {
                v4u w; w.x = va[ks][0].x; w.y = va[ks][0].y; w.z = va[ks][1].x; w.w = va[ks][1].y;
                o0 = __builtin_amdgcn_mfma_f32_32x32x16_bf16(__builtin_bit_cast(bf16x8, w), pf, o0, 0, 0, 0);
            }
            {
                v4u w; w.x = vb[ks][0].x; w.y = vb[ks][0].y; w.z = vb[ks][1].x; w.w = vb[ks][1].y;
                o1 = __builtin_amdgcn_mfma_f32_32x32x16_bf16(__builtin_bit_cast(bf16x8, w), pf, o1, 0, 0, 0);
            }
        }
        if (__builtin_amdgcn_ballot_w64(mx > ATT_THR) != 0ull) {
            const float gmx = fmaxf(mx, 0.f);
            const float alpha = __builtin_amdgcn_exp2f(-gmx);
            l_run *= alpha; m_run += gmx;
#pragma unroll
            for (int r = 0; r < 16; ++r) { o0[r] *= alpha; o1[r] *= alpha; negm[r] -= gmx; }
        }
}
template <bool SEL>
__device__ __forceinline__ void stream(LAS unsigned char* lds, const bf16* Hb, int kcol, int vcol, int j0, int j1, int qt, int t, int W, unsigned selbits,
                                       const bf16x8 (&qf)[4], f32x16& o0, f32x16& o1, float& m_run, float& l_run, int tid, int lane, int wave) {
    const int q = lane & 31, hi = lane >> 5;
    const int krow = tid >> 3, kch = tid & 7, vrow = krow, vch = kch;
    const int vdst = (kch >> 2) * 4096 + (krow >> 3) * 512 + (krow & 7) * 64 + (kch & 3) * 16;
    const int jlo = qt - (W >> 6);
    f32x16 negm;
#pragma unroll
    for (int r = 0; r < 16; ++r) negm[r] = -m_run;
    __syncthreads();
    const bf16* kp0 = Hb + (size_t)(64 * j0 + krow) * HP + kcol + kch * 8;
    const bf16* vp0 = Hb + (size_t)(64 * j0 + vrow) * HP + vcol + vch * 8;
    v4u kA = *(const GAS v4u*)kp0, vA = *(const GAS v4u*)vp0, kB = kA, vB = vA;
    if (j0 + 1 <= j1) { kB = *(const GAS v4u*)(kp0 + (size_t)64 * HP); vB = *(const GAS v4u*)(vp0 + (size_t)64 * HP); }
    int pp = 0;
    for (int jp = j0; jp <= j1; jp += 2, pp ^= 1) {
        const bool has2 = jp + 1 <= j1;
        LAS unsigned char* Kl0 = lds + L_K + pp * (2 * KTB); LAS unsigned char* Kl1 = Kl0 + KTB;
        LAS unsigned char* Vl0 = lds + L_V + pp * (2 * VTB); LAS unsigned char* Vl1 = Vl0 + VTB;
        *(LAS v4u*)(Kl0 + krow * KP + kch * 16) = kA;
        *(LAS v4u*)(Vl0 + vdst) = vA;
        if (has2) { *(LAS v4u*)(Kl1 + krow * KP + kch * 16) = kB; *(LAS v4u*)(Vl1 + vdst) = vB; }
        if (jp + 2 <= j1) { kA = *(const GAS v4u*)(kp0 + (size_t)(64 * (jp + 2 - j0)) * HP); vA = *(const GAS v4u*)(vp0 + (size_t)(64 * (jp + 2 - j0)) * HP); }
        if (jp + 3 <= j1) { kB = *(const GAS v4u*)(kp0 + (size_t)(64 * (jp + 3 - j0)) * HP); vB = *(const GAS v4u*)(vp0 + (size_t)(64 * (jp + 3 - j0)) * HP); }
        __syncthreads();
        att_tile<SEL>(Kl0, Vl0, jp, qt, jlo, t, W, selbits, qf, o0, o1, negm, m_run, l_run, q, hi);
        if (has2) att_tile<SEL>(Kl1, Vl1, jp + 1, qt, jlo, t, W, selbits, qf, o0, o1, negm, m_run, l_run, q, hi);
    }
}

__device__ __forceinline__ void phase_attention(Frame& F, int L, const float* sinks_all) {
    const int tid = F.tid, lane = F.lane, wave = F.wave;
    const int rh = wave >> 1, th = wave & 1;
    unsigned char* ws = F.ws;
    LAS unsigned char* lds = F.lds + RING_OFF;
    const bf16* H = (const bf16*)(ws + WS_H);
    bf16* O = (bf16*)(ws + WS_O);
    const float* gates = (const float*)(ws + WS_GATES);
    const float* sinks = sinks_all + L * 8;
    LAS float* impb = (LAS float*)(lds + L_IMP);
    LAS unsigned* selm = (LAS unsigned*)(lds + L_SEL);
    const int NU = 2048;
    if (wave >= 4) __builtin_amdgcn_s_setprio(1);
    for (int i = 0;; ++i) {
        const int pos = (i & 1) ? (F.G - 1 - (int)blockIdx.x) : (int)blockIdx.x;
        const int n = i * F.G + pos;
        if (i * F.G >= NU) break;
        if (n >= NU) continue;
        const bool nsa = n < 1024;
        int b, g, qt;
        if (nsa) { qt = 31 - (n >> 5); b = (n & 31) >> 1; g = n & 1; }
        else { const int m2 = n - 1024; qt = 31 - (m2 >> 5); b = (m2 & 31) >> 1; g = m2 & 1; }
        int lane_v = lane; asm volatile("" : "+v"(lane_v));
        const int q = lane_v & 31, hi = lane_v >> 5;
        const int hq = 4 * g + rh;
        const int t = 64 * qt + 32 * th + q;
        const size_t row = (size_t)b * T + t;
        const bf16* Hb = H + (size_t)b * T * HP;
        bf16x8 qf[4];
        {
            const bf16* qp = H + row * HP + (nsa ? C_QN : C_QS) + 64 * hq + 8 * hi;
#pragma unroll
            for (int s = 0; s < 4; ++s) qf[s] = *(const GAS bf16x8*)(qp + 16 * s);
        }
        f32x16 ot0, ot1;
        if (nsa) {
            const float* gp = gates + row * 32 + hq * 3;
            const float g_cmp = gp[0], g_slc = gp[1], g_win = gp[2];
            __syncthreads();
            {
                const bf16* kc = (const bf16*)(ws + WS_KCMP) + (size_t)(b * 2 + g) * 128 * 64;
                const bf16* vc = (const bf16*)(ws + WS_VCMP) + (size_t)(b * 2 + g) * 128 * 64;
#pragma unroll
                for (int it = 0; it < 2; ++it) {
                    const int ci = tid + 512 * it, r = ci >> 3, ch = ci & 7;
                    *(LAS v4u*)(lds + L_KC + r * KP + ch * 16) = *(const GAS v4u*)(kc + (size_t)r * 64 + ch * 8);
                    *(LAS v4u*)(lds + L_VC + (ch >> 2) * 8192 + (r >> 3) * 512 + (r & 7) * 64 + (ch & 3) * 16) = *(const GAS v4u*)(vc + (size_t)r * 64 + ch * 8);
                }
            }
            __syncthreads();
            f32x16 sc[4];
#pragma unroll
            for (int kb = 0; kb < 4; ++kb) {
#pragma unroll
                for (int r = 0; r < 16; ++r) sc[kb][r] = 0.f;
#pragma unroll
                for (int s = 0; s < 4; ++s) {
                    const bf16x8 a = *(const LAS bf16x8*)(lds + L_KC + (32 * kb + q) * KP + (16 * s + 8 * hi) * 2);
                    sc[kb] = __builtin_amdgcn_mfma_f32_32x32x16_bf16(a, qf[s], sc[kb], 0, 0, 0);
                }
                __builtin_amdgcn_sched_barrier(0);
            }
            float mx = -INFINITY;
            const int cth = (((t - 31) >> 4) < 126 ? ((t - 31) >> 4) : 126) - 4 * hi;
#pragma unroll
            for (int kb = 0; kb < 4; ++kb)
#pragma unroll
                for (int r = 0; r < 16; ++r) {
                    const bool vis = (32 * kb + (r & 3) + 8 * (r >> 2)) <= cth;
                    sc[kb][r] = vis ? sc[kb][r] : -INFINITY;
                    mx = fmaxf(mx, sc[kb][r]);
                }
            mx = xhalf_max(mx);
            mx = fmaxf(mx, -1e30f);
            float ps = 0.f;
#pragma unroll
            for (int kb = 0; kb < 4; ++kb)
#pragma unroll
                for (int r = 0; r < 16; ++r) { sc[kb][r] = __builtin_amdgcn_exp2f(sc[kb][r] - mx); ps += sc[kb][r]; }
            ps = xhalf_sum(ps);
            const float inv = 1.0f / fmaxf(ps, 1e-30f);
#pragma unroll
            for (int kb = 0; kb < 4; ++kb)
#pragma unroll
                for (int r = 0; r < 16; ++r) sc[kb][r] *= inv;
#pragma unroll
            for (int kb = 0; kb < 4; ++kb)
#pragma unroll
                for (int ii = 0; ii < 4; ++ii)
                    impb[(rh * 64 + 32 * th + q) * 33 + 8 * kb + 2 * ii + hi] = (sc[kb][4 * ii] + sc[kb][4 * ii + 1]) + (sc[kb][4 * ii + 2] + sc[kb][4 * ii + 3]);
            f32x16 c0, c1;
#pragma unroll
            for (int r = 0; r < 16; ++r) { c0[r] = 0.f; c1[r] = 0.f; }
#pragma unroll
            for (int ks = 0; ks < 8; ++ks) {
                const int kb = ks >> 1, sp = ks & 1;
                const bf16x8 pf = pack8(sc[kb][8 * sp + 0], sc[kb][8 * sp + 1], sc[kb][8 * sp + 2], sc[kb][8 * sp + 3], sc[kb][8 * sp + 4], sc[kb][8 * sp + 5], sc[kb][8 * sp + 6], sc[kb][8 * sp + 7]);
                const LAS unsigned char* vp = lds + L_VC + ((q >> 4) & 1) * 32 + (q & 3) * 8 + (4 * hi + ((q & 15) >> 2)) * 64 + ks * 1024;
                {
                    const u32x2 lo = vtr(vp), hh = vtr(vp + 512);
                    v4u w; w.x = lo.x; w.y = lo.y; w.z = hh.x; w.w = hh.y;
                    c0 = __builtin_amdgcn_mfma_f32_32x32x16_bf16(__builtin_bit_cast(bf16x8, w), pf, c0, 0, 0, 0);
                }
                {
                    const u32x2 lo = vtr(vp + 8192), hh = vtr(vp + 8192 + 512);
                    v4u w; w.x = lo.x; w.y = lo.y; w.z = hh.x; w.w = hh.y;
                    c1 = __builtin_amdgcn_mfma_f32_32x32x16_bf16(__builtin_bit_cast(bf16x8, w), pf, c1, 0, 0, 0);
                }
                if (ks & 1) __builtin_amdgcn_sched_barrier(0);
            }
            __syncthreads();
            if (qt >= 8) {
                const int tok = tid >> 3, sub = tid & 7;
                unsigned key[4];
#pragma unroll
                for (int ii = 0; ii < 4; ++ii) {
                    const int j = 4 * sub + ii;
                    const float sum = (impb[tok * 33 + j] + impb[(64 + tok) * 33 + j]) + (impb[(128 + tok) * 33 + j] + impb[(192 + tok) * 33 + j]);
                    const unsigned kb = (__float_as_uint(sum) & ~31u) | (unsigned)(31 - j);
                    key[ii] = (j >= 1 && j <= qt - 2) ? kb : 0u;
                }
                unsigned mask = 1u | (1u << qt) | (1u << (qt - 1));
#pragma unroll
                for (int rnd = 0; rnd < 5; ++rnd) {
                    unsigned bk = key[0] > key[1] ? key[0] : key[1]; const unsigned b2 = key[2] > key[3] ? key[2] : key[3]; bk = bk > b2 ? bk : b2;
                    unsigned o1 = (unsigned)__shfl_xor((int)bk, 1); bk = bk > o1 ? bk : o1;
                    o1 = (unsigned)__shfl_xor((int)bk, 2); bk = bk > o1 ? bk : o1;
                    o1 = (unsigned)__shfl_xor((int)bk, 4); bk = bk > o1 ? bk : o1;
                    mask |= 1u << (31u - (bk & 31u));
#pragma unroll
                    for (int ii = 0; ii < 4; ++ii) key[ii] = key[ii] == bk ? 0u : key[ii];
                }
                if (sub == 0) selm[tok] = mask;
            } else if (tid < 64) selm[tid] = (2u << qt) - 1u;
            __syncthreads();
            const unsigned selbits = selm[32 * th + q];
            LAS float* otl = (LAS float*)(lds + L_OT + wave * 8192) + lane_v;
#pragma unroll
            for (int r = 0; r < 16; ++r) { otl[r * 64] = g_cmp * c0[r]; otl[(16 + r) * 64] = g_cmp * c1[r]; }
            {
                f32x16 a0, a1; float mr = 0.f, lr = 0.f;
#pragma unroll
                for (int r = 0; r < 16; ++r) { a0[r] = 0.f; a1[r] = 0.f; }
                stream<true>(lds, Hb, C_KS + 64 * g, C_VS + 64 * g, 0, qt, qt, t, 1 << 20, selbits, qf, a0, a1, mr, lr, tid, lane_v, wave);
                lr = xhalf_sum(lr);
                const float f = g_slc / fmaxf(lr, 1e-30f);
#pragma unroll
                for (int r = 0; r < 16; ++r) { otl[r * 64] += f * a0[r]; otl[(16 + r) * 64] += f * a1[r]; }
            }
            {
                f32x16 a0, a1; float mr = 0.f, lr = 0.f;
#pragma unroll
                for (int r = 0; r < 16; ++r) { a0[r] = 0.f; a1[r] = 0.f; }
                stream<false>(lds, Hb, C_KW + 64 * g, C_VW + 64 * g, qt >= 8 ? qt - 8 : 0, qt, qt, t, 512, 0u, qf, a0, a1, mr, lr, tid, lane_v, wave);
                lr = xhalf_sum(lr);
                const float f = g_win / fmaxf(lr, 1e-30f);
#pragma unroll
                for (int r = 0; r < 16; ++r) { ot0[r] = otl[r * 64] + f * a0[r]; ot1[r] = otl[(16 + r) * 64] + f * a1[r]; }
            }
        } else {
            f32x16 a0, a1; float mr = 0.f, lr = 0.f;
#pragma unroll
            for (int r = 0; r < 16; ++r) { a0[r] = 0.f; a1[r] = 0.f; }
            stream<false>(lds, Hb, C_KSW + 64 * g, C_VSW + 64 * g, qt >= 2 ? qt - 2 : 0, qt, qt, t, 128, 0u, qf, a0, a1, mr, lr, tid, lane_v, wave);
            lr = xhalf_sum(lr);
            const float sk = sinks[hq] * 1.4426950408889634f;
            const float mf = fmaxf(mr, sk);
            const float sm = __builtin_amdgcn_exp2f(mr - mf);
            const float den = lr * sm + __builtin_amdgcn_exp2f(sk - mf);
            const float f = sm / fmaxf(den, 1e-30f);
#pragma unroll
            for (int r = 0; r < 16; ++r) { ot0[r] = f * a0[r]; ot1[r] = f * a1[r]; }
        }
        bf16* op = O + row * 1024 + (nsa ? 0 : 512) + 64 * hq + 4 * hi;
#pragma unroll
        for (int ii = 0; ii < 4; ++ii) {
            u32x2 w0, w1;
            w0.x = cvtpk(ot0[4 * ii], ot0[4 * ii + 1]); w0.y = cvtpk(ot0[4 * ii + 2], ot0[4 * ii + 3]);
            w1.x = cvtpk(ot1[4 * ii], ot1[4 * ii + 1]); w1.y = cvtpk(ot1[4 * ii + 2], ot1[4 * ii + 3]);
            *(GAS u32x2*)(op + 8 * ii) = w0; *(GAS u32x2*)(op + 32 + 8 * ii) = w1;
        }
    }
    __builtin_amdgcn_s_setprio(0);
}
}

template <bool F8, bool XSPLIT>
__device__ __forceinline__ void phase_ln1_router(Frame& F, int L, const float* xres, const float* ln_g, const float* ln_b, const float* b_r) {
    const int tid = F.tid, lane = F.lane, wave = F.wave;
    unsigned char* ws = F.ws;
    const bf16* A1 = (const bf16*)(ws + WS_Y1);
    unsigned char* X1L = ws + WS_X1L;
    bf16* X1B = (bf16*)(ws + WS_X1B);
    const bf16* XRB = (const bf16*)(ws + WS_XB); const unsigned char* XRL = ws + WS_XNL;
    const bf16* Wh = (const bf16*)(ws + WS_WR) + (size_t)L * 2 * 32 * 1024;
    const bf16* Wl = Wh + 32 * 1024;
    LAS float* scr = (LAS float*)(F.lds + RING_OFF + wave * 4096);
    LAS unsigned* cntl = (LAS unsigned*)(F.lds + RING_OFF + 65536);
    LAS unsigned* basel = cntl + 32;
    gu32* gcnt = F.ctl + CW_CNT + L * 32;
    f32x4 gam[4], bet[4];
#pragma unroll
    for (int j = 0; j < 4; ++j) { gam[j] = *(const GAS f32x4*)(ln_g + (size_t)L * D + 4 * lane + 256 * j); bet[j] = *(const GAS f32x4*)(ln_b + (size_t)L * D + 4 * lane + 256 * j); }
    for (int chunk = blockIdx.x; chunk < M / 128; chunk += F.G) {
        if (tid < 32) cntl[tid] = 0u;
        __syncthreads();
        const int tok0 = chunk * 128 + wave * 16;
        for (int rr = 0; rr < 16; ++rr) {
            const size_t row = (size_t)(tok0 + rr);
            f32x4 v[4]; float s = 0.f;
#pragma unroll
            for (int j = 0; j < 4; ++j) {
                const u32x2 av = *(const GAS u32x2*)(A1 + row * D + 4 * lane + 256 * j);
                f32x4 xr4;
                if constexpr (XSPLIT) xr4 = rs_dec(*(const GAS u32x2*)(XRB + row * D + 4 * lane + 256 * j), *(const GAS unsigned*)(XRL + row * D + 4 * lane + 256 * j));
                else xr4 = *(const GAS f32x4*)(xres + row * D + 4 * lane + 256 * j);
                v[j] = xr4 * DN_ALPHA + (f32x4){bf_lo(av.x), bf_hi(av.x), bf_lo(av.y), bf_hi(av.y)};
                s += (v[j].x + v[j].y) + (v[j].z + v[j].w);
            }
            const float mean = wave_sum(s) * (1.f / D); float s2 = 0.f;
#pragma unroll
            for (int j = 0; j < 4; ++j) { v[j] = v[j] - mean; s2 += (v[j].x * v[j].x + v[j].y * v[j].y) + (v[j].z * v[j].z + v[j].w * v[j].w); }
            const float rstd = 1.f / sqrtf(wave_sum(s2) * (1.f / D) + LN_EPS);
#pragma unroll
            for (int j = 0; j < 4; ++j) {
                const f32x4 o = v[j] * rstd * gam[j] + bet[j];
                u32x2 w; unsigned xb8; rs_enc(o, w, xb8);
                *(GAS u32x2*)(X1B + row * D + 4 * lane + 256 * j) = w;
                if constexpr (!F8) *(GAS unsigned*)(X1L + row * D + 4 * lane + 256 * j) = xb8;
                if constexpr (F8) *(GAS unsigned*)(ws + WS_X1F8 + row * D + 4 * lane + 256 * j) = pk4_fp8(o.x, o.y, o.z, o.w);
            }
            if (lane == 0) { scr[16 * 33 + 2 * rr] = mean; scr[16 * 33 + 2 * rr + 1] = rstd; }
        }
        VM_WAIT(); LDS_WAIT();
        f32x4 acc0 = {0.f, 0.f, 0.f, 0.f}, acc1 = {0.f, 0.f, 0.f, 0.f};
        {
            const int ar = lane & 15, kg = lane >> 4;
            const size_t xo = (size_t)(tok0 + ar) * D + 8 * kg;
            const bf16* ar1 = A1 + xo;
            const float rmean = scr[16 * 33 + 2 * ar], rrstd = scr[16 * 33 + 2 * ar + 1];
            const bf16* wh0 = Wh + (size_t)ar * 1024 + 8 * kg; const bf16* wl0 = Wl + (size_t)ar * 1024 + 8 * kg;
#pragma unroll 4
            for (int ks = 0; ks < 32; ++ks) {
                f32x4 xa, xb;
                if constexpr (XSPLIT) { const v4u hw = *(const GAS v4u*)(XRB + xo + 32 * ks); const u32x2 lw = *(const GAS u32x2*)(XRL + xo + 32 * ks);
                    u32x2 h01; h01.x = hw.x; h01.y = hw.y; u32x2 h23; h23.x = hw.z; h23.y = hw.w; xa = rs_dec(h01, lw.x); xb = rs_dec(h23, lw.y); }
                else { xa = *(const GAS f32x4*)(xres + xo + 32 * ks); xb = *(const GAS f32x4*)(xres + xo + 32 * ks + 4); }
                {
                    const v4u aw = *(const GAS v4u*)(ar1 + 32 * ks);
                    xa = xa * DN_ALPHA + (f32x4){bf_lo(aw.x), bf_hi(aw.x), bf_lo(aw.y), bf_hi(aw.y)}; xb = xb * DN_ALPHA + (f32x4){bf_lo(aw.z), bf_hi(aw.z), bf_lo(aw.w), bf_hi(aw.w)};
                    const float* gp = ln_g + (size_t)L * D + 32 * ks + 8 * kg; const float* bp = ln_b + (size_t)L * D + 32 * ks + 8 * kg;
                    xa = (xa - rmean) * rrstd * *(const GAS f32x4*)gp + *(const GAS f32x4*)bp; xb = (xb - rmean) * rrstd * *(const GAS f32x4*)(gp + 4) + *(const GAS f32x4*)(bp + 4);
                }
                const float xv[8] = {xa.x, xa.y, xa.z, xa.w, xb.x, xb.y, xb.z, xb.w};
                unsigned hh[8], ll[8];
#pragma unroll
                for (int e = 0; e < 8; ++e) { hh[e] = f2bf(xv[e]); ll[e] = f2bf(xv[e] - __uint_as_float(hh[e] << 16)); }
                v4u ah, al;
                ah.x = hh[0] | (hh[1] << 16); ah.y = hh[2] | (hh[3] << 16); ah.z = hh[4] | (hh[5] << 16); ah.w = hh[6] | (hh[7] << 16);
                al.x = ll[0] | (ll[1] << 16); al.y = ll[2] | (ll[3] << 16); al.z = ll[4] | (ll[5] << 16); al.w = ll[6] | (ll[7] << 16);
                const bf16x8 fah = __builtin_bit_cast(bf16x8, ah), fal = __builtin_bit_cast(bf16x8, al);
                const bf16x8 w0h = *(const GAS bf16x8*)(wh0 + 32 * ks), w0l = *(const GAS bf16x8*)(wl0 + 32 * ks);
                const bf16x8 w1h = *(const GAS bf16x8*)(wh0 + 16 * 1024 + 32 * ks), w1l = *(const GAS bf16x8*)(wl0 + 16 * 1024 + 32 * ks);
                acc0 = __builtin_amdgcn_mfma_f32_16x16x32_bf16(fah, w0h, acc0, 0, 0, 0); acc0 = __builtin_amdgcn_mfma_f32_16x16x32_bf16(fal, w0h, acc0, 0, 0, 0); acc0 = __builtin_amdgcn_mfma_f32_16x16x32_bf16(fah, w0l, acc0, 0, 0, 0);
                acc1 = __builtin_amdgcn_mfma_f32_16x16x32_bf16(fah, w1h, acc1, 0, 0, 0); acc1 = __builtin_amdgcn_mfma_f32_16x16x32_bf16(fal, w1h, acc1, 0, 0, 0); acc1 = __builtin_amdgcn_mfma_f32_16x16x32_bf16(fah, w1l, acc1, 0, 0, 0);
            }
#pragma unroll
            for (int r = 0; r < 4; ++r) { scr[(4 * kg + r) * 33 + ar] = acc0[r]; scr[(4 * kg + r) * 33 + 16 + ar] = acc1[r]; }
        }
        LDS_WAIT(); asm volatile("" ::: "memory");
        int ek[4] = {0, 0, 0, 0}; float wk[4] = {0.f, 0.f, 0.f, 0.f}; unsigned lrk[4] = {0u, 0u, 0u, 0u};
        if (lane < 16) {
            float lv[32];
#pragma unroll
            for (int e = 0; e < 32; ++e) lv[e] = scr[lane * 33 + e] + b_r[(size_t)L * 32 + e];
            unsigned taken = 0u; float vk[4];
#pragma unroll
            for (int k = 0; k < 4; ++k) {
                float best = -INFINITY; int bi = 0;
#pragma unroll
                for (int e = 0; e < 32; ++e) { const bool ok = !((taken >> e) & 1u) && lv[e] > best; best = ok ? lv[e] : best; bi = ok ? e : bi; }
                taken |= 1u << bi; ek[k] = bi; vk[k] = best;
            }
            float den = 0.f;
#pragma unroll
            for (int k = 0; k < 4; ++k) { wk[k] = __expf(vk[k] - vk[0]); den += wk[k]; }
#pragma unroll
            for (int k = 0; k < 4; ++k) { wk[k] /= den; lrk[k] = atomicAdd((unsigned*)(cntl + ek[k]), 1u); }
        }
        __syncthreads();
        if (tid < 32) basel[tid] = __hip_atomic_fetch_add(gcnt + tid, cntl[tid], RLX_AGENT);
        __syncthreads();
        if (lane < 16) {
            const size_t tk = (size_t)(tok0 + lane) * 4;
#pragma unroll
            for (int k = 0; k < 4; ++k) {
                const int rank = (int)(basel[ek[k]] + lrk[k]);
                ((int*)(ws + WS_TOKE))[tk + k] = ek[k];
                ((int*)(ws + WS_TOKR))[tk + k] = rank;
                ((float*)(ws + WS_TOKW))[tk + k] = wk[k];
                if (rank < M) ((int*)(ws + WS_LIST))[(size_t)ek[k] * M + rank] = tok0 + lane;
            }
        }
        __syncthreads();
    }
}

__device__ __forceinline__ void build_tables(Frame& F, int L) {
    LAS int* cnt = (LAS int*)(F.lds + TAB_CNT); LAS int* soff = (LAS int*)(F.lds + TAB_SOFF); LAS int* tst = (LAS int*)(F.lds + TAB_TST); LAS int* te = (LAS int*)(F.lds + TAB_TE);
    __syncthreads();
    if (F.tid < 32) { int c = (int)__hip_atomic_load(F.ctl + CW_CNT + L * 32 + F.tid, RLX_AGENT); cnt[F.tid] = c < 0 ? 0 : (c > M ? M : c); }
    __syncthreads();
    if (F.tid == 0) { int a = 0; for (int e = 0; e < 32; ++e) { tst[e] = a; a += (cnt[e] + 255) >> 8; if (a > MAXTILES) a = MAXTILES; } tst[32] = a; }
    __syncthreads();
    if (F.tid < 32) { soff[F.tid] = tst[F.tid] * 256; for (int mt = tst[F.tid]; mt < tst[F.tid + 1]; ++mt) te[mt] = F.tid; }
    __syncthreads();
}

template <bool LAST>
__device__ __forceinline__ void phase_ln2(Frame& F, int L, const float* ln_g, const float* ln_b, float* outp) {
    float prb_scale = 1.f;
#ifdef PRB_SEL
    if (LAST) { const unsigned v = __hip_atomic_load((gu32*)(F.ws + WS_TOKE + 3 * MiB) + PRB_SEL, RLX_AGENT); const float fr = (float)v / (float)PRB_DEN; prb_scale = 1.f + 0.02f * (float)(1 + (int)(fr * 8.f + 0.5f)); }
#endif
    unsigned char* ws = F.ws;
    const unsigned char* X1L = ws + WS_X1L; const bf16* X1B = (const bf16*)(ws + WS_X1B);
    const bf16* E = (const bf16*)(ws + WS_E); const bf16* YS = (const bf16*)(ws + WS_YS);
    bf16* XB = (bf16*)(ws + WS_XB); unsigned char* XNL = ws + WS_XNL;
    const LAS int* soff = (const LAS int*)(F.lds + TAB_SOFF);
    const int gw = F.vcu * NWAVES + F.wave, NGW = F.G * NWAVES, lane = F.lane;
    f32x4 gam[4], bet[4];
#pragma unroll
    for (int j = 0; j < 4; ++j) { gam[j] = *(const GAS f32x4*)(ln_g + (size_t)L * D + 4 * lane + 256 * j); bet[j] = *(const GAS f32x4*)(ln_b + (size_t)L * D + 4 * lane + 256 * j); }
    for (int tok = gw; tok < M; tok += NGW) {
        int sl[4]; float wk[4];
#pragma unroll
        for (int k = 0; k < 4; ++k) {
            const int e = ((const int*)(ws + WS_TOKE))[(size_t)tok * 4 + k] & 31, r = ((const int*)(ws + WS_TOKR))[(size_t)tok * 4 + k];
            int s = soff[e] + r; s = s < 0 ? 0 : (s >= MAXSLOTS ? MAXSLOTS - 1 : s);
            sl[k] = s; wk[k] = ((const float*)(ws + WS_TOKW))[(size_t)tok * 4 + k];
        }
        f32x4 v[4]; float s = 0.f;
#pragma unroll
        for (int j = 0; j < 4; ++j) {
            const int c = 4 * lane + 256 * j;
            f32x4 a;
            if constexpr (LAST) { const u32x2 xv = *(const GAS u32x2*)(X1B + (size_t)tok * D + c); a = (f32x4){bf_lo(xv.x), bf_hi(xv.x), bf_lo(xv.y), bf_hi(xv.y)} * DN_ALPHA; }
            else a = rs_dec(*(const GAS u32x2*)(X1B + (size_t)tok * D + c), *(const GAS unsigned*)(X1L + (size_t)tok * D + c)) * DN_ALPHA;
            const u32x2 ev = *(const GAS u32x2*)(E + (size_t)tok * D + c);
            a.x += bf_lo(ev.x); a.y += bf_hi(ev.x); a.z += bf_lo(ev.y); a.w += bf_hi(ev.y);
#pragma unroll
            for (int k = 0; k < 4; ++k) {
                if constexpr (LAST) {
                    typedef float f32x2_ __attribute__((ext_vector_type(2)));
                    const unsigned yw = *(const GAS unsigned*)((const unsigned char*)YS + (size_t)sl[k] * D + c);
                    const f32x2_ y01 = __builtin_amdgcn_cvt_pk_f32_fp8((int)yw, false), y23 = __builtin_amdgcn_cvt_pk_f32_fp8((int)yw, true);
                    a.x += wk[k] * y01.x; a.y += wk[k] * y01.y; a.z += wk[k] * y23.x; a.w += wk[k] * y23.y;
                } else {
                    const u32x2 yv = *(const GAS u32x2*)(YS + (size_t)sl[k] * D + c);
                    a.x += wk[k] * bf_lo(yv.x); a.y += wk[k] * bf_hi(yv.x); a.z += wk[k] * bf_lo(yv.y); a.w += wk[k] * bf_hi(yv.y);
                }
            }
            v[j] = a; s += (a.x + a.y) + (a.z + a.w);
        }
        const float mean = wave_sum(s) * (1.f / D); float s2 = 0.f;
#pragma unroll
        for (int j = 0; j < 4; ++j) { v[j] = v[j] - mean; s2 += (v[j].x * v[j].x + v[j].y * v[j].y) + (v[j].z * v[j].z + v[j].w * v[j].w); }
        const float rstd = 1.f / sqrtf(wave_sum(s2) * (1.f / D) + LN_EPS);
#pragma unroll
        for (int j = 0; j < 4; ++j) {
            const f32x4 o = v[j] * rstd * gam[j] + bet[j];
            if constexpr (LAST) *(GAS f32x4*)(outp + (size_t)tok * D + 4 * lane + 256 * j) = o * prb_scale;
            else { u32x2 w; unsigned b8; rs_enc(o, w, b8); *(GAS u32x2*)(XB + (size_t)tok * D + 4 * lane + 256 * j) = w; *(GAS unsigned*)(XNL + (size_t)tok * D + 4 * lane + 256 * j) = b8; }
        }
    }
}

#ifndef MK_ONE_LAUNCH
#define MK_ONE_LAUNCH 1
#endif
constexpr int PH_PER_LAYER = 9, NPH = 1 + NL * PH_PER_LAYER;
struct Args { const float* in[27]; float* out; unsigned char* ws; int ph_lo, ph_hi; };
typedef const __attribute__((address_space(4))) unsigned char* kptr_t;
__device__ __forceinline__ kptr_t karg_base() { kptr_t p = (kptr_t)__builtin_amdgcn_kernarg_segment_ptr(); asm volatile("" : "+s"(p)); return p; }
#define KIN(kb, i) (*(const float* const __attribute__((address_space(4)))*)((kb) + 8 * (i)))
#ifndef PH_MASK
#define PH_MASK 0x3ff
#endif
#define PHSEL(k) (((k) == 0) ? ((PH_MASK >> 9) & 1) : ((PH_MASK >> (((k) - 1) % PH_PER_LAYER)) & 1))
#define IN(k) (PHSEL(k) && lo <= (k) && (k) < hi)
#ifndef PROBE_PHASE
#define PROBE_PHASE -1
#endif
#ifndef PROBE_EXTRA
#define PROBE_EXTRA 0
#endif
#define NREP(k) (((k) == PROBE_PHASE) ? 1 + PROBE_EXTRA : 1)
#define PHASE(k) if (IN(k)) for (int rep_ = 0; rep_ < NREP(k); ++rep_)
#define SEAM(k) do { if (IN(k) && IN((k) + 1)) { if (MK_ONE_LAUNCH) xcd_barrier(bar); } } while (0)

#ifdef PRB_SEL
#define SNAP(k, q) do { if (blockIdx.x == 0 && xb_thread0(wave0)) { ((gu32*)(ws + WS_TOKE + 3 * MiB))[k] = __hip_atomic_load(F.ctl + CW_Q + (q), RLX_AGENT); } } while (0)
#else
#define SNAP(k, q) do {} while (0)
#endif
#define RELAUNDER() do { F.lane = (int)__builtin_amdgcn_mbcnt_hi(~0u, __builtin_amdgcn_mbcnt_lo(~0u, 0u)); asm volatile("" : "+v"(F.lane)); F.wave = wave0; F.tid = F.wave * 64 + F.lane; } while (0)
template <int L>
__device__ __forceinline__ void layer_body(Frame& F, const XcdBarrier& bar, const int lo, const int hi, const int wave0) {
    unsigned char* ws = F.ws;
        const int pb = 1 + L * PH_PER_LAYER;
        PHASE(pb + 0) {
            const int nsp = (F.G == 256) ? 24 : 0;
            if ((int)blockIdx.x >= F.G - nsp) { kptr_t kb = karg_base(); RELAUNDER(); conv_run<(L == 0) ? 0 : 2>(F, KIN(kb, 18), KIN(kb, 20), CW_STOP + pb + 0, (unsigned)(F.G - nsp) / 2u, (L == 0) ? 0 : 4); }
            else {
                pg8::Gemm g{(const bf16*)(ws + WS_XB), (const bf16*)(ws + WS_WIN) + (size_t)L * NIN * 1024, M, NIN, D};
                pg8::StaticOrder S; S.init(M, NIN, F.G - nsp, (int)blockIdx.x); S.tailw = F.ctl + CW_STOP + pb + 0;
                pg8::EpiIn E{(bf16*)(ws + WS_H), (float*)(ws + WS_GATES), (const float*)(ws + WS_BINP) + (size_t)L * NIN, (const float*)(ws + WS_ROPE)};
                pg8::gemm_phase<pg8::EpiIn, pg8::StaticOrder, true, true>(F.lds + RING_OFF, g, S, E, wave0, (LAS float*)(F.lds + BIAS_OFF));
            }
        }
        SEAM(pb + 0);
        PHASE(pb + 1) {
            { kptr_t kb = karg_base(); RELAUNDER(); conv_run<(L == 0) ? 0 : 2>(F, KIN(kb, 18), KIN(kb, 20), -1); __syncthreads(); }
            { kptr_t kb = karg_base(); RELAUNDER(); phase_compress(F, L, KIN(kb, 5), KIN(kb, 8)); }
            {
                pg8::Gemm g{(const bf16*)(ws + WS_PB) + (size_t)L * M * PD, (const bf16*)(ws + WS_WPP) + (size_t)L * 1024 * PD, M, D, PD};
                pg8::StaticOrder S; S.init(M, D, F.G, (int)blockIdx.x);
                pg8::EpiPlain E{(bf16*)(ws + WS_PP)};
                pg8::gemm_phase<pg8::EpiPlain, pg8::StaticOrder, true, true>(F.lds + RING_OFF, g, S, E, wave0, (LAS float*)(F.lds + BIAS_OFF));
            }
        }
        SEAM(pb + 1);
        PHASE(pb + 2) { kptr_t kb = karg_base(); RELAUNDER(); att::phase_attention(F, L, KIN(kb, 11)); }
        SEAM(pb + 2);
        PHASE(pb + 3) {
            pg8::Gemm g{(const bf16*)(ws + WS_O), (const bf16*)(ws + WS_WO) + (size_t)L * 1024 * 1024, M, D, D};
            pg8::StaticOrder S; S.init(M, D, F.G, (int)blockIdx.x);
            kptr_t kb = karg_base();
            pg8::EpiOut E{(bf16*)(ws + WS_Y1), KIN(kb, 13) + (size_t)L * D};
            pg8::gemm_phase<pg8::EpiOut, pg8::StaticOrder, true, true>(F.lds + RING_OFF, g, S, E, wave0, (LAS float*)(F.lds + BIAS_OFF));
        }
        SEAM(pb + 3);
        PHASE(pb + 4) { kptr_t kb = karg_base(); RELAUNDER(); phase_ln1_router<(L == NL - 1), (L > 0)>(F, L, KIN(kb, 0), KIN(kb, 14), KIN(kb, 15), KIN(kb, 17)); }
        SEAM(pb + 4);
        PHASE(pb + 6) {
            RELAUNDER();
            build_tables(F, L);
            constexpr int ND6 = (L == 0) ? 4 : 0;
            const int per6 = F.G / 8, bx6 = (int)blockIdx.x;
            const bool cv6 = ND6 > 0 && (F.G % 8 == 0) && per6 > 4 * ND6;
            if (cv6 && bx6 / 8 >= per6 - ND6) { kptr_t kb = karg_base(); conv_run<1>(F, KIN(kb, 18), KIN(kb, 20), -1, 1u, 1); conv_run<2>(F, KIN(kb, 18), KIN(kb, 20), CW_STOP + pb + 6, (unsigned)(F.G - 8 * ND6) / 2u, 2); }
            else {
                constexpr bool F8 = (L == NL - 1);
                pg8::Gemm g{F8 ? (const bf16*)(ws + WS_X1F8) : (const bf16*)(ws + WS_X1B), (const bf16*)(ws + WS_W1T) + (size_t)L * 32 * 2048 * 1024, M, 32 * 2048, F8 ? D / 2 : D};
                pg8::MoeOrder S{(const LAS int*)(F.lds + TAB_TE), ((const LAS int*)(F.lds + TAB_TST))[32] * 8, 3, cv6 ? F.G - 8 * ND6 : F.G, cv6 ? (bx6 % 8) * (per6 - ND6) + bx6 / 8 : F.vcu, (const LAS int*)(F.lds + TAB_TST), (const LAS int*)(F.lds + TAB_CNT), (const int*)(ws + WS_LIST), M, (ND6 > 0) ? F.ctl + CW_STOP + pb + 6 : nullptr};
                pg8::EpiUp<F8> E{(bf16*)(ws + WS_ACT), (const float*)(ws + WS_B1P) + (size_t)L * 32 * 2048, F8 ? 1.0f / W1_F8_SCALE : 1.0f};
                pg8::gemm_phase<pg8::EpiUp<F8>, pg8::MoeOrder, true, true, F8, true>(F.lds + RING_OFF, g, S, E, wave0, (LAS float*)(F.lds + BIAS_OFF), (LAS int*)(F.lds + TOKL_OFF));
                if constexpr (ND6 > 0) { __syncthreads(); kptr_t kb = karg_base(); RELAUNDER(); conv_run<1>(F, KIN(kb, 18), KIN(kb, 20), -1); }
            }
        }
        SEAM(pb + 6);
        PHASE(pb + 7) {
            kptr_t kb = karg_base(); RELAUNDER();
            if (!IN(pb + 6)) build_tables(F, L);
            constexpr int ND7 = (L == 0) ? 2 : 0;
            const int per7 = F.G / 8, bx7 = (int)blockIdx.x;
            const bool cv7 = ND7 > 0 && (F.G % 8 == 0) && per7 > 4 * ND7;
            if (cv7 && bx7 / 8 >= per7 - ND7) { conv_run<2>(F, KIN(kb, 18), KIN(kb, 20), CW_STOP + pb + 7, (unsigned)(F.G - 8 * ND7) / 2u, 3); }
            else {
                constexpr bool F8 = (L == NL - 1);
                pg8::Gemm g{(const bf16*)(ws + WS_ACT), (const bf16*)(ws + WS_W2T) + (size_t)L * 32 * 1024 * 1024, MAXSLOTS, 32 * 1024, F8 ? D / 2 : D};
                pg8::MoeOrder S{(const LAS int*)(F.lds + TAB_TE), ((const LAS int*)(F.lds + TAB_TST))[32] * 4, 2, cv7 ? F.G - 8 * ND7 : F.G, cv7 ? (bx7 % 8) * (per7 - ND7) + bx7 / 8 : F.vcu, (const LAS int*)(F.lds + TAB_TST), (const LAS int*)(F.lds + TAB_CNT), nullptr, 0, (ND7 > 0) ? F.ctl + CW_STOP + pb + 7 : nullptr};
                pg8::EpiDown<F8> E{(bf16*)(ws + WS_YS), KIN(kb, 21) + (size_t)L * 32 * 1024, F8 ? 1.0f / W2_F8_SCALE : 1.0f};
                pg8::gemm_phase<pg8::EpiDown<F8>, pg8::MoeOrder, true, true, F8>(F.lds + RING_OFF, g, S, E, wave0, (LAS float*)(F.lds + BIAS_OFF));
            }
            if constexpr (ND7 > 0) __syncthreads();
            {
                constexpr bool F8 = (L == NL - 1);
                pg8::Gemm g{F8 ? (const bf16*)(ws + WS_X1F8) : (const bf16*)(ws + WS_X1B), (const bf16*)(ws + WS_WPG) + (size_t)L * 1024 * 1024, M, D, F8 ? D / 2 : D};
                pg8::StaticOrder S; S.init(M, D, F.G, (int)blockIdx.x);
                pg8::EpiGate E{(const bf16*)(ws + WS_PP), (bf16*)(ws + WS_E), KIN(kb, 23) + (size_t)L * D, F8 ? 1.0f / WPG_F8_SCALE : 1.0f};
                pg8::gemm_phase<pg8::EpiGate, pg8::StaticOrder, true, true, F8>(F.lds + RING_OFF, g, S, E, wave0, (LAS float*)(F.lds + BIAS_OFF));
            }
        }
        SEAM(pb + 7);
        PHASE(pb + 8) { kptr_t kb = karg_base(); RELAUNDER(); if (!IN(pb + 7)) build_tables(F, L); float* xout = L == NL - 1 ? (float*)KIN(kb, 27) : (float*)(ws + WS_XN); phase_ln2<(L == NL - 1)>(F, L, KIN(kb, 25), KIN(kb, 26), xout); }
        SEAM(pb + 8);
    }
__global__ void __launch_bounds__(NWAVES * 64, 2) mk_fwd(Args args) {
    extern __shared__ __attribute__((aligned(16))) unsigned char lds[];
    Frame F;
    F.lds = (LAS unsigned char*)lds;
    F.MISC = (volatile LAS unsigned*)(F.lds + MISC_OFF);
    const int wave0 = __builtin_amdgcn_readfirstlane((int)threadIdx.x >> 6);
    F.wave = wave0; F.lane = (int)__builtin_amdgcn_mbcnt_hi(~0u, __builtin_amdgcn_mbcnt_lo(~0u, 0u)); F.tid = F.wave * 64 + F.lane;
    F.G = gridDim.x; { const int bx = blockIdx.x; F.vcu = (F.G % 8 == 0) ? (bx % 8) * (F.G / 8) + bx / 8 : bx; }
    F.ws = args.ws; F.ctl = (gu32*)(args.ws + WS_CTL);
    unsigned char* ws = args.ws;
    for (int u = F.tid; u < (LDS_BYTES - LDSCTL_OFF) / 4; u += NWAVES * 64) ((LAS unsigned*)(F.lds + LDSCTL_OFF))[u] = 0u;
    __syncthreads();
    XcdBarrier bar; bar.bar = (unsigned*)(F.ctl + CW_BAR); bar.x = 0; bar.st = nullptr; bar.wave = wave0;
    if (MK_ONE_LAUNCH) bar = xcd_barrier_post((unsigned*)(F.ctl + CW_BAR), F.MISC + 8, wave0);
    const int lo = args.ph_lo, hi = args.ph_hi;
    PHASE(0) {
        kptr_t kb = karg_base(); RELAUNDER();
        PIn I{KIN(kb, 0), KIN(kb, 1), KIN(kb, 3), KIN(kb, 4), KIN(kb, 6), KIN(kb, 7), KIN(kb, 9), KIN(kb, 10), KIN(kb, 12), KIN(kb, 16), KIN(kb, 18), KIN(kb, 19), KIN(kb, 20), KIN(kb, 22), KIN(kb, 24), (const int*)KIN(kb, 2)};
        p0_prologue(F, I);
#ifdef PRB_SEL
        if (blockIdx.x == 0 && F.tid < 8) ((gu32*)(ws + WS_TOKE + 3 * MiB))[F.tid] = 0u;
#endif
    }
    SEAM(0);
    layer_body<0>(F, bar, lo, hi, wave0);
    layer_body<1>(F, bar, lo, hi, wave0);
#undef IN
#undef SEAM
}

extern "C" void kernel_launch(void* const* d_in, const int* in_sizes, int n_in, void* d_out, int out_size, void* d_ws, size_t ws_size, hipStream_t stream) {
    static int grid = 0;
    if (grid == 0) {
        if (n_in != 27 || out_size != M * D || ws_size < WS_END) { fprintf(stderr, "kernel_launch: unexpected problem (n_in %d, out %d, ws %zu); nothing launched\n", n_in, out_size, ws_size); grid = -1; return; }
        int dev = 0, cus = 0, per_cu = 0;
        if (hipGetDevice(&dev) != hipSuccess || hipDeviceGetAttribute(&cus, hipDeviceAttributeMultiprocessorCount, dev) != hipSuccess) { grid = -1; return; }
        if (hipFuncSetAttribute((const void*)mk_fwd, hipFuncAttributeMaxDynamicSharedMemorySize, LDS_BYTES) != hipSuccess) { fprintf(stderr, "kernel_launch: hipFuncSetAttribute failed\n"); grid = -1; return; }
        if (hipOccupancyMaxActiveBlocksPerMultiprocessor(&per_cu, (const void*)mk_fwd, NWAVES * 64, LDS_BYTES) != hipSuccess || per_cu < 1) { fprintf(stderr, "kernel_launch: occupancy query says %d\n", per_cu); }
        (void)hipGetLastError();
        grid = cus;
    }
    if (grid < 0) return;
    (void)in_sizes;
    if (hipMemsetAsync((char*)d_ws + WS_CTL, 0, CTL_ZERO_BYTES, stream) != hipSuccess) return;
    Args a{};
    for (int i = 0; i < 27; ++i) a.in[i] = (const float*)d_in[i];
    a.out = (float*)d_out; a.ws = (unsigned char*)d_ws;
#if MK_ONE_LAUNCH
    a.ph_lo = 0; a.ph_hi = NPH;
    hipLaunchKernelGGL(mk_fwd, dim3(grid), dim3(NWAVES * 64), LDS_BYTES, stream, a);
#else
    for (int ph = 0; ph < NPH; ++ph) { a.ph_lo = ph; a.ph_hi = ph + 1; hipLaunchKernelGGL(mk_fwd, dim3(grid), dim3(NWAVES * 64), LDS_BYTES, stream, a); }
#endif
}
```
